# Optimizing an MI355X kernel written in HIP

```python
import jax, jax.numpy as jnp
from jax import lax
import numpy as np

D_MODEL = 1024
BATCH = 4
SEQ = 4096
DEPTH = 2

GRID_W = 64
CTX_LEN = 256
D_MIX = D_MODEL
D_ATTN = D_MIX // 2
D_LRU = D_MIX - D_ATTN
HEAD_DIM = 64
N_HEADS = D_ATTN // HEAD_DIM
N_KV_HEADS = 2
KV_GROUP = N_HEADS // N_KV_HEADS
KV_W = N_KV_HEADS * HEAD_DIM
LRU_BLOCKS = 8
LRU_BLOCK_W = D_LRU // LRU_BLOCKS
LRU_CONV_W = 4
LRU_C = 8.0
D_FF = 2816
FFN_CONV_W = 3
Q_BLOCK = 128
ROPE_THETA = 10000.0
ROPE_PAIRS_PER_AXIS = HEAD_DIM // 4
EPS = 1e-6
D_IN = D_ATTN + 2 * KV_W + 2 * D_LRU
IN_SPLITS = (D_ATTN, D_ATTN + KV_W, D_ATTN + 2 * KV_W, D_ATTN + 2 * KV_W + D_LRU)

kernel_name = "hymba_griffin_gqa_convffn_dit"


def rms_norm(x, w=None):
    xf = x.astype(jnp.float32)
    y = xf * lax.rsqrt(jnp.mean(xf * xf, axis=-1, keepdims=True) + EPS)
    if w is not None:
        y = y * w.astype(jnp.float32)
    return y.astype(x.dtype)


def modulate(h, shift, scale):
    return h * (1 + scale) + shift


def dwconv_centred(x, w, b):
    width = w.shape[0]
    left = width // 2
    right = width - 1 - left
    T = x.shape[1]
    xp = jnp.pad(x, ((0, 0), (left, right), (0, 0)))
    y = xp[:, 0:T] * w[0]
    for k in range(1, width):
        y = y + xp[:, k:k + T] * w[k]
    return y + b


def grid_rope_tables(S):
    rows = S // GRID_W
    row = jnp.repeat(jnp.arange(rows, dtype=jnp.float32), GRID_W)
    col = jnp.tile(jnp.arange(GRID_W, dtype=jnp.float32), rows)
    inv = ROPE_THETA ** (-jnp.arange(ROPE_PAIRS_PER_AXIS, dtype=jnp.float32) / ROPE_PAIRS_PER_AXIS)
    ang = jnp.concatenate([row[:, None] * inv, col[:, None] * inv], axis=-1)
    return jnp.cos(ang)[:, None, :], jnp.sin(ang)[:, None, :]


def rope_2d(t, cos, sin):
    half = HEAD_DIM // 2
    t1 = t[..., :half].astype(jnp.float32)
    t2 = t[..., half:].astype(jnp.float32)
    return jnp.concatenate([t1 * cos - t2 * sin, t2 * cos + t1 * sin], axis=-1).astype(t.dtype)


def gqa_softmax(q, k, v):
    s = jnp.einsum('bqkgd,blkd->bkgql', q, k).astype(jnp.float32) * (HEAD_DIM ** -0.5)
    p = jax.nn.softmax(s, axis=-1).astype(v.dtype)
    return jnp.einsum('bkgql,blkd->bqkgd', p, v)


def attention_group(q_c, k_c, v_c, q_l, k_l, v_l, cos, sin, q_norm_w, k_norm_w, ctx_out):
    B_, S, _ = q_l.shape
    C = q_c.shape[1]
    heads = lambda t, n: t.reshape(t.shape[0], t.shape[1], n, HEAD_DIM)
    qc = rms_norm(heads(q_c, N_HEADS), q_norm_w)
    kc = rms_norm(heads(k_c, N_KV_HEADS), k_norm_w)
    vc = heads(v_c, N_KV_HEADS)
    ql = rope_2d(rms_norm(heads(q_l, N_HEADS), q_norm_w), cos, sin)
    kl = rope_2d(rms_norm(heads(k_l, N_KV_HEADS), k_norm_w), cos, sin)
    vl = heads(v_l, N_KV_HEADS)
    k_all = jnp.concatenate([kc, kl], axis=1)
    v_all = jnp.concatenate([vc, vl], axis=1)
    nblk = S // Q_BLOCK
    q_blocks = ql.reshape(B_, nblk, Q_BLOCK, N_KV_HEADS, KV_GROUP, HEAD_DIM).transpose(1, 0, 2, 3, 4, 5)
    o_l = lax.map(lambda qb: gqa_softmax(qb, k_all, v_all), q_blocks)
    o_l = o_l.transpose(1, 0, 2, 3, 4, 5).reshape(B_, S, D_ATTN)
    o_c = None
    if ctx_out:
        o_c = gqa_softmax(qc.reshape(B_, C, N_KV_HEADS, KV_GROUP, HEAD_DIM), kc, vc).reshape(B_, C, D_ATTN)
    return o_c, o_l


def rglru_coeffs(x, wa, ba, wx, bx, lam):
    B_, T, _ = x.shape
    xb = x.reshape(B_, T, LRU_BLOCKS, LRU_BLOCK_W)
    r = jax.nn.sigmoid(jnp.einsum('btnc,ncd->btnd', xb, wa).reshape(B_, T, D_LRU) + ba)
    i = jax.nn.sigmoid(jnp.einsum('btnc,ncd->btnd', xb, wx).reshape(B_, T, D_LRU) + bx)
    log_a = -LRU_C * r * jax.nn.softplus(-lam)
    a = jnp.exp(log_a)
    b = jnp.sqrt(-jnp.expm1(2.0 * log_a)) * (i * x)
    return a, b


def _scan_combine(e1, e2):
    a1, b1 = e1
    a2, b2 = e2
    return a1 * a2, a2 * b1 + b2


def linear_scan(a, b, h0, reverse):
    if reverse:
        a, b = jnp.flip(a, 1), jnp.flip(b, 1)
    b = b.at[:, 0].add(a[:, 0] * h0)
    _, h = lax.associative_scan(_scan_combine, (a, b), axis=1)
    final = h[:, -1]
    if reverse:
        h = jnp.flip(h, 1)
    return h, final


def lru_group(x_c, g_c, x_l, g_l, conv_w, conv_b, wa, ba, wx, bx, lam, ctx_out):
    f32 = jnp.float32
    xc = dwconv_centred(x_c, conv_w, conv_b).astype(f32)
    xl = dwconv_centred(x_l, conv_w, conv_b).astype(f32)
    h_c_sum, h_l_sum = 0.0, 0.0
    for d, rev in ((0, False), (1, True)):
        wa_d, ba_d = wa[d].astype(f32), ba[d].astype(f32)
        wx_d, bx_d = wx[d].astype(f32), bx[d].astype(f32)
        lam_d = lam[d].astype(f32)
        a_c, b_c = rglru_coeffs(xc, wa_d, ba_d, wx_d, bx_d, lam_d)
        a_l, b_l = rglru_coeffs(xl, wa_d, ba_d, wx_d, bx_d, lam_d)
        h_c, fin_c = linear_scan(a_c, b_c, jnp.zeros_like(b_c[:, 0]), rev)
        h_l, _ = linear_scan(a_l, b_l, fin_c, rev)
        h_c_sum = h_c_sum + h_c
        h_l_sum = h_l_sum + h_l
    o_l = h_l_sum.astype(x_l.dtype) * jax.nn.gelu(g_l)
    o_c = h_c_sum.astype(x_c.dtype) * jax.nn.gelu(g_c) if ctx_out else None
    return o_c, o_l


def token_mixer(h_ctx, h_lat, cos, sin, w_in, q_norm_w, k_norm_w, lru_conv_w, lru_conv_b,
                lru_wa, lru_ba, lru_wx, lru_bx, lru_lambda, attn_out_norm_w, lru_out_norm_w,
                w_out, ctx_out):
    q_c, k_c, v_c, x_c, g_c = jnp.split(h_ctx @ w_in, IN_SPLITS, axis=-1)
    q_l, k_l, v_l, x_l, g_l = jnp.split(h_lat @ w_in, IN_SPLITS, axis=-1)
    a_c, a_l = attention_group(q_c, k_c, v_c, q_l, k_l, v_l, cos, sin, q_norm_w, k_norm_w, ctx_out)
    r_c, r_l = lru_group(x_c, g_c, x_l, g_l, lru_conv_w, lru_conv_b, lru_wa, lru_ba, lru_wx, lru_bx,
                         lru_lambda, ctx_out)
    y_l = jnp.concatenate([rms_norm(a_l, attn_out_norm_w), rms_norm(r_l, lru_out_norm_w)], axis=-1) @ w_out
    y_c = None
    if ctx_out:
        y_c = jnp.concatenate([rms_norm(a_c, attn_out_norm_w), rms_norm(r_c, lru_out_norm_w)], axis=-1) @ w_out
    return y_c, y_l


def conv_ffn(h, w_up, conv_w, conv_b, w_down):
    u = dwconv_centred(h @ w_up, conv_w, conv_b)
    g, v = jnp.split(u, 2, axis=-1)
    return (jax.nn.silu(g) * v) @ w_down


def setup_inputs(seed: int = 0) -> dict:
    key = jax.random.key(seed)
    ks = jax.random.split(key, 26)
    f32 = jnp.float32

    def nrm(k, shape, scale):
        return jax.random.normal(k, shape, f32) * scale

    a_init = jax.random.uniform(ks[15], (DEPTH, 2, D_LRU), f32, 0.9, 0.999) ** (1.0 / LRU_C)
    return {
        "x": nrm(ks[0], (BATCH, SEQ, D_MODEL), 1.0),
        "c": nrm(ks[1], (BATCH, D_MODEL), 1.0),
        "ctx": nrm(ks[2], (BATCH, CTX_LEN, D_MODEL), 1.0),
        "c_ctx": nrm(ks[3], (D_MODEL,), 1.0),
        "w_ada": nrm(ks[4], (DEPTH, D_MODEL, 6 * D_MODEL), 0.5 * D_MODEL ** -0.5),
        "b_ada": nrm(ks[5], (DEPTH, 6 * D_MODEL), 0.01),
        "w_in": nrm(ks[6], (DEPTH, D_MODEL, D_IN), D_MODEL ** -0.5),
        "q_norm_w": 1.0 + nrm(ks[7], (DEPTH, HEAD_DIM), 0.05),
        "k_norm_w": 1.0 + nrm(ks[8], (DEPTH, HEAD_DIM), 0.05),
        "lru_conv_w": nrm(ks[9], (DEPTH, LRU_CONV_W, D_LRU), LRU_CONV_W ** -0.5),
        "lru_conv_b": nrm(ks[10], (DEPTH, D_LRU), 0.01),
        "lru_wa": nrm(ks[11], (DEPTH, 2, LRU_BLOCKS, LRU_BLOCK_W, LRU_BLOCK_W), LRU_BLOCK_W ** -0.5),
        "lru_ba": nrm(ks[12], (DEPTH, 2, D_LRU), 0.01),
        "lru_wx": nrm(ks[13], (DEPTH, 2, LRU_BLOCKS, LRU_BLOCK_W, LRU_BLOCK_W), LRU_BLOCK_W ** -0.5),
        "lru_bx": nrm(ks[14], (DEPTH, 2, D_LRU), 0.01),
        "lru_lambda": jnp.log(a_init) - jnp.log1p(-a_init),
        "attn_out_norm_w": 1.0 + nrm(ks[16], (DEPTH, D_ATTN), 0.05),
        "lru_out_norm_w": 1.0 + nrm(ks[17], (DEPTH, D_LRU), 0.05),
        "w_out": nrm(ks[18], (DEPTH, D_MIX, D_MODEL), D_MIX ** -0.5),
        "ffn_w_up": nrm(ks[19], (DEPTH, D_MODEL, 2 * D_FF), D_MODEL ** -0.5),
        "ffn_conv_w": nrm(ks[20], (DEPTH, FFN_CONV_W, 2 * D_FF), FFN_CONV_W ** -0.5),
        "ffn_conv_b": nrm(ks[21], (DEPTH, 2 * D_FF), 0.01),
        "ffn_w_down": nrm(ks[22], (DEPTH, D_FF, D_MODEL), D_FF ** -0.5),
        "final_norm_w": 1.0 + nrm(ks[23], (D_MODEL,), 0.05),
    }


def reference(x, c, ctx, c_ctx, w_ada, b_ada, w_in, q_norm_w, k_norm_w, lru_conv_w, lru_conv_b,
              lru_wa, lru_ba, lru_wx, lru_bx, lru_lambda, attn_out_norm_w, lru_out_norm_w, w_out,
              ffn_w_up, ffn_conv_w, ffn_conv_b, ffn_w_down, final_norm_w):
    S = x.shape[1]
    cos, sin = grid_rope_tables(S)
    x_lat, x_ctx = x, ctx
    for l in range(DEPTH):
        ctx_out = l < DEPTH - 1
        mod_lat = (jax.nn.silu(c) @ w_ada[l] + b_ada[l])[:, None, :]
        mod_ctx = (jax.nn.silu(c_ctx) @ w_ada[l] + b_ada[l])[None, None, :]
        shm_l, scm_l, gm_l, shf_l, scf_l, gf_l = jnp.split(mod_lat, 6, axis=-1)
        shm_c, scm_c, gm_c, shf_c, scf_c, gf_c = jnp.split(mod_ctx, 6, axis=-1)
        h_c = modulate(rms_norm(x_ctx), shm_c, scm_c)
        h_l = modulate(rms_norm(x_lat), shm_l, scm_l)
        y_c, y_l = token_mixer(h_c, h_l, cos, sin, w_in[l], q_norm_w[l], k_norm_w[l], lru_conv_w[l],
                               lru_conv_b[l], lru_wa[l], lru_ba[l], lru_wx[l], lru_bx[l], lru_lambda[l],
                               attn_out_norm_w[l], lru_out_norm_w[l], w_out[l], ctx_out)
        x_lat = x_lat + gm_l * y_l
        h_l = modulate(rms_norm(x_lat), shf_l, scf_l)
        x_lat = x_lat + gf_l * conv_ffn(h_l, ffn_w_up[l], ffn_conv_w[l], ffn_conv_b[l], ffn_w_down[l])
        if ctx_out:
            x_ctx = x_ctx + gm_c * y_c
            h_c = modulate(rms_norm(x_ctx), shf_c, scf_c)
            x_ctx = x_ctx + gf_c * conv_ffn(h_c, ffn_w_up[l], ffn_conv_w[l], ffn_conv_b[l], ffn_w_down[l])
    return rms_norm(x_lat, final_norm_w)
```

```cpp
#include <hip/hip_runtime.h>
#include <hip/hip_cooperative_groups.h>
#include <cstdio>
#include <cstdint>
namespace cg = cooperative_groups;
#ifndef MK_MULTI
#define MK_MULTI 0
#endif
__device__ __forceinline__ int mk_tid() { int t = threadIdx.x; asm volatile("" : "+v"(t)); return t; }
namespace pg8 {
#define PG8_LAS __attribute__((address_space(3)))
typedef unsigned short bf16_t;
typedef short bf16x8 __attribute__((ext_vector_type(8)));
typedef float f32x4 __attribute__((ext_vector_type(4)));
typedef unsigned u32x4 __attribute__((ext_vector_type(4)));
constexpr int BM = 256, BK = 64, HALF = 128, HTB = HALF * BK * 2  , STAGE_BYTES = 8 * HTB, NXCD = 8, WGM = 8;

__host__ __device__ __forceinline__ int lds_byte(int r, int c) { const int st = (r >> 4) * 2 + (c >> 5), rr = r & 15, cc = c & 31, ob = rr * 64 + cc * 2; return st * 1024 + (ob ^ (((ob >> 9) & 1) << 5)); }
__host__ __device__ __forceinline__ void stage_rc(int b, int& R, int& C) { const int st = b / 1024, sb = b % 1024, swz = sb ^ (((sb >> 9) & 1) << 5); R = (st >> 1) * 16 + swz / 64; C = (st & 1) * 32 + (swz % 64) / 2; }
__host__ __device__ __forceinline__ int perm32(int rho) { const int n = rho >> 4, i = rho & 15; return 8 * (i >> 2) + 4 * n + (i & 3); }

struct Unit { int pm, pn, koff; };
struct Gemm { const bf16_t* A; const bf16_t* Bt; int M, N, K; int a_rows; int ldk; };

struct StaticOrder {
    int nM, nN, nwg, G, c;
    __host__ __device__ void init(int M, int N, int G_, int c_) { nM = M / BM; nN = N / BM; nwg = nM * nN; G = G_; c = c_; }
    __host__ __device__ bool next(int i, Unit& u) const {
        const long L = (long)i * G + c; if (L >= nwg) return false;
        int wgid = (int)L; { const int q = nwg / NXCD, r = nwg % NXCD, xcd = wgid % NXCD, off = wgid / NXCD; wgid = (xcd < r ? xcd * (q + 1) : r * (q + 1) + (xcd - r) * q) + off; }
        const int nig = WGM * nN, gid = wgid / nig, fm = gid * WGM, gsz = (nM - fm) < WGM ? (nM - fm) : WGM;
        u.pm = fm + ((wgid % nig) % gsz); u.pn = (wgid % nig) / gsz; u.koff = 0; return true;
    }
    __device__ __forceinline__ void a_ready(const Unit&) const {}
    __device__ __forceinline__ void done(const Unit&) const {}
};

__device__ __forceinline__ unsigned cvt_pk_bf16(float lo, float hi) { unsigned r; asm volatile("v_cvt_pk_bf16_f32 %0, %1, %2" : "=v"(r) : "v"(lo), "v"(hi)); return r; }
typedef float f32x2 __attribute__((ext_vector_type(2)));
__device__ __forceinline__ f32x2 gelu_pk(f32x2 v) {
    const f32x2 av = __builtin_elementwise_abs(v), d = av * 0.2316418882f + 1.0f;
    f32x2 t; t.x = __builtin_amdgcn_rcpf(d.x); t.y = __builtin_amdgcn_rcpf(d.y);
    f32x2 q = t * 0.5307027145f + (-0.7265760135f); q = q * t + 0.7107068705f; q = q * t + (-0.142248368f); q = q * t + 0.127414796f; q = q * t;
    const f32x2 s = (v * v) * (-0.72134752044f);
    f32x2 e; e.x = __builtin_amdgcn_exp2f(s.x); e.y = __builtin_amdgcn_exp2f(s.y);
    const f32x2 m = v * (q * e), r = v - m;
    f32x2 o; o.x = v.x < 0.f ? m.x : r.x; o.y = v.y < 0.f ? m.y : r.y; return o;
}

template <int ACT  > struct EpiBf16 {
    static constexpr bool PERM = true, AFTER_DRAIN = false; static_assert(ACT == 0 || ACT == 1, "EpiBf16: ACT is 0 (none) or 1 (gelu_pk)");
    bf16_t* O; int ldc; const float* bias; int split_cols; size_t split_stride; float scale0;
    __device__ __forceinline__ void operator()(const f32x4 (&acc)[2][2][4][2], const Unit& u, int wr, int wc, int fr, int fq) const {
        const int row0 = u.pm * BM + wr * 64 + fr; int colt = u.pn * BM; bf16_t* base = O;
        float sc = 1.f; if (split_cols) { const int t = colt / split_cols; base += (size_t)t * split_stride; colt -= t * split_cols; if (t == 0) sc = scale0; }
        const int col0 = colt + wc * 32 + 8 * fq, bcol0 = u.pn * BM + wc * 32 + 8 * fq;
        f32x4 bv[2][2];
#pragma unroll
        for (int bj = 0; bj < 2; ++bj)
#pragma unroll
            for (int n = 0; n < 2; ++n) bv[bj][n] = bias ? *(const f32x4*)(bias + bcol0 + bj * HALF + 4 * n) : (f32x4){0.f, 0.f, 0.f, 0.f};
#pragma unroll
        for (int ai = 0; ai < 2; ++ai)
#pragma unroll
            for (int m = 0; m < 4; ++m) { bf16_t* rowp = base + (size_t)(row0 + ai * HALF + m * 16) * ldc + col0;
#pragma unroll
                for (int bj = 0; bj < 2; ++bj) { f32x4 v0 = acc[ai][bj][m][0] + bv[bj][0], v1 = acc[ai][bj][m][1] + bv[bj][1];
                    if (ACT == 1) { f32x2 a = gelu_pk((f32x2){v0[0], v0[1]}), b = gelu_pk((f32x2){v0[2], v0[3]}), c = gelu_pk((f32x2){v1[0], v1[1]}), d = gelu_pk((f32x2){v1[2], v1[3]});
                        v0 = (f32x4){a.x, a.y, b.x, b.y}; v1 = (f32x4){c.x, c.y, d.x, d.y}; }
                    v0 = v0 * sc; v1 = v1 * sc; u32x4 w; w.x = cvt_pk_bf16(v0[0], v0[1]); w.y = cvt_pk_bf16(v0[2], v0[3]); w.z = cvt_pk_bf16(v1[0], v1[1]); w.w = cvt_pk_bf16(v1[2], v1[3]);
                    *(u32x4*)(rowp + bj * HALF) = w; } }
    }
};

template <class Epi, class Sched, bool ALIGN_EPI = false, bool SP2 = false>
__device__ __forceinline__ void gemm_phase(PG8_LAS unsigned char* lds, const Gemm g, const Sched& S, const Epi& E) {
    const int tid = mk_tid(), wid = __builtin_amdgcn_readfirstlane(tid >> 6), lane = tid & 63, wr = wid >> 2, wc = wid & 3, fr = lane & 15, fq = lane >> 4;
    const int K = g.K, nt = K / BK;
    unsigned voffA[2], voffB[2];
#pragma unroll
    for (int i = 0; i < 2; ++i) { int R, C; stage_rc(tid * 16 + i * 8192, R, C); const int Rb = Epi::PERM ? ((R & ~31) + perm32(R & 31)) : R;
        voffA[i] = (unsigned)(R * g.ldk + C) * 2u; voffB[i] = (unsigned)(Rb * g.ldk + C) * 2u; }
    const size_t kstep = (size_t)(BK * 2);
    const size_t hstep = (size_t)HALF * g.ldk * 2;
    const size_t tstep = 2 * hstep;
    const unsigned ldsw = (unsigned)wid * 1024u;
    const int aoff = lds_byte(wr * 64 + fr, fq * 8), boff = lds_byte(wc * 32 + fr, fq * 8);
#define PG8_SA(b, h) (((b) * 2 + (h)) * HTB)
#define PG8_SB(b, h) ((4 + (b) * 2 + (h)) * HTB)
#define PG8_STAGE(bufoff, gbase, voff) do { _Pragma("unroll") for (int _i = 0; _i < 2; ++_i) \
        __builtin_amdgcn_global_load_lds((const unsigned*)((const char*)(gbase) + (voff)[_i]), (PG8_LAS unsigned*)(lds + (bufoff) + ldsw + _i * 8192), 16, 0, 0); } while (0)
#define PG8_LDA(dst, b, h) do { _Pragma("unroll") for (int m = 0; m < 4; ++m) _Pragma("unroll") for (int k = 0; k < 2; ++k) dst[m][k] = *(const PG8_LAS bf16x8*)(lds + PG8_SA(b, h) + aoff + m * 2048 + k * 1024); } while (0)
#define PG8_LDB(dst, b, h) do { _Pragma("unroll") for (int n = 0; n < 2; ++n) _Pragma("unroll") for (int k = 0; k < 2; ++k) dst[n][k] = *(const PG8_LAS bf16x8*)(lds + PG8_SB(b, h) + boff + n * 2048 + k * 1024); } while (0)
#define PG8_MMA(ai, bj, At, Bt) do { __builtin_amdgcn_s_setprio(1); _Pragma("unroll") for (int m = 0; m < 4; ++m) _Pragma("unroll") for (int n = 0; n < 2; ++n) _Pragma("unroll") for (int k = 0; k < 2; ++k) \
        acc[ai][bj][m][n] = __builtin_amdgcn_mfma_f32_16x16x32_bf16(Bt[n][k], At[m][k], acc[ai][bj][m][n], 0, 0, 0); __builtin_amdgcn_s_setprio(0); } while (0)
#define PG8_WAIT_V(n) asm volatile("s_waitcnt vmcnt(" #n ")" ::: "memory")
#define PG8_WAIT_L(n) asm volatile("s_waitcnt lgkmcnt(" #n ")" ::: "memory")
#define PG8_BAR __builtin_amdgcn_s_barrier()
#define PG8_SCHED __builtin_amdgcn_sched_barrier(0)
    Unit cur, nxt; int ui = 0;
    if (!S.next(0, cur)) return;
    f32x4 acc[2][2][4][2];
#pragma unroll
    for (int a = 0; a < 2; ++a)
#pragma unroll
        for (int b = 0; b < 2; ++b)
#pragma unroll
            for (int m = 0; m < 4; ++m)
#pragma unroll
                for (int n = 0; n < 2; ++n) acc[a][b][m][n] = (f32x4){0.f, 0.f, 0.f, 0.f};
    bf16x8 At[4][2], B0[2][2], B1[2][2];
    const size_t atstep = (size_t)g.a_rows * g.ldk * 2; const char* cA = (const char*)g.A + (size_t)cur.pm * atstep + (size_t)cur.koff * 2; const char* cB = (const char*)g.Bt + (size_t)cur.pn * tstep + (size_t)cur.koff * 2;
    S.a_ready(cur);
    if constexpr (SP2) {
        PG8_STAGE(PG8_SB(0, 0), cB, voffB); PG8_STAGE(PG8_SB(0, 1), cB + hstep, voffB); PG8_STAGE(PG8_SA(0, 0), cA, voffA); PG8_STAGE(PG8_SA(0, 1), cA + hstep, voffA);
        if (wr == 1) PG8_BAR;
        PG8_WAIT_V(2); PG8_BAR;
        PG8_STAGE(PG8_SB(1, 0), cB + kstep, voffB); PG8_STAGE(PG8_SA(1, 0), cA + kstep, voffA); PG8_STAGE(PG8_SB(1, 1), cB + hstep + kstep, voffB);
        PG8_WAIT_V(6); PG8_BAR;
    } else {
        PG8_STAGE(PG8_SB(0, 0), cB, voffB); PG8_STAGE(PG8_SA(0, 0), cA, voffA); PG8_STAGE(PG8_SB(0, 1), cB + hstep, voffB); PG8_STAGE(PG8_SA(0, 1), cA + hstep, voffA);
        if (wr == 1) PG8_BAR;
        PG8_WAIT_V(4); PG8_BAR;
        PG8_STAGE(PG8_SB(1, 0), cB + kstep, voffB); PG8_STAGE(PG8_SA(1, 0), cA + kstep, voffA); PG8_STAGE(PG8_SB(1, 1), cB + hstep + kstep, voffB);
        PG8_WAIT_V(6); PG8_BAR;
    }
    for (;;) {
        const bool has_next = S.next(ui + 1, nxt);
        const char* nA = has_next ? (const char*)g.A + (size_t)nxt.pm * atstep + (size_t)nxt.koff * 2 : cA; const char* nB = has_next ? (const char*)g.Bt + (size_t)nxt.pn * tstep + (size_t)nxt.koff * 2 : cB;
        for (int t = 0; t < nt; t += 2) {
            const bool last = (t == nt - 2);
            const char* a1 = cA + (size_t)(t + 1) * kstep;
            const char* a2 = last ? nA : cA + (size_t)(t + 2) * kstep; const char* b2 = last ? nB : cB + (size_t)(t + 2) * kstep;
            const char* a3 = a2 + kstep; const char* b3 = b2 + kstep;
            if (last && has_next) S.a_ready(nxt);
            if constexpr (SP2) {
            PG8_LDB(B0, 0, 0); PG8_LDB(B1, 0, 1); PG8_SCHED; PG8_LDA(At, 0, 0); PG8_STAGE(PG8_SA(1, 1), a1 + hstep, voffA);
            PG8_WAIT_V(8); PG8_WAIT_L(0); PG8_BAR; PG8_MMA(0, 0, At, B0); PG8_MMA(0, 1, At, B1); PG8_BAR; PG8_SCHED;
            PG8_LDA(At, 0, 1); PG8_STAGE(PG8_SB(0, 0), b2, voffB); PG8_STAGE(PG8_SB(0, 1), b2 + hstep, voffB); PG8_STAGE(PG8_SA(0, 0), a2, voffA);
            PG8_WAIT_V(8); PG8_WAIT_L(0); PG8_BAR; PG8_MMA(1, 0, At, B0); PG8_MMA(1, 1, At, B1); PG8_BAR; PG8_SCHED;
            PG8_LDB(B0, 1, 0); PG8_LDB(B1, 1, 1); PG8_SCHED; PG8_LDA(At, 1, 0); PG8_STAGE(PG8_SA(0, 1), a2 + hstep, voffA);
            PG8_WAIT_V(8); PG8_WAIT_L(0); PG8_BAR; PG8_MMA(0, 0, At, B0); PG8_MMA(0, 1, At, B1); PG8_BAR; PG8_SCHED;
            PG8_LDA(At, 1, 1); PG8_STAGE(PG8_SB(1, 0), b3, voffB); PG8_STAGE(PG8_SB(1, 1), b3 + hstep, voffB); PG8_STAGE(PG8_SA(1, 0), a3, voffA);
            PG8_WAIT_V(8); PG8_WAIT_L(0); PG8_BAR; PG8_MMA(1, 0, At, B0); PG8_MMA(1, 1, At, B1); PG8_BAR; PG8_SCHED;
            } else {
            PG8_LDB(B0, 0, 0); PG8_SCHED; PG8_LDA(At, 0, 0); PG8_STAGE(PG8_SA(1, 1), a1 + hstep, voffA);
            PG8_WAIT_L(8); PG8_BAR; PG8_WAIT_L(0); PG8_MMA(0, 0, At, B0); PG8_BAR; PG8_SCHED;
            PG8_LDB(B1, 0, 1); PG8_STAGE(PG8_SB(0, 0), b2, voffB);
            PG8_BAR; PG8_WAIT_L(0); PG8_MMA(0, 1, At, B1); PG8_BAR;
            PG8_LDA(At, 0, 1); PG8_STAGE(PG8_SA(0, 0), a2, voffA);
            PG8_BAR; PG8_WAIT_L(0); PG8_MMA(1, 0, At, B0); PG8_BAR; PG8_SCHED;
            PG8_STAGE(PG8_SB(0, 1), b2 + hstep, voffB);
            PG8_WAIT_V(6); PG8_BAR; PG8_MMA(1, 1, At, B1); PG8_BAR;
            PG8_LDB(B0, 1, 0); PG8_SCHED; PG8_LDA(At, 1, 0); PG8_STAGE(PG8_SA(0, 1), a2 + hstep, voffA);
            PG8_WAIT_L(8); PG8_BAR; PG8_WAIT_L(0); PG8_MMA(0, 0, At, B0); PG8_BAR; PG8_SCHED;
            PG8_LDB(B1, 1, 1); PG8_STAGE(PG8_SB(1, 0), b3, voffB);
            PG8_BAR; PG8_WAIT_L(0); PG8_MMA(0, 1, At, B1); PG8_BAR;
            PG8_LDA(At, 1, 1); PG8_STAGE(PG8_SA(1, 0), a3, voffA);
            PG8_BAR; PG8_WAIT_L(0); PG8_MMA(1, 0, At, B0); PG8_BAR; PG8_SCHED;
            PG8_STAGE(PG8_SB(1, 1), b3 + hstep, voffB);
            PG8_WAIT_V(6); PG8_BAR; PG8_MMA(1, 1, At, B1); PG8_BAR;
            }
        }
        if constexpr (ALIGN_EPI) { if (wr == 0) PG8_BAR; }
        if constexpr (!Epi::AFTER_DRAIN) { const int l2_ = mk_tid() & 63; E(acc, cur, wr, wc, l2_ & 15, l2_ >> 4); S.done(cur); }
        if (!has_next) break;
#pragma unroll
        for (int a = 0; a < 2; ++a)
#pragma unroll
            for (int b = 0; b < 2; ++b)
#pragma unroll
                for (int m = 0; m < 4; ++m)
#pragma unroll
                    for (int n = 0; n < 2; ++n) acc[a][b][m][n] = (f32x4){0.f, 0.f, 0.f, 0.f};
        cur = nxt; cA = nA; cB = nB; ++ui;
        if constexpr (ALIGN_EPI) { if (wr == 1) PG8_BAR; }
    }
    PG8_WAIT_V(0);
    if constexpr (!ALIGN_EPI) { if (wr == 0) PG8_BAR; }
    PG8_BAR;
    if constexpr (Epi::AFTER_DRAIN) { const int l2_ = mk_tid() & 63; E.fused(acc, cur, wr, wc, l2_ & 15, l2_ >> 4, lds, wid, l2_); S.done(cur); }
#undef PG8_SA
#undef PG8_SB
#undef PG8_STAGE
#undef PG8_LDA
#undef PG8_LDB
#undef PG8_MMA
#undef PG8_WAIT_V
#undef PG8_WAIT_L
#undef PG8_BAR
#undef PG8_SCHED
}
}

#include <hip/hip_bf16.h>
#include <cmath>
namespace attn_body {
using bf16=__hip_bfloat16;
using bf16x8=__attribute__((ext_vector_type(8)))short;
using s16x4=__attribute__((ext_vector_type(4)))short;
using f32x16=__attribute__((ext_vector_type(16)))float;
using u32x4=__attribute__((ext_vector_type(4)))unsigned;
constexpr int D=64,QP=512,KVP=128;
constexpr int NW=8,QBLK=32,QB=QBLK*NW,KVBLK=64;
constexpr int ATTN_UNIT_ROWS=QB;
__device__ __forceinline__ int crow(int r,int hi){return (r&3)+8*(r>>2)+4*hi;}
#define SBAR() __builtin_amdgcn_sched_barrier(0)
__device__ __forceinline__ void cmask(f32x16&p0,f32x16&p1,int jb,int qrel,int hi){
  const float NEG=-INFINITY; int kb=64*jb+4*hi;
  #pragma unroll
  for(int r=0;r<16;++r){int kv=kb+(r&3)+8*(r>>2); if(kv>qrel)p0[r]=NEG; if(kv+32>qrel)p1[r]=NEG;}
}

constexpr int NSLOT=3, SLOTB=8192;
constexpr int LDS_K=0, LDS_V=NSLOT*SLOTB, LDS_WS=2*NSLOT*SLOTB, LDS_OST=LDS_WS+NW*64*4, LDS_BYTES=LDS_OST+NW*4096;
constexpr float C2=0.125f*1.4426950408889634f;
__device__ __forceinline__ void glds16(const void*gsrc,unsigned lds_dst){unsigned keep;
  asm volatile("s_mov_b32 %0, m0\n\ts_mov_b32 m0, %2\n\ts_nop 0\n\tglobal_load_lds_dwordx4 %1, off\n\ts_mov_b32 m0, %0":"=&s"(keep):"v"(gsrc),"s"(lds_dst):"memory");}
__device__ __forceinline__ float max3f(float a,float b,float c){float r;asm("v_max3_f32 %0, %1, %2, %3":"=v"(r):"v"(a),"v"(b),"v"(c));return r;}
__device__ __forceinline__ float max2f(float a,float b){float r;asm("v_max_f32_e32 %0, %1, %2":"=v"(r):"v"(a),"v"(b));return r;}
__device__ __forceinline__ float fadd_s(float a,float b){float r;asm("v_add_f32_e32 %0, %1, %2":"=v"(r):"v"(a),"v"(b));return r;}
__device__ __forceinline__ float fsub_s(float a,float b){float r;asm("v_sub_f32_e32 %0, %1, %2":"=v"(r):"v"(a),"v"(b));return r;}
typedef float f32x2_t __attribute__((ext_vector_type(2))); typedef __bf16 bf16x2_t __attribute__((ext_vector_type(2)));
__device__ __forceinline__ unsigned cvtpk_s(float lo,float hi){f32x2_t v={lo,hi};bf16x2_t b=__builtin_convertvector(v,bf16x2_t);return __builtin_bit_cast(unsigned,b);}
#define WAIT_BAR(N) asm volatile("s_waitcnt vmcnt(" #N ") lgkmcnt(0)\n\ts_barrier":::"memory")

__device__ __forceinline__ void qkt(f32x16&p0,f32x16&p1,const char*Kslot,const bf16x8*qr,const f32x16&negm,int r32,int hi){
  const char*kb=Kslot+hi*1024+r32*16;
  #pragma unroll
  for(int d0=0;d0<4;++d0){
    const bf16x8 b0=*reinterpret_cast<const bf16x8*>(kb+d0*2048);
    const bf16x8 b1=*reinterpret_cast<const bf16x8*>(kb+d0*2048+512);
    if(d0==0){p0=__builtin_amdgcn_mfma_f32_32x32x16_bf16(b0,qr[0],negm,0,0,0);p1=__builtin_amdgcn_mfma_f32_32x32x16_bf16(b1,qr[0],negm,0,0,0);}
    else{p0=__builtin_amdgcn_mfma_f32_32x32x16_bf16(b0,qr[d0],p0,0,0,0);p1=__builtin_amdgcn_mfma_f32_32x32x16_bf16(b1,qr[d0],p1,0,0,0);}}
}
typedef __attribute__((address_space(3))) const char* lds_cptr;
typedef short v4i16_t __attribute__((ext_vector_type(4)));
__device__ __forceinline__ void kload8(bf16x8*kf,lds_cptr kp){
  kf[0]=*(const __attribute__((address_space(3))) bf16x8*)(kp);      kf[1]=*(const __attribute__((address_space(3))) bf16x8*)(kp+512);
  kf[2]=*(const __attribute__((address_space(3))) bf16x8*)(kp+2048); kf[3]=*(const __attribute__((address_space(3))) bf16x8*)(kp+2560);
  kf[4]=*(const __attribute__((address_space(3))) bf16x8*)(kp+4096); kf[5]=*(const __attribute__((address_space(3))) bf16x8*)(kp+4608);
  kf[6]=*(const __attribute__((address_space(3))) bf16x8*)(kp+6144); kf[7]=*(const __attribute__((address_space(3))) bf16x8*)(kp+6656);
}
__device__ __forceinline__ void kload2(bf16x8*kf,lds_cptr kp,int j){ kf[2*j]=*(const __attribute__((address_space(3))) bf16x8*)(kp+j*2048); kf[2*j+1]=*(const __attribute__((address_space(3))) bf16x8*)(kp+j*2048+512); }
__device__ __forceinline__ s16x4 vtr(lds_cptr p){ return __builtin_bit_cast(s16x4,__builtin_amdgcn_ds_read_tr16_b64_v4i16((__attribute__((address_space(3))) v4i16_t*)p)); }
__device__ __forceinline__ float rowmax(const f32x16&p0,const f32x16&p1){
  float a=max3f(p0[0],p0[1],p1[0]),b=max3f(p0[2],p0[3],p1[1]);a=max3f(a,p1[2],p1[3]);
  #pragma unroll
  for(int r=4;r<16;r+=4){a=max3f(a,p0[r],p0[r+1]);b=max3f(b,p0[r+2],p0[r+3]);a=max3f(a,p1[r],p1[r+1]);b=max3f(b,p1[r+2],p1[r+3]);}
  const float m=max2f(a,b);
  auto rr=__builtin_amdgcn_permlane32_swap(__float_as_uint(m),__float_as_uint(m),false,false);
  return max2f(__uint_as_float(rr[0]),__uint_as_float(rr[1]));
}
__device__ __forceinline__ void pv(f32x16*o,int vb,bf16x8 pa0,bf16x8 pa1,bf16x8 pa2,bf16x8 pa3){
  #pragma unroll
  for(int d0=0;d0<2;++d0){s16x4 lo[4],hi[4];
    #pragma unroll
    for(int ks=0;ks<4;++ks){
      asm volatile("ds_read_b64_tr_b16 %0,%1 offset:%c2":"=&v"(lo[ks]):"v"(vb),"i"(d0*4096+ks*1024):"memory");
      asm volatile("ds_read_b64_tr_b16 %0,%1 offset:%c2":"=&v"(hi[ks]):"v"(vb),"i"(d0*4096+ks*1024+512):"memory");}
    asm volatile("s_waitcnt lgkmcnt(0)":::"memory");SBAR();
    #define PK(k) (bf16x8){lo[k][0],lo[k][1],lo[k][2],lo[k][3],hi[k][0],hi[k][1],hi[k][2],hi[k][3]}
    o[d0]=__builtin_amdgcn_mfma_f32_32x32x16_bf16(pa0,PK(0),o[d0],0,0,0);
    o[d0]=__builtin_amdgcn_mfma_f32_32x32x16_bf16(pa1,PK(1),o[d0],0,0,0);
    o[d0]=__builtin_amdgcn_mfma_f32_32x32x16_bf16(pa2,PK(2),o[d0],0,0,0);
    o[d0]=__builtin_amdgcn_mfma_f32_32x32x16_bf16(pa3,PK(3),o[d0],0,0,0);
    #undef PK
  }
}

#ifndef ATTN_STORE16
#define ATTN_STORE16(p,v) (*(u32x4*)(p)=(v))
#endif
template<int THRL> __device__ __forceinline__ void attn_unit(const bf16*Qu,const bf16*__restrict__ Kh,const bf16*__restrict__ Vh,bf16*Ou,const int NT,char*shm){
  const int tid=mk_tid(),lane=tid&63,r32=lane&31,hi=lane>>5; const int wid=__builtin_amdgcn_readfirstlane(tid>>6);
  const bf16*Qw=Qu+(long)(wid*QBLK)*QP;
  const unsigned lds0=(unsigned)(uintptr_t)shm;
  float*wsf=(float*)(shm+LDS_WS)+wid*64;
  const bf16*ksrc=Kh+(long)lane*KVP+wid*8;
  const bf16*vsrc=Vh+(long)(16*(wid&3)+(lane>>2))*KVP+(wid>>2)*32+(lane&3)*8;
  const unsigned kdst=lds0+LDS_K+wid*1024, vdst=lds0+LDS_V+wid*1024;
  #define DMA_K(t,slot) glds16(ksrc+(long)(t)*KVBLK*KVP,(unsigned)__builtin_amdgcn_readfirstlane(kdst+(slot)))
  #define DMA_V(t,slot) glds16(vsrc+(long)(t)*KVBLK*KVP,(unsigned)__builtin_amdgcn_readfirstlane(vdst+(slot)))
  const int vb0=(int)(lds0+LDS_V)+((lane>>4)&1)*32+(lane&3)*8+(4*hi+((lane&15)>>2))*64;
  const char*Kbase=shm+LDS_K; bf16x8 kf[8];
  const lds_cptr shm3=(lds_cptr)shm; const lds_cptr kp0=shm3+LDS_K+hi*1024+r32*16; const lds_cptr vp0=shm3+LDS_V+((lane>>4)&1)*32+(lane&3)*8+(4*hi+((lane&15)>>2))*64;
  DMA_K(0,0);DMA_V(0,0);DMA_K(1,SLOTB);
  bf16x8 qr[4];
  #pragma unroll
  for(int d0=0;d0<4;++d0)qr[d0]=*reinterpret_cast<const bf16x8*>(&Qw[(long)r32*QP+d0*16+hi*8]);
  float mhat=0.f,l_reg=0.f;f32x16 o[2];o[0]=f32x16{};o[1]=f32x16{};f32x16 negm=f32x16{};asm volatile("":"+v"(negm));
  #define CMASK(P0,P1,t) do{}while(0)
  bool resc=false;
  #define START(P0,P1) do{ const float rm=rowmax(P0,P1); resc=false; \
    { const float dl=rm; mhat=fadd_s(mhat,dl); \
      _Pragma("unroll") for(int r=0;r<16;++r){P0[r]=fsub_s(P0[r],dl);P1[r]=fsub_s(P1[r],dl);} \
      _Pragma("unroll") for(int r=0;r<16;++r)negm[r]=-mhat; asm volatile("":"+v"(negm)); } \
    _Pragma("unroll") for(int r=0;r<16;++r)P0[r]=__builtin_amdgcn_exp2f(P0[r]); }while(0)
  #define RESC() do{ if(resc){ asm volatile("s_waitcnt lgkmcnt(0)":::"memory"); \
      _Pragma("unroll") for(int d_=0;d_<2;++d_) _Pragma("unroll") for(int r=0;r<16;++r)o[d_][r]*=wsf[crow(r,hi)]; } }while(0)
  f32x16 pA0,pA1,pB0,pB1;
  int sl_prev=0,sl_cur=0,sl_next=SLOTB;
  #define ROT() do{sl_prev=sl_cur;sl_cur=sl_next;sl_next=(sl_next==(NSLOT-1)*SLOTB)?0:sl_next+SLOTB;}while(0)
  DMA_K(2,2*SLOTB);
  WAIT_BAR(3);
  qkt(pA0,pA1,Kbase,qr,negm,r32,hi);asm volatile("s_nop 15\n\ts_nop 7":"+v"(pA0),"+v"(pA1));CMASK(pA0,pA1,0);
  START(pA0,pA1);
  _Pragma("unroll") for(int r=0;r<16;++r)pA1[r]=__builtin_amdgcn_exp2f(pA1[r]);
  WAIT_BAR(0);
  DMA_K(3,0);DMA_V(1,SLOTB);
  ROT();
  kload8(kf,kp0+sl_cur);
  WAIT_BAR(2);
  s16x4 vlo[8],vhi[8]; u32x4 pw0,pw1,pw2,pw3;
  #define PKW(P,B) cvtpk_s(P[B],P[B+1])
  #define PAF(k) __builtin_bit_cast(bf16x8,pw##k)
  #define VFR(i) (bf16x8){vlo[i][0],vlo[i][1],vlo[i][2],vlo[i][3],vhi[i][0],vhi[i][1],vhi[i][2],vhi[i][3]}
  #define PIN(x) asm volatile("":"+v"(x))
  #define MX3(a,b,c) __builtin_fmaxf(__builtin_fmaxf((a),(b)),(c))
  #define GAPA(MF,A0,A1,A2,A3,W0,W1,PW) do{ MF; sacc+=A0; sacc+=A1; sacc+=A2; sacc+=A3; PIN(sacc); W0; W1; PIN(PW); SBAR(); }while(0)
  #define EX(v) __builtin_amdgcn_exp2f(v)
  #define GAPB(MF,X,B) do{ MF; X[B]=EX(X[B]); X[B+1]=EX(X[B+1]); X[B+2]=EX(X[B+2]); X[B+3]=EX(X[B+3]); PIN(X); SBAR(); }while(0)
  #define VRD(i) do{ vlo[i]=vtr(vp_+(((i)>>2)*4096+((i)&3)*1024)); vhi[i]=vtr(vp_+(((i)>>2)*4096+((i)&3)*1024+512)); }while(0)
  #define KRD(G,j) do{ if(G){ kload2(kf,kp0+sl_next,j); SBAR(); } }while(0)
  #define STEP(C0,C1,P0,P1,t,GK,GV,GL) do{ SBAR(); \
    const lds_cptr vp_=vp0+sl_prev; \
    VRD(0); SBAR(); float sacc=(P0[0]+P0[1]); \
    GAPA(C0=__builtin_amdgcn_mfma_f32_32x32x16_bf16(kf[0],qr[0],negm,0,0,0), P0[2],P0[3],P0[4],P0[5],     pw0[0]=PKW(P0,0), pw0[1]=PKW(P0,2), pw0); \
    VRD(4); SBAR(); GAPA(C1=__builtin_amdgcn_mfma_f32_32x32x16_bf16(kf[1],qr[0],negm,0,0,0), P0[6],P0[7],P0[8],P0[9],     pw0[2]=PKW(P0,4), pw0[3]=PKW(P0,6), pw0); \
    VRD(1); SBAR(); GAPA(C0=__builtin_amdgcn_mfma_f32_32x32x16_bf16(kf[2],qr[1],C0,0,0,0),   P0[10],P0[11],P0[12],P0[13], pw1[0]=PKW(P0,8), pw1[1]=PKW(P0,10), pw1); \
    VRD(5); SBAR(); GAPA(C1=__builtin_amdgcn_mfma_f32_32x32x16_bf16(kf[3],qr[1],C1,0,0,0),   P0[14],P0[15],P1[0],P1[1],   pw1[2]=PKW(P0,12),pw1[3]=PKW(P0,14), pw1); \
    VRD(2); SBAR(); GAPA(C0=__builtin_amdgcn_mfma_f32_32x32x16_bf16(kf[4],qr[2],C0,0,0,0),   P1[2],P1[3],P1[4],P1[5],     pw2[0]=PKW(P1,0), pw2[1]=PKW(P1,2), pw2); \
    VRD(6); SBAR(); GAPA(C1=__builtin_amdgcn_mfma_f32_32x32x16_bf16(kf[5],qr[2],C1,0,0,0),   P1[6],P1[7],P1[8],P1[9],     pw2[2]=PKW(P1,4), pw2[3]=PKW(P1,6), pw2); \
    VRD(3); SBAR(); GAPA(C0=__builtin_amdgcn_mfma_f32_32x32x16_bf16(kf[6],qr[3],C0,0,0,0),   P1[10],P1[11],P1[12],P1[13], pw3[0]=PKW(P1,8), pw3[1]=PKW(P1,10), pw3); \
    VRD(7); SBAR(); GAPA(C1=__builtin_amdgcn_mfma_f32_32x32x16_bf16(kf[7],qr[3],C1,0,0,0),   P1[14],P1[15],0.f,0.f,       pw3[2]=PKW(P1,12),pw3[3]=PKW(P1,14), pw3); \
    l_reg+=sacc; \
    if(GK){DMA_K((t)+3,sl_cur);} if(GV){DMA_V((t)+1,sl_next);} \
    CMASK(C0,C1,t); \
    { float a=MX3(C0[0],C0[1],C1[0]),b=MX3(C0[2],C0[3],C1[1]); a=MX3(a,C1[2],C1[3]); \
      _Pragma("unroll") for(int r=4;r<16;r+=4){a=MX3(a,C0[r],C0[r+1]);b=MX3(b,C0[r+2],C0[r+3]);a=MX3(a,C1[r],C1[r+1]);b=MX3(b,C1[r+2],C1[r+3]);} \
      float rm=__builtin_fmaxf(a,b); { auto rr=__builtin_amdgcn_permlane32_swap(__float_as_uint(rm),__float_as_uint(rm),false,false); rm=__builtin_fmaxf(__uint_as_float(rr[0]),__uint_as_float(rr[1])); } \
      resc=false; \
      if(__builtin_expect(__any(rm>(float)THRL),0)){ const float dl=__builtin_fmaxf(rm,0.f); mhat+=dl; \
        _Pragma("unroll") for(int r=0;r<16;++r){C0[r]-=dl;C1[r]-=dl;} \
        _Pragma("unroll") for(int r=0;r<16;++r)negm[r]=-mhat; asm volatile("":"+v"(negm)); \
        const float f=__builtin_amdgcn_exp2f(-dl); l_reg*=f; if(hi==0)wsf[r32]=f; resc=true; } } \
    SBAR(); \
    GAPB(o[0]=__builtin_amdgcn_mfma_f32_32x32x16_bf16(PAF(0),VFR(0),o[0],0,0,0), C0,0); \
    GAPB(o[1]=__builtin_amdgcn_mfma_f32_32x32x16_bf16(PAF(0),VFR(4),o[1],0,0,0), C0,4); \
    KRD(GL,0); GAPB(o[0]=__builtin_amdgcn_mfma_f32_32x32x16_bf16(PAF(1),VFR(1),o[0],0,0,0), C0,8); \
    KRD(GL,1); GAPB(o[1]=__builtin_amdgcn_mfma_f32_32x32x16_bf16(PAF(1),VFR(5),o[1],0,0,0), C0,12); \
    KRD(GL,2); GAPB(o[0]=__builtin_amdgcn_mfma_f32_32x32x16_bf16(PAF(2),VFR(2),o[0],0,0,0), C1,0); \
    KRD(GL,3); GAPB(o[1]=__builtin_amdgcn_mfma_f32_32x32x16_bf16(PAF(2),VFR(6),o[1],0,0,0), C1,4); \
    GAPB(o[0]=__builtin_amdgcn_mfma_f32_32x32x16_bf16(PAF(3),VFR(3),o[0],0,0,0), C1,8); \
    GAPB(o[1]=__builtin_amdgcn_mfma_f32_32x32x16_bf16(PAF(3),VFR(7),o[1],0,0,0), C1,12); \
    }while(0)
  int t=1;
  #undef CMASK
  #define CMASK(P0,P1,t) do{}while(0)
  for(;t+5<NT;t+=2){
    STEP(pB0,pB1,pA0,pA1,t,true,true,true);     WAIT_BAR(2); RESC(); ROT();
    STEP(pA0,pA1,pB0,pB1,t+1,true,true,true);   WAIT_BAR(2); RESC(); ROT();
  }
  #undef CMASK
  #define CMASK(P0,P1,t) do{}while(0)
  #define ENDW(tt) do{ if((tt)+3<NT){WAIT_BAR(2);} else if((tt)+2<NT){WAIT_BAR(1);} else {WAIT_BAR(0);} }while(0)
  for(;t+1<NT;t+=2){
    STEP(pB0,pB1,pA0,pA1,t,(t+3<NT),(t+1<NT),(t+1<NT));       ENDW(t);   RESC(); ROT();
    STEP(pA0,pA1,pB0,pB1,t+1,(t+4<NT),(t+2<NT),(t+2<NT));     ENDW(t+1); RESC(); ROT();
  }
  STEP(pB0,pB1,pA0,pA1,NT-1,false,false,false); RESC();
  { float sacc=pB0[0]+pB0[1]; _Pragma("unroll") for(int r=2;r<16;++r)sacc+=pB0[r]; _Pragma("unroll") for(int r=0;r<16;++r)sacc+=pB1[r]; l_reg+=sacc;
    pw0=(u32x4){PKW(pB0,0),PKW(pB0,2),PKW(pB0,4),PKW(pB0,6)};pw1=(u32x4){PKW(pB0,8),PKW(pB0,10),PKW(pB0,12),PKW(pB0,14)};pw2=(u32x4){PKW(pB1,0),PKW(pB1,2),PKW(pB1,4),PKW(pB1,6)};pw3=(u32x4){PKW(pB1,8),PKW(pB1,10),PKW(pB1,12),PKW(pB1,14)};
    SBAR(); pv(o,vb0+sl_cur,PAF(0),PAF(1),PAF(2),PAF(3)); }
  #undef PKW
  #undef PAF
  #undef VFR
  #undef PIN
  #undef MX3
  #undef GAPA
  #undef GAPB
  #undef EX
  #undef VRD
  #undef KRD
  #undef STEP
  #undef ENDW
  {auto rr=__builtin_amdgcn_permlane32_swap(__float_as_uint(l_reg),__float_as_uint(l_reg),false,false);l_reg=__uint_as_float(rr[0])+__uint_as_float(rr[1]);}
  if(hi==0)wsf[32+r32]=l_reg;asm volatile("s_waitcnt lgkmcnt(0)":::"memory");
  float rli[16];
  #pragma unroll
  for(int r=0;r<16;++r)rli[r]=__builtin_amdgcn_rcpf(wsf[32+crow(r,hi)]);
  bf16*Ow=Ou+(long)(wid*QBLK)*QP;
  { bf16*stg=(bf16*)(shm+LDS_OST)+wid*2048;
    #pragma unroll
    for(int r=0;r<16;++r){const int orow=crow(r,hi);
      #pragma unroll
      for(int d0=0;d0<2;++d0)stg[orow*64+d0*32+r32]=__float2bfloat16(o[d0][r]*rli[r]);}
    asm volatile("s_waitcnt lgkmcnt(0)":::"memory");
    #pragma unroll
    for(int i=0;i<4;++i){const int row=i*8+(lane>>3),ch=lane&7; const u32x4 v=*(const u32x4*)(stg+row*64+ch*8); ATTN_STORE16(Ow+(long)row*QP+ch*8,v);} }
  asm volatile("s_waitcnt lgkmcnt(0)\n\ts_barrier":::"memory");
  #undef DMA_K
  #undef DMA_V
  #undef CMASK
  #undef START
  #undef RESC
  #undef ROT
}
constexpr int ATTN_LDS_BYTES=LDS_BYTES;
#undef SBAR
#undef WAIT_BAR
}

#define LAS __attribute__((address_space(3)))
typedef unsigned short bf16r;
typedef float f4 __attribute__((ext_vector_type(4)));
typedef unsigned u4 __attribute__((ext_vector_type(4)));
typedef unsigned u2 __attribute__((ext_vector_type(2)));
typedef short s8v __attribute__((ext_vector_type(8)));

constexpr int DM = 1024, SEQL = 4096, CTXL = 256, MLAT = 16384, MCTX = 1024, MALL = 17408;
constexpr int DIN = 1792, DFF = 2816, DFF2 = 5632, KVR = 4352, NCH = 68;
constexpr float EPSN = 1e-6f;
constexpr size_t MiB = 1u << 20;
constexpr size_t WS_MOD = 1 * MiB, WS_COS = 2 * MiB, WS_SIN = 2 * MiB + 512 * 1024, WS_GW = 3 * MiB, WS_AGGA = 4 * MiB, WS_AGGB = 6 * MiB, WS_CTXRES = 8 * MiB;
constexpr size_t WS_W = 12 * MiB, W_LAYER = 22 * MiB, W_IN = 0, W_OUT = 3 * MiB + 512 * 1024, W_UP = 5 * MiB + 512 * 1024, W_DOWN = 16 * MiB + 512 * 1024;
constexpr size_t WS_HN = 56 * MiB + 4096;
constexpr size_t WS_Q = 92 * MiB, WS_K = 109 * MiB, WS_V = 114 * MiB, WS_XL = 119 * MiB, WS_GG = 136 * MiB, WS_MIX = 153 * MiB;
constexpr size_t WS_LAB = 187 * MiB;
constexpr size_t WS_O = WS_HN;
constexpr size_t WS_PART = 187 * MiB;
constexpr size_t WS_ACT = 92 * MiB;
constexpr int LDS_BYTES = 147456;
constexpr int NPHASE = 18;
constexpr int L1_TAB_OFF = 84992;
#ifndef PHM
#define PHM 0x3ff
#endif
#define PON(k) ((PHM >> (k)) & 1)

struct Args { const float* in[24]; float* out; unsigned char* ws; int ph_lo, ph_hi; };
typedef const __attribute__((address_space(4))) Args* KA;

#define LDS_WAIT() asm volatile("s_waitcnt lgkmcnt(0)" ::: "memory")
__device__ __forceinline__ unsigned pk2(float lo, float hi) { return attn_body::cvtpk_s(lo, hi); }
__device__ __forceinline__ float bf_lo(unsigned w) { return __builtin_bit_cast(float, w << 16); }
__device__ __forceinline__ float bf_hi(unsigned w) { return __builtin_bit_cast(float, w & 0xffff0000u); }
__device__ __forceinline__ float wave_sum(float v) {
#pragma unroll
    for (int o = 1; o < 64; o <<= 1) v += __shfl_xor(v, o);
    return v;
}
__device__ __forceinline__ float fexp(float x) { return __builtin_amdgcn_exp2f(x * 1.4426950408889634f); }
__device__ __forceinline__ float sigmoidf_(float x) { return __builtin_amdgcn_rcpf(1.f + fexp(-x)); }
__device__ __forceinline__ float gelu_tanh(float x) { const float z = 0.7978845608028654f * (x + 0.044715f * x * x * x); return x * sigmoidf_(2.f * z); }
__device__ __forceinline__ int kvrow(int row) { return row < MLAT ? (row >> 12) * KVR + CTXL + (row & 4095) : ((row - MLAT) >> 8) * KVR + ((row - MLAT) & 255); }

__device__ __forceinline__ int win_dst(int s) {
    if (s < 512) { const int h = s >> 6, d = s & 63; return (h >> 2) * 256 + (d >> 5) * 128 + (h & 3) * 32 + (d & 31); }
    if (s < 768) { const int t = s - 512, hh = t >> 6, d = t & 63; return 512 + (d >> 5) * 128 + hh * 32 + (d & 31); }
    return s;
}
__device__ __forceinline__ int wup_dst(int s) { return s < DFF ? (s >> 7) * 256 + (s & 127) : ((s - DFF) >> 7) * 256 + 128 + ((s - DFF) & 127); }

template <int MODE> __device__ __forceinline__ void p0_transpose_item(const float* W, int K, int N, bf16r* WT, const float* ksA, const float* ksB, LAS float* scr, int item, int lane) {
    const int nblk = N / 32, kb = item / nblk, nb = item % nblk, k0 = 64 * kb, n0 = 32 * nb;
    float tv[32];
#pragma unroll
    for (int i = 0; i < 32; ++i) { const int kk = 2 * i + (lane >> 5); tv[i] = W[(size_t)(k0 + kk) * N + n0 + (lane & 31)]; }
#pragma unroll
    for (int i = 0; i < 32; ++i) { const int kk = 2 * i + (lane >> 5); float v = tv[i];
        if (MODE == 3) { const int k = k0 + kk; v *= (k < 512 ? ksA[k] : ksB[k - 512]); }
        scr[kk * 33 + (lane & 31)] = v; }
    LDS_WAIT();
    const int c = lane & 7;
#pragma unroll
    for (int j = 0; j < 4; ++j) { const int n = (lane >> 3) + 8 * j; const LAS float* s = scr + (8 * c) * 33 + n;
        u4 o; o.x = pk2(s[0 * 33], s[1 * 33]); o.y = pk2(s[2 * 33], s[3 * 33]); o.z = pk2(s[4 * 33], s[5 * 33]); o.w = pk2(s[6 * 33], s[7 * 33]);
        const int sc = n0 + n; const int dst = MODE == 1 ? win_dst(sc) : MODE == 2 ? wup_dst(sc) : sc;
        *(u4*)(WT + (size_t)dst * K + k0 + 8 * c) = o; }
    LDS_WAIT();
}

__device__ __forceinline__ void p0_phase(KA a, LAS unsigned char* lds, int tid, int wid, int lane, int G) {
    unsigned char* ws = a->ws;
    float* MOD = (float*)(ws + WS_MOD);
    {
        LAS float* sc = (LAS float*)lds; LAS float* red = sc + 5 * 1024;
        bool have = false;
        for (int it = blockIdx.x; it < 192; it += G) {
            if (!have) { for (int e = tid; e < 5 * 1024; e += 512) { const int r = e >> 10, k = e & 1023; const float v = r < 4 ? a->in[1][r * 1024 + k] : a->in[3][k]; sc[e] = v * sigmoidf_(v); } have = true; }
            __syncthreads();
            const int l = it / 96, nb = it % 96;
            const float* wp = a->in[4] + (size_t)l * 1024 * 6144 + (size_t)(wid * 128) * 6144 + nb * 64 + lane;
            float acc[5] = {0.f, 0.f, 0.f, 0.f, 0.f};
#pragma unroll 32
            for (int k = 0; k < 128; ++k) { const float wv = wp[(size_t)k * 6144];
#pragma unroll
                for (int r = 0; r < 5; ++r) acc[r] += sc[r * 1024 + wid * 128 + k] * wv; }
#pragma unroll
            for (int r = 0; r < 5; ++r) red[(wid * 5 + r) * 64 + lane] = acc[r];
            __syncthreads();
            if (tid < 320) { const int r = tid >> 6, col = tid & 63; float s = a->in[5][l * 6144 + nb * 64 + col];
#pragma unroll
                for (int w = 0; w < 8; ++w) s += red[(w * 5 + r) * 64 + col];
                MOD[(l * 5 + r) * 6144 + nb * 64 + col] = s; }
        }
        __syncthreads();
    }
    {
        float* cosT = (float*)(ws + WS_COS); float* sinT = (float*)(ws + WS_SIN); bf16r* GW = (bf16r*)(ws + WS_GW);
        const int gt = blockIdx.x * 512 + tid, NT_ = G * 512;
        for (int e = gt; e < 4096 * 32; e += NT_) { const int t = e >> 5, j = e & 31; const float pos = (float)(j < 16 ? (t >> 6) : (t & 63));
            const float inv = powf(10000.0f, -(float)(j & 15) * (1.0f / 16.0f)); const float ang = pos * inv; cosT[e] = cosf(ang); sinT[e] = sinf(ang); }
        for (int e = gt; e < 2 * 2 * 2 * 8 * 64 * 64; e += NT_) {
            const int c = e & 63, d = (e >> 6) & 63, n = (e >> 12) & 7, mat = (e >> 15) & 1, dir = (e >> 16) & 1, l = e >> 17;
            const float* src = mat ? a->in[13] : a->in[11];
            GW[e] = (bf16r)(pk2(src[((((size_t)l * 2 + dir) * 8 + n) * 64 + c) * 64 + d], 0.f) & 0xffffu); }
    }
    {
        LAS float* scr = (LAS float*)lds + wid * (64 * 33 + 16);
        const int gw = blockIdx.x * 8 + wid, NGW = G * 8;
        constexpr int I_IN = 16 * 56, I_OUT = 16 * 32, I_UP = 16 * 176, I_DN = 44 * 32, I_L = I_IN + I_OUT + I_UP + I_DN;
        for (int it = gw; it < 2 * I_L; it += NGW) {
            const int l = it / I_L; int r = it % I_L;
            unsigned char* wl = ws + WS_W + (size_t)l * W_LAYER;
            if (r < I_IN) { p0_transpose_item<1>(a->in[6] + (size_t)l * DM * DIN, DM, DIN, (bf16r*)(wl + W_IN), nullptr, nullptr, scr, r, lane); continue; } r -= I_IN;
            if (r < I_OUT) { p0_transpose_item<3>(a->in[18] + (size_t)l * DM * DM, DM, DM, (bf16r*)(wl + W_OUT), a->in[16] + l * 512, a->in[17] + l * 512, scr, r, lane); continue; } r -= I_OUT;
            if (r < I_UP) { p0_transpose_item<2>(a->in[19] + (size_t)l * DM * DFF2, DM, DFF2, (bf16r*)(wl + W_UP), nullptr, nullptr, scr, r, lane); continue; } r -= I_UP;
            p0_transpose_item<0>(a->in[22] + (size_t)l * DFF * DM, DFF, DM, (bf16r*)(wl + W_DOWN), nullptr, nullptr, scr, r, lane);
        }
    }
}

__device__ __forceinline__ void prenorm_phase(KA a, int l, int which, int nrows, int nsplit, const float* ctx_src, int wid, int lane, int G) {
    const float* MOD = (const float*)(a->ws + WS_MOD); bf16r* HN = (bf16r*)(a->ws + WS_HN);
    float* ctxres = (float*)(a->ws + WS_CTXRES); const float* PART = (const float*)(a->ws + WS_PART);
    const int gw = blockIdx.x * 8 + wid, NGW = G * 8;
    const bool from_in = (l == 0 && which == 0);
    for (int row = gw; row < nrows; row += 2 * NGW) {
        const int row2 = row + NGW; const bool has2 = row2 < nrows; const int r2 = has2 ? row2 : row;
        const float* lat = from_in ? a->in[0] : a->out;
        const float* s0 = row < MLAT ? lat + (size_t)row * DM : ctx_src + (size_t)(row - MLAT) * DM;
        const float* s1 = r2 < MLAT ? lat + (size_t)r2 * DM : ctx_src + (size_t)(r2 - MLAT) * DM;
        const float* md0 = MOD + (l * 5 + (row < MLAT ? (row >> 12) : 4)) * 6144 + (which ? 3 * 1024 : 0);
        const float* md1 = MOD + (l * 5 + (r2 < MLAT ? (r2 >> 12) : 4)) * 6144 + (which ? 3 * 1024 : 0);
        f4 v0[4], v1[4];
#pragma unroll
        for (int j = 0; j < 4; ++j) { v0[j] = *(const f4*)(s0 + 4 * (lane + 64 * j)); v1[j] = *(const f4*)(s1 + 4 * (lane + 64 * j)); }
        if (nsplit > 0) {
            if (row >= MLAT) { const float* pp = PART + (size_t)(row - MLAT) * DM + 4 * lane;
                for (int ks = 0; ks < nsplit; ks += 4) {
                    f4 t_[4][4]; float wk_[4];
#pragma unroll
                    for (int kk = 0; kk < 4; ++kk) { const int k2 = ks + kk < nsplit ? ks + kk : nsplit - 1; wk_[kk] = ks + kk < nsplit ? 1.f : 0.f;
#pragma unroll
                        for (int j = 0; j < 4; ++j) t_[kk][j] = *(const f4*)(pp + (size_t)k2 * MCTX * DM + 256 * j); }
                    __builtin_amdgcn_sched_barrier(0);
#pragma unroll
                    for (int kk = 0; kk < 4; ++kk)
#pragma unroll
                        for (int j = 0; j < 4; ++j) v0[j] += t_[kk][j] * wk_[kk];
                }
#pragma unroll
                for (int j = 0; j < 4; ++j) *(f4*)(ctxres + (size_t)(row - MLAT) * DM + 4 * (lane + 64 * j)) = v0[j]; }
            if (has2 && row2 >= MLAT) { const float* pp = PART + (size_t)(row2 - MLAT) * DM + 4 * lane;
                for (int ks = 0; ks < nsplit; ks += 4) {
                    f4 t_[4][4]; float wk_[4];
#pragma unroll
                    for (int kk = 0; kk < 4; ++kk) { const int k2 = ks + kk < nsplit ? ks + kk : nsplit - 1; wk_[kk] = ks + kk < nsplit ? 1.f : 0.f;
#pragma unroll
                        for (int j = 0; j < 4; ++j) t_[kk][j] = *(const f4*)(pp + (size_t)k2 * MCTX * DM + 256 * j); }
                    __builtin_amdgcn_sched_barrier(0);
#pragma unroll
                    for (int kk = 0; kk < 4; ++kk)
#pragma unroll
                        for (int j = 0; j < 4; ++j) v1[j] += t_[kk][j] * wk_[kk];
                }
#pragma unroll
                for (int j = 0; j < 4; ++j) *(f4*)(ctxres + (size_t)(row2 - MLAT) * DM + 4 * (lane + 64 * j)) = v1[j]; }
        }
        float ss0 = 0.f, ss1 = 0.f;
#pragma unroll
        for (int j = 0; j < 4; ++j) { ss0 += (v0[j].x * v0[j].x + v0[j].y * v0[j].y) + (v0[j].z * v0[j].z + v0[j].w * v0[j].w); ss1 += (v1[j].x * v1[j].x + v1[j].y * v1[j].y) + (v1[j].z * v1[j].z + v1[j].w * v1[j].w); }
#pragma unroll
        for (int o = 1; o < 64; o <<= 1) { ss0 += __shfl_xor(ss0, o); ss1 += __shfl_xor(ss1, o); }
        const float rs0 = rsqrtf(ss0 * (1.f / DM) + EPSN), rs1 = rsqrtf(ss1 * (1.f / DM) + EPSN);
#pragma unroll
        for (int j = 0; j < 4; ++j) { const int col = 4 * (lane + 64 * j);
            { const f4 sh = *(const f4*)(md0 + col), sc = *(const f4*)(md0 + 1024 + col); const f4 h = v0[j] * rs0 * (sc + 1.f) + sh; u2 w; w.x = pk2(h.x, h.y); w.y = pk2(h.z, h.w); *(u2*)(HN + (size_t)row * DM + col) = w; }
            if (has2) { const f4 sh = *(const f4*)(md1 + col), sc = *(const f4*)(md1 + 1024 + col); const f4 h = v1[j] * rs1 * (sc + 1.f) + sh; u2 w; w.x = pk2(h.x, h.y); w.y = pk2(h.z, h.w); *(u2*)(HN + (size_t)row2 * DM + col) = w; } }
    }
}
__device__ __forceinline__ void finalnorm_phase(KA a, int wid, int lane, int G) {
    const float* fw = a->in[23];
    const int gw = blockIdx.x * 8 + wid, NGW = G * 8;
    f4 wv[4];
#pragma unroll
    for (int j = 0; j < 4; ++j) wv[j] = *(const f4*)(fw + 4 * (lane + 64 * j));
    for (int row = gw; row < MLAT; row += 2 * NGW) {
        const int row2 = row + NGW; const bool has2 = row2 < MLAT;
        float* p0 = a->out + (size_t)row * DM; float* p1 = a->out + (size_t)(has2 ? row2 : row) * DM;
        f4 v0[4], v1[4]; float ss0 = 0.f, ss1 = 0.f;
#pragma unroll
        for (int j = 0; j < 4; ++j) { v0[j] = *(const f4*)(p0 + 4 * (lane + 64 * j)); v1[j] = *(const f4*)(p1 + 4 * (lane + 64 * j)); }
#pragma unroll
        for (int j = 0; j < 4; ++j) { ss0 += (v0[j].x * v0[j].x + v0[j].y * v0[j].y) + (v0[j].z * v0[j].z + v0[j].w * v0[j].w); ss1 += (v1[j].x * v1[j].x + v1[j].y * v1[j].y) + (v1[j].z * v1[j].z + v1[j].w * v1[j].w); }
#pragma unroll
        for (int o = 1; o < 64; o <<= 1) { ss0 += __shfl_xor(ss0, o); ss1 += __shfl_xor(ss1, o); }
        const float rs0 = rsqrtf(ss0 * (1.f / DM) + EPSN), rs1 = rsqrtf(ss1 * (1.f / DM) + EPSN);
#pragma unroll
        for (int j = 0; j < 4; ++j) { *(f4*)(p0 + 4 * (lane + 64 * j)) = v0[j] * rs0 * wv[j]; if (has2) *(f4*)(p1 + 4 * (lane + 64 * j)) = v1[j] * rs1 * wv[j]; }
    }
}

struct EpiWin {
    static constexpr bool PERM = true, AFTER_DRAIN = false;
    unsigned char* ws_; const float *qw, *kw;
    __device__ __forceinline__ void operator()(const pg8::f32x4 (&acc)[2][2][4][2], const pg8::Unit& u, int wr, int wc, int fr, int fq) const {
        bf16r* const Q = (bf16r*)(ws_ + WS_Q); bf16r* const Kb = (bf16r*)(ws_ + WS_K); bf16r* const Vb = (bf16r*)(ws_ + WS_V); bf16r* const XL = (bf16r*)(ws_ + WS_XL); bf16r* const GG = (bf16r*)(ws_ + WS_GG);
        const float* const cosT = (const float*)(ws_ + WS_COS); const float* const sinT = (const float*)(ws_ + WS_SIN);
        const int pn = u.pn, row0 = u.pm * 256 + wr * 64 + fr;
        if (pn >= 3) {
            const bool isg = pn >= 5; bf16r* dst = isg ? GG : XL; const int cb = (pn - (isg ? 5 : 3)) * 256 + wc * 32 + 8 * fq;
#pragma unroll
            for (int ai = 0; ai < 2; ++ai)
#pragma unroll
                for (int m = 0; m < 4; ++m) { const int row = row0 + ai * 128 + m * 16;
#pragma unroll
                    for (int bj = 0; bj < 2; ++bj)
#pragma unroll
                        for (int n = 0; n < 2; ++n) { pg8::f32x4 v = acc[ai][bj][m][n];
                            if (isg) { v[0] = gelu_tanh(v[0]); v[1] = gelu_tanh(v[1]); v[2] = gelu_tanh(v[2]); v[3] = gelu_tanh(v[3]); }
                            u2 w; w.x = pk2(v[0], v[1]); w.y = pk2(v[2], v[3]);
                            const int col = cb + bj * 128 + n * 4;
                            if (isg) *(u2*)(dst + (size_t)(row >> 4) * 8192 + (col >> 6) * 1024 + ((col >> 4) & 3) * 256 + (row & 15) * 16 + (col & 15)) = w;
                            else *(u2*)(dst + (size_t)row * 512 + col) = w; } }
            return;
        }
        if (pn == 2 && wc >= 2) {
#pragma unroll
            for (int ai = 0; ai < 2; ++ai)
#pragma unroll
                for (int m = 0; m < 4; ++m) { const int row = row0 + ai * 128 + m * 16; bf16r* base = Vb + (size_t)kvrow(row) * 128 + (wc - 2) * 64 + 8 * fq;
#pragma unroll
                    for (int bj = 0; bj < 2; ++bj)
#pragma unroll
                        for (int n = 0; n < 2; ++n) { const pg8::f32x4 v = acc[ai][bj][m][n]; u2 w; w.x = pk2(v[0], v[1]); w.y = pk2(v[2], v[3]);
                            *(u2*)(base + 32 * bj + 4 * n) = w; } }
            return;
        }
        const bool isk = pn == 2; const float* nw = isk ? kw : qw;
        pg8::f32x4 wv[2][2];
#pragma unroll
        for (int bj = 0; bj < 2; ++bj)
#pragma unroll
            for (int n = 0; n < 2; ++n) wv[bj][n] = *(const pg8::f32x4*)(nw + 32 * bj + 8 * fq + 4 * n);
        const float osc = isk ? 1.f : attn_body::C2;
#pragma unroll
        for (int am = 0; am < 4; ++am) { const int ai = am >> 1, m0 = (am & 1) * 2;
            pg8::f32x4 csv[2][2], snv[2][2];
            const bool lat_ = (row0 + ai * 128) < MLAT;
#pragma unroll
            for (int mm = 0; mm < 2; ++mm) { const int t = (row0 + ai * 128 + (m0 + mm) * 16) & 4095;
#pragma unroll
                for (int n = 0; n < 2; ++n) { csv[mm][n] = *(const pg8::f32x4*)(cosT + t * 32 + 8 * fq + 4 * n); snv[mm][n] = *(const pg8::f32x4*)(sinT + t * 32 + 8 * fq + 4 * n); } }
            __builtin_amdgcn_sched_barrier(0);
#pragma unroll
            for (int mm = 0; mm < 2; ++mm) { const int m = m0 + mm; const int row = row0 + ai * 128 + m * 16;
                float ss = 0.f;
#pragma unroll
                for (int bj = 0; bj < 2; ++bj)
#pragma unroll
                    for (int n = 0; n < 2; ++n) { const pg8::f32x4 v = acc[ai][bj][m][n]; ss += (v[0] * v[0] + v[1] * v[1]) + (v[2] * v[2] + v[3] * v[3]); }
                ss += __shfl_xor(ss, 16); ss += __shfl_xor(ss, 32);
                const float rstd = rsqrtf(ss * (1.f / 64.f) + EPSN) * osc;
                pg8::f32x4 y[2][2];
#pragma unroll
                for (int bj = 0; bj < 2; ++bj)
#pragma unroll
                    for (int n = 0; n < 2; ++n) y[bj][n] = acc[ai][bj][m][n] * rstd * wv[bj][n];
                if (lat_) {
#pragma unroll
                    for (int n = 0; n < 2; ++n) { const pg8::f32x4 cs = csv[mm][n], sn = snv[mm][n];
                        const pg8::f32x4 o0 = y[0][n] * cs - y[1][n] * sn, o1 = y[1][n] * cs + y[0][n] * sn; y[0][n] = o0; y[1][n] = o1; } }
                bf16r* base = isk ? Kb + (size_t)kvrow(row) * 128 + wc * 64 + 8 * fq : Q + (size_t)row * 512 + (4 * pn + wc) * 64 + 8 * fq;
#pragma unroll
                for (int bj = 0; bj < 2; ++bj)
#pragma unroll
                    for (int n = 0; n < 2; ++n) { u2 w; w.x = pk2(y[bj][n][0], y[bj][n][1]); w.y = pk2(y[bj][n][2], y[bj][n][3]); *(u2*)(base + 32 * bj + 4 * n) = w; }
            }
            __builtin_amdgcn_sched_barrier(0);
        }
    }
};
struct EpiRes {
    static constexpr bool PERM = false, AFTER_DRAIN = false;
    const float *base_lat, *base_ctx; float *out_lat, *out_ctx; const float* gate;
    __device__ __forceinline__ void operator()(const pg8::f32x4 (&acc)[2][2][4][2], const pg8::Unit& u, int wr, int wc, int fr, int fq) const {
        const int pm = u.pm; const bool isctx = pm >= 64;
        const float* base = isctx ? base_ctx + (size_t)(pm - 64) * 256 * DM : base_lat + (size_t)pm * 256 * DM;
        float* out = isctx ? out_ctx + (size_t)(pm - 64) * 256 * DM : out_lat + (size_t)pm * 256 * DM;
        const float* gt = gate + (isctx ? 4 : (pm >> 4)) * 6144;
        const int col0 = u.pn * 256 + wc * 32 + 4 * fq;
        pg8::f32x4 gv[2][2];
#pragma unroll
        for (int bj = 0; bj < 2; ++bj)
#pragma unroll
            for (int n = 0; n < 2; ++n) gv[bj][n] = *(const pg8::f32x4*)(gt + col0 + bj * 128 + n * 16);
#pragma unroll
        for (int am = 0; am < 4; ++am) {
            const int ai = am >> 1, m0 = (am & 1) * 2;
            pg8::f32x4 bs[2][2][2];
#pragma unroll
            for (int mm = 0; mm < 2; ++mm) { const size_t ro = (size_t)(ai * 128 + wr * 64 + (m0 + mm) * 16 + fr) * DM + col0;
#pragma unroll
                for (int bj = 0; bj < 2; ++bj)
#pragma unroll
                    for (int n = 0; n < 2; ++n) bs[mm][bj][n] = *(const pg8::f32x4*)(base + ro + bj * 128 + n * 16); }
            __builtin_amdgcn_sched_barrier(0);
#pragma unroll
            for (int mm = 0; mm < 2; ++mm) { const size_t ro = (size_t)(ai * 128 + wr * 64 + (m0 + mm) * 16 + fr) * DM + col0;
#pragma unroll
                for (int bj = 0; bj < 2; ++bj)
#pragma unroll
                    for (int n = 0; n < 2; ++n) *(pg8::f32x4*)(out + ro + bj * 128 + n * 16) = bs[mm][bj][n] + gv[bj][n] * acc[ai][bj][m0 + mm][n]; }
            __builtin_amdgcn_sched_barrier(0);
        }
    }
};
struct EpiUpConv {
    static constexpr bool PERM = true, AFTER_DRAIN = true;
    bf16r* ACT; const float* cw; const float* cb; int mrows;
    __device__ __forceinline__ void fused(pg8::f32x4 (&acc)[2][2][4][2], const pg8::Unit& u, int wr, int wc, int fr, int fq, PG8_LAS unsigned char* lds, int wid, int lane) const {
        constexpr int PITCH = 544;
#pragma unroll
        for (int ai = 0; ai < 2; ++ai)
#pragma unroll
            for (int m = 0; m < 4; ++m) { const int lr = ai * 128 + wr * 64 + m * 16 + fr;
#pragma unroll
                for (int bj = 0; bj < 2; ++bj)
#pragma unroll
                    for (int n = 0; n < 2; ++n) { const pg8::f32x4 v = acc[ai][bj][m][n]; u2 w; w.x = pk2(v[0], v[1]); w.y = pk2(v[2], v[3]);
                        *(PG8_LAS u2*)(lds + lr * PITCH + (bj * 128 + wc * 32 + 8 * fq + 4 * n) * 2) = w; } }
        LDS_WAIT(); __syncthreads();
        const int tid = wid * 64 + lane, cgp = tid & 15, rr = tid >> 4;
        const int ch = u.pn * 128 + 8 * cgp;
        float wg[3][8], wvv[3][8], bg[8], bv[8];
#pragma unroll
        for (int k = 0; k < 3; ++k)
#pragma unroll
            for (int h = 0; h < 2; ++h) { const f4 t0 = *(const f4*)(cw + k * DFF2 + ch + 4 * h), t1 = *(const f4*)(cw + k * DFF2 + DFF + ch + 4 * h);
                wg[k][4 * h] = t0.x; wg[k][4 * h + 1] = t0.y; wg[k][4 * h + 2] = t0.z; wg[k][4 * h + 3] = t0.w; wvv[k][4 * h] = t1.x; wvv[k][4 * h + 1] = t1.y; wvv[k][4 * h + 2] = t1.z; wvv[k][4 * h + 3] = t1.w; }
#pragma unroll
        for (int h = 0; h < 2; ++h) { const f4 t0 = *(const f4*)(cb + ch + 4 * h), t1 = *(const f4*)(cb + DFF + ch + 4 * h);
            bg[4 * h] = t0.x; bg[4 * h + 1] = t0.y; bg[4 * h + 2] = t0.z; bg[4 * h + 3] = t0.w; bv[4 * h] = t1.x; bv[4 * h + 1] = t1.y; bv[4 * h + 2] = t1.z; bv[4 * h + 3] = t1.w; }
        const int row_first = u.pm * 254 - 1, lr0 = 1 + 8 * rr;
        PG8_LAS const unsigned char* up = lds + 16 * cgp;
        u4 pg_ = *(PG8_LAS const u4*)(up + (lr0 - 1) * PITCH), pv_ = *(PG8_LAS const u4*)(up + (lr0 - 1) * PITCH + 256);
        u4 cg_ = *(PG8_LAS const u4*)(up + lr0 * PITCH), cv_ = *(PG8_LAS const u4*)(up + lr0 * PITCH + 256);
#pragma unroll
        for (int i = 0; i < 8; ++i) { const int lr = lr0 + i;
            if (lr <= 254) {
                const u4 ng_ = *(PG8_LAS const u4*)(up + (lr + 1) * PITCH), nv_ = *(PG8_LAS const u4*)(up + (lr + 1) * PITCH + 256);
                const int r = row_first + lr;
                if (r < mrows) {
                    const int p = r < MLAT ? (r & 4095) : ((r - MLAT) & 255), T = r < MLAT ? SEQL : CTXL;
                    const bool hp = p > 0, hn = p < T - 1;
                    const u4 z4 = (u4){0u, 0u, 0u, 0u};
                    const u4 pgm = hp ? pg_ : z4, pvm = hp ? pv_ : z4, ngm = hn ? ng_ : z4, nvm = hn ? nv_ : z4;
                    unsigned ow[4];
#pragma unroll
                    for (int e2 = 0; e2 < 4; ++e2) {
                        float o2[2];
#pragma unroll
                        for (int hh = 0; hh < 2; ++hh) { const int e = 2 * e2 + hh;
                            const float gp = hh ? bf_hi(pgm[e2]) : bf_lo(pgm[e2]), gc = hh ? bf_hi(cg_[e2]) : bf_lo(cg_[e2]), gn = hh ? bf_hi(ngm[e2]) : bf_lo(ngm[e2]);
                            const float vp = hh ? bf_hi(pvm[e2]) : bf_lo(pvm[e2]), vc = hh ? bf_hi(cv_[e2]) : bf_lo(cv_[e2]), vn = hh ? bf_hi(nvm[e2]) : bf_lo(nvm[e2]);
                            const float g = bg[e] + wg[1][e] * gc + wg[0][e] * gp + wg[2][e] * gn;
                            const float v = bv[e] + wvv[1][e] * vc + wvv[0][e] * vp + wvv[2][e] * vn;
                            o2[hh] = g * sigmoidf_(g) * v; }
                        ow[e2] = pk2(o2[0], o2[1]); }
                    u4 o; o.x = ow[0]; o.y = ow[1]; o.z = ow[2]; o.w = ow[3];
                    *(u4*)(ACT + (size_t)r * DFF + ch) = o;
                }
                pg_ = cg_; pv_ = cv_; cg_ = ng_; cv_ = nv_;
            } }
        LDS_WAIT(); __syncthreads();
    }
};
struct SplitOrder { int nsub, S, kslice, G, c;
    __device__ __forceinline__ bool next(int i, pg8::Unit& u) const { const int x = c + i * G; if (x >= nsub) return false; const int ks = x % S, t = x / S; u.pm = 64 + (t >> 2); u.pn = t & 3; u.koff = ks * kslice; return true; }
    __device__ __forceinline__ void a_ready(const pg8::Unit&) const {}
    __device__ __forceinline__ void done(const pg8::Unit&) const {} };
struct EpiPart {
    static constexpr bool PERM = false, AFTER_DRAIN = false;
    float* part; const float* gate; int kslice;
    __device__ __forceinline__ void operator()(const pg8::f32x4 (&acc)[2][2][4][2], const pg8::Unit& u, int wr, int wc, int fr, int fq) const {
        asm volatile("" : "+v"(fr), "+v"(fq));
        float* out = part + ((size_t)(u.koff / kslice) * MCTX + (size_t)(u.pm - 64) * 256) * DM;
        const float* gt = gate + 4 * 6144;
        const int col0 = u.pn * 256 + wc * 32 + 4 * fq;
        pg8::f32x4 gv[2][2];
#pragma unroll
        for (int bj = 0; bj < 2; ++bj)
#pragma unroll
            for (int n = 0; n < 2; ++n) gv[bj][n] = *(const pg8::f32x4*)(gt + col0 + bj * 128 + n * 16);
#pragma unroll
        for (int ai = 0; ai < 2; ++ai)
#pragma unroll
            for (int m = 0; m < 4; ++m) { const size_t ro = (size_t)(ai * 128 + wr * 64 + m * 16 + fr) * DM + col0;
#pragma unroll
                for (int bj = 0; bj < 2; ++bj)
#pragma unroll
                    for (int n = 0; n < 2; ++n) *(pg8::f32x4*)(out + ro + bj * 128 + n * 16) = gv[bj][n] * acc[ai][bj][m][n]; }
    }
};
struct OneUnit { pg8::Unit u;
    __device__ __forceinline__ bool next(int i, pg8::Unit& o) const { if (i) return false; o = u; return true; }
    __device__ __forceinline__ void a_ready(const pg8::Unit&) const {}
    __device__ __forceinline__ void done(const pg8::Unit&) const {} };

#define DPPF(old, src, ctrl) __builtin_bit_cast(float, __builtin_amdgcn_update_dpp(__builtin_bit_cast(int, (float)(old)), __builtin_bit_cast(int, (float)(src)), ctrl, 0xf, 0xf, false))
struct LruCtx { const bf16r* XLp; const bf16r* GWn; LAS const float* tab; LAS float* scr; int p0, T, n, tok, q; };
typedef _Float16 h2v __attribute__((ext_vector_type(2)));
__device__ __forceinline__ unsigned pkh2(float lo, float hi) { h2v v; v.x = (_Float16)lo; v.y = (_Float16)hi; return __builtin_bit_cast(unsigned, v); }
__device__ __forceinline__ float h2lo(unsigned w) { return (float)__builtin_bit_cast(h2v, w).x; }
__device__ __forceinline__ float h2hi(unsigned w) { return (float)__builtin_bit_cast(h2v, w).y; }
__device__ __forceinline__ void lru_conv_load(const LruCtx& c, int s, u4 (&raw)[8]) {
    const int i = 16 * s + c.tok, p = c.p0 + i;
#pragma unroll
    for (int ks = 0; ks < 2; ++ks)
#pragma unroll
        for (int k = 0; k < 4; ++k) { const int pp = p + k - 2; const bool ok = pp >= 0 && pp < c.T;
            raw[4 * ks + k] = *(const u4*)(c.XLp + (ptrdiff_t)(ok ? i + k - 2 : i) * 512 + 32 * ks + 8 * c.q); }
}
__device__ __forceinline__ void lru_conv(const LruCtx& c, int s, const u4 (&raw)[8], s8v (&frag)[2], f4 (&xc)[4]) {
    const int i = 16 * s + c.tok, p = c.p0 + i;
    float xb[2][8];
#pragma unroll
    for (int ks = 0; ks < 2; ++ks) { const int c0 = 32 * ks + 8 * c.q, chn = 64 * c.n + c0;
#pragma unroll
        for (int h = 0; h < 2; ++h) { const f4 t = *(LAS const f4*)(c.tab + 2048 + chn + 4 * h); xb[ks][4 * h] = t.x; xb[ks][4 * h + 1] = t.y; xb[ks][4 * h + 2] = t.z; xb[ks][4 * h + 3] = t.w; }
#pragma unroll
        for (int k = 0; k < 4; ++k) { const int pp = p + k - 2; const bool ok = pp >= 0 && pp < c.T;
            const u4 rw = raw[4 * ks + k];
#pragma unroll
            for (int h = 0; h < 2; ++h) { f4 w = *(LAS const f4*)(c.tab + k * 512 + chn + 4 * h); if (!ok) w = (f4){0.f, 0.f, 0.f, 0.f};
                xb[ks][4 * h] += w.x * bf_lo(rw[2 * h]); xb[ks][4 * h + 1] += w.y * bf_hi(rw[2 * h]); xb[ks][4 * h + 2] += w.z * bf_lo(rw[2 * h + 1]); xb[ks][4 * h + 3] += w.w * bf_hi(rw[2 * h + 1]); } } }
#pragma unroll
    for (int ks = 0; ks < 2; ++ks) { LAS float* sp = c.scr + c.tok * 68 + 32 * ks + 8 * c.q;
        *(LAS f4*)sp = (f4){xb[ks][0], xb[ks][1], xb[ks][2], xb[ks][3]}; *(LAS f4*)(sp + 4) = (f4){xb[ks][4], xb[ks][5], xb[ks][6], xb[ks][7]};
        u4 w; w.x = pk2(xb[ks][0], xb[ks][1]); w.y = pk2(xb[ks][2], xb[ks][3]); w.z = pk2(xb[ks][4], xb[ks][5]); w.w = pk2(xb[ks][6], xb[ks][7]); frag[ks] = __builtin_bit_cast(s8v, w); }
    LDS_WAIT();
#pragma unroll
    for (int rb = 0; rb < 4; ++rb) xc[rb] = *(LAS const f4*)(c.scr + c.tok * 68 + 16 * rb + 4 * c.q);
    LDS_WAIT();
}
__device__ __forceinline__ void lru_wload(const LruCtx& c, int dir, s8v (&W)[16]) {
    const bf16r* gwa = c.GWn + (size_t)(dir * 2) * 8 * 4096, *gwx = gwa + 8 * 4096;
#pragma unroll
    for (int rb = 0; rb < 4; ++rb)
#pragma unroll
        for (int ks = 0; ks < 2; ++ks) { const int off = (16 * rb + c.tok) * 64 + 32 * ks + 8 * c.q; W[4 * rb + 2 * ks] = *(const s8v*)(gwa + off); W[4 * rb + 2 * ks + 1] = *(const s8v*)(gwx + off); }
}
__device__ __forceinline__ void lru_gates(const LruCtx& c, int dir, const s8v (&W)[16], const s8v (&frag)[2], const f4 (&xc)[4], float (&LA)[16], float (&AV)[16], float (&B)[16]) {
    f4 ga[4], gx[4];
#pragma unroll
    for (int rb = 0; rb < 4; ++rb) { ga[rb] = (f4){0.f, 0.f, 0.f, 0.f}; gx[rb] = (f4){0.f, 0.f, 0.f, 0.f};
#pragma unroll
        for (int ks = 0; ks < 2; ++ks) {
            ga[rb] = __builtin_amdgcn_mfma_f32_16x16x32_bf16(W[4 * rb + 2 * ks], frag[ks], ga[rb], 0, 0, 0);
            gx[rb] = __builtin_amdgcn_mfma_f32_16x16x32_bf16(W[4 * rb + 2 * ks + 1], frag[ks], gx[rb], 0, 0, 0); } }
#pragma unroll
    for (int rb = 0; rb < 4; ++rb) { const int chn = dir * 512 + 64 * c.n + 16 * rb + 4 * c.q;
        const f4 ba = *(LAS const f4*)(c.tab + 2560 + chn), bx = *(LAS const f4*)(c.tab + 3584 + chn), cl = *(LAS const f4*)(c.tab + 4608 + chn);
#pragma unroll
        for (int j = 0; j < 4; ++j) { const float r = sigmoidf_(ga[rb][j] + ba[j]), ii = sigmoidf_(gx[rb][j] + bx[j]);
            const float la = cl[j] * r, z = 2.f * la, av = fexp(la);
            const float om = (z > -0.0078125f) ? -z * (1.f + 0.5f * z) : __builtin_fmaf(-av, av, 1.f);
            LA[4 * rb + j] = la; AV[4 * rb + j] = av; B[4 * rb + j] = __builtin_amdgcn_sqrtf(om) * ii * xc[rb][j]; } }
}
__device__ __forceinline__ void scan_fwd(float (&A)[16], float (&B)[16]) {
#pragma unroll
    for (int k = 0; k < 16; ++k) { float a_ = A[k], b_ = B[k], ap, bp;
        ap = DPPF(1.f, a_, 0x111); bp = DPPF(0.f, b_, 0x111); b_ = a_ * bp + b_; a_ = a_ * ap;
        ap = DPPF(1.f, a_, 0x112); bp = DPPF(0.f, b_, 0x112); b_ = a_ * bp + b_; a_ = a_ * ap;
        ap = DPPF(1.f, a_, 0x114); bp = DPPF(0.f, b_, 0x114); b_ = a_ * bp + b_; a_ = a_ * ap;
        ap = DPPF(1.f, a_, 0x118); bp = DPPF(0.f, b_, 0x118); b_ = a_ * bp + b_; a_ = a_ * ap;
        A[k] = a_; B[k] = b_; }
}
__device__ __forceinline__ void scan_bwd(float (&A)[16], float (&B)[16]) {
#pragma unroll
    for (int k = 0; k < 16; ++k) { float a_ = A[k], b_ = B[k], ap, bp;
        ap = DPPF(1.f, a_, 0x101); bp = DPPF(0.f, b_, 0x101); b_ = a_ * bp + b_; a_ = a_ * ap;
        ap = DPPF(1.f, a_, 0x102); bp = DPPF(0.f, b_, 0x102); b_ = a_ * bp + b_; a_ = a_ * ap;
        ap = DPPF(1.f, a_, 0x104); bp = DPPF(0.f, b_, 0x104); b_ = a_ * bp + b_; a_ = a_ * ap;
        ap = DPPF(1.f, a_, 0x108); bp = DPPF(0.f, b_, 0x108); b_ = a_ * bp + b_; a_ = a_ * ap;
        A[k] = a_; B[k] = b_; }
}
__device__ __forceinline__ void lru_tables(KA a, int l, LAS float* tab, int tid) {
    for (int e = tid; e < 5632; e += 512) { float v;
        if (e < 2048) v = a->in[9][l * 2048 + e];
        else if (e < 2560) v = a->in[10][l * 512 + (e - 2048)];
        else if (e < 3584) v = a->in[12][l * 1024 + (e - 2560)];
        else if (e < 4608) v = a->in[14][l * 1024 + (e - 3584)];
        else { const float lam = a->in[15][l * 1024 + (e - 4608)]; const float x = fexp(-lam); const float sp = x < 0.03f ? x * (1.f - x * (0.5f - x * (0.33333334f - x * 0.25f))) : (lam < -20.f ? -lam : __builtin_amdgcn_logf(1.f + x) * 0.6931471805599453f); v = -8.f * sp; }
        tab[e] = v; }
}
__device__ __forceinline__ void lru_l1_tile(KA a, int l, int b, int cid, int dir, LAS unsigned char* lds, int tid, int wid, int lane) {
    asm volatile("" : "+v"(lane), "+v"(tid));
    unsigned char* ws = a->ws;
    LAS float* tab = (LAS float*)(lds + L1_TAB_OFF); LAS float* scr = (LAS float*)(lds + L1_TAB_OFF + 22528) + wid * (16 * 68);
    LruCtx c; c.n = wid; c.tok = lane & 15; c.q = lane >> 4; c.tab = tab; c.scr = scr;
    const bool isctx = cid < 4; c.p0 = (isctx ? cid : cid - 4) * 64; c.T = isctx ? CTXL : SEQL;
    const int rowbase = isctx ? MLAT + b * CTXL + c.p0 : b * SEQL + c.p0;
    c.XLp = (const bf16r*)(ws + WS_XL) + (size_t)rowbase * 512 + c.n * 64;
    c.GWn = (const bf16r*)(ws + WS_GW) + (size_t)(l * 4) * 8 * 4096 + c.n * 4096;
    float* AGGA = (float*)(ws + WS_AGGA); float* AGGB = (float*)(ws + WS_AGGB);
    unsigned* LAB = (unsigned*)(ws + WS_LAB) + (size_t)(rowbase >> 4) * 8192 + 1024 * c.n + 16 * c.tok + 4 * c.q;
    const int bl = (lane & 48) | 15, bf_ = (lane & 48);
    {
        LAS float* rab = (LAS float*)(lds + L1_TAB_OFF + 22528 + 34816) + wid * 128 + c.q * 32;
#pragma unroll
        for (int k = 0; k < 16; ++k) { rab[2 * k] = 1.f; rab[2 * k + 1] = 0.f; }
        s8v W[16];
        lru_wload(c, dir, W);
        u4 rawc[8];
        lru_conv_load(c, 0, rawc);
#pragma unroll 1
        for (int s = 0; s < 4; ++s) {
            s8v frag[2]; f4 xc[4];
            lru_conv(c, s, rawc, frag, xc);
            __builtin_amdgcn_sched_barrier(0);
            lru_conv_load(c, s < 3 ? s + 1 : 3, rawc);
            __builtin_amdgcn_sched_barrier(0);
            float LAv[16], A[16], B[16];
            lru_gates(c, dir, W, frag, xc, LAv, A, B);
            unsigned* lp = LAB + (size_t)dir * MALL * 512 + (size_t)s * 8192;
#pragma unroll
            for (int rb = 0; rb < 4; ++rb) { u4 w; w.x = pkh2(LAv[4 * rb], B[4 * rb]); w.y = pkh2(LAv[4 * rb + 1], B[4 * rb + 1]); w.z = pkh2(LAv[4 * rb + 2], B[4 * rb + 2]); w.w = pkh2(LAv[4 * rb + 3], B[4 * rb + 3]); *(u4*)(lp + 256 * rb) = w; }
            if (dir == 0) scan_fwd(A, B); else scan_bwd(A, B);
#pragma unroll
            for (int k = 0; k < 16; ++k) {
                const float a_ = __shfl(A[k], dir ? bf_ : bl), b_ = __shfl(B[k], dir ? bf_ : bl);
                const float ra = rab[2 * k], rb_ = rab[2 * k + 1];
                if (dir == 0) { rab[2 * k + 1] = a_ * rb_ + b_; rab[2 * k] = a_ * ra; }
                else { rab[2 * k + 1] = ra * b_ + rb_; rab[2 * k] = ra * a_; } }
            LDS_WAIT();
        }
        if (c.tok == 0) { const size_t o = ((size_t)(b * 2 + dir) * NCH + cid) * 512 + 64 * c.n + 4 * c.q;
#pragma unroll
            for (int rb = 0; rb < 4; ++rb) { *(f4*)(AGGA + o + 16 * rb) = (f4){rab[8 * rb], rab[8 * rb + 2], rab[8 * rb + 4], rab[8 * rb + 6]}; *(f4*)(AGGB + o + 16 * rb) = (f4){rab[8 * rb + 1], rab[8 * rb + 3], rab[8 * rb + 5], rab[8 * rb + 7]}; } }
    }
    LDS_WAIT(); __syncthreads();
}
__device__ __forceinline__ void lru_l2_tile(KA a, int l, int b, int cid, LAS unsigned char* lds, int tid, int wid, int lane) {
    asm volatile("" : "+v"(lane));
    unsigned char* ws = a->ws;
    LAS float* part = (LAS float*)lds;
    LAS float* hfl = (LAS float*)(lds + 4096) + wid * 4096 + lane;
    const int n = wid, tok = lane & 15, q = lane >> 4;
    const bool isctx = cid < 4; const int p0 = (isctx ? cid : cid - 4) * 64;
    const int rowbase = isctx ? MLAT + b * CTXL + p0 : b * SEQL + p0;
    const float* AGGA = (const float*)(ws + WS_AGGA); const float* AGGB = (const float*)(ws + WS_AGGB);
    const unsigned* LAB = (const unsigned*)(ws + WS_LAB) + (size_t)(rowbase >> 4) * 8192 + 1024 * n + 16 * tok + 4 * q;
    const bf16r* GGp = (const bf16r*)(ws + WS_GG) + (size_t)(rowbase >> 4) * 8192 + 1024 * n + 16 * tok + 4 * q;
    const int bl = (lane & 48) | 15, bf_ = (lane & 48);
    float hin[16], hinb[16], A[16], B[16];
#pragma unroll 1
    for (int dir = 0; dir < 2; ++dir) {
        const float* ap_ = AGGA + ((size_t)(b * 2 + dir) * NCH) * 512 + 64 * n + 4 * q; const float* bp_ = AGGB + ((size_t)(b * 2 + dir) * NCH) * 512 + 64 * n + 4 * q;
#pragma unroll
        for (int k = 0; k < 16; ++k) { A[k] = 1.f; B[k] = 0.f; }
#pragma unroll
        for (int eb = 0; eb < 5; eb += 3) {
            f4 avv[3][4], bvv[3][4]; bool okv[3];
#pragma unroll
            for (int e2 = 0; e2 < 3; ++e2) { if (eb + e2 < 5) { const int o = 5 * tok + eb + e2; int ch; bool ok;
                if (dir == 0) { ch = o; ok = o < cid; } else { ch = o < 4 ? 3 - o : 71 - o; ok = isctx ? (o < 4 && ch > cid) : (o < 4 || (o < 68 && ch > cid)); }
                ch = ch < 0 ? 0 : (ch > NCH - 1 ? NCH - 1 : ch); okv[e2] = ok;
#pragma unroll
                for (int rb = 0; rb < 4; ++rb) { avv[e2][rb] = *(const f4*)(ap_ + (size_t)ch * 512 + 16 * rb); bvv[e2][rb] = *(const f4*)(bp_ + (size_t)ch * 512 + 16 * rb); } } }
            __builtin_amdgcn_sched_barrier(0);
#pragma unroll
            for (int e2 = 0; e2 < 3; ++e2) { if (eb + e2 < 5) {
#pragma unroll
                for (int rb = 0; rb < 4; ++rb) { f4 av = avv[e2][rb], bv = bvv[e2][rb];
                    if (!okv[e2]) { av = (f4){1.f, 1.f, 1.f, 1.f}; bv = (f4){0.f, 0.f, 0.f, 0.f}; }
#pragma unroll
                    for (int jj = 0; jj < 4; ++jj) { B[4 * rb + jj] = av[jj] * B[4 * rb + jj] + bv[jj]; A[4 * rb + jj] = av[jj] * A[4 * rb + jj]; } } } }
            __builtin_amdgcn_sched_barrier(0);
        }
        scan_fwd(A, B);
        if (dir == 0) {
#pragma unroll
            for (int k = 0; k < 16; ++k) hin[k] = __shfl(B[k], bl);
        } else {
#pragma unroll
            for (int k = 0; k < 16; ++k) hinb[k] = __shfl(B[k], bl);
        }
    }
    u4 wc_[4], wn_[4]; u2 gc_[4], gn_[4];
#pragma unroll
    for (int rb = 0; rb < 4; ++rb) { wc_[rb] = *(const u4*)(LAB + 256 * rb); gc_[rb] = (u2){0u, 0u}; gn_[rb] = (u2){0u, 0u}; }
#pragma unroll 1
    for (int st = 0; st < 8; ++st) {
        const int s = st < 4 ? st : 7 - st;
        { const int sn = st + 1 < 8 ? st + 1 : 7; const int s2 = sn < 4 ? sn : 7 - sn; const bool bw = sn >= 4;
          const unsigned* lp_ = LAB + (size_t)(bw ? MALL : 0) * 512 + (size_t)s2 * 8192; const bf16r* gp_ = GGp + (size_t)s2 * 8192;
#pragma unroll
          for (int rb = 0; rb < 4; ++rb) { wn_[rb] = *(const u4*)(lp_ + 256 * rb); gn_[rb] = *(const u2*)(gp_ + 256 * rb); } }
        __builtin_amdgcn_sched_barrier(0);
#pragma unroll
        for (int rb = 0; rb < 4; ++rb)
#pragma unroll
            for (int j = 0; j < 4; ++j) { A[4 * rb + j] = fexp(h2lo(wc_[rb][j])); B[4 * rb + j] = h2hi(wc_[rb][j]); }
        LAS float* hs = hfl + s * 1024;
        if (st < 4) {
            scan_fwd(A, B);
#pragma unroll
            for (int k = 0; k < 16; ++k) { const float h = A[k] * hin[k] + B[k]; hs[k * 64] = h; hin[k] = __shfl(h, bl); }
        } else {
            if (st == 4) {
#pragma unroll
                for (int k = 0; k < 16; ++k) hin[k] = hinb[k]; }
            scan_bwd(A, B);
            float sq = 0.f;
#pragma unroll
            for (int rb = 0; rb < 4; ++rb)
#pragma unroll
                for (int j = 0; j < 4; ++j) { const int k = 4 * rb + j; const float h = A[k] * hin[k] + B[k]; hin[k] = __shfl(h, bf_);
                    const float gg = (j & 1) ? bf_hi(gc_[rb][j >> 1]) : bf_lo(gc_[rb][j >> 1]);
                    const float r = (hs[k * 64] + h) * gg; hs[k * 64] = r; sq += r * r; }
            sq += __shfl_xor(sq, 16); sq += __shfl_xor(sq, 32); if (q == 0) part[wid * 64 + 16 * s + tok] = sq;
        }
#pragma unroll
        for (int rb = 0; rb < 4; ++rb) { wc_[rb] = wn_[rb]; gc_[rb] = gn_[rb]; }
    }
    LDS_WAIT(); __syncthreads();
    bf16r* MIX = (bf16r*)(ws + WS_MIX);
#pragma unroll 1
    for (int s = 0; s < 4; ++s) { float t = 0.f;
#pragma unroll
        for (int w = 0; w < 8; ++w) t += part[w * 64 + 16 * s + tok];
        const float rstd = rsqrtf(t * (1.f / 512.f) + EPSN);
        bf16r* mp = MIX + (size_t)(rowbase + 16 * s + tok) * DM + 512 + 64 * n + 4 * q;
        const LAS float* hs = hfl + s * 1024;
#pragma unroll
        for (int rb = 0; rb < 4; ++rb) { u2 w; w.x = pk2(hs[(4 * rb) * 64] * rstd, hs[(4 * rb + 1) * 64] * rstd); w.y = pk2(hs[(4 * rb + 2) * 64] * rstd, hs[(4 * rb + 3) * 64] * rstd); *(u2*)(mp + 16 * rb) = w; } }
    const bf16r* O = (const bf16r*)(ws + WS_O) + (size_t)(rowbase + wid * 8) * 512 + 8 * lane;
    u4 rawc = *(const u4*)O;
#pragma unroll 1
    for (int tt = 0; tt < 8; ++tt) {
        const u4 rawn = *(const u4*)(O + (size_t)(tt < 7 ? tt + 1 : 7) * 512);
        float v[8]; float ss = 0.f;
#pragma unroll
        for (int e = 0; e < 4; ++e) { v[2 * e] = bf_lo(rawc[e]); v[2 * e + 1] = bf_hi(rawc[e]); ss += v[2 * e] * v[2 * e] + v[2 * e + 1] * v[2 * e + 1]; }
        const float rstd = rsqrtf(wave_sum(ss) * (1.f / 512.f) + EPSN);
        u4 o; o.x = pk2(v[0] * rstd, v[1] * rstd); o.y = pk2(v[2] * rstd, v[3] * rstd); o.z = pk2(v[4] * rstd, v[5] * rstd); o.w = pk2(v[6] * rstd, v[7] * rstd);
        *(u4*)(MIX + (size_t)(rowbase + wid * 8 + tt) * DM + 8 * lane) = o;
        rawc = rawn; }
    LDS_WAIT(); __syncthreads();
}

#define GAS __attribute__((address_space(1)))
#define XB_TMO      128
#define XB_XCNT(j)  (256  + 64 * (j))
#define XB_XSUB(j)  (1280 + 64 * (j))
#define XB_XGEN(j)  (2304 + 64 * (j))
#define XB_TOP      3328
#define XB_TOPGEN   3392
#define XCD_BAR_WORDS 3456
#define XB_SPIN_CAP (1u << 18)

__device__ __forceinline__ unsigned xb_ld(unsigned* p)              { return __hip_atomic_load(p, __ATOMIC_RELAXED, __HIP_MEMORY_SCOPE_AGENT); }
__device__ __forceinline__ unsigned xb_add(unsigned* p, unsigned v) { return __hip_atomic_fetch_add(p, v, __ATOMIC_RELAXED, __HIP_MEMORY_SCOPE_AGENT); }
__device__ __forceinline__ unsigned xb_xcc_id() { return (unsigned)__builtin_amdgcn_s_getreg((3 << 11) | 20) & 0xFu; }
#define XB_SPIN(cond, bar) do { unsigned _sp = 0; while (cond) { __builtin_amdgcn_s_sleep(1); \
    if ((++_sp & 255u) == 0u) { if (xb_ld(&(bar)[XB_TMO])) break; if (_sp > XB_SPIN_CAP) { atomicAdd(&(bar)[XB_TMO], 1u); break; } } } } while (0)

struct XcdBarrier {
    unsigned* bar; unsigned x;
    volatile LAS unsigned* st;
};

__device__ __forceinline__ XcdBarrier xcd_barrier_post(unsigned* bar, volatile LAS unsigned* st) {
    XcdBarrier b; b.bar = bar; b.x = xb_xcc_id(); b.st = st;
    if (threadIdx.x == 0) (void)xb_add(&bar[XB_XCNT(b.x)], 1u);
    return b;
}
__device__ __forceinline__ void xcd_barrier_complete(unsigned* bar, unsigned x, unsigned& nloc, unsigned& nx) {
    const unsigned G = gridDim.x * gridDim.y * gridDim.z;
    unsigned sum, cnt, mine, sp = 0u;
    for (;;) {
        sum = 0u; cnt = 0u; mine = 0u;
#pragma unroll
        for (unsigned j = 0; j < 16; ++j) { const unsigned c = xb_ld(&bar[XB_XCNT(j)]); sum += c; cnt += (c > 0u) ? 1u : 0u; mine = (j == x) ? c : mine; }
        if (sum == G) break;
        __builtin_amdgcn_s_sleep(1);
        if ((++sp & 255u) == 0u) { if (xb_ld(&bar[XB_TMO])) break; if (sp > XB_SPIN_CAP) { atomicAdd(&bar[XB_TMO], 1u); break; } }
    }
    nloc = mine > 0u ? mine : 1u; nx = cnt > 0u ? cnt : 1u;
}

__device__ __forceinline__ void xcd_barrier(const XcdBarrier& b) {
    asm volatile("s_waitcnt vmcnt(0)" ::: "memory");
    __syncthreads();
    if (threadIdx.x == 0) {
        unsigned* bar = b.bar;
        __builtin_amdgcn_s_waitcnt(0);
        unsigned nloc = b.st[0], nx = b.st[1];
        if (nloc == 0u) { xcd_barrier_complete(bar, b.x, nloc, nx); b.st[0] = nloc; b.st[1] = nx; }
        const unsigned old = xb_add(&bar[XB_XSUB(b.x)], 1u);
        const unsigned gen = old / nloc;
        if (old + 1u == (gen + 1u) * nloc) {
            __builtin_amdgcn_fence(__ATOMIC_RELEASE, "agent");
            asm volatile("s_waitcnt vmcnt(0)" ::: "memory");
            const unsigned og = xb_add(&bar[XB_TOP], 1u);
            const unsigned tg = og / nx;
            if (og + 1u == (tg + 1u) * nx) xb_add(&bar[XB_TOPGEN], 1u);
            else XB_SPIN(xb_ld(&bar[XB_TOPGEN]) == tg, bar);
            __builtin_amdgcn_fence(__ATOMIC_ACQUIRE, "agent");
            xb_add(&bar[XB_XGEN(b.x)], 1u);
            asm volatile("s_waitcnt vmcnt(0)" ::: "memory");
        } else {
            XB_SPIN(xb_ld(&bar[XB_XGEN(b.x)]) == gen, bar);
            __builtin_amdgcn_fence(__ATOMIC_ACQUIRE, "agent");
            asm volatile("s_waitcnt vmcnt(0)" ::: "memory");
        }
    }
    __syncthreads();
}

#ifndef REP_PH
#define REP_PH -1
#endif
#ifndef REP_SKIP_L1
#define REP_SKIP_L1 0
#endif
#ifndef USE_XBAR
#define USE_XBAR 1
#endif
__global__ void __launch_bounds__(512, 2) mega(Args a_) {
    extern __shared__ __attribute__((aligned(16))) unsigned char lds_raw[];
    LAS unsigned char* lds = (LAS unsigned char*)lds_raw;
    const int G = gridDim.x, bx = blockIdx.x;
    const int vcu = (G % 8 == 0) ? (bx % 8) * (G / 8) + bx / 8 : bx;
    KA a = (KA)__builtin_amdgcn_kernarg_segment_ptr();
    volatile LAS unsigned* bst = (volatile LAS unsigned*)(lds + LDS_BYTES - 64);
    if (threadIdx.x < 2) bst[threadIdx.x] = 0u;
    __syncthreads();
    (void)xcd_barrier_post((unsigned*)a->ws, bst);
    int nsync = 0;
#define GRID_SYNC() do { if (!USE_XBAR || a->ph_lo < 0) cg::this_grid().sync();     else { XcdBarrier xb_; xb_.bar = (unsigned*)a->ws; xb_.x = xb_xcc_id(); xb_.st = (volatile LAS unsigned*)(lds + LDS_BYTES - 64); xcd_barrier(xb_); } ++nsync; } while (0)
    const int ph_hi = a->ph_hi;
    for (int ph = a->ph_lo; ph < ph_hi; ++ph) {
        asm volatile("" : "+s"(a));
        for (int rep = 0; rep < (ph == REP_PH ? 2 : 1); ++rep) {
        if (rep) GRID_SYNC();
#define TL const int tid = mk_tid(), lane = tid & 63, wid = __builtin_amdgcn_readfirstlane(tid >> 6); (void)tid; (void)lane; (void)wid
        unsigned char* ws = a->ws;
        float* MOD = (float*)(ws + WS_MOD); float* ctxres = (float*)(ws + WS_CTXRES);
        bf16r* HN = (bf16r*)(ws + WS_HN);
        if (ph == 0) { if (PON(8)) { TL; p0_phase(a, lds, tid, wid, lane, G); } }
        else if (ph == NPHASE - 1) { if (PON(9)) { TL; finalnorm_phase(a, wid, lane, G); } }
        else {
            const int l = (ph - 1) >> 3, sub = (ph - 1) & 7;
            unsigned char* wl = ws + WS_W + (size_t)l * W_LAYER;
            const bool ctx_out = l == 0;
            if (sub == 0) { if (PON(0)) { TL; prenorm_phase(a, l, 0, MALL, l == 0 ? 0 : 11, l == 0 ? a->in[2] : ctxres, wid, lane, G); } }
            else if (sub == 1) { if (PON(1)) {
                pg8::Gemm g{HN, (const bf16r*)(wl + W_IN), MALL, DIN, DM, 256, DM}; pg8::StaticOrder S; S.init(MALL, DIN, G, bx);
                EpiWin E{ws, a->in[7] + l * 64, a->in[8] + l * 64};
                pg8::gemm_phase<EpiWin, pg8::StaticOrder, true, true>(lds, g, S, E); }
            } else if (sub == 2) { if (PON(2)) { TL;
                const int nctx = ctx_out ? 4 : 0, cnt = 64 + nctx + ((rep && REP_SKIP_L1) ? 0 : 68);
                attn_body::bf16* Qb = (attn_body::bf16*)(ws + WS_Q); attn_body::bf16* Ob = (attn_body::bf16*)(ws + WS_O); const attn_body::bf16* Kb = (const attn_body::bf16*)(ws + WS_K); const attn_body::bf16* Vb = (const attn_body::bf16*)(ws + WS_V);
                LAS unsigned char* l3 = lds; asm volatile("" : "+s"(l3)); char* shm = (char*)l3;
                volatile LAS int* qw = (volatile LAS int*)(lds + LDS_BYTES - 32);
                unsigned* qctr = (unsigned*)ws + 3584 + (l * 2 + rep) * 8 * 64;
                const int hx = (int)(xb_xcc_id() & 7u);
                lru_tables(a, l, (LAS float*)(lds + L1_TAB_OFF), tid); __syncthreads();
                for (int li = 0; li < 8; ++li) { const int x = (hx + li) & 7; const int b = x >> 1, kvh = x & 1;
                    for (;;) {
                        __syncthreads();
                        if (tid == 0) *qw = (int)__hip_atomic_fetch_add(qctr + x * 64, 1u, __ATOMIC_RELAXED, __HIP_MEMORY_SCOPE_AGENT);
                        __syncthreads();
                        const int i = __builtin_amdgcn_readfirstlane(*qw);
                        if (i >= cnt) break;
                        if (i < 64 + nctx) {
                            const bool lat = i < 64; const int h = kvh * 4 + (lat ? (i >> 4) : (i - 64));
                            const size_t qo = (size_t)(lat ? b * SEQL + (i & 15) * 256 : MLAT + b * CTXL) * 512 + h * 64;
                            attn_body::attn_unit<8>(Qb + qo, Kb + (size_t)b * KVR * 128 + kvh * 64, Vb + (size_t)b * KVR * 128 + kvh * 64, Ob + qo, lat ? NCH : 4, shm);
                        } else { const int it = i - 64 - nctx, t = x * 34 + (it >> 1); lru_l1_tile(a, l, t / NCH, t % NCH, it & 1, lds, tid, wid, lane); }
                    }
                } }
            } else if (sub == 3) { if (PON(3)) { TL;
                const int nt = ctx_out ? 4 * NCH : 4 * 64;
                for (int t = vcu; t < nt; t += G) { int b, cid; if (ctx_out) { b = t / NCH; cid = t % NCH; } else { b = t >> 6; cid = 4 + (t & 63); }
                    lru_l2_tile(a, l, b, cid, lds, tid, wid, lane); } }
            } else if (sub == 4) { if (PON(4)) {
                { pg8::Gemm g{(const bf16r*)(ws + WS_MIX), (const bf16r*)(wl + W_OUT), MLAT, DM, DM, 256, DM}; pg8::StaticOrder S; S.init(MLAT, DM, G, bx);
                  EpiRes E{l == 0 ? a->in[0] : a->out, l == 0 ? a->in[2] : ctxres, a->out, ctxres, MOD + l * 5 * 6144 + 2 * 1024};
                  pg8::gemm_phase<EpiRes, pg8::StaticOrder, true, true>(lds, g, S, E); }
                if (ctx_out) {
                    pg8::Gemm g{(const bf16r*)(ws + WS_MIX), (const bf16r*)(wl + W_OUT), MALL, DM, 256, 256, DM}; SplitOrder S{64, 4, 256, G, bx};
                    EpiPart E{(float*)(ws + WS_PART), MOD + l * 5 * 6144 + 2 * 1024, 256};
                    pg8::gemm_phase<EpiPart, SplitOrder, true, true>(lds, g, S, E); } }
            } else if (sub == 5) { if (PON(5)) { TL; prenorm_phase(a, l, 1, ctx_out ? MALL : MLAT, ctx_out ? 4 : 0, ctx_out ? a->in[2] : ctxres, wid, lane, G); } }
            else if (sub == 6) { if (PON(6)) {
                const int mrows = ctx_out ? MALL : MLAT, nM = (mrows + 253) / 254;
                pg8::Gemm g{HN - DM, (const bf16r*)(wl + W_UP), nM * 256, DFF2, DM, 254, DM}; pg8::StaticOrder S; S.init(nM * 256, DFF2, G, bx);
                EpiUpConv E{(bf16r*)(ws + WS_ACT), a->in[20] + (size_t)l * 3 * DFF2, a->in[21] + (size_t)l * DFF2, mrows};
                for (int i = 0;; ++i) { pg8::Unit u; if (!S.next(i, u)) break; OneUnit S1{u}; pg8::gemm_phase<EpiUpConv, OneUnit, false, true>(lds, g, S1, E); } }
            } else { if (PON(7)) {
                { pg8::Gemm g{(const bf16r*)(ws + WS_ACT), (const bf16r*)(wl + W_DOWN), MLAT, DM, DFF, 256, DFF}; pg8::StaticOrder S; S.init(MLAT, DM, G, bx);
                  EpiRes E{a->out, ctxres, a->out, ctxres, MOD + l * 5 * 6144 + 5 * 1024};
                  pg8::gemm_phase<EpiRes, pg8::StaticOrder, true, true>(lds, g, S, E); }
                if (ctx_out) {
                    pg8::Gemm g{(const bf16r*)(ws + WS_ACT), (const bf16r*)(wl + W_DOWN), MALL, DM, 256, 256, DFF}; SplitOrder S{176, 11, 256, G, bx};
                    EpiPart E{(float*)(ws + WS_PART), MOD + l * 5 * 6144 + 5 * 1024, 256};
                    pg8::gemm_phase<EpiPart, SplitOrder, true, true>(lds, g, S, E); } }
            }
        }
        }
        if (ph + 1 < ph_hi) GRID_SYNC();
    }
}

extern "C" void kernel_launch(void* const* d_in, const int* in_sizes, int n_in, void* d_out, int out_size, void* d_ws, size_t ws_size, hipStream_t stream) {
    static int grid = 0;
    if (grid == 0) {
        int dev = 0, cus = 0, per_cu = 0;
        if (n_in != 24 || ws_size < 255 * MiB) { fprintf(stderr, "kernel_launch: unexpected n_in %d / ws %zu\n", n_in, ws_size); grid = -1; return; }
        hipGetDevice(&dev); hipDeviceGetAttribute(&cus, hipDeviceAttributeMultiprocessorCount, dev);
        if (hipFuncSetAttribute((const void*)mega, hipFuncAttributeMaxDynamicSharedMemorySize, LDS_BYTES) != hipSuccess) { fprintf(stderr, "kernel_launch: hipFuncSetAttribute failed\n"); grid = -1; return; }
        if (hipOccupancyMaxActiveBlocksPerMultiprocessor(&per_cu, (const void*)mega, 512, LDS_BYTES) != hipSuccess || per_cu < 1) { fprintf(stderr, "kernel_launch: occupancy query says %d\n", per_cu); per_cu = 1; }
        (void)hipGetLastError();
        grid = cus;
    }
    if (grid < 0) return;
    if (hipMemsetAsync(d_ws, 0, 32768, stream) != hipSuccess) { fprintf(stderr, "kernel_launch: memset failed\n"); return; }
    Args a{};
    for (int i = 0; i < 24; ++i) a.in[i] = (const float*)d_in[i];
    a.out = (float*)d_out; a.ws = (unsigned char*)d_ws;
#if MK_MULTI
    for (int ph = 0; ph < NPHASE; ++ph) { a.ph_lo = ph; a.ph_hi = ph + 1; hipLaunchKernelGGL(mega, dim3(grid), dim3(512), LDS_BYTES, stream, a); }
#else
    a.ph_lo = 0; a.ph_hi = NPHASE;
    void* args[] = {&a};
    hipError_t e = hipLaunchCooperativeKernel((const void*)mega, dim3(grid), dim3(512), args, LDS_BYTES, stream);
    if (e != hipSuccess) fprintf(stderr, "cooperative launch failed: %s (grid %d)\n", hipGetErrorString(e), grid);
#endif
}
```

```cpp
#include <hip/hip_runtime.h>
#include <hip/hip_cooperative_groups.h>
#include <cstdio>
#include <cstdint>
namespace cg = cooperative_groups;
#ifndef MK_MULTI
#define MK_MULTI 0
#endif
__device__ __forceinline__ int mk_tid() { int t = threadIdx.x; asm volatile("" : "+v"(t)); return t; }
namespace pg8 {
#define PG8_LAS __attribute__((address_space(3)))
typedef unsigned short bf16_t;
typedef short bf16x8 __attribute__((ext_vector_type(8)));
typedef float f32x4 __attribute__((ext_vector_type(4)));
typedef unsigned u32x4 __attribute__((ext_vector_type(4)));
constexpr int BM = 256, BK = 64, HALF = 128, HTB = HALF * BK * 2  , STAGE_BYTES = 8 * HTB, NXCD = 8, WGM = 8;

__host__ __device__ __forceinline__ int lds_byte(int r, int c) { const int st = (r >> 4) * 2 + (c >> 5), rr = r & 15, cc = c & 31, ob = rr * 64 + cc * 2; return st * 1024 + (ob ^ (((ob >> 9) & 1) << 5)); }
__host__ __device__ __forceinline__ void stage_rc(int b, int& R, int& C) { const int st = b / 1024, sb = b % 1024, swz = sb ^ (((sb >> 9) & 1) << 5); R = (st >> 1) * 16 + swz / 64; C = (st & 1) * 32 + (swz % 64) / 2; }
__host__ __device__ __forceinline__ int perm32(int rho) { const int n = rho >> 4, i = rho & 15; return 8 * (i >> 2) + 4 * n + (i & 3); }

struct Unit { int pm, pn, koff; };
struct Gemm { const bf16_t* A; const bf16_t* Bt; int M, N, K; int a_rows; int ldk; };

struct StaticOrder {
    int nM, nN, nwg, G, c;
    __host__ __device__ void init(int M, int N, int G_, int c_) { nM = M / BM; nN = N / BM; nwg = nM * nN; G = G_; c = c_; }
    __host__ __device__ bool next(int i, Unit& u) const {
        const long L = (long)i * G + c; if (L >= nwg) return false;
        int wgid = (int)L; { const int q = nwg / NXCD, r = nwg % NXCD, xcd = wgid % NXCD, off = wgid / NXCD; wgid = (xcd < r ? xcd * (q + 1) : r * (q + 1) + (xcd - r) * q) + off; }
        const int nig = WGM * nN, gid = wgid / nig, fm = gid * WGM, gsz = (nM - fm) < WGM ? (nM - fm) : WGM;
        u.pm = fm + ((wgid % nig) % gsz); u.pn = (wgid % nig) / gsz; u.koff = 0; return true;
    }
    __device__ __forceinline__ void a_ready(const Unit&) const {}
    __device__ __forceinline__ void done(const Unit&) const {}
};

__device__ __forceinline__ unsigned cvt_pk_bf16(float lo, float hi) { unsigned r; asm volatile("v_cvt_pk_bf16_f32 %0, %1, %2" : "=v"(r) : "v"(lo), "v"(hi)); return r; }
typedef float f32x2 __attribute__((ext_vector_type(2)));
__device__ __forceinline__ f32x2 gelu_pk(f32x2 v) {
    const f32x2 av = __builtin_elementwise_abs(v), d = av * 0.2316418882f + 1.0f;
    f32x2 t; t.x = __builtin_amdgcn_rcpf(d.x); t.y = __builtin_amdgcn_rcpf(d.y);
    f32x2 q = t * 0.5307027145f + (-0.7265760135f); q = q * t + 0.7107068705f; q = q * t + (-0.142248368f); q = q * t + 0.127414796f; q = q * t;
    const f32x2 s = (v * v) * (-0.72134752044f);
    f32x2 e; e.x = __builtin_amdgcn_exp2f(s.x); e.y = __builtin_amdgcn_exp2f(s.y);
    const f32x2 m = v * (q * e), r = v - m;
    f32x2 o; o.x = v.x < 0.f ? m.x : r.x; o.y = v.y < 0.f ? m.y : r.y; return o;
}

template <int ACT  > struct EpiBf16 {
    static constexpr bool PERM = true, AFTER_DRAIN = false; static_assert(ACT == 0 || ACT == 1, "EpiBf16: ACT is 0 (none) or 1 (gelu_pk)");
    bf16_t* O; int ldc; const float* bias; int split_cols; size_t split_stride; float scale0;
    __device__ __forceinline__ void operator()(const f32x4 (&acc)[2][2][4][2], const Unit& u, int wr, int wc, int fr, int fq) const {
        const int row0 = u.pm * BM + wr * 64 + fr; int colt = u.pn * BM; bf16_t* base = O;
        float sc = 1.f; if (split_cols) { const int t = colt / split_cols; base += (size_t)t * split_stride; colt -= t * split_cols; if (t == 0) sc = scale0; }
        const int col0 = colt + wc * 32 + 8 * fq, bcol0 = u.pn * BM + wc * 32 + 8 * fq;
        f32x4 bv[2][2];
#pragma unroll
        for (int bj = 0; bj < 2; ++bj)
#pragma unroll
            for (int n = 0; n < 2; ++n) bv[bj][n] = bias ? *(const f32x4*)(bias + bcol0 + bj * HALF + 4 * n) : (f32x4){0.f, 0.f, 0.f, 0.f};
#pragma unroll
        for (int ai = 0; ai < 2; ++ai)
#pragma unroll
            for (int m = 0; m < 4; ++m) { bf16_t* rowp = base + (size_t)(row0 + ai * HALF + m * 16) * ldc + col0;
#pragma unroll
                for (int bj = 0; bj < 2; ++bj) { f32x4 v0 = acc[ai][bj][m][0] + bv[bj][0], v1 = acc[ai][bj][m][1] + bv[bj][1];
                    if (ACT == 1) { f32x2 a = gelu_pk((f32x2){v0[0], v0[1]}), b = gelu_pk((f32x2){v0[2], v0[3]}), c = gelu_pk((f32x2){v1[0], v1[1]}), d = gelu_pk((f32x2){v1[2], v1[3]});
                        v0 = (f32x4){a.x, a.y, b.x, b.y}; v1 = (f32x4){c.x, c.y, d.x, d.y}; }
                    v0 = v0 * sc; v1 = v1 * sc; u32x4 w; w.x = cvt_pk_bf16(v0[0], v0[1]); w.y = cvt_pk_bf16(v0[2], v0[3]); w.z = cvt_pk_bf16(v1[0], v1[1]); w.w = cvt_pk_bf16(v1[2], v1[3]);
                    *(u32x4*)(rowp + bj * HALF) = w; } }
    }
};

template <class Epi, class Sched, bool ALIGN_EPI = false, bool SP2 = false>
__device__ __forceinline__ void gemm_phase(PG8_LAS unsigned char* lds, const Gemm g, const Sched& S, const Epi& E) {
    const int tid = mk_tid(), wid = __builtin_amdgcn_readfirstlane(tid >> 6), lane = tid & 63, wr = wid >> 2, wc = wid & 3, fr = lane & 15, fq = lane >> 4;
    const int K = g.K, nt = K / BK;
    unsigned voffA[2], voffB[2];
#pragma unroll
    for (int i = 0; i < 2; ++i) { int R, C; stage_rc(tid * 16 + i * 8192, R, C); const int Rb = Epi::PERM ? ((R & ~31) + perm32(R & 31)) : R;
        voffA[i] = (unsigned)(R * g.ldk + C) * 2u; voffB[i] = (unsigned)(Rb * g.ldk + C) * 2u; }
    const size_t kstep = (size_t)(BK * 2);
    const size_t hstep = (size_t)HALF * g.ldk * 2;
    const size_t tstep = 2 * hstep;
    const unsigned ldsw = (unsigned)wid * 1024u;
    const int aoff = lds_byte(wr * 64 + fr, fq * 8), boff = lds_byte(wc * 32 + fr, fq * 8);
#define PG8_SA(b, h) (((b) * 2 + (h)) * HTB)
#define PG8_SB(b, h) ((4 + (b) * 2 + (h)) * HTB)
#define PG8_STAGE(bufoff, gbase, voff) do { _Pragma("unroll") for (int _i = 0; _i < 2; ++_i) \
        __builtin_amdgcn_global_load_lds((const unsigned*)((const char*)(gbase) + (voff)[_i]), (PG8_LAS unsigned*)(lds + (bufoff) + ldsw + _i * 8192), 16, 0, 0); } while (0)
#define PG8_LDA(dst, b, h) do { _Pragma("unroll") for (int m = 0; m < 4; ++m) _Pragma("unroll") for (int k = 0; k < 2; ++k) dst[m][k] = *(const PG8_LAS bf16x8*)(lds + PG8_SA(b, h) + aoff + m * 2048 + k * 1024); } while (0)
#define PG8_LDB(dst, b, h) do { _Pragma("unroll") for (int n = 0; n < 2; ++n) _Pragma("unroll") for (int k = 0; k < 2; ++k) dst[n][k] = *(const PG8_LAS bf16x8*)(lds + PG8_SB(b, h) + boff + n * 2048 + k * 1024); } while (0)
#define PG8_MMA(ai, bj, At, Bt) do { __builtin_amdgcn_s_setprio(1); _Pragma("unroll") for (int m = 0; m < 4; ++m) _Pragma("unroll") for (int n = 0; n < 2; ++n) _Pragma("unroll") for (int k = 0; k < 2; ++k) \
        acc[ai][bj][m][n] = __builtin_amdgcn_mfma_f32_16x16x32_bf16(Bt[n][k], At[m][k], acc[ai][bj][m][n], 0, 0, 0); __builtin_amdgcn_s_setprio(0); } while (0)
#define PG8_WAIT_V(n) asm volatile("s_waitcnt vmcnt(" #n ")" ::: "memory")
#define PG8_WAIT_L(n) asm volatile("s_waitcnt lgkmcnt(" #n ")" ::: "memory")
#define PG8_BAR __builtin_amdgcn_s_barrier()
#define PG8_SCHED __builtin_amdgcn_sched_barrier(0)
    Unit cur, nxt; int ui = 0;
    if (!S.next(0, cur)) return;
    f32x4 acc[2][2][4][2];
#pragma unroll
    for (int a = 0; a < 2; ++a)
#pragma unroll
        for (int b = 0; b < 2; ++b)
#pragma unroll
            for (int m = 0; m < 4; ++m)
#pragma unroll
                for (int n = 0; n < 2; ++n) acc[a][b][m][n] = (f32x4){0.f, 0.f, 0.f, 0.f};
    bf16x8 At[4][2], B0[2][2], B1[2][2];
    const size_t atstep = (size_t)g.a_rows * g.ldk * 2; const char* cA = (const char*)g.A + (size_t)cur.pm * atstep + (size_t)cur.koff * 2; const char* cB = (const char*)g.Bt + (size_t)cur.pn * tstep + (size_t)cur.koff * 2;
    S.a_ready(cur);
    if constexpr (SP2) {
        PG8_STAGE(PG8_SB(0, 0), cB, voffB); PG8_STAGE(PG8_SB(0, 1), cB + hstep, voffB); PG8_STAGE(PG8_SA(0, 0), cA, voffA); PG8_STAGE(PG8_SA(0, 1), cA + hstep, voffA);
        if (wr == 1) PG8_BAR;
        PG8_WAIT_V(2); PG8_BAR;
        PG8_STAGE(PG8_SB(1, 0), cB + kstep, voffB); PG8_STAGE(PG8_SA(1, 0), cA + kstep, voffA); PG8_STAGE(PG8_SB(1, 1), cB + hstep + kstep, voffB);
        PG8_WAIT_V(6); PG8_BAR;
    } else {
        PG8_STAGE(PG8_SB(0, 0), cB, voffB); PG8_STAGE(PG8_SA(0, 0), cA, voffA); PG8_STAGE(PG8_SB(0, 1), cB + hstep, voffB); PG8_STAGE(PG8_SA(0, 1), cA + hstep, voffA);
        if (wr == 1) PG8_BAR;
        PG8_WAIT_V(4); PG8_BAR;
        PG8_STAGE(PG8_SB(1, 0), cB + kstep, voffB); PG8_STAGE(PG8_SA(1, 0), cA + kstep, voffA); PG8_STAGE(PG8_SB(1, 1), cB + hstep + kstep, voffB);
        PG8_WAIT_V(6); PG8_BAR;
    }
    for (;;) {
        const bool has_next = S.next(ui + 1, nxt);
        const char* nA = has_next ? (const char*)g.A + (size_t)nxt.pm * atstep + (size_t)nxt.koff * 2 : cA; const char* nB = has_next ? (const char*)g.Bt + (size_t)nxt.pn * tstep + (size_t)nxt.koff * 2 : cB;
        for (int t = 0; t < nt; t += 2) {
            const bool last = (t == nt - 2);
            const char* a1 = cA + (size_t)(t + 1) * kstep;
            const char* a2 = last ? nA : cA + (size_t)(t + 2) * kstep; const char* b2 = last ? nB : cB + (size_t)(t + 2) * kstep;
            const char* a3 = a2 + kstep; const char* b3 = b2 + kstep;
            if (last && has_next) S.a_ready(nxt);
            if constexpr (SP2) {
            PG8_LDB(B0, 0, 0); PG8_LDB(B1, 0, 1); PG8_SCHED; PG8_LDA(At, 0, 0); PG8_STAGE(PG8_SA(1, 1), a1 + hstep, voffA);
            PG8_WAIT_V(8); PG8_WAIT_L(0); PG8_BAR; PG8_MMA(0, 0, At, B0); PG8_MMA(0, 1, At, B1); PG8_BAR; PG8_SCHED;
            PG8_LDA(At, 0, 1); PG8_STAGE(PG8_SB(0, 0), b2, voffB); PG8_STAGE(PG8_SB(0, 1), b2 + hstep, voffB); PG8_STAGE(PG8_SA(0, 0), a2, voffA);
            PG8_WAIT_V(8); PG8_WAIT_L(0); PG8_BAR; PG8_MMA(1, 0, At, B0); PG8_MMA(1, 1, At, B1); PG8_BAR; PG8_SCHED;
            PG8_LDB(B0, 1, 0); PG8_LDB(B1, 1, 1); PG8_SCHED; PG8_LDA(At, 1, 0); PG8_STAGE(PG8_SA(0, 1), a2 + hstep, voffA);
            PG8_WAIT_V(8); PG8_WAIT_L(0); PG8_BAR; PG8_MMA(0, 0, At, B0); PG8_MMA(0, 1, At, B1); PG8_BAR; PG8_SCHED;
            PG8_LDA(At, 1, 1); PG8_STAGE(PG8_SB(1, 0), b3, voffB); PG8_STAGE(PG8_SB(1, 1), b3 + hstep, voffB); PG8_STAGE(PG8_SA(1, 0), a3, voffA);
            PG8_WAIT_V(8); PG8_WAIT_L(0); PG8_BAR; PG8_MMA(1, 0, At, B0); PG8_MMA(1, 1, At, B1); PG8_BAR; PG8_SCHED;
            } else {
            PG8_LDB(B0, 0, 0); PG8_SCHED; PG8_LDA(At, 0, 0); PG8_STAGE(PG8_SA(1, 1), a1 + hstep, voffA);
            PG8_WAIT_L(8); PG8_BAR; PG8_WAIT_L(0); PG8_MMA(0, 0, At, B0); PG8_BAR; PG8_SCHED;
            PG8_LDB(B1, 0, 1); PG8_STAGE(PG8_SB(0, 0), b2, voffB);
            PG8_BAR; PG8_WAIT_L(0); PG8_MMA(0, 1, At, B1); PG8_BAR;
            PG8_LDA(At, 0, 1); PG8_STAGE(PG8_SA(0, 0), a2, voffA);
            PG8_BAR; PG8_WAIT_L(0); PG8_MMA(1, 0, At, B0); PG8_BAR; PG8_SCHED;
            PG8_STAGE(PG8_SB(0, 1), b2 + hstep, voffB);
            PG8_WAIT_V(6); PG8_BAR; PG8_MMA(1, 1, At, B1); PG8_BAR;
            PG8_LDB(B0, 1, 0); PG8_SCHED; PG8_LDA(At, 1, 0); PG8_STAGE(PG8_SA(0, 1), a2 + hstep, voffA);
            PG8_WAIT_L(8); PG8_BAR; PG8_WAIT_L(0); PG8_MMA(0, 0, At, B0); PG8_BAR; PG8_SCHED;
            PG8_LDB(B1, 1, 1); PG8_STAGE(PG8_SB(1, 0), b3, voffB);
            PG8_BAR; PG8_WAIT_L(0); PG8_MMA(0, 1, At, B1); PG8_BAR;
            PG8_LDA(At, 1, 1); PG8_STAGE(PG8_SA(1, 0), a3, voffA);
            PG8_BAR; PG8_WAIT_L(0); PG8_MMA(1, 0, At, B0); PG8_BAR; PG8_SCHED;
            PG8_STAGE(PG8_SB(1, 1), b3 + hstep, voffB);
            PG8_WAIT_V(6); PG8_BAR; PG8_MMA(1, 1, At, B1); PG8_BAR;
            }
        }
        if constexpr (ALIGN_EPI) { if (wr == 0) PG8_BAR; }
        if constexpr (!Epi::AFTER_DRAIN) { const int l2_ = mk_tid() & 63; E(acc, cur, wr, wc, l2_ & 15, l2_ >> 4); S.done(cur); }
        if (!has_next) break;
#pragma unroll
        for (int a = 0; a < 2; ++a)
#pragma unroll
            for (int b = 0; b < 2; ++b)
#pragma unroll
                for (int m = 0; m < 4; ++m)
#pragma unroll
                    for (int n = 0; n < 2; ++n) acc[a][b][m][n] = (f32x4){0.f, 0.f, 0.f, 0.f};
        cur = nxt; cA = nA; cB = nB; ++ui;
        if constexpr (ALIGN_EPI) { if (wr == 1) PG8_BAR; }
    }
    PG8_WAIT_V(0);
    if constexpr (!ALIGN_EPI) { if (wr == 0) PG8_BAR; }
    PG8_BAR;
    if constexpr (Epi::AFTER_DRAIN) { const int l2_ = mk_tid() & 63; E.fused(acc, cur, wr, wc, l2_ & 15, l2_ >> 4, lds, wid, l2_); S.done(cur); }
#undef PG8_SA
#undef PG8_SB
#undef PG8_STAGE
#undef PG8_LDA
#undef PG8_LDB
#undef PG8_MMA
#undef PG8_WAIT_V
#undef PG8_WAIT_L
#undef PG8_BAR
#undef PG8_SCHED
}
}

#include <hip/hip_bf16.h>
#include <cmath>
namespace attn_body {
using bf16=__hip_bfloat16;
using bf16x8=__attribute__((ext_vector_type(8)))short;
using s16x4=__attribute__((ext_vector_type(4)))short;
using f32x16=__attribute__((ext_vector_type(16)))float;
using u32x4=__attribute__((ext_vector_type(4)))unsigned;
constexpr int D=64,QP=512,KVP=128;
constexpr int NW=8,QBLK=32,QB=QBLK*NW,KVBLK=64;
constexpr int ATTN_UNIT_ROWS=QB;
__device__ __forceinline__ int crow(int r,int hi){return (r&3)+8*(r>>2)+4*hi;}
#define SBAR() __builtin_amdgcn_sched_barrier(0)
__device__ __forceinline__ void cmask(f32x16&p0,f32x16&p1,int jb,int qrel,int hi){
  const float NEG=-INFINITY; int kb=64*jb+4*hi;
  #pragma unroll
  for(int r=0;r<16;++r){int kv=kb+(r&3)+8*(r>>2); if(kv>qrel)p0[r]=NEG; if(kv+32>qrel)p1[r]=NEG;}
}

constexpr int NSLOT=3, SLOTB=8192;
constexpr int LDS_K=0, LDS_V=NSLOT*SLOTB, LDS_WS=2*NSLOT*SLOTB, LDS_OST=LDS_WS+NW*64*4, LDS_BYTES=LDS_OST+NW*4096;
constexpr float C2=0.125f*1.4426950408889634f;
__device__ __forceinline__ void glds16(const void*gsrc,unsigned lds_dst){unsigned keep;
  asm volatile("s_mov_b32 %0, m0\n\ts_mov_b32 m0, %2\n\ts_nop 0\n\tglobal_load_lds_dwordx4 %1, off\n\ts_mov_b32 m0, %0":"=&s"(keep):"v"(gsrc),"s"(lds_dst):"memory");}
__device__ __forceinline__ float max3f(float a,float b,float c){float r;asm("v_max3_f32 %0, %1, %2, %3":"=v"(r):"v"(a),"v"(b),"v"(c));return r;}
__device__ __forceinline__ float max2f(float a,float b){float r;asm("v_max_f32_e32 %0, %1, %2":"=v"(r):"v"(a),"v"(b));return r;}
__device__ __forceinline__ float fadd_s(float a,float b){float r;asm("v_add_f32_e32 %0, %1, %2":"=v"(r):"v"(a),"v"(b));return r;}
__device__ __forceinline__ float fsub_s(float a,float b){float r;asm("v_sub_f32_e32 %0, %1, %2":"=v"(r):"v"(a),"v"(b));return r;}
typedef float f32x2_t __attribute__((ext_vector_type(2))); typedef __bf16 bf16x2_t __attribute__((ext_vector_type(2)));
__device__ __forceinline__ unsigned cvtpk_s(float lo,float hi){f32x2_t v={lo,hi};bf16x2_t b=__builtin_convertvector(v,bf16x2_t);return __builtin_bit_cast(unsigned,b);}
#define WAIT_BAR(N) asm volatile("s_waitcnt vmcnt(" #N ") lgkmcnt(0)\n\ts_barrier":::"memory")

__device__ __forceinline__ void qkt(f32x16&p0,f32x16&p1,const char*Kslot,const bf16x8*qr,const f32x16&negm,int r32,int hi){
  const char*kb=Kslot+hi*1024+r32*16;
  #pragma unroll
  for(int d0=0;d0<4;++d0){
    const bf16x8 b0=*reinterpret_cast<const bf16x8*>(kb+d0*2048);
    const bf16x8 b1=*reinterpret_cast<const bf16x8*>(kb+d0*2048+512);
    if(d0==0){p0=__builtin_amdgcn_mfma_f32_32x32x16_bf16(b0,qr[0],negm,0,0,0);p1=__builtin_amdgcn_mfma_f32_32x32x16_bf16(b1,qr[0],negm,0,0,0);}
    else{p0=__builtin_amdgcn_mfma_f32_32x32x16_bf16(b0,qr[d0],p0,0,0,0);p1=__builtin_amdgcn_mfma_f32_32x32x16_bf16(b1,qr[d0],p1,0,0,0);}}
}
typedef __attribute__((address_space(3))) const char* lds_cptr;
typedef short v4i16_t __attribute__((ext_vector_type(4)));
__device__ __forceinline__ void kload8(bf16x8*kf,lds_cptr kp){
  kf[0]=*(const __attribute__((address_space(3))) bf16x8*)(kp);      kf[1]=*(const __attribute__((address_space(3))) bf16x8*)(kp+512);
  kf[2]=*(const __attribute__((address_space(3))) bf16x8*)(kp+2048); kf[3]=*(const __attribute__((address_space(3))) bf16x8*)(kp+2560);
  kf[4]=*(const __attribute__((address_space(3))) bf16x8*)(kp+4096); kf[5]=*(const __attribute__((address_space(3))) bf16x8*)(kp+4608);
  kf[6]=*(const __attribute__((address_space(3))) bf16x8*)(kp+6144); kf[7]=*(const __attribute__((address_space(3))) bf16x8*)(kp+6656);
}
__device__ __forceinline__ void kload2(bf16x8*kf,lds_cptr kp,int j){ kf[2*j]=*(const __attribute__((address_space(3))) bf16x8*)(kp+j*2048); kf[2*j+1]=*(const __attribute__((address_space(3))) bf16x8*)(kp+j*2048+512); }
__device__ __forceinline__ s16x4 vtr(lds_cptr p){ return __builtin_bit_cast(s16x4,__builtin_amdgcn_ds_read_tr16_b64_v4i16((__attribute__((address_space(3))) v4i16_t*)p)); }
__device__ __forceinline__ float rowmax(const f32x16&p0,const f32x16&p1){
  float a=max3f(p0[0],p0[1],p1[0]),b=max3f(p0[2],p0[3],p1[1]);a=max3f(a,p1[2],p1[3]);
  #pragma unroll
  for(int r=4;r<16;r+=4){a=max3f(a,p0[r],p0[r+1]);b=max3f(b,p0[r+2],p0[r+3]);a=max3f(a,p1[r],p1[r+1]);b=max3f(b,p1[r+2],p1[r+3]);}
  const float m=max2f(a,b);
  auto rr=__builtin_amdgcn_permlane32_swap(__float_as_uint(m),__float_as_uint(m),false,false);
  return max2f(__uint_as_float(rr[0]),__uint_as_float(rr[1]));
}
__device__ __forceinline__ void pv(f32x16*o,int vb,bf16x8 pa0,bf16x8 pa1,bf16x8 pa2,bf16x8 pa3){
  #pragma unroll
  for(int d0=0;d0<2;++d0){s16x4 lo[4],hi[4];
    #pragma unroll
    for(int ks=0;ks<4;++ks){
      asm volatile("ds_read_b64_tr_b16 %0,%1 offset:%c2":"=&v"(lo[ks]):"v"(vb),"i"(d0*4096+ks*1024):"memory");
      asm volatile("ds_read_b64_tr_b16 %0,%1 offset:%c2":"=&v"(hi[ks]):"v"(vb),"i"(d0*4096+ks*1024+512):"memory");}
    asm volatile("s_waitcnt lgkmcnt(0)":::"memory");SBAR();
    #define PK(k) (bf16x8){lo[k][0],lo[k][1],lo[k][2],lo[k][3],hi[k][0],hi[k][1],hi[k][2],hi[k][3]}
    o[d0]=__builtin_amdgcn_mfma_f32_32x32x16_bf16(pa0,PK(0),o[d0],0,0,0);
    o[d0]=__builtin_amdgcn_mfma_f32_32x32x16_bf16(pa1,PK(1),o[d0],0,0,0);
    o[d0]=__builtin_amdgcn_mfma_f32_32x32x16_bf16(pa2,PK(2),o[d0],0,0,0);
    o[d0]=__builtin_amdgcn_mfma_f32_32x32x16_bf16(pa3,PK(3),o[d0],0,0,0);
    #undef PK
  }
}

#ifndef ATTN_STORE16
#define ATTN_STORE16(p,v) (*(u32x4*)(p)=(v))
#endif
template<int THRL> __device__ __forceinline__ void attn_unit(const bf16*Qu,const bf16*__restrict__ Kh,const bf16*__restrict__ Vh,bf16*Ou,const int NT,char*shm){
  const int tid=mk_tid(),lane=tid&63,r32=lane&31,hi=lane>>5; const int wid=__builtin_amdgcn_readfirstlane(tid>>6);
  const bf16*Qw=Qu+(long)(wid*QBLK)*QP;
  const unsigned lds0=(unsigned)(uintptr_t)shm;
  float*wsf=(float*)(shm+LDS_WS)+wid*64;
  const bf16*ksrc=Kh+(long)lane*KVP+wid*8;
  const bf16*vsrc=Vh+(long)(16*(wid&3)+(lane>>2))*KVP+(wid>>2)*32+(lane&3)*8;
  const unsigned kdst=lds0+LDS_K+wid*1024, vdst=lds0+LDS_V+wid*1024;
  #define DMA_K(t,slot) glds16(ksrc+(long)(t)*KVBLK*KVP,(unsigned)__builtin_amdgcn_readfirstlane(kdst+(slot)))
  #define DMA_V(t,slot) glds16(vsrc+(long)(t)*KVBLK*KVP,(unsigned)__builtin_amdgcn_readfirstlane(vdst+(slot)))
  const int vb0=(int)(lds0+LDS_V)+((lane>>4)&1)*32+(lane&3)*8+(4*hi+((lane&15)>>2))*64;
  const char*Kbase=shm+LDS_K; bf16x8 kf[8];
  const lds_cptr shm3=(lds_cptr)shm; const lds_cptr kp0=shm3+LDS_K+hi*1024+r32*16; const lds_cptr vp0=shm3+LDS_V+((lane>>4)&1)*32+(lane&3)*8+(4*hi+((lane&15)>>2))*64;
  DMA_K(0,0);DMA_V(0,0);DMA_K(1,SLOTB);
  bf16x8 qr[4];
  #pragma unroll
  for(int d0=0;d0<4;++d0)qr[d0]=*reinterpret_cast<const bf16x8*>(&Qw[(long)r32*QP+d0*16+hi*8]);
  float mhat=0.f,l_reg=0.f;f32x16 o[2];o[0]=f32x16{};o[1]=f32x16{};f32x16 negm=f32x16{};asm volatile("":"+v"(negm));
  #define CMASK(P0,P1,t) do{}while(0)
  bool resc=false;
  #define START(P0,P1) do{ const float rm=rowmax(P0,P1); resc=false; \
    { const float dl=rm; mhat=fadd_s(mhat,dl); \
      _Pragma("unroll") for(int r=0;r<16;++r){P0[r]=fsub_s(P0[r],dl);P1[r]=fsub_s(P1[r],dl);} \
      _Pragma("unroll") for(int r=0;r<16;++r)negm[r]=-mhat; asm volatile("":"+v"(negm)); } \
    _Pragma("unroll") for(int r=0;r<16;++r)P0[r]=__builtin_amdgcn_exp2f(P0[r]); }while(0)
  #define RESC() do{ if(resc){ asm volatile("s_waitcnt lgkmcnt(0)":::"memory"); \
      _Pragma("unroll") for(int d_=0;d_<2;++d_) _Pragma("unroll") for(int r=0;r<16;++r)o[d_][r]*=wsf[crow(r,hi)]; } }while(0)
  f32x16 pA0,pA1,pB0,pB1;
  int sl_prev=0,sl_cur=0,sl_next=SLOTB;
  #define ROT() do{sl_prev=sl_cur;sl_cur=sl_next;sl_next=(sl_next==(NSLOT-1)*SLOTB)?0:sl_next+SLOTB;}while(0)
  DMA_K(2,2*SLOTB);
  WAIT_BAR(3);
  qkt(pA0,pA1,Kbase,qr,negm,r32,hi);asm volatile("s_nop 15\n\ts_nop 7":"+v"(pA0),"+v"(pA1));CMASK(pA0,pA1,0);
  START(pA0,pA1);
  _Pragma("unroll") for(int r=0;r<16;++r)pA1[r]=__builtin_amdgcn_exp2f(pA1[r]);
  WAIT_BAR(0);
  DMA_K(3,0);DMA_V(1,SLOTB);
  ROT();
  kload8(kf,kp0+sl_cur);
  WAIT_BAR(2);
  s16x4 vlo[8],vhi[8]; u32x4 pw0,pw1,pw2,pw3;
  #define PKW(P,B) cvtpk_s(P[B],P[B+1])
  #define PAF(k) __builtin_bit_cast(bf16x8,pw##k)
  #define VFR(i) (bf16x8){vlo[i][0],vlo[i][1],vlo[i][2],vlo[i][3],vhi[i][0],vhi[i][1],vhi[i][2],vhi[i][3]}
  #define PIN(x) asm volatile("":"+v"(x))
  #define MX3(a,b,c) __builtin_fmaxf(__builtin_fmaxf((a),(b)),(c))
  #define GAPA(MF,A0,A1,A2,A3,W0,W1,PW) do{ MF; sacc+=A0; sacc+=A1; sacc+=A2; sacc+=A3; PIN(sacc); W0; W1; PIN(PW); SBAR(); }while(0)
  #define EX(v) __builtin_amdgcn_exp2f(v)
  #define GAPB(MF,X,B) do{ MF; X[B]=EX(X[B]); X[B+1]=EX(X[B+1]); X[B+2]=EX(X[B+2]); X[B+3]=EX(X[B+3]); PIN(X); SBAR(); }while(0)
  #define VRD(i) do{ vlo[i]=vtr(vp_+(((i)>>2)*4096+((i)&3)*1024)); vhi[i]=vtr(vp_+(((i)>>2)*4096+((i)&3)*1024+512)); }while(0)
  #define KRD(G,j) do{ if(G){ kload2(kf,kp0+sl_next,j); SBAR(); } }while(0)
  #define STEP(C0,C1,P0,P1,t,GK,GV,GL) do{ SBAR(); \
    const lds_cptr vp_=vp0+sl_prev; \
    VRD(0); SBAR(); float sacc=(P0[0]+P0[1]); \
    GAPA(C0=__builtin_amdgcn_mfma_f32_32x32x16_bf16(kf[0],qr[0],negm,0,0,0), P0[2],P0[3],P0[4],P0[5],     pw0[0]=PKW(P0,0), pw0[1]=PKW(P0,2), pw0); \
    VRD(4); SBAR(); GAPA(C1=__builtin_amdgcn_mfma_f32_32x32x16_bf16(kf[1],qr[0],negm,0,0,0), P0[6],P0[7],P0[8],P0[9],     pw0[2]=PKW(P0,4), pw0[3]=PKW(P0,6), pw0); \
    VRD(1); SBAR(); GAPA(C0=__builtin_amdgcn_mfma_f32_32x32x16_bf16(kf[2],qr[1],C0,0,0,0),   P0[10],P0[11],P0[12],P0[13], pw1[0]=PKW(P0,8), pw1[1]=PKW(P0,10), pw1); \
    VRD(5); SBAR(); GAPA(C1=__builtin_amdgcn_mfma_f32_32x32x16_bf16(kf[3],qr[1],C1,0,0,0),   P0[14],P0[15],P1[0],P1[1],   pw1[2]=PKW(P0,12),pw1[3]=PKW(P0,14), pw1); \
    VRD(2); SBAR(); GAPA(C0=__builtin_amdgcn_mfma_f32_32x32x16_bf16(kf[4],qr[2],C0,0,0,0),   P1[2],P1[3],P1[4],P1[5],     pw2[0]=PKW(P1,0), pw2[1]=PKW(P1,2), pw2); \
    VRD(6); SBAR(); GAPA(C1=__builtin_amdgcn_mfma_f32_32x32x16_bf16(kf[5],qr[2],C1,0,0,0),   P1[6],P1[7],P1[8],P1[9],     pw2[2]=PKW(P1,4), pw2[3]=PKW(P1,6), pw2); \
    VRD(3); SBAR(); GAPA(C0=__builtin_amdgcn_mfma_f32_32x32x16_bf16(kf[6],qr[3],C0,0,0,0),   P1[10],P1[11],P1[12],P1[13], pw3[0]=PKW(P1,8), pw3[1]=PKW(P1,10), pw3); \
    VRD(7); SBAR(); GAPA(C1=__builtin_amdgcn_mfma_f32_32x32x16_bf16(kf[7],qr[3],C1,0,0,0),   P1[14],P1[15],0.f,0.f,       pw3[2]=PKW(P1,12),pw3[3]=PKW(P1,14), pw3); \
    l_reg+=sacc; \
    if(GK){DMA_K((t)+3,sl_cur);} if(GV){DMA_V((t)+1,sl_next);} \
    CMASK(C0,C1,t); \
    { float a=MX3(C0[0],C0[1],C1[0]),b=MX3(C0[2],C0[3],C1[1]); a=MX3(a,C1[2],C1[3]); \
      _Pragma("unroll") for(int r=4;r<16;r+=4){a=MX3(a,C0[r],C0[r+1]);b=MX3(b,C0[r+2],C0[r+3]);a=MX3(a,C1[r],C1[r+1]);b=MX3(b,C1[r+2],C1[r+3]);} \
      float rm=__builtin_fmaxf(a,b); { auto rr=__builtin_amdgcn_permlane32_swap(__float_as_uint(rm),__float_as_uint(rm),false,false); rm=__builtin_fmaxf(__uint_as_float(rr[0]),__uint_as_float(rr[1])); } \
      resc=false; \
      if(__builtin_expect(__any(rm>(float)THRL),0)){ const float dl=__builtin_fmaxf(rm,0.f); mhat+=dl; \
        _Pragma("unroll") for(int r=0;r<16;++r){C0[r]-=dl;C1[r]-=dl;} \
        _Pragma("unroll") for(int r=0;r<16;++r)negm[r]=-mhat; asm volatile("":"+v"(negm)); \
        const float f=__builtin_amdgcn_exp2f(-dl); l_reg*=f; if(hi==0)wsf[r32]=f; resc=true; } } \
    SBAR(); \
    GAPB(o[0]=__builtin_amdgcn_mfma_f32_32x32x16_bf16(PAF(0),VFR(0),o[0],0,0,0), C0,0); \
    GAPB(o[1]=__builtin_amdgcn_mfma_f32_32x32x16_bf16(PAF(0),VFR(4),o[1],0,0,0), C0,4); \
    KRD(GL,0); GAPB(o[0]=__builtin_amdgcn_mfma_f32_32x32x16_bf16(PAF(1),VFR(1),o[0],0,0,0), C0,8); \
    KRD(GL,1); GAPB(o[1]=__builtin_amdgcn_mfma_f32_32x32x16_bf16(PAF(1),VFR(5),o[1],0,0,0), C0,12); \
    KRD(GL,2); GAPB(o[0]=__builtin_amdgcn_mfma_f32_32x32x16_bf16(PAF(2),VFR(2),o[0],0,0,0), C1,0); \
    KRD(GL,3); GAPB(o[1]=__builtin_amdgcn_mfma_f32_32x32x16_bf16(PAF(2),VFR(6),o[1],0,0,0), C1,4); \
    GAPB(o[0]=__builtin_amdgcn_mfma_f32_32x32x16_bf16(PAF(3),VFR(3),o[0],0,0,0), C1,8); \
    GAPB(o[1]=__builtin_amdgcn_mfma_f32_32x32x16_bf16(PAF(3),VFR(7),o[1],0,0,0), C1,12); \
    }while(0)
  int t=1;
  #undef CMASK
  #define CMASK(P0,P1,t) do{}while(0)
  for(;t+5<NT;t+=2){
    STEP(pB0,pB1,pA0,pA1,t,true,true,true);     WAIT_BAR(2); RESC(); ROT();
    STEP(pA0,pA1,pB0,pB1,t+1,true,true,true);   WAIT_BAR(2); RESC(); ROT();
  }
  #undef CMASK
  #define CMASK(P0,P1,t) do{}while(0)
  #define ENDW(tt) do{ if((tt)+3<NT){WAIT_BAR(2);} else if((tt)+2<NT){WAIT_BAR(1);} else {WAIT_BAR(0);} }while(0)
  for(;t+1<NT;t+=2){
    STEP(pB0,pB1,pA0,pA1,t,(t+3<NT),(t+1<NT),(t+1<NT));       ENDW(t);   RESC(); ROT();
    STEP(pA0,pA1,pB0,pB1,t+1,(t+4<NT),(t+2<NT),(t+2<NT));     ENDW(t+1); RESC(); ROT();
  }
  STEP(pB0,pB1,pA0,pA1,NT-1,false,false,false); RESC();
  { float sacc=pB0[0]+pB0[1]; _Pragma("unroll") for(int r=2;r<16;++r)sacc+=pB0[r]; _Pragma("unroll") for(int r=0;r<16;++r)sacc+=pB1[r]; l_reg+=sacc;
    pw0=(u32x4){PKW(pB0,0),PKW(pB0,2),PKW(pB0,4),PKW(pB0,6)};pw1=(u32x4){PKW(pB0,8),PKW(pB0,10),PKW(pB0,12),PKW(pB0,14)};pw2=(u32x4){PKW(pB1,0),PKW(pB1,2),PKW(pB1,4),PKW(pB1,6)};pw3=(u32x4){PKW(pB1,8),PKW(pB1,10),PKW(pB1,12),PKW(pB1,14)};
    SBAR(); pv(o,vb0+sl_cur,PAF(0),PAF(1),PAF(2),PAF(3)); }
  #undef PKW
  #undef PAF
  #undef VFR
  #undef PIN
  #undef MX3
  #undef GAPA
  #undef GAPB
  #undef EX
  #undef VRD
  #undef KRD
  #undef STEP
  #undef ENDW
  {auto rr=__builtin_amdgcn_permlane32_swap(__float_as_uint(l_reg),__float_as_uint(l_reg),false,false);l_reg=__uint_as_float(rr[0])+__uint_as_float(rr[1]);}
  if(hi==0)wsf[32+r32]=l_reg;asm volatile("s_waitcnt lgkmcnt(0)":::"memory");
  float rli[16];
  #pragma unroll
  for(int r=0;r<16;++r)rli[r]=__builtin_amdgcn_rcpf(wsf[32+crow(r,hi)]);
  bf16*Ow=Ou+(long)(wid*QBLK)*QP;
  { bf16*stg=(bf16*)(shm+LDS_OST)+wid*2048;
    #pragma unroll
    for(int r=0;r<16;++r){const int orow=crow(r,hi);
      #pragma unroll
      for(int d0=0;d0<2;++d0)stg[orow*64+d0*32+r32]=__float2bfloat16(o[d0][r]*rli[r]);}
    asm volatile("s_waitcnt lgkmcnt(0)":::"memory");
    #pragma unroll
    for(int i=0;i<4;++i){const int row=i*8+(lane>>3),ch=lane&7; const u32x4 v=*(const u32x4*)(stg+row*64+ch*8); ATTN_STORE16(Ow+(long)row*QP+ch*8,v);} }
  asm volatile("s_waitcnt lgkmcnt(0)\n\ts_barrier":::"memory");
  #undef DMA_K
  #undef DMA_V
  #undef CMASK
  #undef START
  #undef RESC
  #undef ROT
}
constexpr int ATTN_LDS_BYTES=LDS_BYTES;
#undef SBAR
#undef WAIT_BAR
}

#define LAS __attribute__((address_space(3)))
typedef unsigned short bf16r;
typedef float f4 __attribute__((ext_vector_type(4)));
typedef unsigned u4 __attribute__((ext_vector_type(4)));
typedef unsigned u2 __attribute__((ext_vector_type(2)));
typedef short s8v __attribute__((ext_vector_type(8)));

constexpr int DM = 1024, SEQL = 4096, CTXL = 256, MLAT = 16384, MCTX = 1024, MALL = 17408;
constexpr int DIN = 1792, DFF = 2816, DFF2 = 5632, KVR = 4352, NCH = 68;
constexpr float EPSN = 1e-6f;
constexpr size_t MiB = 1u << 20;
constexpr size_t WS_MOD = 1 * MiB, WS_COS = 2 * MiB, WS_SIN = 2 * MiB + 512 * 1024, WS_GW = 3 * MiB, WS_AGGA = 4 * MiB, WS_AGGB = 6 * MiB, WS_CTXRES = 8 * MiB;
constexpr size_t WS_W = 12 * MiB, W_LAYER = 22 * MiB, W_IN = 0, W_OUT = 3 * MiB + 512 * 1024, W_UP = 5 * MiB + 512 * 1024, W_DOWN = 16 * MiB + 512 * 1024;
constexpr size_t WS_HN = 56 * MiB + 4096;
constexpr size_t WS_Q = 92 * MiB, WS_K = 109 * MiB, WS_V = 114 * MiB, WS_XL = 119 * MiB, WS_GG = 136 * MiB, WS_MIX = 153 * MiB;
constexpr size_t WS_LAB = 187 * MiB;
constexpr size_t WS_O = WS_HN;
constexpr size_t WS_PART = 187 * MiB;
constexpr size_t WS_ACT = 92 * MiB;
constexpr int LDS_BYTES = 147456;
constexpr int NPHASE = 18;
constexpr int L1_TAB_OFF = 84992;
#ifndef PHM
#define PHM 0x3ff
#endif
#define PON(k) ((PHM >> (k)) & 1)

struct Args { const float* in[24]; float* out; unsigned char* ws; int ph_lo, ph_hi; };
typedef const __attribute__((address_space(4))) Args* KA;

#define LDS_WAIT() asm volatile("s_waitcnt lgkmcnt(0)" ::: "memory")
__device__ __forceinline__ unsigned pk2(float lo, float hi) { return attn_body::cvtpk_s(lo, hi); }
__device__ __forceinline__ float bf_lo(unsigned w) { return __builtin_bit_cast(float, w << 16); }
__device__ __forceinline__ float bf_hi(unsigned w) { return __builtin_bit_cast(float, w & 0xffff0000u); }
__device__ __forceinline__ float wave_sum(float v) {
#pragma unroll
    for (int o = 1; o < 64; o <<= 1) v += __shfl_xor(v, o);
    return v;
}
__device__ __forceinline__ float fexp(float x) { return __builtin_amdgcn_exp2f(x * 1.4426950408889634f); }
__device__ __forceinline__ float sigmoidf_(float x) { return __builtin_amdgcn_rcpf(1.f + fexp(-x)); }
__device__ __forceinline__ float gelu_tanh(float x) { const float z = 0.7978845608028654f * (x + 0.044715f * x * x * x); return x * sigmoidf_(2.f * z); }
__device__ __forceinline__ int kvrow(int row) { return row < MLAT ? (row >> 12) * KVR + CTXL + (row & 4095) : ((row - MLAT) >> 8) * KVR + ((row - MLAT) & 255); }

__device__ __forceinline__ int win_dst(int s) {
    if (s < 512) { const int h = s >> 6, d = s & 63; return (h >> 2) * 256 + (d >> 5) * 128 + (h & 3) * 32 + (d & 31); }
    if (s < 768) { const int t = s - 512, hh = t >> 6, d = t & 63; return 512 + (d >> 5) * 128 + hh * 32 + (d & 31); }
    return s;
}
__device__ __forceinline__ int wup_dst(int s) { return s < DFF ? (s >> 7) * 256 + (s & 127) : ((s - DFF) >> 7) * 256 + 128 + ((s - DFF) & 127); }

template <int MODE> __device__ __forceinline__ void p0_transpose_item(const float* W, int K, int N, bf16r* WT, const float* ksA, const float* ksB, LAS float* scr, int item, int lane) {
    const int nblk = N / 32, kb = item / nblk, nb = item % nblk, k0 = 64 * kb, n0 = 32 * nb;
    float tv[32];
#pragma unroll
    for (int i = 0; i < 32; ++i) { const int kk = 2 * i + (lane >> 5); tv[i] = W[(size_t)(k0 + kk) * N + n0 + (lane & 31)]; }
#pragma unroll
    for (int i = 0; i < 32; ++i) { const int kk = 2 * i + (lane >> 5); float v = tv[i];
        if (MODE == 3) { const int k = k0 + kk; v *= (k < 512 ? ksA[k] : ksB[k - 512]); }
        scr[kk * 33 + (lane & 31)] = v; }
    LDS_WAIT();
    const int c = lane & 7;
#pragma unroll
    for (int j = 0; j < 4; ++j) { const int n = (lane >> 3) + 8 * j; const LAS float* s = scr + (8 * c) * 33 + n;
        u4 o; o.x = pk2(s[0 * 33], s[1 * 33]); o.y = pk2(s[2 * 33], s[3 * 33]); o.z = pk2(s[4 * 33], s[5 * 33]); o.w = pk2(s[6 * 33], s[7 * 33]);
        const int sc = n0 + n; const int dst = MODE == 1 ? win_dst(sc) : MODE == 2 ? wup_dst(sc) : sc;
        *(u4*)(WT + (size_t)dst * K + k0 + 8 * c) = o; }
    LDS_WAIT();
}

__device__ __forceinline__ void p0_phase(KA a, LAS unsigned char* lds, int tid, int wid, int lane, int G) {
    unsigned char* ws = a->ws;
    float* MOD = (float*)(ws + WS_MOD);
    {
        LAS float* sc = (LAS float*)lds; LAS float* red = sc + 5 * 1024;
        bool have = false;
        for (int it = blockIdx.x; it < 192; it += G) {
            if (!have) { for (int e = tid; e < 5 * 1024; e += 512) { const int r = e >> 10, k = e & 1023; const float v = r < 4 ? a->in[1][r * 1024 + k] : a->in[3][k]; sc[e] = v * sigmoidf_(v); } have = true; }
            __syncthreads();
            const int l = it / 96, nb = it % 96;
            const float* wp = a->in[4] + (size_t)l * 1024 * 6144 + (size_t)(wid * 128) * 6144 + nb * 64 + lane;
            float acc[5] = {0.f, 0.f, 0.f, 0.f, 0.f};
#pragma unroll 32
            for (int k = 0; k < 128; ++k) { const float wv = wp[(size_t)k * 6144];
#pragma unroll
                for (int r = 0; r < 5; ++r) acc[r] += sc[r * 1024 + wid * 128 + k] * wv; }
#pragma unroll
            for (int r = 0; r < 5; ++r) red[(wid * 5 + r) * 64 + lane] = acc[r];
            __syncthreads();
            if (tid < 320) { const int r = tid >> 6, col = tid & 63; float s = a->in[5][l * 6144 + nb * 64 + col];
#pragma unroll
                for (int w = 0; w < 8; ++w) s += red[(w * 5 + r) * 64 + col];
                MOD[(l * 5 + r) * 6144 + nb * 64 + col] = s; }
        }
        __syncthreads();
    }
    {
        float* cosT = (float*)(ws + WS_COS); float* sinT = (float*)(ws + WS_SIN); bf16r* GW = (bf16r*)(ws + WS_GW);
        const int gt = blockIdx.x * 512 + tid, NT_ = G * 512;
        for (int e = gt; e < 4096 * 32; e += NT_) { const int t = e >> 5, j = e & 31; const float pos = (float)(j < 16 ? (t >> 6) : (t & 63));
            const float inv = powf(10000.0f, -(float)(j & 15) * (1.0f / 16.0f)); const float ang = pos * inv; cosT[e] = cosf(ang); sinT[e] = sinf(ang); }
        for (int e = gt; e < 2 * 2 * 2 * 8 * 64 * 64; e += NT_) {
            const int c = e & 63, d = (e >> 6) & 63, n = (e >> 12) & 7, mat = (e >> 15) & 1, dir = (e >> 16) & 1, l = e >> 17;
            const float* src = mat ? a->in[13] : a->in[11];
            GW[e] = (bf16r)(pk2(src[((((size_t)l * 2 + dir) * 8 + n) * 64 + c) * 64 + d], 0.f) & 0xffffu); }
    }
    {
        LAS float* scr = (LAS float*)lds + wid * (64 * 33 + 16);
        const int gw = blockIdx.x * 8 + wid, NGW = G * 8;
        constexpr int I_IN = 16 * 56, I_OUT = 16 * 32, I_UP = 16 * 176, I_DN = 44 * 32, I_L = I_IN + I_OUT + I_UP + I_DN;
        for (int it = gw; it < 2 * I_L; it += NGW) {
            const int l = it / I_L; int r = it % I_L;
            unsigned char* wl = ws + WS_W + (size_t)l * W_LAYER;
            if (r < I_IN) { p0_transpose_item<1>(a->in[6] + (size_t)l * DM * DIN, DM, DIN, (bf16r*)(wl + W_IN), nullptr, nullptr, scr, r, lane); continue; } r -= I_IN;
            if (r < I_OUT) { p0_transpose_item<3>(a->in[18] + (size_t)l * DM * DM, DM, DM, (bf16r*)(wl + W_OUT), a->in[16] + l * 512, a->in[17] + l * 512, scr, r, lane); continue; } r -= I_OUT;
            if (r < I_UP) { p0_transpose_item<2>(a->in[19] + (size_t)l * DM * DFF2, DM, DFF2, (bf16r*)(wl + W_UP), nullptr, nullptr, scr, r, lane); continue; } r -= I_UP;
            p0_transpose_item<0>(a->in[22] + (size_t)l * DFF * DM, DFF, DM, (bf16r*)(wl + W_DOWN), nullptr, nullptr, scr, r, lane);
        }
    }
}

__device__ __forceinline__ void prenorm_phase(KA a, int l, int which, int nrows, int nsplit, const float* ctx_src, int wid, int lane, int G) {
    const float* MOD = (const float*)(a->ws + WS_MOD); bf16r* HN = (bf16r*)(a->ws + WS_HN);
    float* ctxres = (float*)(a->ws + WS_CTXRES); const float* PART = (const float*)(a->ws + WS_PART);
    const int gw = blockIdx.x * 8 + wid, NGW = G * 8;
    const bool from_in = (l == 0 && which == 0);
    for (int row = gw; row < nrows; row += 2 * NGW) {
        const int row2 = row + NGW; const bool has2 = row2 < nrows; const int r2 = has2 ? row2 : row;
        const float* lat = from_in ? a->in[0] : a->out;
        const float* s0 = row < MLAT ? lat + (size_t)row * DM : ctx_src + (size_t)(row - MLAT) * DM;
        const float* s1 = r2 < MLAT ? lat + (size_t)r2 * DM : ctx_src + (size_t)(r2 - MLAT) * DM;
        const float* md0 = MOD + (l * 5 + (row < MLAT ? (row >> 12) : 4)) * 6144 + (which ? 3 * 1024 : 0);
        const float* md1 = MOD + (l * 5 + (r2 < MLAT ? (r2 >> 12) : 4)) * 6144 + (which ? 3 * 1024 : 0);
        f4 v0[4], v1[4];
#pragma unroll
        for (int j = 0; j < 4; ++j) { v0[j] = *(const f4*)(s0 + 4 * (lane + 64 * j)); v1[j] = *(const f4*)(s1 + 4 * (lane + 64 * j)); }
        if (nsplit > 0) {
            if (row >= MLAT) { const float* pp = PART + (size_t)(row - MLAT) * DM + 4 * lane;
                for (int ks = 0; ks < nsplit; ks += 4) {
                    f4 t_[4][4]; float wk_[4];
#pragma unroll
                    for (int kk = 0; kk < 4; ++kk) { const int k2 = ks + kk < nsplit ? ks + kk : nsplit - 1; wk_[kk] = ks + kk < nsplit ? 1.f : 0.f;
#pragma unroll
                        for (int j = 0; j < 4; ++j) t_[kk][j] = *(const f4*)(pp + (size_t)k2 * MCTX * DM + 256 * j); }
                    __builtin_amdgcn_sched_barrier(0);
#pragma unroll
                    for (int kk = 0; kk < 4; ++kk)
#pragma unroll
                        for (int j = 0; j < 4; ++j) v0[j] += t_[kk][j] * wk_[kk];
                }
#pragma unroll
                for (int j = 0; j < 4; ++j) *(f4*)(ctxres + (size_t)(row - MLAT) * DM + 4 * (lane + 64 * j)) = v0[j]; }
            if (has2 && row2 >= MLAT) { const float* pp = PART + (size_t)(row2 - MLAT) * DM + 4 * lane;
                for (int ks = 0; ks < nsplit; ks += 4) {
                    f4 t_[4][4]; float wk_[4];
#pragma unroll
                    for (int kk = 0; kk < 4; ++kk) { const int k2 = ks + kk < nsplit ? ks + kk : nsplit - 1; wk_[kk] = ks + kk < nsplit ? 1.f : 0.f;
#pragma unroll
                        for (int j = 0; j < 4; ++j) t_[kk][j] = *(const f4*)(pp + (size_t)k2 * MCTX * DM + 256 * j); }
                    __builtin_amdgcn_sched_barrier(0);
#pragma unroll
                    for (int kk = 0; kk < 4; ++kk)
#pragma unroll
                        for (int j = 0; j < 4; ++j) v1[j] += t_[kk][j] * wk_[kk];
                }
#pragma unroll
                for (int j = 0; j < 4; ++j) *(f4*)(ctxres + (size_t)(row2 - MLAT) * DM + 4 * (lane + 64 * j)) = v1[j]; }
        }
        float ss0 = 0.f, ss1 = 0.f;
#pragma unroll
        for (int j = 0; j < 4; ++j) { ss0 += (v0[j].x * v0[j].x + v0[j].y * v0[j].y) + (v0[j].z * v0[j].z + v0[j].w * v0[j].w); ss1 += (v1[j].x * v1[j].x + v1[j].y * v1[j].y) + (v1[j].z * v1[j].z + v1[j].w * v1[j].w); }
#pragma unroll
        for (int o = 1; o < 64; o <<= 1) { ss0 += __shfl_xor(ss0, o); ss1 += __shfl_xor(ss1, o); }
        const float rs0 = rsqrtf(ss0 * (1.f / DM) + EPSN), rs1 = rsqrtf(ss1 * (1.f / DM) + EPSN);
#pragma unroll
        for (int j = 0; j < 4; ++j) { const int col = 4 * (lane + 64 * j);
            { const f4 sh = *(const f4*)(md0 + col), sc = *(const f4*)(md0 + 1024 + col); const f4 h = v0[j] * rs0 * (sc + 1.f) + sh; u2 w; w.x = pk2(h.x, h.y); w.y = pk2(h.z, h.w); *(u2*)(HN + (size_t)row * DM + col) = w; }
            if (has2) { const f4 sh = *(const f4*)(md1 + col), sc = *(const f4*)(md1 + 1024 + col); const f4 h = v1[j] * rs1 * (sc + 1.f) + sh; u2 w; w.x = pk2(h.x, h.y); w.y = pk2(h.z, h.w); *(u2*)(HN + (size_t)row2 * DM + col) = w; } }
    }
}
__device__ __forceinline__ void finalnorm_phase(KA a, int wid, int lane, int G) {
    const float* fw = a->in[23];
    const int gw = blockIdx.x * 8 + wid, NGW = G * 8;
    f4 wv[4];
#pragma unroll
    for (int j = 0; j < 4; ++j) wv[j] = *(const f4*)(fw + 4 * (lane + 64 * j));
    for (int row = gw; row < MLAT; row += 2 * NGW) {
        const int row2 = row + NGW; const bool has2 = row2 < MLAT;
        float* p0 = a->out + (size_t)row * DM; float* p1 = a->out + (size_t)(has2 ? row2 : row) * DM;
        f4 v0[4], v1[4]; float ss0 = 0.f, ss1 = 0.f;
#pragma unroll
        for (int j = 0; j < 4; ++j) { v0[j] = *(const f4*)(p0 + 4 * (lane + 64 * j)); v1[j] = *(const f4*)(p1 + 4 * (lane + 64 * j)); }
#pragma unroll
        for (int j = 0; j < 4; ++j) { ss0 += (v0[j].x * v0[j].x + v0[j].y * v0[j].y) + (v0[j].z * v0[j].z + v0[j].w * v0[j].w); ss1 += (v1[j].x * v1[j].x + v1[j].y * v1[j].y) + (v1[j].z * v1[j].z + v1[j].w * v1[j].w); }
#pragma unroll
        for (int o = 1; o < 64; o <<= 1) { ss0 += __shfl_xor(ss0, o); ss1 += __shfl_xor(ss1, o); }
        const float rs0 = rsqrtf(ss0 * (1.f / DM) + EPSN), rs1 = rsqrtf(ss1 * (1.f / DM) + EPSN);
#pragma unroll
        for (int j = 0; j < 4; ++j) { *(f4*)(p0 + 4 * (lane + 64 * j)) = v0[j] * rs0 * wv[j]; if (has2) *(f4*)(p1 + 4 * (lane + 64 * j)) = v1[j] * rs1 * wv[j]; }
    }
}

struct EpiWin {
    static constexpr bool PERM = true, AFTER_DRAIN = false;
    unsigned char* ws_; const float *qw, *kw;
    __device__ __forceinline__ void operator()(const pg8::f32x4 (&acc)[2][2][4][2], const pg8::Unit& u, int wr, int wc, int fr, int fq) const {
        bf16r* const Q = (bf16r*)(ws_ + WS_Q); bf16r* const Kb = (bf16r*)(ws_ + WS_K); bf16r* const Vb = (bf16r*)(ws_ + WS_V); bf16r* const XL = (bf16r*)(ws_ + WS_XL); bf16r* const GG = (bf16r*)(ws_ + WS_GG);
        const float* const cosT = (const float*)(ws_ + WS_COS); const float* const sinT = (const float*)(ws_ + WS_SIN);
        const int pn = u.pn, row0 = u.pm * 256 + wr * 64 + fr;
        if (pn >= 3) {
            const bool isg = pn >= 5; bf16r* dst = isg ? GG : XL; const int cb = (pn - (isg ? 5 : 3)) * 256 + wc * 32 + 8 * fq;
#pragma unroll
            for (int ai = 0; ai < 2; ++ai)
#pragma unroll
                for (int m = 0; m < 4; ++m) { const int row = row0 + ai * 128 + m * 16;
#pragma unroll
                    for (int bj = 0; bj < 2; ++bj)
#pragma unroll
                        for (int n = 0; n < 2; ++n) { pg8::f32x4 v = acc[ai][bj][m][n];
                            if (isg) { v[0] = gelu_tanh(v[0]); v[1] = gelu_tanh(v[1]); v[2] = gelu_tanh(v[2]); v[3] = gelu_tanh(v[3]); }
                            u2 w; w.x = pk2(v[0], v[1]); w.y = pk2(v[2], v[3]);
                            const int col = cb + bj * 128 + n * 4;
                            if (isg) *(u2*)(dst + (size_t)(row >> 4) * 8192 + (col >> 6) * 1024 + ((col >> 4) & 3) * 256 + (row & 15) * 16 + (col & 15)) = w;
                            else *(u2*)(dst + (size_t)row * 512 + col) = w; } }
            return;
        }
        if (pn == 2 && wc >= 2) {
#pragma unroll
            for (int ai = 0; ai < 2; ++ai)
#pragma unroll
                for (int m = 0; m < 4; ++m) { const int row = row0 + ai * 128 + m * 16; bf16r* base = Vb + (size_t)kvrow(row) * 128 + (wc - 2) * 64 + 8 * fq;
#pragma unroll
                    for (int bj = 0; bj < 2; ++bj)
#pragma unroll
                        for (int n = 0; n < 2; ++n) { const pg8::f32x4 v = acc[ai][bj][m][n]; u2 w; w.x = pk2(v[0], v[1]); w.y = pk2(v[2], v[3]);
                            *(u2*)(base + 32 * bj + 4 * n) = w; } }
            return;
        }
        const bool isk = pn == 2; const float* nw = isk ? kw : qw;
        pg8::f32x4 wv[2][2];
#pragma unroll
        for (int bj = 0; bj < 2; ++bj)
#pragma unroll
            for (int n = 0; n < 2; ++n) wv[bj][n] = *(const pg8::f32x4*)(nw + 32 * bj + 8 * fq + 4 * n);
        const float osc = isk ? 1.f : attn_body::C2;
#pragma unroll
        for (int am = 0; am < 4; ++am) { const int ai = am >> 1, m0 = (am & 1) * 2;
            pg8::f32x4 csv[2][2], snv[2][2];
            const bool lat_ = (row0 + ai * 128) < MLAT;
#pragma unroll
            for (int mm = 0; mm < 2; ++mm) { const int t = (row0 + ai * 128 + (m0 + mm) * 16) & 4095;
#pragma unroll
                for (int n = 0; n < 2; ++n) { csv[mm][n] = *(const pg8::f32x4*)(cosT + t * 32 + 8 * fq + 4 * n); snv[mm][n] = *(const pg8::f32x4*)(sinT + t * 32 + 8 * fq + 4 * n); } }
            __builtin_amdgcn_sched_barrier(0);
#pragma unroll
            for (int mm = 0; mm < 2; ++mm) { const int m = m0 + mm; const int row = row0 + ai * 128 + m * 16;
                float ss = 0.f;
#pragma unroll
                for (int bj = 0; bj < 2; ++bj)
#pragma unroll
                    for (int n = 0; n < 2; ++n) { const pg8::f32x4 v = acc[ai][bj][m][n]; ss += (v[0] * v[0] + v[1] * v[1]) + (v[2] * v[2] + v[3] * v[3]); }
                ss += __shfl_xor(ss, 16); ss += __shfl_xor(ss, 32);
                const float rstd = rsqrtf(ss * (1.f / 64.f) + EPSN) * osc;
                pg8::f32x4 y[2][2];
#pragma unroll
                for (int bj = 0; bj < 2; ++bj)
#pragma unroll
                    for (int n = 0; n < 2; ++n) y[bj][n] = acc[ai][bj][m][n] * rstd * wv[bj][n];
                if (lat_) {
#pragma unroll
                    for (int n = 0; n < 2; ++n) { const pg8::f32x4 cs = csv[mm][n], sn = snv[mm][n];
                        const pg8::f32x4 o0 = y[0][n] * cs - y[1][n] * sn, o1 = y[1][n] * cs + y[0][n] * sn; y[0][n] = o0; y[1][n] = o1; } }
                bf16r* base = isk ? Kb + (size_t)kvrow(row) * 128 + wc * 64 + 8 * fq : Q + (size_t)row * 512 + (4 * pn + wc) * 64 + 8 * fq;
#pragma unroll
                for (int bj = 0; bj < 2; ++bj)
#pragma unroll
                    for (int n = 0; n < 2; ++n) { u2 w; w.x = pk2(y[bj][n][0], y[bj][n][1]); w.y = pk2(y[bj][n][2], y[bj][n][3]); *(u2*)(base + 32 * bj + 4 * n) = w; }
            }
            __builtin_amdgcn_sched_barrier(0);
        }
    }
};
struct EpiRes {
    static constexpr bool PERM = false, AFTER_DRAIN = false;
    const float *base_lat, *base_ctx; float *out_lat, *out_ctx; const float* gate;
    __device__ __forceinline__ void operator()(const pg8::f32x4 (&acc)[2][2][4][2], const pg8::Unit& u, int wr, int wc, int fr, int fq) const {
        const int pm = u.pm; const bool isctx = pm >= 64;
        const float* base = isctx ? base_ctx + (size_t)(pm - 64) * 256 * DM : base_lat + (size_t)pm * 256 * DM;
        float* out = isctx ? out_ctx + (size_t)(pm - 64) * 256 * DM : out_lat + (size_t)pm * 256 * DM;
        const float* gt = gate + (isctx ? 4 : (pm >> 4)) * 6144;
        const int col0 = u.pn * 256 + wc * 32 + 4 * fq;
        pg8::f32x4 gv[2][2];
#pragma unroll
        for (int bj = 0; bj < 2; ++bj)
#pragma unroll
            for (int n = 0; n < 2; ++n) gv[bj][n] = *(const pg8::f32x4*)(gt + col0 + bj * 128 + n * 16);
#pragma unroll
        for (int am = 0; am < 4; ++am) {
            const int ai = am >> 1, m0 = (am & 1) * 2;
            pg8::f32x4 bs[2][2][2];
#pragma unroll
            for (int mm = 0; mm < 2; ++mm) { const size_t ro = (size_t)(ai * 128 + wr * 64 + (m0 + mm) * 16 + fr) * DM + col0;
#pragma unroll
                for (int bj = 0; bj < 2; ++bj)
#pragma unroll
                    for (int n = 0; n < 2; ++n) bs[mm][bj][n] = *(const pg8::f32x4*)(base + ro + bj * 128 + n * 16); }
            __builtin_amdgcn_sched_barrier(0);
#pragma unroll
            for (int mm = 0; mm < 2; ++mm) { const size_t ro = (size_t)(ai * 128 + wr * 64 + (m0 + mm) * 16 + fr) * DM + col0;
#pragma unroll
                for (int bj = 0; bj < 2; ++bj)
#pragma unroll
                    for (int n = 0; n < 2; ++n) *(pg8::f32x4*)(out + ro + bj * 128 + n * 16) = bs[mm][bj][n] + gv[bj][n] * acc[ai][bj][m0 + mm][n]; }
            __builtin_amdgcn_sched_barrier(0);
        }
    }
};
struct EpiUpConv {
    static constexpr bool PERM = true, AFTER_DRAIN = true;
    bf16r* ACT; const float* cw; const float* cb; int mrows;
    __device__ __forceinline__ void fused(pg8::f32x4 (&acc)[2][2][4][2], const pg8::Unit& u, int wr, int wc, int fr, int fq, PG8_LAS unsigned char* lds, int wid, int lane) const {
        constexpr int PITCH = 544;
#pragma unroll
        for (int ai = 0; ai < 2; ++ai)
#pragma unroll
            for (int m = 0; m < 4; ++m) { const int lr = ai * 128 + wr * 64 + m * 16 + fr;
#pragma unroll
                for (int bj = 0; bj < 2; ++bj)
#pragma unroll
                    for (int n = 0; n < 2; ++n) { const pg8::f32x4 v = acc[ai][bj][m][n]; u2 w; w.x = pk2(v[0], v[1]); w.y = pk2(v[2], v[3]);
                        *(PG8_LAS u2*)(lds + lr * PITCH + (bj * 128 + wc * 32 + 8 * fq + 4 * n) * 2) = w; } }
        LDS_WAIT(); __syncthreads();
        const int tid = wid * 64 + lane, cgp = tid & 15, rr = tid >> 4;
        const int ch = u.pn * 128 + 8 * cgp;
        float wg[3][8], wvv[3][8], bg[8], bv[8];
#pragma unroll
        for (int k = 0; k < 3; ++k)
#pragma unroll
            for (int h = 0; h < 2; ++h) { const f4 t0 = *(const f4*)(cw + k * DFF2 + ch + 4 * h), t1 = *(const f4*)(cw + k * DFF2 + DFF + ch + 4 * h);
                wg[k][4 * h] = t0.x; wg[k][4 * h + 1] = t0.y; wg[k][4 * h + 2] = t0.z; wg[k][4 * h + 3] = t0.w; wvv[k][4 * h] = t1.x; wvv[k][4 * h + 1] = t1.y; wvv[k][4 * h + 2] = t1.z; wvv[k][4 * h + 3] = t1.w; }
#pragma unroll
        for (int h = 0; h < 2; ++h) { const f4 t0 = *(const f4*)(cb + ch + 4 * h), t1 = *(const f4*)(cb + DFF + ch + 4 * h);
            bg[4 * h] = t0.x; bg[4 * h + 1] = t0.y; bg[4 * h + 2] = t0.z; bg[4 * h + 3] = t0.w; bv[4 * h] = t1.x; bv[4 * h + 1] = t1.y; bv[4 * h + 2] = t1.z; bv[4 * h + 3] = t1.w; }
        const int row_first = u.pm * 254 - 1, lr0 = 1 + 8 * rr;
        PG8_LAS const unsigned char* up = lds + 16 * cgp;
        u4 pg_ = *(PG8_LAS const u4*)(up + (lr0 - 1) * PITCH), pv_ = *(PG8_LAS const u4*)(up + (lr0 - 1) * PITCH + 256);
        u4 cg_ = *(PG8_LAS const u4*)(up + lr0 * PITCH), cv_ = *(PG8_LAS const u4*)(up + lr0 * PITCH + 256);
#pragma unroll
        for (int i = 0; i < 8; ++i) { const int lr = lr0 + i;
            if (lr <= 254) {
                const u4 ng_ = *(PG8_LAS const u4*)(up + (lr + 1) * PITCH), nv_ = *(PG8_LAS const u4*)(up + (lr + 1) * PITCH + 256);
                const int r = row_first + lr;
                if (r < mrows) {
                    const int p = r < MLAT ? (r & 4095) : ((r - MLAT) & 255), T = r < MLAT ? SEQL : CTXL;
                    const bool hp = p > 0, hn = p < T - 1;
                    const u4 z4 = (u4){0u, 0u, 0u, 0u};
                    const u4 pgm = hp ? pg_ : z4, pvm = hp ? pv_ : z4, ngm = hn ? ng_ : z4, nvm = hn ? nv_ : z4;
                    unsigned ow[4];
#pragma unroll
                    for (int e2 = 0; e2 < 4; ++e2) {
                        float o2[2];
#pragma unroll
                        for (int hh = 0; hh < 2; ++hh) { const int e = 2 * e2 + hh;
                            const float gp = hh ? bf_hi(pgm[e2]) : bf_lo(pgm[e2]), gc = hh ? bf_hi(cg_[e2]) : bf_lo(cg_[e2]), gn = hh ? bf_hi(ngm[e2]) : bf_lo(ngm[e2]);
                            const float vp = hh ? bf_hi(pvm[e2]) : bf_lo(pvm[e2]), vc = hh ? bf_hi(cv_[e2]) : bf_lo(cv_[e2]), vn = hh ? bf_hi(nvm[e2]) : bf_lo(nvm[e2]);
                            const float g = bg[e] + wg[1][e] * gc + wg[0][e] * gp + wg[2][e] * gn;
                            const float v = bv[e] + wvv[1][e] * vc + wvv[0][e] * vp + wvv[2][e] * vn;
                            o2[hh] = g * sigmoidf_(g) * v; }
                        ow[e2] = pk2(o2[0], o2[1]); }
                    u4 o; o.x = ow[0]; o.y = ow[1]; o.z = ow[2]; o.w = ow[3];
                    *(u4*)(ACT + (size_t)r * DFF + ch) = o;
                }
                pg_ = cg_; pv_ = cv_; cg_ = ng_; cv_ = nv_;
            } }
        LDS_WAIT(); __syncthreads();
    }
};
struct SplitOrder { int nsub, S, kslice, G, c;
    __device__ __forceinline__ bool next(int i, pg8::Unit& u) const { const int x = c + i * G; if (x >= nsub) return false; const int ks = x % S, t = x / S; u.pm = 64 + (t >> 2); u.pn = t & 3; u.koff = ks * kslice; return true; }
    __device__ __forceinline__ void a_ready(const pg8::Unit&) const {}
    __device__ __forceinline__ void done(const pg8::Unit&) const {} };
struct EpiPart {
    static constexpr bool PERM = false, AFTER_DRAIN = false;
    float* part; const float* gate; int kslice;
    __device__ __forceinline__ void operator()(const pg8::f32x4 (&acc)[2][2][4][2], const pg8::Unit& u, int wr, int wc, int fr, int fq) const {
        asm volatile("" : "+v"(fr), "+v"(fq));
        float* out = part + ((size_t)(u.koff / kslice) * MCTX + (size_t)(u.pm - 64) * 256) * DM;
        const float* gt = gate + 4 * 6144;
        const int col0 = u.pn * 256 + wc * 32 + 4 * fq;
        pg8::f32x4 gv[2][2];
#pragma unroll
        for (int bj = 0; bj < 2; ++bj)
#pragma unroll
            for (int n = 0; n < 2; ++n) gv[bj][n] = *(const pg8::f32x4*)(gt + col0 + bj * 128 + n * 16);
#pragma unroll
        for (int ai = 0; ai < 2; ++ai)
#pragma unroll
            for (int m = 0; m < 4; ++m) { const size_t ro = (size_t)(ai * 128 + wr * 64 + m * 16 + fr) * DM + col0;
#pragma unroll
                for (int bj = 0; bj < 2; ++bj)
#pragma unroll
                    for (int n = 0; n < 2; ++n) *(pg8::f32x4*)(out + ro + bj * 128 + n * 16) = gv[bj][n] * acc[ai][bj][m][n]; }
    }
};
struct OneUnit { pg8::Unit u;
    __device__ __forceinline__ bool next(int i, pg8::Unit& o) const { if (i) return false; o = u; return true; }
    __device__ __forceinline__ void a_ready(const pg8::Unit&) const {}
    __device__ __forceinline__ void done(const pg8::Unit&) const {} };

#define DPPF(old, src, ctrl) __builtin_bit_cast(float, __builtin_amdgcn_update_dpp(__builtin_bit_cast(int, (float)(old)), __builtin_bit_cast(int, (float)(src)), ctrl, 0xf, 0xf, false))
struct LruCtx { const bf16r* XLp; const bf16r* GWn; LAS const float* tab; LAS float* scr; int p0, T, n, tok, q; };
typedef _Float16 h2v __attribute__((ext_vector_type(2)));
__device__ __forceinline__ unsigned pkh2(float lo, float hi) { return __builtin_bit_cast(unsigned, __builtin_amdgcn_cvt_pkrtz(lo, hi)); }
__device__ __forceinline__ float h2lo(unsigned w) { return (float)__builtin_bit_cast(h2v, w).x; }
__device__ __forceinline__ float h2hi(unsigned w) { return (float)__builtin_bit_cast(h2v, w).y; }
__device__ __forceinline__ void lru_conv_load(const LruCtx& c, int s, u4 (&raw)[8]) {
    const int i = 16 * s + c.tok, p = c.p0 + i;
#pragma unroll
    for (int ks = 0; ks < 2; ++ks)
#pragma unroll
        for (int k = 0; k < 4; ++k) { const int pp = p + k - 2; const bool ok = pp >= 0 && pp < c.T;
            raw[4 * ks + k] = *(const u4*)(c.XLp + (ptrdiff_t)(ok ? i + k - 2 : i) * 512 + 32 * ks + 8 * c.q); }
}
__device__ __forceinline__ void lru_conv(const LruCtx& c, int s, const u4 (&raw)[8], s8v (&frag)[2], f4 (&xc)[4]) {
    const int i = 16 * s + c.tok, p = c.p0 + i;
    float xb[2][8];
#pragma unroll
    for (int ks = 0; ks < 2; ++ks) { const int c0 = 32 * ks + 8 * c.q, chn = 64 * c.n + c0;
#pragma unroll
        for (int h = 0; h < 2; ++h) { const f4 t = *(LAS const f4*)(c.tab + 2048 + chn + 4 * h); xb[ks][4 * h] = t.x; xb[ks][4 * h + 1] = t.y; xb[ks][4 * h + 2] = t.z; xb[ks][4 * h + 3] = t.w; }
#pragma unroll
        for (int k = 0; k < 4; ++k) { const int pp = p + k - 2; const bool ok = pp >= 0 && pp < c.T;
            const u4 rw = raw[4 * ks + k];
#pragma unroll
            for (int h = 0; h < 2; ++h) { f4 w = *(LAS const f4*)(c.tab + k * 512 + chn + 4 * h); if (!ok) w = (f4){0.f, 0.f, 0.f, 0.f};
                xb[ks][4 * h] += w.x * bf_lo(rw[2 * h]); xb[ks][4 * h + 1] += w.y * bf_hi(rw[2 * h]); xb[ks][4 * h + 2] += w.z * bf_lo(rw[2 * h + 1]); xb[ks][4 * h + 3] += w.w * bf_hi(rw[2 * h + 1]); } } }
#pragma unroll
    for (int ks = 0; ks < 2; ++ks) { LAS float* sp = c.scr + c.tok * 68 + 32 * ks + 8 * c.q;
        *(LAS f4*)sp = (f4){xb[ks][0], xb[ks][1], xb[ks][2], xb[ks][3]}; *(LAS f4*)(sp + 4) = (f4){xb[ks][4], xb[ks][5], xb[ks][6], xb[ks][7]};
        u4 w; w.x = pk2(xb[ks][0], xb[ks][1]); w.y = pk2(xb[ks][2], xb[ks][3]); w.z = pk2(xb[ks][4], xb[ks][5]); w.w = pk2(xb[ks][6], xb[ks][7]); frag[ks] = __builtin_bit_cast(s8v, w); }
    LDS_WAIT();
#pragma unroll
    for (int rb = 0; rb < 4; ++rb) xc[rb] = *(LAS const f4*)(c.scr + c.tok * 68 + 16 * rb + 4 * c.q);
    LDS_WAIT();
}
__device__ __forceinline__ void lru_wload(const LruCtx& c, int dir, s8v (&W)[16]) {
    const bf16r* gwa = c.GWn + (size_t)(dir * 2) * 8 * 4096, *gwx = gwa + 8 * 4096;
#pragma unroll
    for (int rb = 0; rb < 4; ++rb)
#pragma unroll
        for (int ks = 0; ks < 2; ++ks) { const int off = (16 * rb + c.tok) * 64 + 32 * ks + 8 * c.q; W[4 * rb + 2 * ks] = *(const s8v*)(gwa + off); W[4 * rb + 2 * ks + 1] = *(const s8v*)(gwx + off); }
}
__device__ __forceinline__ void lru_gates(const LruCtx& c, int dir, const s8v (&W)[16], const s8v (&frag)[2], const f4 (&xc)[4], float (&LA)[16], float (&AV)[16], float (&B)[16]) {
    f4 ga[4], gx[4];
#pragma unroll
    for (int rb = 0; rb < 4; ++rb) { ga[rb] = (f4){0.f, 0.f, 0.f, 0.f}; gx[rb] = (f4){0.f, 0.f, 0.f, 0.f};
#pragma unroll
        for (int ks = 0; ks < 2; ++ks) {
            ga[rb] = __builtin_amdgcn_mfma_f32_16x16x32_bf16(W[4 * rb + 2 * ks], frag[ks], ga[rb], 0, 0, 0);
            gx[rb] = __builtin_amdgcn_mfma_f32_16x16x32_bf16(W[4 * rb + 2 * ks + 1], frag[ks], gx[rb], 0, 0, 0); } }
#pragma unroll
    for (int rb = 0; rb < 4; ++rb) { const int chn = dir * 512 + 64 * c.n + 16 * rb + 4 * c.q;
        const f4 ba = *(LAS const f4*)(c.tab + 2560 + chn), bx = *(LAS const f4*)(c.tab + 3584 + chn), cl = *(LAS const f4*)(c.tab + 4608 + chn);
#pragma unroll
        for (int j = 0; j < 4; ++j) { const float r = sigmoidf_(ga[rb][j] + ba[j]), ii = sigmoidf_(gx[rb][j] + bx[j]);
            const float la = cl[j] * r, z = 2.f * la, av = fexp(la);
            const float om = (z > -0.0078125f) ? -z * (1.f + 0.5f * z) : __builtin_fmaf(-av, av, 1.f);
            LA[4 * rb + j] = la; AV[4 * rb + j] = av; B[4 * rb + j] = __builtin_amdgcn_sqrtf(om) * ii * xc[rb][j]; } }
}
__device__ __forceinline__ void scan_fwd(float (&A)[16], float (&B)[16]) {
#pragma unroll
    for (int k = 0; k < 16; ++k) { float a_ = A[k], b_ = B[k], ap, bp;
        ap = DPPF(1.f, a_, 0x111); bp = DPPF(0.f, b_, 0x111); b_ = a_ * bp + b_; a_ = a_ * ap;
        ap = DPPF(1.f, a_, 0x112); bp = DPPF(0.f, b_, 0x112); b_ = a_ * bp + b_; a_ = a_ * ap;
        ap = DPPF(1.f, a_, 0x114); bp = DPPF(0.f, b_, 0x114); b_ = a_ * bp + b_; a_ = a_ * ap;
        ap = DPPF(1.f, a_, 0x118); bp = DPPF(0.f, b_, 0x118); b_ = a_ * bp + b_; a_ = a_ * ap;
        A[k] = a_; B[k] = b_; }
}
__device__ __forceinline__ void scan_bwd(float (&A)[16], float (&B)[16]) {
#pragma unroll
    for (int k = 0; k < 16; ++k) { float a_ = A[k], b_ = B[k], ap, bp;
        ap = DPPF(1.f, a_, 0x101); bp = DPPF(0.f, b_, 0x101); b_ = a_ * bp + b_; a_ = a_ * ap;
        ap = DPPF(1.f, a_, 0x102); bp = DPPF(0.f, b_, 0x102); b_ = a_ * bp + b_; a_ = a_ * ap;
        ap = DPPF(1.f, a_, 0x104); bp = DPPF(0.f, b_, 0x104); b_ = a_ * bp + b_; a_ = a_ * ap;
        ap = DPPF(1.f, a_, 0x108); bp = DPPF(0.f, b_, 0x108); b_ = a_ * bp + b_; a_ = a_ * ap;
        A[k] = a_; B[k] = b_; }
}
__device__ __forceinline__ void lru_tables(KA a, int l, LAS float* tab, int tid) {
    for (int e = tid; e < 5632; e += 512) { float v;
        if (e < 2048) v = a->in[9][l * 2048 + e];
        else if (e < 2560) v = a->in[10][l * 512 + (e - 2048)];
        else if (e < 3584) v = a->in[12][l * 1024 + (e - 2560)];
        else if (e < 4608) v = a->in[14][l * 1024 + (e - 3584)];
        else { const float lam = a->in[15][l * 1024 + (e - 4608)]; const float x = fexp(-lam); const float sp = x < 0.03f ? x * (1.f - x * (0.5f - x * (0.33333334f - x * 0.25f))) : (lam < -20.f ? -lam : __builtin_amdgcn_logf(1.f + x) * 0.6931471805599453f); v = -8.f * sp; }
        tab[e] = v; }
}
__device__ __forceinline__ void lru_l1_tile(KA a, int l, int b, int cid, int dir, LAS unsigned char* lds, int tid, int wid, int lane) {
    asm volatile("" : "+v"(lane), "+v"(tid));
    unsigned char* ws = a->ws;
    LAS float* tab = (LAS float*)(lds + L1_TAB_OFF); LAS float* scr = (LAS float*)(lds + L1_TAB_OFF + 22528) + wid * (16 * 68);
    LruCtx c; c.n = wid; c.tok = lane & 15; c.q = lane >> 4; c.tab = tab; c.scr = scr;
    const bool isctx = cid < 4; c.p0 = (isctx ? cid : cid - 4) * 64; c.T = isctx ? CTXL : SEQL;
    const int rowbase = isctx ? MLAT + b * CTXL + c.p0 : b * SEQL + c.p0;
    c.XLp = (const bf16r*)(ws + WS_XL) + (size_t)rowbase * 512 + c.n * 64;
    c.GWn = (const bf16r*)(ws + WS_GW) + (size_t)(l * 4) * 8 * 4096 + c.n * 4096;
    float* AGGA = (float*)(ws + WS_AGGA); float* AGGB = (float*)(ws + WS_AGGB);
    unsigned* LAB = (unsigned*)(ws + WS_LAB) + (size_t)(rowbase >> 4) * 8192 + 1024 * c.n + 16 * c.tok + 4 * c.q;
    const int bl = (lane & 48) | 15, bf_ = (lane & 48);
    {
        LAS float* rab = (LAS float*)(lds + L1_TAB_OFF + 22528 + 34816) + wid * 128 + c.q * 32;
#pragma unroll
        for (int k = 0; k < 16; ++k) { rab[2 * k] = 1.f; rab[2 * k + 1] = 0.f; }
        s8v W[16];
        lru_wload(c, dir, W);
        u4 rawc[8];
        lru_conv_load(c, 0, rawc);
#pragma unroll 1
        for (int s = 0; s < 4; ++s) {
            s8v frag[2]; f4 xc[4];
            lru_conv(c, s, rawc, frag, xc);
            __builtin_amdgcn_sched_barrier(0);
            lru_conv_load(c, s < 3 ? s + 1 : 3, rawc);
            __builtin_amdgcn_sched_barrier(0);
            float LAv[16], A[16], B[16];
            lru_gates(c, dir, W, frag, xc, LAv, A, B);
            unsigned* lp = LAB + (size_t)dir * MALL * 512 + (size_t)s * 8192;
#pragma unroll
            for (int rb = 0; rb < 4; ++rb) { u4 w; w.x = pkh2(LAv[4 * rb], B[4 * rb]); w.y = pkh2(LAv[4 * rb + 1], B[4 * rb + 1]); w.z = pkh2(LAv[4 * rb + 2], B[4 * rb + 2]); w.w = pkh2(LAv[4 * rb + 3], B[4 * rb + 3]); *(u4*)(lp + 256 * rb) = w; }
            if (dir == 0) scan_fwd(A, B); else scan_bwd(A, B);
#pragma unroll
            for (int k = 0; k < 16; ++k) {
                const float a_ = __shfl(A[k], dir ? bf_ : bl), b_ = __shfl(B[k], dir ? bf_ : bl);
                const float ra = rab[2 * k], rb_ = rab[2 * k + 1];
                if (dir == 0) { rab[2 * k + 1] = a_ * rb_ + b_; rab[2 * k] = a_ * ra; }
                else { rab[2 * k + 1] = ra * b_ + rb_; rab[2 * k] = ra * a_; } }
            LDS_WAIT();
        }
        if (c.tok == 0) { const size_t o = ((size_t)(b * 2 + dir) * NCH + cid) * 512 + 64 * c.n + 4 * c.q;
#pragma unroll
            for (int rb = 0; rb < 4; ++rb) { *(f4*)(AGGA + o + 16 * rb) = (f4){rab[8 * rb], rab[8 * rb + 2], rab[8 * rb + 4], rab[8 * rb + 6]}; *(f4*)(AGGB + o + 16 * rb) = (f4){rab[8 * rb + 1], rab[8 * rb + 3], rab[8 * rb + 5], rab[8 * rb + 7]}; } }
    }
    LDS_WAIT(); __syncthreads();
}
__device__ __forceinline__ void lru_l2_tile(KA a, int l, int b, int cid, LAS unsigned char* lds, int tid, int wid, int lane) {
    asm volatile("" : "+v"(lane));
    unsigned char* ws = a->ws;
    LAS float* part = (LAS float*)lds;
    LAS float* hfl = (LAS float*)(lds + 4096) + wid * 4096 + lane;
    const int n = wid, tok = lane & 15, q = lane >> 4;
    const bool isctx = cid < 4; const int p0 = (isctx ? cid : cid - 4) * 64;
    const int rowbase = isctx ? MLAT + b * CTXL + p0 : b * SEQL + p0;
    const float* AGGA = (const float*)(ws + WS_AGGA); const float* AGGB = (const float*)(ws + WS_AGGB);
    const unsigned* LAB = (const unsigned*)(ws + WS_LAB) + (size_t)(rowbase >> 4) * 8192 + 1024 * n + 16 * tok + 4 * q;
    const bf16r* GGp = (const bf16r*)(ws + WS_GG) + (size_t)(rowbase >> 4) * 8192 + 1024 * n + 16 * tok + 4 * q;
    const int bl = (lane & 48) | 15, bf_ = (lane & 48);
    float hin[16], hinb[16], A[16], B[16];
#pragma unroll 1
    for (int dir = 0; dir < 2; ++dir) {
        const float* ap_ = AGGA + ((size_t)(b * 2 + dir) * NCH) * 512 + 64 * n + 4 * q; const float* bp_ = AGGB + ((size_t)(b * 2 + dir) * NCH) * 512 + 64 * n + 4 * q;
#pragma unroll
        for (int k = 0; k < 16; ++k) { A[k] = 1.f; B[k] = 0.f; }
#pragma unroll
        for (int eb = 0; eb < 5; eb += 3) {
            f4 avv[3][4], bvv[3][4]; bool okv[3];
#pragma unroll
            for (int e2 = 0; e2 < 3; ++e2) { if (eb + e2 < 5) { const int o = 5 * tok + eb + e2; int ch; bool ok;
                if (dir == 0) { ch = o; ok = o < cid; } else { ch = o < 4 ? 3 - o : 71 - o; ok = isctx ? (o < 4 && ch > cid) : (o < 4 || (o < 68 && ch > cid)); }
                ch = ch < 0 ? 0 : (ch > NCH - 1 ? NCH - 1 : ch); okv[e2] = ok;
#pragma unroll
                for (int rb = 0; rb < 4; ++rb) { avv[e2][rb] = *(const f4*)(ap_ + (size_t)ch * 512 + 16 * rb); bvv[e2][rb] = *(const f4*)(bp_ + (size_t)ch * 512 + 16 * rb); } } }
            __builtin_amdgcn_sched_barrier(0);
#pragma unroll
            for (int e2 = 0; e2 < 3; ++e2) { if (eb + e2 < 5) {
#pragma unroll
                for (int rb = 0; rb < 4; ++rb) { f4 av = avv[e2][rb], bv = bvv[e2][rb];
                    if (!okv[e2]) { av = (f4){1.f, 1.f, 1.f, 1.f}; bv = (f4){0.f, 0.f, 0.f, 0.f}; }
#pragma unroll
                    for (int jj = 0; jj < 4; ++jj) { B[4 * rb + jj] = av[jj] * B[4 * rb + jj] + bv[jj]; A[4 * rb + jj] = av[jj] * A[4 * rb + jj]; } } } }
            __builtin_amdgcn_sched_barrier(0);
        }
        scan_fwd(A, B);
        if (dir == 0) {
#pragma unroll
            for (int k = 0; k < 16; ++k) hin[k] = __shfl(B[k], bl);
        } else {
#pragma unroll
            for (int k = 0; k < 16; ++k) hinb[k] = __shfl(B[k], bl);
        }
    }
    u4 wc_[4], wn_[4]; u2 gc_[4], gn_[4];
#pragma unroll
    for (int rb = 0; rb < 4; ++rb) { wc_[rb] = *(const u4*)(LAB + 256 * rb); gc_[rb] = (u2){0u, 0u}; gn_[rb] = (u2){0u, 0u}; }
#pragma unroll 1
    for (int st = 0; st < 8; ++st) {
        const int s = st < 4 ? st : 7 - st;
        { const int sn = st + 1 < 8 ? st + 1 : 7; const int s2 = sn < 4 ? sn : 7 - sn; const bool bw = sn >= 4;
          const unsigned* lp_ = LAB + (size_t)(bw ? MALL : 0) * 512 + (size_t)s2 * 8192; const bf16r* gp_ = GGp + (size_t)s2 * 8192;
#pragma unroll
          for (int rb = 0; rb < 4; ++rb) { wn_[rb] = *(const u4*)(lp_ + 256 * rb); gn_[rb] = *(const u2*)(gp_ + 256 * rb); } }
        __builtin_amdgcn_sched_barrier(0);
#pragma unroll
        for (int rb = 0; rb < 4; ++rb)
#pragma unroll
            for (int j = 0; j < 4; ++j) { A[4 * rb + j] = fexp(h2lo(wc_[rb][j])); B[4 * rb + j] = h2hi(wc_[rb][j]); }
        LAS float* hs = hfl + s * 1024;
        if (st < 4) {
            scan_fwd(A, B);
#pragma unroll
            for (int k = 0; k < 16; ++k) { const float h = A[k] * hin[k] + B[k]; hs[k * 64] = h; hin[k] = __shfl(h, bl); }
        } else {
            if (st == 4) {
#pragma unroll
                for (int k = 0; k < 16; ++k) hin[k] = hinb[k]; }
            scan_bwd(A, B);
            float sq = 0.f;
#pragma unroll
            for (int rb = 0; rb < 4; ++rb)
#pragma unroll
                for (int j = 0; j < 4; ++j) { const int k = 4 * rb + j; const float h = A[k] * hin[k] + B[k]; hin[k] = __shfl(h, bf_);
                    const float gg = (j & 1) ? bf_hi(gc_[rb][j >> 1]) : bf_lo(gc_[rb][j >> 1]);
                    const float r = (hs[k * 64] + h) * gg; hs[k * 64] = r; sq += r * r; }
            sq += __shfl_xor(sq, 16); sq += __shfl_xor(sq, 32); if (q == 0) part[wid * 64 + 16 * s + tok] = sq;
        }
#pragma unroll
        for (int rb = 0; rb < 4; ++rb) { wc_[rb] = wn_[rb]; gc_[rb] = gn_[rb]; }
    }
    LDS_WAIT(); __syncthreads();
    bf16r* MIX = (bf16r*)(ws + WS_MIX);
#pragma unroll 1
    for (int s = 0; s < 4; ++s) { float t = 0.f;
#pragma unroll
        for (int w = 0; w < 8; ++w) t += part[w * 64 + 16 * s + tok];
        const float rstd = rsqrtf(t * (1.f / 512.f) + EPSN);
        bf16r* mp = MIX + (size_t)(rowbase + 16 * s + tok) * DM + 512 + 64 * n + 4 * q;
        const LAS float* hs = hfl + s * 1024;
#pragma unroll
        for (int rb = 0; rb < 4; ++rb) { u2 w; w.x = pk2(hs[(4 * rb) * 64] * rstd, hs[(4 * rb + 1) * 64] * rstd); w.y = pk2(hs[(4 * rb + 2) * 64] * rstd, hs[(4 * rb + 3) * 64] * rstd); *(u2*)(mp + 16 * rb) = w; } }
    const bf16r* O = (const bf16r*)(ws + WS_O) + (size_t)(rowbase + wid * 8) * 512 + 8 * lane;
    u4 rawc = *(const u4*)O;
#pragma unroll 1
    for (int tt = 0; tt < 8; ++tt) {
        const u4 rawn = *(const u4*)(O + (size_t)(tt < 7 ? tt + 1 : 7) * 512);
        float v[8]; float ss = 0.f;
#pragma unroll
        for (int e = 0; e < 4; ++e) { v[2 * e] = bf_lo(rawc[e]); v[2 * e + 1] = bf_hi(rawc[e]); ss += v[2 * e] * v[2 * e] + v[2 * e + 1] * v[2 * e + 1]; }
        const float rstd = rsqrtf(wave_sum(ss) * (1.f / 512.f) + EPSN);
        u4 o; o.x = pk2(v[0] * rstd, v[1] * rstd); o.y = pk2(v[2] * rstd, v[3] * rstd); o.z = pk2(v[4] * rstd, v[5] * rstd); o.w = pk2(v[6] * rstd, v[7] * rstd);
        *(u4*)(MIX + (size_t)(rowbase + wid * 8 + tt) * DM + 8 * lane) = o;
        rawc = rawn; }
    LDS_WAIT(); __syncthreads();
}

#define GAS __attribute__((address_space(1)))
#define XB_TMO      128
#define XB_XCNT(j)  (256  + 64 * (j))
#define XB_XSUB(j)  (1280 + 64 * (j))
#define XB_XGEN(j)  (2304 + 64 * (j))
#define XB_TOP      3328
#define XB_TOPGEN   3392
#define XCD_BAR_WORDS 3456
#define XB_SPIN_CAP (1u << 18)

__device__ __forceinline__ unsigned xb_ld(unsigned* p)              { return __hip_atomic_load(p, __ATOMIC_RELAXED, __HIP_MEMORY_SCOPE_AGENT); }
__device__ __forceinline__ unsigned xb_add(unsigned* p, unsigned v) { return __hip_atomic_fetch_add(p, v, __ATOMIC_RELAXED, __HIP_MEMORY_SCOPE_AGENT); }
__device__ __forceinline__ unsigned xb_xcc_id() { return (unsigned)__builtin_amdgcn_s_getreg((3 << 11) | 20) & 0xFu; }
#define XB_SPIN(cond, bar) do { unsigned _sp = 0; while (cond) { __builtin_amdgcn_s_sleep(1); \
    if ((++_sp & 255u) == 0u) { if (xb_ld(&(bar)[XB_TMO])) break; if (_sp > XB_SPIN_CAP) { atomicAdd(&(bar)[XB_TMO], 1u); break; } } } } while (0)

struct XcdBarrier {
    unsigned* bar; unsigned x;
    volatile LAS unsigned* st;
};

__device__ __forceinline__ XcdBarrier xcd_barrier_post(unsigned* bar, volatile LAS unsigned* st) {
    XcdBarrier b; b.bar = bar; b.x = xb_xcc_id(); b.st = st;
    if (threadIdx.x == 0) (void)xb_add(&bar[XB_XCNT(b.x)], 1u);
    return b;
}
__device__ __forceinline__ void xcd_barrier_complete(unsigned* bar, unsigned x, unsigned& nloc, unsigned& nx) {
    const unsigned G = gridDim.x * gridDim.y * gridDim.z;
    unsigned sum, cnt, mine, sp = 0u;
    for (;;) {
        sum = 0u; cnt = 0u; mine = 0u;
#pragma unroll
        for (unsigned j = 0; j < 16; ++j) { const unsigned c = xb_ld(&bar[XB_XCNT(j)]); sum += c; cnt += (c > 0u) ? 1u : 0u; mine = (j == x) ? c : mine; }
        if (sum == G) break;
        __builtin_amdgcn_s_sleep(1);
        if ((++sp & 255u) == 0u) { if (xb_ld(&bar[XB_TMO])) break; if (sp > XB_SPIN_CAP) { atomicAdd(&bar[XB_TMO], 1u); break; } }
    }
    nloc = mine > 0u ? mine : 1u; nx = cnt > 0u ? cnt : 1u;
}

__device__ __forceinline__ void xcd_barrier(const XcdBarrier& b) {
    asm volatile("s_waitcnt vmcnt(0)" ::: "memory");
    __syncthreads();
    if (threadIdx.x == 0) {
        unsigned* bar = b.bar;
        __builtin_amdgcn_s_waitcnt(0);
        unsigned nloc = b.st[0], nx = b.st[1];
        if (nloc == 0u) { xcd_barrier_complete(bar, b.x, nloc, nx); b.st[0] = nloc; b.st[1] = nx; }
        const unsigned old = xb_add(&bar[XB_XSUB(b.x)], 1u);
        const unsigned gen = old / nloc;
        if (old + 1u == (gen + 1u) * nloc) {
            __builtin_amdgcn_fence(__ATOMIC_RELEASE, "agent");
            asm volatile("s_waitcnt vmcnt(0)" ::: "memory");
            const unsigned og = xb_add(&bar[XB_TOP], 1u);
            const unsigned tg = og / nx;
            if (og + 1u == (tg + 1u) * nx) xb_add(&bar[XB_TOPGEN], 1u);
            else XB_SPIN(xb_ld(&bar[XB_TOPGEN]) == tg, bar);
            __builtin_amdgcn_fence(__ATOMIC_ACQUIRE, "agent");
            xb_add(&bar[XB_XGEN(b.x)], 1u);
            asm volatile("s_waitcnt vmcnt(0)" ::: "memory");
        } else {
            XB_SPIN(xb_ld(&bar[XB_XGEN(b.x)]) == gen, bar);
            __builtin_amdgcn_fence(__ATOMIC_ACQUIRE, "agent");
            asm volatile("s_waitcnt vmcnt(0)" ::: "memory");
        }
    }
    __syncthreads();
}

#ifndef REP_PH
#define REP_PH -1
#endif
#ifndef REP_SKIP_L1
#define REP_SKIP_L1 0
#endif
#ifndef USE_XBAR
#define USE_XBAR 1
#endif
__global__ void __launch_bounds__(512, 2) mega(Args a_) {
    extern __shared__ __attribute__((aligned(16))) unsigned char lds_raw[];
    LAS unsigned char* lds = (LAS unsigned char*)lds_raw;
    const int G = gridDim.x, bx = blockIdx.x;
    const int vcu = (G % 8 == 0) ? (bx % 8) * (G / 8) + bx / 8 : bx;
    KA a = (KA)__builtin_amdgcn_kernarg_segment_ptr();
    volatile LAS unsigned* bst = (volatile LAS unsigned*)(lds + LDS_BYTES - 64);
    if (threadIdx.x < 2) bst[threadIdx.x] = 0u;
    __syncthreads();
    (void)xcd_barrier_post((unsigned*)a->ws, bst);
    int nsync = 0;
#define GRID_SYNC() do { if (!USE_XBAR || a->ph_lo < 0) cg::this_grid().sync();     else { XcdBarrier xb_; xb_.bar = (unsigned*)a->ws; xb_.x = xb_xcc_id(); xb_.st = (volatile LAS unsigned*)(lds + LDS_BYTES - 64); xcd_barrier(xb_); } ++nsync; } while (0)
    const int ph_hi = a->ph_hi;
    for (int ph = a->ph_lo; ph < ph_hi; ++ph) {
        asm volatile("" : "+s"(a));
        for (int rep = 0; rep < (ph == REP_PH ? 2 : 1); ++rep) {
        if (rep) GRID_SYNC();
#define TL const int tid = mk_tid(), lane = tid & 63, wid = __builtin_amdgcn_readfirstlane(tid >> 6); (void)tid; (void)lane; (void)wid
        unsigned char* ws = a->ws;
        float* MOD = (float*)(ws + WS_MOD); float* ctxres = (float*)(ws + WS_CTXRES);
        bf16r* HN = (bf16r*)(ws + WS_HN);
        if (ph == 0) { if (PON(8)) { TL; p0_phase(a, lds, tid, wid, lane, G); } }
        else if (ph == NPHASE - 1) { if (PON(9)) { TL; finalnorm_phase(a, wid, lane, G); } }
        else {
            const int l = (ph - 1) >> 3, sub = (ph - 1) & 7;
            unsigned char* wl = ws + WS_W + (size_t)l * W_LAYER;
            const bool ctx_out = l == 0;
            if (sub == 0) { if (PON(0)) { TL; prenorm_phase(a, l, 0, MALL, l == 0 ? 0 : 11, l == 0 ? a->in[2] : ctxres, wid, lane, G); } }
            else if (sub == 1) { if (PON(1)) {
                pg8::Gemm g{HN, (const bf16r*)(wl + W_IN), MALL, DIN, DM, 256, DM}; pg8::StaticOrder S; S.init(MALL, DIN, G, bx);
                EpiWin E{ws, a->in[7] + l * 64, a->in[8] + l * 64};
                pg8::gemm_phase<EpiWin, pg8::StaticOrder, true, true>(lds, g, S, E); }
            } else if (sub == 2) { if (PON(2)) { TL;
                const int nctx = ctx_out ? 4 : 0, cnt = 64 + nctx + ((rep && REP_SKIP_L1) ? 0 : 68);
                attn_body::bf16* Qb = (attn_body::bf16*)(ws + WS_Q); attn_body::bf16* Ob = (attn_body::bf16*)(ws + WS_O); const attn_body::bf16* Kb = (const attn_body::bf16*)(ws + WS_K); const attn_body::bf16* Vb = (const attn_body::bf16*)(ws + WS_V);
                LAS unsigned char* l3 = lds; asm volatile("" : "+s"(l3)); char* shm = (char*)l3;
                volatile LAS int* qw = (volatile LAS int*)(lds + LDS_BYTES - 32);
                unsigned* qctr = (unsigned*)ws + 3584 + (l * 2 + rep) * 8 * 64;
                const int hx = (int)(xb_xcc_id() & 7u);
                lru_tables(a, l, (LAS float*)(lds + L1_TAB_OFF), tid); __syncthreads();
                for (int li = 0; li < 8; ++li) { const int x = (hx + li) & 7; const int b = x >> 1, kvh = x & 1;
                    for (;;) {
                        __syncthreads();
                        if (tid == 0) *qw = (int)__hip_atomic_fetch_add(qctr + x * 64, 1u, __ATOMIC_RELAXED, __HIP_MEMORY_SCOPE_AGENT);
                        __syncthreads();
                        const int i = __builtin_amdgcn_readfirstlane(*qw);
                        if (i >= cnt) break;
                        if (i < 64 + nctx) {
                            const bool lat = i < 64; const int h = kvh * 4 + (lat ? (i >> 4) : (i - 64));
                            const size_t qo = (size_t)(lat ? b * SEQL + (i & 15) * 256 : MLAT + b * CTXL) * 512 + h * 64;
                            attn_body::attn_unit<8>(Qb + qo, Kb + (size_t)b * KVR * 128 + kvh * 64, Vb + (size_t)b * KVR * 128 + kvh * 64, Ob + qo, lat ? NCH : 4, shm);
                        } else { const int it = i - 64 - nctx, t = x * 34 + (it >> 1); lru_l1_tile(a, l, t / NCH, t % NCH, it & 1, lds, tid, wid, lane); }
                    }
                } }
            } else if (sub == 3) { if (PON(3)) { TL;
                const int nt = ctx_out ? 4 * NCH : 4 * 64;
                for (int t = vcu; t < nt; t += G) { int b, cid; if (ctx_out) { b = t / NCH; cid = t % NCH; } else { b = t >> 6; cid = 4 + (t & 63); }
                    lru_l2_tile(a, l, b, cid, lds, tid, wid, lane); } }
            } else if (sub == 4) { if (PON(4)) {
                { pg8::Gemm g{(const bf16r*)(ws + WS_MIX), (const bf16r*)(wl + W_OUT), MLAT, DM, DM, 256, DM}; pg8::StaticOrder S; S.init(MLAT, DM, G, bx);
                  EpiRes E{l == 0 ? a->in[0] : a->out, l == 0 ? a->in[2] : ctxres, a->out, ctxres, MOD + l * 5 * 6144 + 2 * 1024};
                  pg8::gemm_phase<EpiRes, pg8::StaticOrder, true, true>(lds, g, S, E); }
                if (ctx_out) {
                    pg8::Gemm g{(const bf16r*)(ws + WS_MIX), (const bf16r*)(wl + W_OUT), MALL, DM, 256, 256, DM}; SplitOrder S{64, 4, 256, G, bx};
                    EpiPart E{(float*)(ws + WS_PART), MOD + l * 5 * 6144 + 2 * 1024, 256};
                    pg8::gemm_phase<EpiPart, SplitOrder, true, true>(lds, g, S, E); } }
            } else if (sub == 5) { if (PON(5)) { TL; prenorm_phase(a, l, 1, ctx_out ? MALL : MLAT, ctx_out ? 4 : 0, ctx_out ? a->in[2] : ctxres, wid, lane, G); } }
            else if (sub == 6) { if (PON(6)) {
                const int mrows = ctx_out ? MALL : MLAT, nM = (mrows + 253) / 254;
                pg8::Gemm g{HN - DM, (const bf16r*)(wl + W_UP), nM * 256, DFF2, DM, 254, DM}; pg8::StaticOrder S; S.init(nM * 256, DFF2, G, bx);
                EpiUpConv E{(bf16r*)(ws + WS_ACT), a->in[20] + (size_t)l * 3 * DFF2, a->in[21] + (size_t)l * DFF2, mrows};
                for (int i = 0;; ++i) { pg8::Unit u; if (!S.next(i, u)) break; OneUnit S1{u}; pg8::gemm_phase<EpiUpConv, OneUnit, false, true>(lds, g, S1, E); } }
            } else { if (PON(7)) {
                { pg8::Gemm g{(const bf16r*)(ws + WS_ACT), (const bf16r*)(wl + W_DOWN), MLAT, DM, DFF, 256, DFF}; pg8::StaticOrder S; S.init(MLAT, DM, G, bx);
                  EpiRes E{a->out, ctxres, a->out, ctxres, MOD + l * 5 * 6144 + 5 * 1024};
                  pg8::gemm_phase<EpiRes, pg8::StaticOrder, true, true>(lds, g, S, E); }
                if (ctx_out) {
                    pg8::Gemm g{(const bf16r*)(ws + WS_ACT), (const bf16r*)(wl + W_DOWN), MALL, DM, 256, 256, DFF}; SplitOrder S{176, 11, 256, G, bx};
                    EpiPart E{(float*)(ws + WS_PART), MOD + l * 5 * 6144 + 5 * 1024, 256};
                    pg8::gemm_phase<EpiPart, SplitOrder, true, true>(lds, g, S, E); } }
            }
        }
        }
        if (ph + 1 < ph_hi) GRID_SYNC();
    }
}

extern "C" void kernel_launch(void* const* d_in, const int* in_sizes, int n_in, void* d_out, int out_size, void* d_ws, size_t ws_size, hipStream_t stream) {
    static int grid = 0;
    if (grid == 0) {
        int dev = 0, cus = 0, per_cu = 0;
        if (n_in != 24 || ws_size < 255 * MiB) { fprintf(stderr, "kernel_launch: unexpected n_in %d / ws %zu\n", n_in, ws_size); grid = -1; return; }
        hipGetDevice(&dev); hipDeviceGetAttribute(&cus, hipDeviceAttributeMultiprocessorCount, dev);
        if (hipFuncSetAttribute((const void*)mega, hipFuncAttributeMaxDynamicSharedMemorySize, LDS_BYTES) != hipSuccess) { fprintf(stderr, "kernel_launch: hipFuncSetAttribute failed\n"); grid = -1; return; }
        if (hipOccupancyMaxActiveBlocksPerMultiprocessor(&per_cu, (const void*)mega, 512, LDS_BYTES) != hipSuccess || per_cu < 1) { fprintf(stderr, "kernel_launch: occupancy query says %d\n", per_cu); per_cu = 1; }
        (void)hipGetLastError();
        grid = cus;
    }
    if (grid < 0) return;
    if (hipMemsetAsync(d_ws, 0, 32768, stream) != hipSuccess) { fprintf(stderr, "kernel_launch: memset failed\n"); return; }
    Args a{};
    for (int i = 0; i < 24; ++i) a.in[i] = (const float*)d_in[i];
    a.out = (float*)d_out; a.ws = (unsigned char*)d_ws;
#if MK_MULTI
    for (int ph = 0; ph < NPHASE; ++ph) { a.ph_lo = ph; a.ph_hi = ph + 1; hipLaunchKernelGGL(mega, dim3(grid), dim3(512), LDS_BYTES, stream, a); }
#else
    a.ph_lo = 0; a.ph_hi = NPHASE;
    void* args[] = {&a};
    hipError_t e = hipLaunchCooperativeKernel((const void*)mega, dim3(grid), dim3(512), args, LDS_BYTES, stream);
    if (e != hipSuccess) fprintf(stderr, "cooperative launch failed: %s (grid %d)\n", hipGetErrorString(e), grid);
#endif
}
```

```cpp
#include <hip/hip_runtime.h>
#include <hip/hip_cooperative_groups.h>
#include <cstdio>
#include <cstdint>
namespace cg = cooperative_groups;
#ifndef MK_MULTI
#define MK_MULTI 0
#endif
__device__ __forceinline__ int mk_tid() { int t = threadIdx.x; asm volatile("" : "+v"(t)); return t; }
namespace pg8 {
#define PG8_LAS __attribute__((address_space(3)))
typedef unsigned short bf16_t;
typedef short bf16x8 __attribute__((ext_vector_type(8)));
typedef float f32x4 __attribute__((ext_vector_type(4)));
typedef unsigned u32x4 __attribute__((ext_vector_type(4)));
constexpr int BM = 256, BK = 64, HALF = 128, HTB = HALF * BK * 2  , STAGE_BYTES = 8 * HTB, NXCD = 8, WGM = 8;

__host__ __device__ __forceinline__ int lds_byte(int r, int c) { const int st = (r >> 4) * 2 + (c >> 5), rr = r & 15, cc = c & 31, ob = rr * 64 + cc * 2; return st * 1024 + (ob ^ (((ob >> 9) & 1) << 5)); }
__host__ __device__ __forceinline__ void stage_rc(int b, int& R, int& C) { const int st = b / 1024, sb = b % 1024, swz = sb ^ (((sb >> 9) & 1) << 5); R = (st >> 1) * 16 + swz / 64; C = (st & 1) * 32 + (swz % 64) / 2; }
__host__ __device__ __forceinline__ int perm32(int rho) { const int n = rho >> 4, i = rho & 15; return 8 * (i >> 2) + 4 * n + (i & 3); }

struct Unit { int pm, pn, koff; };
struct Gemm { const bf16_t* A; const bf16_t* Bt; int M, N, K; int a_rows; int ldk; };

struct StaticOrder {
    int nM, nN, nwg, G, c;
    __host__ __device__ void init(int M, int N, int G_, int c_) { nM = M / BM; nN = N / BM; nwg = nM * nN; G = G_; c = c_; }
    __host__ __device__ bool next(int i, Unit& u) const {
        const long L = (long)i * G + c; if (L >= nwg) return false;
        int wgid = (int)L; { const int q = nwg / NXCD, r = nwg % NXCD, xcd = wgid % NXCD, off = wgid / NXCD; wgid = (xcd < r ? xcd * (q + 1) : r * (q + 1) + (xcd - r) * q) + off; }
        const int nig = WGM * nN, gid = wgid / nig, fm = gid * WGM, gsz = (nM - fm) < WGM ? (nM - fm) : WGM;
        u.pm = fm + ((wgid % nig) % gsz); u.pn = (wgid % nig) / gsz; u.koff = 0; return true;
    }
    __device__ __forceinline__ void a_ready(const Unit&) const {}
    __device__ __forceinline__ void done(const Unit&) const {}
};

__device__ __forceinline__ unsigned cvt_pk_bf16(float lo, float hi) { unsigned r; asm volatile("v_cvt_pk_bf16_f32 %0, %1, %2" : "=v"(r) : "v"(lo), "v"(hi)); return r; }
typedef float f32x2 __attribute__((ext_vector_type(2)));
__device__ __forceinline__ f32x2 gelu_pk(f32x2 v) {
    const f32x2 av = __builtin_elementwise_abs(v), d = av * 0.2316418882f + 1.0f;
    f32x2 t; t.x = __builtin_amdgcn_rcpf(d.x); t.y = __builtin_amdgcn_rcpf(d.y);
    f32x2 q = t * 0.5307027145f + (-0.7265760135f); q = q * t + 0.7107068705f; q = q * t + (-0.142248368f); q = q * t + 0.127414796f; q = q * t;
    const f32x2 s = (v * v) * (-0.72134752044f);
    f32x2 e; e.x = __builtin_amdgcn_exp2f(s.x); e.y = __builtin_amdgcn_exp2f(s.y);
    const f32x2 m = v * (q * e), r = v - m;
    f32x2 o; o.x = v.x < 0.f ? m.x : r.x; o.y = v.y < 0.f ? m.y : r.y; return o;
}

template <int ACT  > struct EpiBf16 {
    static constexpr bool PERM = true, AFTER_DRAIN = false; static_assert(ACT == 0 || ACT == 1, "EpiBf16: ACT is 0 (none) or 1 (gelu_pk)");
    bf16_t* O; int ldc; const float* bias; int split_cols; size_t split_stride; float scale0;
    __device__ __forceinline__ void operator()(const f32x4 (&acc)[2][2][4][2], const Unit& u, int wr, int wc, int fr, int fq) const {
        const int row0 = u.pm * BM + wr * 64 + fr; int colt = u.pn * BM; bf16_t* base = O;
        float sc = 1.f; if (split_cols) { const int t = colt / split_cols; base += (size_t)t * split_stride; colt -= t * split_cols; if (t == 0) sc = scale0; }
        const int col0 = colt + wc * 32 + 8 * fq, bcol0 = u.pn * BM + wc * 32 + 8 * fq;
        f32x4 bv[2][2];
#pragma unroll
        for (int bj = 0; bj < 2; ++bj)
#pragma unroll
            for (int n = 0; n < 2; ++n) bv[bj][n] = bias ? *(const f32x4*)(bias + bcol0 + bj * HALF + 4 * n) : (f32x4){0.f, 0.f, 0.f, 0.f};
#pragma unroll
        for (int ai = 0; ai < 2; ++ai)
#pragma unroll
            for (int m = 0; m < 4; ++m) { bf16_t* rowp = base + (size_t)(row0 + ai * HALF + m * 16) * ldc + col0;
#pragma unroll
                for (int bj = 0; bj < 2; ++bj) { f32x4 v0 = acc[ai][bj][m][0] + bv[bj][0], v1 = acc[ai][bj][m][1] + bv[bj][1];
                    if (ACT == 1) { f32x2 a = gelu_pk((f32x2){v0[0], v0[1]}), b = gelu_pk((f32x2){v0[2], v0[3]}), c = gelu_pk((f32x2){v1[0], v1[1]}), d = gelu_pk((f32x2){v1[2], v1[3]});
                        v0 = (f32x4){a.x, a.y, b.x, b.y}; v1 = (f32x4){c.x, c.y, d.x, d.y}; }
                    v0 = v0 * sc; v1 = v1 * sc; u32x4 w; w.x = cvt_pk_bf16(v0[0], v0[1]); w.y = cvt_pk_bf16(v0[2], v0[3]); w.z = cvt_pk_bf16(v1[0], v1[1]); w.w = cvt_pk_bf16(v1[2], v1[3]);
                    *(u32x4*)(rowp + bj * HALF) = w; } }
    }
};

template <class Epi, class Sched, bool ALIGN_EPI = false, bool SP2 = false>
__device__ __forceinline__ void gemm_phase(PG8_LAS unsigned char* lds, const Gemm g, const Sched& S, const Epi& E) {
    const int tid = mk_tid(), wid = __builtin_amdgcn_readfirstlane(tid >> 6), lane = tid & 63, wr = wid >> 2, wc = wid & 3, fr = lane & 15, fq = lane >> 4;
    const int K = g.K, nt = K / BK;
    unsigned voffA[2], voffB[2];
#pragma unroll
    for (int i = 0; i < 2; ++i) { int R, C; stage_rc(tid * 16 + i * 8192, R, C); const int Rb = Epi::PERM ? ((R & ~31) + perm32(R & 31)) : R;
        voffA[i] = (unsigned)(R * g.ldk + C) * 2u; voffB[i] = (unsigned)(Rb * g.ldk + C) * 2u; }
    const size_t kstep = (size_t)(BK * 2);
    const size_t hstep = (size_t)HALF * g.ldk * 2;
    const size_t tstep = 2 * hstep;
    const unsigned ldsw = (unsigned)wid * 1024u;
    const int aoff = lds_byte(wr * 64 + fr, fq * 8), boff = lds_byte(wc * 32 + fr, fq * 8);
#define PG8_SA(b, h) (((b) * 2 + (h)) * HTB)
#define PG8_SB(b, h) ((4 + (b) * 2 + (h)) * HTB)
#define PG8_STAGE(bufoff, gbase, voff) do { _Pragma("unroll") for (int _i = 0; _i < 2; ++_i) \
        __builtin_amdgcn_global_load_lds((const unsigned*)((const char*)(gbase) + (voff)[_i]), (PG8_LAS unsigned*)(lds + (bufoff) + ldsw + _i * 8192), 16, 0, 0); } while (0)
#define PG8_LDA(dst, b, h) do { _Pragma("unroll") for (int m = 0; m < 4; ++m) _Pragma("unroll") for (int k = 0; k < 2; ++k) dst[m][k] = *(const PG8_LAS bf16x8*)(lds + PG8_SA(b, h) + aoff + m * 2048 + k * 1024); } while (0)
#define PG8_LDB(dst, b, h) do { _Pragma("unroll") for (int n = 0; n < 2; ++n) _Pragma("unroll") for (int k = 0; k < 2; ++k) dst[n][k] = *(const PG8_LAS bf16x8*)(lds + PG8_SB(b, h) + boff + n * 2048 + k * 1024); } while (0)
#define PG8_MMA(ai, bj, At, Bt) do { __builtin_amdgcn_s_setprio(1); _Pragma("unroll") for (int m = 0; m < 4; ++m) _Pragma("unroll") for (int n = 0; n < 2; ++n) _Pragma("unroll") for (int k = 0; k < 2; ++k) \
        acc[ai][bj][m][n] = __builtin_amdgcn_mfma_f32_16x16x32_bf16(Bt[n][k], At[m][k], acc[ai][bj][m][n], 0, 0, 0); __builtin_amdgcn_s_setprio(0); } while (0)
#define PG8_WAIT_V(n) asm volatile("s_waitcnt vmcnt(" #n ")" ::: "memory")
#define PG8_WAIT_L(n) asm volatile("s_waitcnt lgkmcnt(" #n ")" ::: "memory")
#define PG8_BAR __builtin_amdgcn_s_barrier()
#define PG8_SCHED __builtin_amdgcn_sched_barrier(0)
    Unit cur, nxt; int ui = 0;
    if (!S.next(0, cur)) return;
    f32x4 acc[2][2][4][2];
#pragma unroll
    for (int a = 0; a < 2; ++a)
#pragma unroll
        for (int b = 0; b < 2; ++b)
#pragma unroll
            for (int m = 0; m < 4; ++m)
#pragma unroll
                for (int n = 0; n < 2; ++n) acc[a][b][m][n] = (f32x4){0.f, 0.f, 0.f, 0.f};
    bf16x8 At[4][2], B0[2][2], B1[2][2];
    const size_t atstep = (size_t)g.a_rows * g.ldk * 2; const char* cA = (const char*)g.A + (size_t)cur.pm * atstep + (size_t)cur.koff * 2; const char* cB = (const char*)g.Bt + (size_t)cur.pn * tstep + (size_t)cur.koff * 2;
    S.a_ready(cur);
    if constexpr (SP2) {
        PG8_STAGE(PG8_SB(0, 0), cB, voffB); PG8_STAGE(PG8_SB(0, 1), cB + hstep, voffB); PG8_STAGE(PG8_SA(0, 0), cA, voffA); PG8_STAGE(PG8_SA(0, 1), cA + hstep, voffA);
        if (wr == 1) PG8_BAR;
        PG8_WAIT_V(2); PG8_BAR;
        PG8_STAGE(PG8_SB(1, 0), cB + kstep, voffB); PG8_STAGE(PG8_SA(1, 0), cA + kstep, voffA); PG8_STAGE(PG8_SB(1, 1), cB + hstep + kstep, voffB);
        PG8_WAIT_V(6); PG8_BAR;
    } else {
        PG8_STAGE(PG8_SB(0, 0), cB, voffB); PG8_STAGE(PG8_SA(0, 0), cA, voffA); PG8_STAGE(PG8_SB(0, 1), cB + hstep, voffB); PG8_STAGE(PG8_SA(0, 1), cA + hstep, voffA);
        if (wr == 1) PG8_BAR;
        PG8_WAIT_V(4); PG8_BAR;
        PG8_STAGE(PG8_SB(1, 0), cB + kstep, voffB); PG8_STAGE(PG8_SA(1, 0), cA + kstep, voffA); PG8_STAGE(PG8_SB(1, 1), cB + hstep + kstep, voffB);
        PG8_WAIT_V(6); PG8_BAR;
    }
    for (;;) {
        const bool has_next = S.next(ui + 1, nxt);
        const char* nA = has_next ? (const char*)g.A + (size_t)nxt.pm * atstep + (size_t)nxt.koff * 2 : cA; const char* nB = has_next ? (const char*)g.Bt + (size_t)nxt.pn * tstep + (size_t)nxt.koff * 2 : cB;
        for (int t = 0; t < nt; t += 2) {
            const bool last = (t == nt - 2);
            const char* a1 = cA + (size_t)(t + 1) * kstep;
            const char* a2 = last ? nA : cA + (size_t)(t + 2) * kstep; const char* b2 = last ? nB : cB + (size_t)(t + 2) * kstep;
            const char* a3 = a2 + kstep; const char* b3 = b2 + kstep;
            if (last && has_next) S.a_ready(nxt);
            if constexpr (SP2) {
            PG8_LDB(B0, 0, 0); PG8_LDB(B1, 0, 1); PG8_SCHED; PG8_LDA(At, 0, 0); PG8_STAGE(PG8_SA(1, 1), a1 + hstep, voffA);
            PG8_WAIT_V(8); PG8_WAIT_L(0); PG8_BAR; PG8_MMA(0, 0, At, B0); PG8_MMA(0, 1, At, B1); PG8_BAR; PG8_SCHED;
            PG8_LDA(At, 0, 1); PG8_STAGE(PG8_SB(0, 0), b2, voffB); PG8_STAGE(PG8_SB(0, 1), b2 + hstep, voffB); PG8_STAGE(PG8_SA(0, 0), a2, voffA);
            PG8_WAIT_V(8); PG8_WAIT_L(0); PG8_BAR; PG8_MMA(1, 0, At, B0); PG8_MMA(1, 1, At, B1); PG8_BAR; PG8_SCHED;
            PG8_LDB(B0, 1, 0); PG8_LDB(B1, 1, 1); PG8_SCHED; PG8_LDA(At, 1, 0); PG8_STAGE(PG8_SA(0, 1), a2 + hstep, voffA);
            PG8_WAIT_V(8); PG8_WAIT_L(0); PG8_BAR; PG8_MMA(0, 0, At, B0); PG8_MMA(0, 1, At, B1); PG8_BAR; PG8_SCHED;
            PG8_LDA(At, 1, 1); PG8_STAGE(PG8_SB(1, 0), b3, voffB); PG8_STAGE(PG8_SB(1, 1), b3 + hstep, voffB); PG8_STAGE(PG8_SA(1, 0), a3, voffA);
            PG8_WAIT_V(8); PG8_WAIT_L(0); PG8_BAR; PG8_MMA(1, 0, At, B0); PG8_MMA(1, 1, At, B1); PG8_BAR; PG8_SCHED;
            } else {
            PG8_LDB(B0, 0, 0); PG8_SCHED; PG8_LDA(At, 0, 0); PG8_STAGE(PG8_SA(1, 1), a1 + hstep, voffA);
            PG8_WAIT_L(8); PG8_BAR; PG8_WAIT_L(0); PG8_MMA(0, 0, At, B0); PG8_BAR; PG8_SCHED;
            PG8_LDB(B1, 0, 1); PG8_STAGE(PG8_SB(0, 0), b2, voffB);
            PG8_BAR; PG8_WAIT_L(0); PG8_MMA(0, 1, At, B1); PG8_BAR;
            PG8_LDA(At, 0, 1); PG8_STAGE(PG8_SA(0, 0), a2, voffA);
            PG8_BAR; PG8_WAIT_L(0); PG8_MMA(1, 0, At, B0); PG8_BAR; PG8_SCHED;
            PG8_STAGE(PG8_SB(0, 1), b2 + hstep, voffB);
            PG8_WAIT_V(6); PG8_BAR; PG8_MMA(1, 1, At, B1); PG8_BAR;
            PG8_LDB(B0, 1, 0); PG8_SCHED; PG8_LDA(At, 1, 0); PG8_STAGE(PG8_SA(0, 1), a2 + hstep, voffA);
            PG8_WAIT_L(8); PG8_BAR; PG8_WAIT_L(0); PG8_MMA(0, 0, At, B0); PG8_BAR; PG8_SCHED;
            PG8_LDB(B1, 1, 1); PG8_STAGE(PG8_SB(1, 0), b3, voffB);
            PG8_BAR; PG8_WAIT_L(0); PG8_MMA(0, 1, At, B1); PG8_BAR;
            PG8_LDA(At, 1, 1); PG8_STAGE(PG8_SA(1, 0), a3, voffA);
            PG8_BAR; PG8_WAIT_L(0); PG8_MMA(1, 0, At, B0); PG8_BAR; PG8_SCHED;
            PG8_STAGE(PG8_SB(1, 1), b3 + hstep, voffB);
            PG8_WAIT_V(6); PG8_BAR; PG8_MMA(1, 1, At, B1); PG8_BAR;
            }
        }
        if constexpr (ALIGN_EPI) { if (wr == 0) PG8_BAR; }
        if constexpr (!Epi::AFTER_DRAIN) { const int l2_ = mk_tid() & 63; E(acc, cur, wr, wc, l2_ & 15, l2_ >> 4); S.done(cur); }
        if (!has_next) break;
#pragma unroll
        for (int a = 0; a < 2; ++a)
#pragma unroll
            for (int b = 0; b < 2; ++b)
#pragma unroll
                for (int m = 0; m < 4; ++m)
#pragma unroll
                    for (int n = 0; n < 2; ++n) acc[a][b][m][n] = (f32x4){0.f, 0.f, 0.f, 0.f};
        cur = nxt; cA = nA; cB = nB; ++ui;
        if constexpr (ALIGN_EPI) { if (wr == 1) PG8_BAR; }
    }
    PG8_WAIT_V(0);
    if constexpr (!ALIGN_EPI) { if (wr == 0) PG8_BAR; }
    PG8_BAR;
    if constexpr (Epi::AFTER_DRAIN) { const int l2_ = mk_tid() & 63; E.fused(acc, cur, wr, wc, l2_ & 15, l2_ >> 4, lds, wid, l2_); S.done(cur); }
#undef PG8_SA
#undef PG8_SB
#undef PG8_STAGE
#undef PG8_LDA
#undef PG8_LDB
#undef PG8_MMA
#undef PG8_WAIT_V
#undef PG8_WAIT_L
#undef PG8_BAR
#undef PG8_SCHED
}
}

#include <hip/hip_bf16.h>
#include <cmath>
namespace attn_body {
using bf16=__hip_bfloat16;
using bf16x8=__attribute__((ext_vector_type(8)))short;
using s16x4=__attribute__((ext_vector_type(4)))short;
using f32x16=__attribute__((ext_vector_type(16)))float;
using u32x4=__attribute__((ext_vector_type(4)))unsigned;
constexpr int D=64,QP=512,KVP=128;
constexpr int NW=8,QBLK=32,QB=QBLK*NW,KVBLK=64;
constexpr int ATTN_UNIT_ROWS=QB;
__device__ __forceinline__ int crow(int r,int hi){return (r&3)+8*(r>>2)+4*hi;}
#define SBAR() __builtin_amdgcn_sched_barrier(0)
__device__ __forceinline__ void cmask(f32x16&p0,f32x16&p1,int jb,int qrel,int hi){
  const float NEG=-INFINITY; int kb=64*jb+4*hi;
  #pragma unroll
  for(int r=0;r<16;++r){int kv=kb+(r&3)+8*(r>>2); if(kv>qrel)p0[r]=NEG; if(kv+32>qrel)p1[r]=NEG;}
}

constexpr int NSLOT=3, SLOTB=8192;
constexpr int LDS_K=0, LDS_V=NSLOT*SLOTB, LDS_WS=2*NSLOT*SLOTB, LDS_OST=LDS_WS+NW*64*4, LDS_BYTES=LDS_OST+NW*4096;
constexpr float C2=0.125f*1.4426950408889634f;
__device__ __forceinline__ void glds16(const void*gsrc,unsigned lds_dst){unsigned keep;
  asm volatile("s_mov_b32 %0, m0\n\ts_mov_b32 m0, %2\n\ts_nop 0\n\tglobal_load_lds_dwordx4 %1, off\n\ts_mov_b32 m0, %0":"=&s"(keep):"v"(gsrc),"s"(lds_dst):"memory");}
__device__ __forceinline__ float max3f(float a,float b,float c){float r;asm("v_max3_f32 %0, %1, %2, %3":"=v"(r):"v"(a),"v"(b),"v"(c));return r;}
__device__ __forceinline__ float max2f(float a,float b){float r;asm("v_max_f32_e32 %0, %1, %2":"=v"(r):"v"(a),"v"(b));return r;}
__device__ __forceinline__ float fadd_s(float a,float b){float r;asm("v_add_f32_e32 %0, %1, %2":"=v"(r):"v"(a),"v"(b));return r;}
__device__ __forceinline__ float fsub_s(float a,float b){float r;asm("v_sub_f32_e32 %0, %1, %2":"=v"(r):"v"(a),"v"(b));return r;}
typedef float f32x2_t __attribute__((ext_vector_type(2))); typedef __bf16 bf16x2_t __attribute__((ext_vector_type(2)));
__device__ __forceinline__ unsigned cvtpk_s(float lo,float hi){f32x2_t v={lo,hi};bf16x2_t b=__builtin_convertvector(v,bf16x2_t);return __builtin_bit_cast(unsigned,b);}
#define WAIT_BAR(N) asm volatile("s_waitcnt vmcnt(" #N ") lgkmcnt(0)\n\ts_barrier":::"memory")

__device__ __forceinline__ void qkt(f32x16&p0,f32x16&p1,const char*Kslot,const bf16x8*qr,const f32x16&negm,int r32,int hi){
  const char*kb=Kslot+hi*1024+r32*16;
  #pragma unroll
  for(int d0=0;d0<4;++d0){
    const bf16x8 b0=*reinterpret_cast<const bf16x8*>(kb+d0*2048);
    const bf16x8 b1=*reinterpret_cast<const bf16x8*>(kb+d0*2048+512);
    if(d0==0){p0=__builtin_amdgcn_mfma_f32_32x32x16_bf16(b0,qr[0],negm,0,0,0);p1=__builtin_amdgcn_mfma_f32_32x32x16_bf16(b1,qr[0],negm,0,0,0);}
    else{p0=__builtin_amdgcn_mfma_f32_32x32x16_bf16(b0,qr[d0],p0,0,0,0);p1=__builtin_amdgcn_mfma_f32_32x32x16_bf16(b1,qr[d0],p1,0,0,0);}}
}
typedef __attribute__((address_space(3))) const char* lds_cptr;
typedef short v4i16_t __attribute__((ext_vector_type(4)));
__device__ __forceinline__ void kload8(bf16x8*kf,lds_cptr kp){
  kf[0]=*(const __attribute__((address_space(3))) bf16x8*)(kp);      kf[1]=*(const __attribute__((address_space(3))) bf16x8*)(kp+512);
  kf[2]=*(const __attribute__((address_space(3))) bf16x8*)(kp+2048); kf[3]=*(const __attribute__((address_space(3))) bf16x8*)(kp+2560);
  kf[4]=*(const __attribute__((address_space(3))) bf16x8*)(kp+4096); kf[5]=*(const __attribute__((address_space(3))) bf16x8*)(kp+4608);
  kf[6]=*(const __attribute__((address_space(3))) bf16x8*)(kp+6144); kf[7]=*(const __attribute__((address_space(3))) bf16x8*)(kp+6656);
}
__device__ __forceinline__ void kload2(bf16x8*kf,lds_cptr kp,int j){ kf[2*j]=*(const __attribute__((address_space(3))) bf16x8*)(kp+j*2048); kf[2*j+1]=*(const __attribute__((address_space(3))) bf16x8*)(kp+j*2048+512); }
__device__ __forceinline__ s16x4 vtr(lds_cptr p){ return __builtin_bit_cast(s16x4,__builtin_amdgcn_ds_read_tr16_b64_v4i16((__attribute__((address_space(3))) v4i16_t*)p)); }
__device__ __forceinline__ float rowmax(const f32x16&p0,const f32x16&p1){
  float a=max3f(p0[0],p0[1],p1[0]),b=max3f(p0[2],p0[3],p1[1]);a=max3f(a,p1[2],p1[3]);
  #pragma unroll
  for(int r=4;r<16;r+=4){a=max3f(a,p0[r],p0[r+1]);b=max3f(b,p0[r+2],p0[r+3]);a=max3f(a,p1[r],p1[r+1]);b=max3f(b,p1[r+2],p1[r+3]);}
  const float m=max2f(a,b);
  auto rr=__builtin_amdgcn_permlane32_swap(__float_as_uint(m),__float_as_uint(m),false,false);
  return max2f(__uint_as_float(rr[0]),__uint_as_float(rr[1]));
}
__device__ __forceinline__ void pv(f32x16*o,int vb,bf16x8 pa0,bf16x8 pa1,bf16x8 pa2,bf16x8 pa3){
  #pragma unroll
  for(int d0=0;d0<2;++d0){s16x4 lo[4],hi[4];
    #pragma unroll
    for(int ks=0;ks<4;++ks){
      asm volatile("ds_read_b64_tr_b16 %0,%1 offset:%c2":"=&v"(lo[ks]):"v"(vb),"i"(d0*4096+ks*1024):"memory");
      asm volatile("ds_read_b64_tr_b16 %0,%1 offset:%c2":"=&v"(hi[ks]):"v"(vb),"i"(d0*4096+ks*1024+512):"memory");}
    asm volatile("s_waitcnt lgkmcnt(0)":::"memory");SBAR();
    #define PK(k) (bf16x8){lo[k][0],lo[k][1],lo[k][2],lo[k][3],hi[k][0],hi[k][1],hi[k][2],hi[k][3]}
    o[d0]=__builtin_amdgcn_mfma_f32_32x32x16_bf16(pa0,PK(0),o[d0],0,0,0);
    o[d0]=__builtin_amdgcn_mfma_f32_32x32x16_bf16(pa1,PK(1),o[d0],0,0,0);
    o[d0]=__builtin_amdgcn_mfma_f32_32x32x16_bf16(pa2,PK(2),o[d0],0,0,0);
    o[d0]=__builtin_amdgcn_mfma_f32_32x32x16_bf16(pa3,PK(3),o[d0],0,0,0);
    #undef PK
  }
}

#ifndef ATTN_STORE16
#define ATTN_STORE16(p,v) (*(u32x4*)(p)=(v))
#endif
template<int THRL> __device__ __forceinline__ void attn_unit(const bf16*Qu,const bf16*__restrict__ Kh,const bf16*__restrict__ Vh,bf16*Ou,const int NT,char*shm){
  const int tid=mk_tid(),lane=tid&63,r32=lane&31,hi=lane>>5; const int wid=__builtin_amdgcn_readfirstlane(tid>>6);
  const bf16*Qw=Qu+(long)(wid*QBLK)*QP;
  const unsigned lds0=(unsigned)(uintptr_t)shm;
  float*wsf=(float*)(shm+LDS_WS)+wid*64;
  const bf16*ksrc=Kh+(long)lane*KVP+wid*8;
  const bf16*vsrc=Vh+(long)(16*(wid&3)+(lane>>2))*KVP+(wid>>2)*32+(lane&3)*8;
  const unsigned kdst=lds0+LDS_K+wid*1024, vdst=lds0+LDS_V+wid*1024;
  #define DMA_K(t,slot) glds16(ksrc+(long)(t)*KVBLK*KVP,(unsigned)__builtin_amdgcn_readfirstlane(kdst+(slot)))
  #define DMA_V(t,slot) glds16(vsrc+(long)(t)*KVBLK*KVP,(unsigned)__builtin_amdgcn_readfirstlane(vdst+(slot)))
  const int vb0=(int)(lds0+LDS_V)+((lane>>4)&1)*32+(lane&3)*8+(4*hi+((lane&15)>>2))*64;
  const char*Kbase=shm+LDS_K; bf16x8 kf[8];
  const lds_cptr shm3=(lds_cptr)shm; const lds_cptr kp0=shm3+LDS_K+hi*1024+r32*16; const lds_cptr vp0=shm3+LDS_V+((lane>>4)&1)*32+(lane&3)*8+(4*hi+((lane&15)>>2))*64;
  DMA_K(0,0);DMA_V(0,0);DMA_K(1,SLOTB);
  bf16x8 qr[4];
  #pragma unroll
  for(int d0=0;d0<4;++d0)qr[d0]=*reinterpret_cast<const bf16x8*>(&Qw[(long)r32*QP+d0*16+hi*8]);
  float mhat=0.f,l_reg=0.f;f32x16 o[2];o[0]=f32x16{};o[1]=f32x16{};f32x16 negm=f32x16{};asm volatile("":"+v"(negm));
  #define CMASK(P0,P1,t) do{}while(0)
  bool resc=false;
  #define START(P0,P1) do{ const float rm=rowmax(P0,P1); resc=false; \
    { const float dl=rm; mhat=fadd_s(mhat,dl); \
      _Pragma("unroll") for(int r=0;r<16;++r){P0[r]=fsub_s(P0[r],dl);P1[r]=fsub_s(P1[r],dl);} \
      _Pragma("unroll") for(int r=0;r<16;++r)negm[r]=-mhat; asm volatile("":"+v"(negm)); } \
    _Pragma("unroll") for(int r=0;r<16;++r)P0[r]=__builtin_amdgcn_exp2f(P0[r]); }while(0)
  #define RESC() do{ if(resc){ asm volatile("s_waitcnt lgkmcnt(0)":::"memory"); \
      _Pragma("unroll") for(int d_=0;d_<2;++d_) _Pragma("unroll") for(int r=0;r<16;++r)o[d_][r]*=wsf[crow(r,hi)]; } }while(0)
  f32x16 pA0,pA1,pB0,pB1;
  int sl_prev=0,sl_cur=0,sl_next=SLOTB;
  #define ROT() do{sl_prev=sl_cur;sl_cur=sl_next;sl_next=(sl_next==(NSLOT-1)*SLOTB)?0:sl_next+SLOTB;}while(0)
  DMA_K(2,2*SLOTB);
  WAIT_BAR(3);
  qkt(pA0,pA1,Kbase,qr,negm,r32,hi);asm volatile("s_nop 15\n\ts_nop 7":"+v"(pA0),"+v"(pA1));CMASK(pA0,pA1,0);
  START(pA0,pA1);
  _Pragma("unroll") for(int r=0;r<16;++r)pA1[r]=__builtin_amdgcn_exp2f(pA1[r]);
  WAIT_BAR(0);
  DMA_K(3,0);DMA_V(1,SLOTB);
  ROT();
  kload8(kf,kp0+sl_cur);
  WAIT_BAR(2);
  s16x4 vlo[8],vhi[8]; u32x4 pw0,pw1,pw2,pw3;
  #define PKW(P,B) cvtpk_s(P[B],P[B+1])
  #define PAF(k) __builtin_bit_cast(bf16x8,pw##k)
  #define VFR(i) (bf16x8){vlo[i][0],vlo[i][1],vlo[i][2],vlo[i][3],vhi[i][0],vhi[i][1],vhi[i][2],vhi[i][3]}
  #define PIN(x) asm volatile("":"+v"(x))
  #define MX3(a,b,c) __builtin_fmaxf(__builtin_fmaxf((a),(b)),(c))
  #define GAPA(MF,A0,A1,A2,A3,W0,W1,PW) do{ MF; sacc+=A0; sacc+=A1; sacc+=A2; sacc+=A3; PIN(sacc); W0; W1; PIN(PW); SBAR(); }while(0)
  #define EX(v) __builtin_amdgcn_exp2f(v)
  #define GAPB(MF,X,B) do{ MF; X[B]=EX(X[B]); X[B+1]=EX(X[B+1]); X[B+2]=EX(X[B+2]); X[B+3]=EX(X[B+3]); PIN(X); SBAR(); }while(0)
  #define VRD(i) do{ vlo[i]=vtr(vp_+(((i)>>2)*4096+((i)&3)*1024)); vhi[i]=vtr(vp_+(((i)>>2)*4096+((i)&3)*1024+512)); }while(0)
  #define KRD(G,j) do{ if(G){ kload2(kf,kp0+sl_next,j); SBAR(); } }while(0)
  #define STEP(C0,C1,P0,P1,t,GK,GV,GL) do{ SBAR(); \
    const lds_cptr vp_=vp0+sl_prev; \
    VRD(0); SBAR(); float sacc=(P0[0]+P0[1]); \
    GAPA(C0=__builtin_amdgcn_mfma_f32_32x32x16_bf16(kf[0],qr[0],negm,0,0,0), P0[2],P0[3],P0[4],P0[5],     pw0[0]=PKW(P0,0), pw0[1]=PKW(P0,2), pw0); \
    VRD(4); SBAR(); GAPA(C1=__builtin_amdgcn_mfma_f32_32x32x16_bf16(kf[1],qr[0],negm,0,0,0), P0[6],P0[7],P0[8],P0[9],     pw0[2]=PKW(P0,4), pw0[3]=PKW(P0,6), pw0); \
    VRD(1); SBAR(); GAPA(C0=__builtin_amdgcn_mfma_f32_32x32x16_bf16(kf[2],qr[1],C0,0,0,0),   P0[10],P0[11],P0[12],P0[13], pw1[0]=PKW(P0,8), pw1[1]=PKW(P0,10), pw1); \
    VRD(5); SBAR(); GAPA(C1=__builtin_amdgcn_mfma_f32_32x32x16_bf16(kf[3],qr[1],C1,0,0,0),   P0[14],P0[15],P1[0],P1[1],   pw1[2]=PKW(P0,12),pw1[3]=PKW(P0,14), pw1); \
    VRD(2); SBAR(); GAPA(C0=__builtin_amdgcn_mfma_f32_32x32x16_bf16(kf[4],qr[2],C0,0,0,0),   P1[2],P1[3],P1[4],P1[5],     pw2[0]=PKW(P1,0), pw2[1]=PKW(P1,2), pw2); \
    VRD(6); SBAR(); GAPA(C1=__builtin_amdgcn_mfma_f32_32x32x16_bf16(kf[5],qr[2],C1,0,0,0),   P1[6],P1[7],P1[8],P1[9],     pw2[2]=PKW(P1,4), pw2[3]=PKW(P1,6), pw2); \
    VRD(3); SBAR(); GAPA(C0=__builtin_amdgcn_mfma_f32_32x32x16_bf16(kf[6],qr[3],C0,0,0,0),   P1[10],P1[11],P1[12],P1[13], pw3[0]=PKW(P1,8), pw3[1]=PKW(P1,10), pw3); \
    VRD(7); SBAR(); GAPA(C1=__builtin_amdgcn_mfma_f32_32x32x16_bf16(kf[7],qr[3],C1,0,0,0),   P1[14],P1[15],0.f,0.f,       pw3[2]=PKW(P1,12),pw3[3]=PKW(P1,14), pw3); \
    l_reg+=sacc; \
    if(GK){DMA_K((t)+3,sl_cur);} if(GV){DMA_V((t)+1,sl_next);} \
    CMASK(C0,C1,t); \
    { float a=MX3(C0[0],C0[1],C1[0]),b=MX3(C0[2],C0[3],C1[1]); a=MX3(a,C1[2],C1[3]); \
      _Pragma("unroll") for(int r=4;r<16;r+=4){a=MX3(a,C0[r],C0[r+1]);b=MX3(b,C0[r+2],C0[r+3]);a=MX3(a,C1[r],C1[r+1]);b=MX3(b,C1[r+2],C1[r+3]);} \
      float rm=__builtin_fmaxf(a,b); { auto rr=__builtin_amdgcn_permlane32_swap(__float_as_uint(rm),__float_as_uint(rm),false,false); rm=__builtin_fmaxf(__uint_as_float(rr[0]),__uint_as_float(rr[1])); } \
      resc=false; \
      if(__builtin_expect(__any(rm>(float)THRL),0)){ const float dl=__builtin_fmaxf(rm,0.f); mhat+=dl; \
        _Pragma("unroll") for(int r=0;r<16;++r){C0[r]-=dl;C1[r]-=dl;} \
        _Pragma("unroll") for(int r=0;r<16;++r)negm[r]=-mhat; asm volatile("":"+v"(negm)); \
        const float f=__builtin_amdgcn_exp2f(-dl); l_reg*=f; if(hi==0)wsf[r32]=f; resc=true; } } \
    SBAR(); \
    GAPB(o[0]=__builtin_amdgcn_mfma_f32_32x32x16_bf16(PAF(0),VFR(0),o[0],0,0,0), C0,0); \
    GAPB(o[1]=__builtin_amdgcn_mfma_f32_32x32x16_bf16(PAF(0),VFR(4),o[1],0,0,0), C0,4); \
    KRD(GL,0); GAPB(o[0]=__builtin_amdgcn_mfma_f32_32x32x16_bf16(PAF(1),VFR(1),o[0],0,0,0), C0,8); \
    KRD(GL,1); GAPB(o[1]=__builtin_amdgcn_mfma_f32_32x32x16_bf16(PAF(1),VFR(5),o[1],0,0,0), C0,12); \
    KRD(GL,2); GAPB(o[0]=__builtin_amdgcn_mfma_f32_32x32x16_bf16(PAF(2),VFR(2),o[0],0,0,0), C1,0); \
    KRD(GL,3); GAPB(o[1]=__builtin_amdgcn_mfma_f32_32x32x16_bf16(PAF(2),VFR(6),o[1],0,0,0), C1,4); \
    GAPB(o[0]=__builtin_amdgcn_mfma_f32_32x32x16_bf16(PAF(3),VFR(3),o[0],0,0,0), C1,8); \
    GAPB(o[1]=__builtin_amdgcn_mfma_f32_32x32x16_bf16(PAF(3),VFR(7),o[1],0,0,0), C1,12); \
    }while(0)
  int t=1;
  #undef CMASK
  #define CMASK(P0,P1,t) do{}while(0)
  for(;t+5<NT;t+=2){
    STEP(pB0,pB1,pA0,pA1,t,true,true,true);     WAIT_BAR(2); RESC(); ROT();
    STEP(pA0,pA1,pB0,pB1,t+1,true,true,true);   WAIT_BAR(2); RESC(); ROT();
  }
  #undef CMASK
  #define CMASK(P0,P1,t) do{}while(0)
  #define ENDW(tt) do{ if((tt)+3<NT){WAIT_BAR(2);} else if((tt)+2<NT){WAIT_BAR(1);} else {WAIT_BAR(0);} }while(0)
  for(;t+1<NT;t+=2){
    STEP(pB0,pB1,pA0,pA1,t,(t+3<NT),(t+1<NT),(t+1<NT));       ENDW(t);   RESC(); ROT();
    STEP(pA0,pA1,pB0,pB1,t+1,(t+4<NT),(t+2<NT),(t+2<NT));     ENDW(t+1); RESC(); ROT();
  }
  STEP(pB0,pB1,pA0,pA1,NT-1,false,false,false); RESC();
  { float sacc=pB0[0]+pB0[1]; _Pragma("unroll") for(int r=2;r<16;++r)sacc+=pB0[r]; _Pragma("unroll") for(int r=0;r<16;++r)sacc+=pB1[r]; l_reg+=sacc;
    pw0=(u32x4){PKW(pB0,0),PKW(pB0,2),PKW(pB0,4),PKW(pB0,6)};pw1=(u32x4){PKW(pB0,8),PKW(pB0,10),PKW(pB0,12),PKW(pB0,14)};pw2=(u32x4){PKW(pB1,0),PKW(pB1,2),PKW(pB1,4),PKW(pB1,6)};pw3=(u32x4){PKW(pB1,8),PKW(pB1,10),PKW(pB1,12),PKW(pB1,14)};
    SBAR(); pv(o,vb0+sl_cur,PAF(0),PAF(1),PAF(2),PAF(3)); }
  #undef PKW
  #undef PAF
  #undef VFR
  #undef PIN
  #undef MX3
  #undef GAPA
  #undef GAPB
  #undef EX
  #undef VRD
  #undef KRD
  #undef STEP
  #undef ENDW
  {auto rr=__builtin_amdgcn_permlane32_swap(__float_as_uint(l_reg),__float_as_uint(l_reg),false,false);l_reg=__uint_as_float(rr[0])+__uint_as_float(rr[1]);}
  if(hi==0)wsf[32+r32]=l_reg;asm volatile("s_waitcnt lgkmcnt(0)":::"memory");
  float rli[16];
  #pragma unroll
  for(int r=0;r<16;++r)rli[r]=__builtin_amdgcn_rcpf(wsf[32+crow(r,hi)]);
  bf16*Ow=Ou+(long)(wid*QBLK)*QP;
  { bf16*stg=(bf16*)(shm+LDS_OST)+wid*2048;
    #pragma unroll
    for(int r=0;r<16;++r){const int orow=crow(r,hi);
      #pragma unroll
      for(int d0=0;d0<2;++d0)stg[orow*64+d0*32+r32]=__float2bfloat16(o[d0][r]*rli[r]);}
    asm volatile("s_waitcnt lgkmcnt(0)":::"memory");
    #pragma unroll
    for(int i=0;i<4;++i){const int row=i*8+(lane>>3),ch=lane&7; const u32x4 v=*(const u32x4*)(stg+row*64+ch*8); ATTN_STORE16(Ow+(long)row*QP+ch*8,v);} }
  asm volatile("s_waitcnt lgkmcnt(0)\n\ts_barrier":::"memory");
  #undef DMA_K
  #undef DMA_V
  #undef CMASK
  #undef START
  #undef RESC
  #undef ROT
}
constexpr int ATTN_LDS_BYTES=LDS_BYTES;
#undef SBAR
#undef WAIT_BAR
}

#define LAS __attribute__((address_space(3)))
typedef unsigned short bf16r;
typedef float f4 __attribute__((ext_vector_type(4)));
typedef unsigned u4 __attribute__((ext_vector_type(4)));
typedef unsigned u2 __attribute__((ext_vector_type(2)));
typedef short s8v __attribute__((ext_vector_type(8)));

constexpr int DM = 1024, SEQL = 4096, CTXL = 256, MLAT = 16384, MCTX = 1024, MALL = 17408;
constexpr int DIN = 1792, DFF = 2816, DFF2 = 5632, KVR = 4352, NCH = 68;
constexpr float EPSN = 1e-6f;
constexpr size_t MiB = 1u << 20;
constexpr size_t WS_MOD = 1 * MiB, WS_COS = 2 * MiB, WS_SIN = 2 * MiB + 512 * 1024, WS_GW = 3 * MiB, WS_AGGA = 4 * MiB, WS_AGGB = 6 * MiB, WS_CTXRES = 8 * MiB;
constexpr size_t WS_W = 12 * MiB, W_LAYER = 22 * MiB, W_IN = 0, W_OUT = 3 * MiB + 512 * 1024, W_UP = 5 * MiB + 512 * 1024, W_DOWN = 16 * MiB + 512 * 1024;
constexpr size_t WS_HN = 56 * MiB + 4096;
constexpr size_t WS_Q = 92 * MiB, WS_K = 109 * MiB, WS_V = 114 * MiB, WS_XL = 119 * MiB, WS_GG = 136 * MiB, WS_MIX = 153 * MiB;
constexpr size_t WS_LAB = 187 * MiB;
constexpr size_t WS_O = WS_HN;
constexpr size_t WS_PART = 187 * MiB;
constexpr size_t WS_ACT = 92 * MiB;
constexpr int LDS_BYTES = 147456;
constexpr int NPHASE = 18;
constexpr int L1_TAB_OFF = 84992;
#ifndef PHM
#define PHM 0x3ff
#endif
#define PON(k) ((PHM >> (k)) & 1)

struct Args { const float* in[24]; float* out; unsigned char* ws; int ph_lo, ph_hi; };
typedef const __attribute__((address_space(4))) Args* KA;

#define LDS_WAIT() asm volatile("s_waitcnt lgkmcnt(0)" ::: "memory")
__device__ __forceinline__ unsigned pk2(float lo, float hi) { return attn_body::cvtpk_s(lo, hi); }
__device__ __forceinline__ float bf_lo(unsigned w) { return __builtin_bit_cast(float, w << 16); }
__device__ __forceinline__ float bf_hi(unsigned w) { return __builtin_bit_cast(float, w & 0xffff0000u); }
__device__ __forceinline__ float wave_sum(float v) {
#pragma unroll
    for (int o = 1; o < 64; o <<= 1) v += __shfl_xor(v, o);
    return v;
}
__device__ __forceinline__ float fexp(float x) { return __builtin_amdgcn_exp2f(x * 1.4426950408889634f); }
__device__ __forceinline__ float sigmoidf_(float x) { return __builtin_amdgcn_rcpf(1.f + fexp(-x)); }
__device__ __forceinline__ float gelu_tanh(float x) { const float z = 0.7978845608028654f * (x + 0.044715f * x * x * x); return x * sigmoidf_(2.f * z); }
__device__ __forceinline__ int kvrow(int row) { return row < MLAT ? (row >> 12) * KVR + CTXL + (row & 4095) : ((row - MLAT) >> 8) * KVR + ((row - MLAT) & 255); }

__device__ __forceinline__ int win_dst(int s) {
    if (s < 512) { const int h = s >> 6, d = s & 63; return (h >> 2) * 256 + (d >> 5) * 128 + (h & 3) * 32 + (d & 31); }
    if (s < 768) { const int t = s - 512, hh = t >> 6, d = t & 63; return 512 + (d >> 5) * 128 + hh * 32 + (d & 31); }
    return s;
}
__device__ __forceinline__ int wup_dst(int s) { return s < DFF ? (s >> 7) * 256 + (s & 127) : ((s - DFF) >> 7) * 256 + 128 + ((s - DFF) & 127); }

template <int MODE> __device__ __forceinline__ void p0_transpose_item(const float* W, int K, int N, bf16r* WT, const float* ksA, const float* ksB, LAS float* scr, int item, int lane) {
    const int nblk = N / 32, kb = item / nblk, nb = item % nblk, k0 = 64 * kb, n0 = 32 * nb;
    float tv[32];
#pragma unroll
    for (int i = 0; i < 32; ++i) { const int kk = 2 * i + (lane >> 5); tv[i] = W[(size_t)(k0 + kk) * N + n0 + (lane & 31)]; }
#pragma unroll
    for (int i = 0; i < 32; ++i) { const int kk = 2 * i + (lane >> 5); float v = tv[i];
        if (MODE == 3) { const int k = k0 + kk; v *= (k < 512 ? ksA[k] : ksB[k - 512]); }
        scr[kk * 33 + (lane & 31)] = v; }
    LDS_WAIT();
    const int c = lane & 7;
#pragma unroll
    for (int j = 0; j < 4; ++j) { const int n = (lane >> 3) + 8 * j; const LAS float* s = scr + (8 * c) * 33 + n;
        u4 o; o.x = pk2(s[0 * 33], s[1 * 33]); o.y = pk2(s[2 * 33], s[3 * 33]); o.z = pk2(s[4 * 33], s[5 * 33]); o.w = pk2(s[6 * 33], s[7 * 33]);
        const int sc = n0 + n; const int dst = MODE == 1 ? win_dst(sc) : MODE == 2 ? wup_dst(sc) : sc;
        *(u4*)(WT + (size_t)dst * K + k0 + 8 * c) = o; }
    LDS_WAIT();
}

__device__ __forceinline__ void p0_phase(KA a, LAS unsigned char* lds, int tid, int wid, int lane, int G) {
    unsigned char* ws = a->ws;
    float* MOD = (float*)(ws + WS_MOD);
    {
        LAS float* sc = (LAS float*)lds; LAS float* red = sc + 5 * 1024;
        bool have = false;
        for (int it = blockIdx.x; it < 192; it += G) {
            if (!have) { for (int e = tid; e < 5 * 1024; e += 512) { const int r = e >> 10, k = e & 1023; const float v = r < 4 ? a->in[1][r * 1024 + k] : a->in[3][k]; sc[e] = v * sigmoidf_(v); } have = true; }
            __syncthreads();
            const int l = it / 96, nb = it % 96;
            const float* wp = a->in[4] + (size_t)l * 1024 * 6144 + (size_t)(wid * 128) * 6144 + nb * 64 + lane;
            float acc[5] = {0.f, 0.f, 0.f, 0.f, 0.f};
#pragma unroll 32
            for (int k = 0; k < 128; ++k) { const float wv = wp[(size_t)k * 6144];
#pragma unroll
                for (int r = 0; r < 5; ++r) acc[r] += sc[r * 1024 + wid * 128 + k] * wv; }
#pragma unroll
            for (int r = 0; r < 5; ++r) red[(wid * 5 + r) * 64 + lane] = acc[r];
            __syncthreads();
            if (tid < 320) { const int r = tid >> 6, col = tid & 63; float s = a->in[5][l * 6144 + nb * 64 + col];
#pragma unroll
                for (int w = 0; w < 8; ++w) s += red[(w * 5 + r) * 64 + col];
                MOD[(l * 5 + r) * 6144 + nb * 64 + col] = s; }
        }
        __syncthreads();
    }
    {
        float* cosT = (float*)(ws + WS_COS); float* sinT = (float*)(ws + WS_SIN); bf16r* GW = (bf16r*)(ws + WS_GW);
        const int gt = blockIdx.x * 512 + tid, NT_ = G * 512;
        for (int e = gt; e < 4096 * 32; e += NT_) { const int t = e >> 5, j = e & 31; const float pos = (float)(j < 16 ? (t >> 6) : (t & 63));
            const float inv = powf(10000.0f, -(float)(j & 15) * (1.0f / 16.0f)); const float ang = pos * inv; cosT[e] = cosf(ang); sinT[e] = sinf(ang); }
        for (int e = gt; e < 2 * 2 * 2 * 8 * 64 * 64; e += NT_) {
            const int c = e & 63, d = (e >> 6) & 63, n = (e >> 12) & 7, mat = (e >> 15) & 1, dir = (e >> 16) & 1, l = e >> 17;
            const float* src = mat ? a->in[13] : a->in[11];
            GW[e] = (bf16r)(pk2(src[((((size_t)l * 2 + dir) * 8 + n) * 64 + c) * 64 + d], 0.f) & 0xffffu); }
    }
    {
        LAS float* scr = (LAS float*)lds + wid * (64 * 33 + 16);
        const int gw = blockIdx.x * 8 + wid, NGW = G * 8;
        constexpr int I_IN = 16 * 56, I_OUT = 16 * 32, I_UP = 16 * 176, I_DN = 44 * 32, I_L = I_IN + I_OUT + I_UP + I_DN;
        for (int it = gw; it < 2 * I_L; it += NGW) {
            const int l = it / I_L; int r = it % I_L;
            unsigned char* wl = ws + WS_W + (size_t)l * W_LAYER;
            if (r < I_IN) { p0_transpose_item<1>(a->in[6] + (size_t)l * DM * DIN, DM, DIN, (bf16r*)(wl + W_IN), nullptr, nullptr, scr, r, lane); continue; } r -= I_IN;
            if (r < I_OUT) { p0_transpose_item<3>(a->in[18] + (size_t)l * DM * DM, DM, DM, (bf16r*)(wl + W_OUT), a->in[16] + l * 512, a->in[17] + l * 512, scr, r, lane); continue; } r -= I_OUT;
            if (r < I_UP) { p0_transpose_item<2>(a->in[19] + (size_t)l * DM * DFF2, DM, DFF2, (bf16r*)(wl + W_UP), nullptr, nullptr, scr, r, lane); continue; } r -= I_UP;
            p0_transpose_item<0>(a->in[22] + (size_t)l * DFF * DM, DFF, DM, (bf16r*)(wl + W_DOWN), nullptr, nullptr, scr, r, lane);
        }
    }
}

__device__ __forceinline__ void prenorm_phase(KA a, int l, int which, int nrows, int nsplit, const float* ctx_src, int wid, int lane, int G) {
    const float* MOD = (const float*)(a->ws + WS_MOD); bf16r* HN = (bf16r*)(a->ws + WS_HN);
    float* ctxres = (float*)(a->ws + WS_CTXRES); const float* PART = (const float*)(a->ws + WS_PART);
    const int gw = blockIdx.x * 8 + wid, NGW = G * 8;
    const bool from_in = (l == 0 && which == 0);
    for (int row = gw; row < nrows; row += 2 * NGW) {
        const int row2 = row + NGW; const bool has2 = row2 < nrows; const int r2 = has2 ? row2 : row;
        const float* lat = from_in ? a->in[0] : a->out;
        const float* s0 = row < MLAT ? lat + (size_t)row * DM : ctx_src + (size_t)(row - MLAT) * DM;
        const float* s1 = r2 < MLAT ? lat + (size_t)r2 * DM : ctx_src + (size_t)(r2 - MLAT) * DM;
        const float* md0 = MOD + (l * 5 + (row < MLAT ? (row >> 12) : 4)) * 6144 + (which ? 3 * 1024 : 0);
        const float* md1 = MOD + (l * 5 + (r2 < MLAT ? (r2 >> 12) : 4)) * 6144 + (which ? 3 * 1024 : 0);
        f4 v0[4], v1[4];
#pragma unroll
        for (int j = 0; j < 4; ++j) { v0[j] = *(const f4*)(s0 + 4 * (lane + 64 * j)); v1[j] = *(const f4*)(s1 + 4 * (lane + 64 * j)); }
        if (nsplit > 0) {
            if (row >= MLAT) { const float* pp = PART + (size_t)(row - MLAT) * DM + 4 * lane;
                for (int ks = 0; ks < nsplit; ks += 4) {
                    f4 t_[4][4]; float wk_[4];
#pragma unroll
                    for (int kk = 0; kk < 4; ++kk) { const int k2 = ks + kk < nsplit ? ks + kk : nsplit - 1; wk_[kk] = ks + kk < nsplit ? 1.f : 0.f;
#pragma unroll
                        for (int j = 0; j < 4; ++j) t_[kk][j] = *(const f4*)(pp + (size_t)k2 * MCTX * DM + 256 * j); }
                    __builtin_amdgcn_sched_barrier(0);
#pragma unroll
                    for (int kk = 0; kk < 4; ++kk)
#pragma unroll
                        for (int j = 0; j < 4; ++j) v0[j] += t_[kk][j] * wk_[kk];
                }
#pragma unroll
                for (int j = 0; j < 4; ++j) *(f4*)(ctxres + (size_t)(row - MLAT) * DM + 4 * (lane + 64 * j)) = v0[j]; }
            if (has2 && row2 >= MLAT) { const float* pp = PART + (size_t)(row2 - MLAT) * DM + 4 * lane;
                for (int ks = 0; ks < nsplit; ks += 4) {
                    f4 t_[4][4]; float wk_[4];
#pragma unroll
                    for (int kk = 0; kk < 4; ++kk) { const int k2 = ks + kk < nsplit ? ks + kk : nsplit - 1; wk_[kk] = ks + kk < nsplit ? 1.f : 0.f;
#pragma unroll
                        for (int j = 0; j < 4; ++j) t_[kk][j] = *(const f4*)(pp + (size_t)k2 * MCTX * DM + 256 * j); }
                    __builtin_amdgcn_sched_barrier(0);
#pragma unroll
                    for (int kk = 0; kk < 4; ++kk)
#pragma unroll
                        for (int j = 0; j < 4; ++j) v1[j] += t_[kk][j] * wk_[kk];
                }
#pragma unroll
                for (int j = 0; j < 4; ++j) *(f4*)(ctxres + (size_t)(row2 - MLAT) * DM + 4 * (lane + 64 * j)) = v1[j]; }
        }
        float ss0 = 0.f, ss1 = 0.f;
#pragma unroll
        for (int j = 0; j < 4; ++j) { ss0 += (v0[j].x * v0[j].x + v0[j].y * v0[j].y) + (v0[j].z * v0[j].z + v0[j].w * v0[j].w); ss1 += (v1[j].x * v1[j].x + v1[j].y * v1[j].y) + (v1[j].z * v1[j].z + v1[j].w * v1[j].w); }
#pragma unroll
        for (int o = 1; o < 64; o <<= 1) { ss0 += __shfl_xor(ss0, o); ss1 += __shfl_xor(ss1, o); }
        const float rs0 = rsqrtf(ss0 * (1.f / DM) + EPSN), rs1 = rsqrtf(ss1 * (1.f / DM) + EPSN);
#pragma unroll
        for (int j = 0; j < 4; ++j) { const int col = 4 * (lane + 64 * j);
            { const f4 sh = *(const f4*)(md0 + col), sc = *(const f4*)(md0 + 1024 + col); const f4 h = v0[j] * rs0 * (sc + 1.f) + sh; u2 w; w.x = pk2(h.x, h.y); w.y = pk2(h.z, h.w); *(u2*)(HN + (size_t)row * DM + col) = w; }
            if (has2) { const f4 sh = *(const f4*)(md1 + col), sc = *(const f4*)(md1 + 1024 + col); const f4 h = v1[j] * rs1 * (sc + 1.f) + sh; u2 w; w.x = pk2(h.x, h.y); w.y = pk2(h.z, h.w); *(u2*)(HN + (size_t)row2 * DM + col) = w; } }
    }
}
__device__ __forceinline__ void finalnorm_phase(KA a, int wid, int lane, int G) {
    const float* fw = a->in[23];
    const int gw = blockIdx.x * 8 + wid, NGW = G * 8;
    f4 wv[4];
#pragma unroll
    for (int j = 0; j < 4; ++j) wv[j] = *(const f4*)(fw + 4 * (lane + 64 * j));
    for (int row = gw; row < MLAT; row += 2 * NGW) {
        const int row2 = row + NGW; const bool has2 = row2 < MLAT;
        float* p0 = a->out + (size_t)row * DM; float* p1 = a->out + (size_t)(has2 ? row2 : row) * DM;
        f4 v0[4], v1[4]; float ss0 = 0.f, ss1 = 0.f;
#pragma unroll
        for (int j = 0; j < 4; ++j) { v0[j] = *(const f4*)(p0 + 4 * (lane + 64 * j)); v1[j] = *(const f4*)(p1 + 4 * (lane + 64 * j)); }
#pragma unroll
        for (int j = 0; j < 4; ++j) { ss0 += (v0[j].x * v0[j].x + v0[j].y * v0[j].y) + (v0[j].z * v0[j].z + v0[j].w * v0[j].w); ss1 += (v1[j].x * v1[j].x + v1[j].y * v1[j].y) + (v1[j].z * v1[j].z + v1[j].w * v1[j].w); }
#pragma unroll
        for (int o = 1; o < 64; o <<= 1) { ss0 += __shfl_xor(ss0, o); ss1 += __shfl_xor(ss1, o); }
        const float rs0 = rsqrtf(ss0 * (1.f / DM) + EPSN), rs1 = rsqrtf(ss1 * (1.f / DM) + EPSN);
#pragma unroll
        for (int j = 0; j < 4; ++j) { *(f4*)(p0 + 4 * (lane + 64 * j)) = v0[j] * rs0 * wv[j]; if (has2) *(f4*)(p1 + 4 * (lane + 64 * j)) = v1[j] * rs1 * wv[j]; }
    }
}

struct EpiWin {
    static constexpr bool PERM = true, AFTER_DRAIN = false;
    unsigned char* ws_; const float *qw, *kw;
    __device__ __forceinline__ void operator()(const pg8::f32x4 (&acc)[2][2][4][2], const pg8::Unit& u, int wr, int wc, int fr, int fq) const {
        bf16r* const Q = (bf16r*)(ws_ + WS_Q); bf16r* const Kb = (bf16r*)(ws_ + WS_K); bf16r* const Vb = (bf16r*)(ws_ + WS_V); bf16r* const XL = (bf16r*)(ws_ + WS_XL); bf16r* const GG = (bf16r*)(ws_ + WS_GG);
        const float* const cosT = (const float*)(ws_ + WS_COS); const float* const sinT = (const float*)(ws_ + WS_SIN);
        const int pn = u.pn, row0 = u.pm * 256 + wr * 64 + fr;
        if (pn >= 3) {
            const bool isg = pn >= 5; bf16r* dst = isg ? GG : XL; const int cb = (pn - (isg ? 5 : 3)) * 256 + wc * 32 + 8 * fq;
#pragma unroll
            for (int ai = 0; ai < 2; ++ai)
#pragma unroll
                for (int m = 0; m < 4; ++m) { const int row = row0 + ai * 128 + m * 16;
#pragma unroll
                    for (int bj = 0; bj < 2; ++bj)
#pragma unroll
                        for (int n = 0; n < 2; ++n) { pg8::f32x4 v = acc[ai][bj][m][n];
                            if (isg) { v[0] = gelu_tanh(v[0]); v[1] = gelu_tanh(v[1]); v[2] = gelu_tanh(v[2]); v[3] = gelu_tanh(v[3]); }
                            u2 w; w.x = pk2(v[0], v[1]); w.y = pk2(v[2], v[3]);
                            const int col = cb + bj * 128 + n * 4;
                            if (isg) *(u2*)(dst + (size_t)(row >> 4) * 8192 + (col >> 6) * 1024 + ((col >> 4) & 3) * 256 + (row & 15) * 16 + (col & 15)) = w;
                            else *(u2*)(dst + (size_t)row * 512 + col) = w; } }
            return;
        }
        if (pn == 2 && wc >= 2) {
#pragma unroll
            for (int ai = 0; ai < 2; ++ai)
#pragma unroll
                for (int m = 0; m < 4; ++m) { const int row = row0 + ai * 128 + m * 16; bf16r* base = Vb + (size_t)kvrow(row) * 128 + (wc - 2) * 64 + 8 * fq;
#pragma unroll
                    for (int bj = 0; bj < 2; ++bj)
#pragma unroll
                        for (int n = 0; n < 2; ++n) { const pg8::f32x4 v = acc[ai][bj][m][n]; u2 w; w.x = pk2(v[0], v[1]); w.y = pk2(v[2], v[3]);
                            *(u2*)(base + 32 * bj + 4 * n) = w; } }
            return;
        }
        const bool isk = pn == 2; const float* nw = isk ? kw : qw;
        pg8::f32x4 wv[2][2];
#pragma unroll
        for (int bj = 0; bj < 2; ++bj)
#pragma unroll
            for (int n = 0; n < 2; ++n) wv[bj][n] = *(const pg8::f32x4*)(nw + 32 * bj + 8 * fq + 4 * n);
        const float osc = isk ? 1.f : attn_body::C2;
#pragma unroll
        for (int am = 0; am < 4; ++am) { const int ai = am >> 1, m0 = (am & 1) * 2;
            pg8::f32x4 csv[2][2], snv[2][2];
            const bool lat_ = (row0 + ai * 128) < MLAT;
#pragma unroll
            for (int mm = 0; mm < 2; ++mm) { const int t = (row0 + ai * 128 + (m0 + mm) * 16) & 4095;
#pragma unroll
                for (int n = 0; n < 2; ++n) { csv[mm][n] = *(const pg8::f32x4*)(cosT + t * 32 + 8 * fq + 4 * n); snv[mm][n] = *(const pg8::f32x4*)(sinT + t * 32 + 8 * fq + 4 * n); } }
            __builtin_amdgcn_sched_barrier(0);
#pragma unroll
            for (int mm = 0; mm < 2; ++mm) { const int m = m0 + mm; const int row = row0 + ai * 128 + m * 16;
                float ss = 0.f;
#pragma unroll
                for (int bj = 0; bj < 2; ++bj)
#pragma unroll
                    for (int n = 0; n < 2; ++n) { const pg8::f32x4 v = acc[ai][bj][m][n]; ss += (v[0] * v[0] + v[1] * v[1]) + (v[2] * v[2] + v[3] * v[3]); }
                ss += __shfl_xor(ss, 16); ss += __shfl_xor(ss, 32);
                const float rstd = rsqrtf(ss * (1.f / 64.f) + EPSN) * osc;
                pg8::f32x4 y[2][2];
#pragma unroll
                for (int bj = 0; bj < 2; ++bj)
#pragma unroll
                    for (int n = 0; n < 2; ++n) y[bj][n] = acc[ai][bj][m][n] * rstd * wv[bj][n];
                if (lat_) {
#pragma unroll
                    for (int n = 0; n < 2; ++n) { const pg8::f32x4 cs = csv[mm][n], sn = snv[mm][n];
                        const pg8::f32x4 o0 = y[0][n] * cs - y[1][n] * sn, o1 = y[1][n] * cs + y[0][n] * sn; y[0][n] = o0; y[1][n] = o1; } }
                bf16r* base = isk ? Kb + (size_t)kvrow(row) * 128 + wc * 64 + 8 * fq : Q + (size_t)row * 512 + (4 * pn + wc) * 64 + 8 * fq;
#pragma unroll
                for (int bj = 0; bj < 2; ++bj)
#pragma unroll
                    for (int n = 0; n < 2; ++n) { u2 w; w.x = pk2(y[bj][n][0], y[bj][n][1]); w.y = pk2(y[bj][n][2], y[bj][n][3]); *(u2*)(base + 32 * bj + 4 * n) = w; }
            }
            __builtin_amdgcn_sched_barrier(0);
        }
    }
};
struct EpiRes {
    static constexpr bool PERM = false, AFTER_DRAIN = false;
    const float *base_lat, *base_ctx; float *out_lat, *out_ctx; const float* gate;
    __device__ __forceinline__ void operator()(const pg8::f32x4 (&acc)[2][2][4][2], const pg8::Unit& u, int wr, int wc, int fr, int fq) const {
        const int pm = u.pm; const bool isctx = pm >= 64;
        const float* base = isctx ? base_ctx + (size_t)(pm - 64) * 256 * DM : base_lat + (size_t)pm * 256 * DM;
        float* out = isctx ? out_ctx + (size_t)(pm - 64) * 256 * DM : out_lat + (size_t)pm * 256 * DM;
        const float* gt = gate + (isctx ? 4 : (pm >> 4)) * 6144;
        const int col0 = u.pn * 256 + wc * 32 + 4 * fq;
        pg8::f32x4 gv[2][2];
#pragma unroll
        for (int bj = 0; bj < 2; ++bj)
#pragma unroll
            for (int n = 0; n < 2; ++n) gv[bj][n] = *(const pg8::f32x4*)(gt + col0 + bj * 128 + n * 16);
#pragma unroll
        for (int am = 0; am < 4; ++am) {
            const int ai = am >> 1, m0 = (am & 1) * 2;
            pg8::f32x4 bs[2][2][2];
#pragma unroll
            for (int mm = 0; mm < 2; ++mm) { const size_t ro = (size_t)(ai * 128 + wr * 64 + (m0 + mm) * 16 + fr) * DM + col0;
#pragma unroll
                for (int bj = 0; bj < 2; ++bj)
#pragma unroll
                    for (int n = 0; n < 2; ++n) bs[mm][bj][n] = *(const pg8::f32x4*)(base + ro + bj * 128 + n * 16); }
            __builtin_amdgcn_sched_barrier(0);
#pragma unroll
            for (int mm = 0; mm < 2; ++mm) { const size_t ro = (size_t)(ai * 128 + wr * 64 + (m0 + mm) * 16 + fr) * DM + col0;
#pragma unroll
                for (int bj = 0; bj < 2; ++bj)
#pragma unroll
                    for (int n = 0; n < 2; ++n) *(pg8::f32x4*)(out + ro + bj * 128 + n * 16) = bs[mm][bj][n] + gv[bj][n] * acc[ai][bj][m0 + mm][n]; }
            __builtin_amdgcn_sched_barrier(0);
        }
    }
};
struct EpiUpConv {
    static constexpr bool PERM = true, AFTER_DRAIN = true;
    bf16r* ACT; const float* cw; const float* cb; int mrows;
    __device__ __forceinline__ void fused(pg8::f32x4 (&acc)[2][2][4][2], const pg8::Unit& u, int wr, int wc, int fr, int fq, PG8_LAS unsigned char* lds, int wid, int lane) const {
        constexpr int PITCH = 544;
#pragma unroll
        for (int ai = 0; ai < 2; ++ai)
#pragma unroll
            for (int m = 0; m < 4; ++m) { const int lr = ai * 128 + wr * 64 + m * 16 + fr;
#pragma unroll
                for (int bj = 0; bj < 2; ++bj)
#pragma unroll
                    for (int n = 0; n < 2; ++n) { const pg8::f32x4 v = acc[ai][bj][m][n]; u2 w; w.x = pk2(v[0], v[1]); w.y = pk2(v[2], v[3]);
                        *(PG8_LAS u2*)(lds + lr * PITCH + (bj * 128 + wc * 32 + 8 * fq + 4 * n) * 2) = w; } }
        LDS_WAIT(); __syncthreads();
        const int tid = wid * 64 + lane, cgp = tid & 15, rr = tid >> 4;
        const int ch = u.pn * 128 + 8 * cgp;
        float wg[3][8], wvv[3][8], bg[8], bv[8];
#pragma unroll
        for (int k = 0; k < 3; ++k)
#pragma unroll
            for (int h = 0; h < 2; ++h) { const f4 t0 = *(const f4*)(cw + k * DFF2 + ch + 4 * h), t1 = *(const f4*)(cw + k * DFF2 + DFF + ch + 4 * h);
                wg[k][4 * h] = t0.x; wg[k][4 * h + 1] = t0.y; wg[k][4 * h + 2] = t0.z; wg[k][4 * h + 3] = t0.w; wvv[k][4 * h] = t1.x; wvv[k][4 * h + 1] = t1.y; wvv[k][4 * h + 2] = t1.z; wvv[k][4 * h + 3] = t1.w; }
#pragma unroll
        for (int h = 0; h < 2; ++h) { const f4 t0 = *(const f4*)(cb + ch + 4 * h), t1 = *(const f4*)(cb + DFF + ch + 4 * h);
            bg[4 * h] = t0.x; bg[4 * h + 1] = t0.y; bg[4 * h + 2] = t0.z; bg[4 * h + 3] = t0.w; bv[4 * h] = t1.x; bv[4 * h + 1] = t1.y; bv[4 * h + 2] = t1.z; bv[4 * h + 3] = t1.w; }
        const int row_first = u.pm * 254 - 1, lr0 = 1 + 8 * rr;
        PG8_LAS const unsigned char* up = lds + 16 * cgp;
        u4 pg_ = *(PG8_LAS const u4*)(up + (lr0 - 1) * PITCH), pv_ = *(PG8_LAS const u4*)(up + (lr0 - 1) * PITCH + 256);
        u4 cg_ = *(PG8_LAS const u4*)(up + lr0 * PITCH), cv_ = *(PG8_LAS const u4*)(up + lr0 * PITCH + 256);
#pragma unroll
        for (int i = 0; i < 8; ++i) { const int lr = lr0 + i;
            if (lr <= 254) {
                const u4 ng_ = *(PG8_LAS const u4*)(up + (lr + 1) * PITCH), nv_ = *(PG8_LAS const u4*)(up + (lr + 1) * PITCH + 256);
                const int r = row_first + lr;
                if (r < mrows) {
                    const int p = r < MLAT ? (r & 4095) : ((r - MLAT) & 255), T = r < MLAT ? SEQL : CTXL;
                    const bool hp = p > 0, hn = p < T - 1;
                    const u4 z4 = (u4){0u, 0u, 0u, 0u};
                    const u4 pgm = hp ? pg_ : z4, pvm = hp ? pv_ : z4, ngm = hn ? ng_ : z4, nvm = hn ? nv_ : z4;
                    unsigned ow[4];
#pragma unroll
                    for (int e2 = 0; e2 < 4; ++e2) {
                        float o2[2];
#pragma unroll
                        for (int hh = 0; hh < 2; ++hh) { const int e = 2 * e2 + hh;
                            const float gp = hh ? bf_hi(pgm[e2]) : bf_lo(pgm[e2]), gc = hh ? bf_hi(cg_[e2]) : bf_lo(cg_[e2]), gn = hh ? bf_hi(ngm[e2]) : bf_lo(ngm[e2]);
                            const float vp = hh ? bf_hi(pvm[e2]) : bf_lo(pvm[e2]), vc = hh ? bf_hi(cv_[e2]) : bf_lo(cv_[e2]), vn = hh ? bf_hi(nvm[e2]) : bf_lo(nvm[e2]);
                            const float g = bg[e] + wg[1][e] * gc + wg[0][e] * gp + wg[2][e] * gn;
                            const float v = bv[e] + wvv[1][e] * vc + wvv[0][e] * vp + wvv[2][e] * vn;
                            o2[hh] = g * sigmoidf_(g) * v; }
                        ow[e2] = pk2(o2[0], o2[1]); }
                    u4 o; o.x = ow[0]; o.y = ow[1]; o.z = ow[2]; o.w = ow[3];
                    *(u4*)(ACT + (size_t)r * DFF + ch) = o;
                }
                pg_ = cg_; pv_ = cv_; cg_ = ng_; cv_ = nv_;
            } }
        LDS_WAIT(); __syncthreads();
    }
};
struct SplitOrder { int nsub, S, kslice, G, c;
    __device__ __forceinline__ bool next(int i, pg8::Unit& u) const { const int x = c + i * G; if (x >= nsub) return false; const int ks = x % S, t = x / S; u.pm = 64 + (t >> 2); u.pn = t & 3; u.koff = ks * kslice; return true; }
    __device__ __forceinline__ void a_ready(const pg8::Unit&) const {}
    __device__ __forceinline__ void done(const pg8::Unit&) const {} };
struct EpiPart {
    static constexpr bool PERM = false, AFTER_DRAIN = false;
    float* part; const float* gate; int kslice;
    __device__ __forceinline__ void operator()(const pg8::f32x4 (&acc)[2][2][4][2], const pg8::Unit& u, int wr, int wc, int fr, int fq) const {
        asm volatile("" : "+v"(fr), "+v"(fq));
        float* out = part + ((size_t)(u.koff / kslice) * MCTX + (size_t)(u.pm - 64) * 256) * DM;
        const float* gt = gate + 4 * 6144;
        const int col0 = u.pn * 256 + wc * 32 + 4 * fq;
        pg8::f32x4 gv[2][2];
#pragma unroll
        for (int bj = 0; bj < 2; ++bj)
#pragma unroll
            for (int n = 0; n < 2; ++n) gv[bj][n] = *(const pg8::f32x4*)(gt + col0 + bj * 128 + n * 16);
#pragma unroll
        for (int ai = 0; ai < 2; ++ai)
#pragma unroll
            for (int m = 0; m < 4; ++m) { const size_t ro = (size_t)(ai * 128 + wr * 64 + m * 16 + fr) * DM + col0;
#pragma unroll
                for (int bj = 0; bj < 2; ++bj)
#pragma unroll
                    for (int n = 0; n < 2; ++n) *(pg8::f32x4*)(out + ro + bj * 128 + n * 16) = gv[bj][n] * acc[ai][bj][m][n]; }
    }
};
struct OneUnit { pg8::Unit u;
    __device__ __forceinline__ bool next(int i, pg8::Unit& o) const { if (i) return false; o = u; return true; }
    __device__ __forceinline__ void a_ready(const pg8::Unit&) const {}
    __device__ __forceinline__ void done(const pg8::Unit&) const {} };

#define DPPF(old, src, ctrl) __builtin_bit_cast(float, __builtin_amdgcn_update_dpp(__builtin_bit_cast(int, (float)(old)), __builtin_bit_cast(int, (float)(src)), ctrl, 0xf, 0xf, false))
struct LruCtx { const bf16r* XLp; const bf16r* GWn; LAS const float* tab; LAS float* scr; int p0, T, n, tok, q; };
typedef _Float16 h2v __attribute__((ext_vector_type(2)));
__device__ __forceinline__ unsigned pkh2(float lo, float hi) { return __builtin_bit_cast(unsigned, __builtin_amdgcn_cvt_pkrtz(lo, hi)); }
__device__ __forceinline__ float h2lo(unsigned w) { return (float)__builtin_bit_cast(h2v, w).x; }
__device__ __forceinline__ float h2hi(unsigned w) { return (float)__builtin_bit_cast(h2v, w).y; }
__device__ __forceinline__ void lru_conv_load(const LruCtx& c, int s, u4 (&raw)[8]) {
    const int i = 16 * s + c.tok, p = c.p0 + i;
#pragma unroll
    for (int ks = 0; ks < 2; ++ks)
#pragma unroll
        for (int k = 0; k < 4; ++k) { const int pp = p + k - 2; const bool ok = pp >= 0 && pp < c.T;
            raw[4 * ks + k] = *(const u4*)(c.XLp + (ptrdiff_t)(ok ? i + k - 2 : i) * 512 + 32 * ks + 8 * c.q); }
}
__device__ __forceinline__ void lru_conv(const LruCtx& c, int s, const u4 (&raw)[8], s8v (&frag)[2], f4 (&xc)[4]) {
    const int i = 16 * s + c.tok, p = c.p0 + i;
    float xb[2][8];
#pragma unroll
    for (int ks = 0; ks < 2; ++ks) { const int c0 = 32 * ks + 8 * c.q, chn = 64 * c.n + c0;
#pragma unroll
        for (int h = 0; h < 2; ++h) { const f4 t = *(LAS const f4*)(c.tab + 2048 + chn + 4 * h); xb[ks][4 * h] = t.x; xb[ks][4 * h + 1] = t.y; xb[ks][4 * h + 2] = t.z; xb[ks][4 * h + 3] = t.w; }
#pragma unroll
        for (int k = 0; k < 4; ++k) { const int pp = p + k - 2; const bool ok = pp >= 0 && pp < c.T;
            const u4 rw = raw[4 * ks + k];
#pragma unroll
            for (int h = 0; h < 2; ++h) { f4 w = *(LAS const f4*)(c.tab + k * 512 + chn + 4 * h); if (!ok) w = (f4){0.f, 0.f, 0.f, 0.f};
                xb[ks][4 * h] += w.x * bf_lo(rw[2 * h]); xb[ks][4 * h + 1] += w.y * bf_hi(rw[2 * h]); xb[ks][4 * h + 2] += w.z * bf_lo(rw[2 * h + 1]); xb[ks][4 * h + 3] += w.w * bf_hi(rw[2 * h + 1]); } } }
#pragma unroll
    for (int ks = 0; ks < 2; ++ks) { LAS float* sp = c.scr + c.tok * 68 + 32 * ks + 8 * c.q;
        *(LAS f4*)sp = (f4){xb[ks][0], xb[ks][1], xb[ks][2], xb[ks][3]}; *(LAS f4*)(sp + 4) = (f4){xb[ks][4], xb[ks][5], xb[ks][6], xb[ks][7]};
        u4 w; w.x = pk2(xb[ks][0], xb[ks][1]); w.y = pk2(xb[ks][2], xb[ks][3]); w.z = pk2(xb[ks][4], xb[ks][5]); w.w = pk2(xb[ks][6], xb[ks][7]); frag[ks] = __builtin_bit_cast(s8v, w); }
    LDS_WAIT();
#pragma unroll
    for (int rb = 0; rb < 4; ++rb) xc[rb] = *(LAS const f4*)(c.scr + c.tok * 68 + 16 * rb + 4 * c.q);
    LDS_WAIT();
}
__device__ __forceinline__ void lru_wload(const LruCtx& c, int dir, s8v (&W)[16]) {
    const bf16r* gwa = c.GWn + (size_t)(dir * 2) * 8 * 4096, *gwx = gwa + 8 * 4096;
#pragma unroll
    for (int rb = 0; rb < 4; ++rb)
#pragma unroll
        for (int ks = 0; ks < 2; ++ks) { const int off = (16 * rb + c.tok) * 64 + 32 * ks + 8 * c.q; W[4 * rb + 2 * ks] = *(const s8v*)(gwa + off); W[4 * rb + 2 * ks + 1] = *(const s8v*)(gwx + off); }
}
__device__ __forceinline__ void lru_gates(const LruCtx& c, int dir, const s8v (&W)[16], const s8v (&frag)[2], const f4 (&xc)[4], float (&LA)[16], float (&AV)[16], float (&B)[16]) {
    f4 ga[4], gx[4];
#pragma unroll
    for (int rb = 0; rb < 4; ++rb) { ga[rb] = (f4){0.f, 0.f, 0.f, 0.f}; gx[rb] = (f4){0.f, 0.f, 0.f, 0.f};
#pragma unroll
        for (int ks = 0; ks < 2; ++ks) {
            ga[rb] = __builtin_amdgcn_mfma_f32_16x16x32_bf16(W[4 * rb + 2 * ks], frag[ks], ga[rb], 0, 0, 0);
            gx[rb] = __builtin_amdgcn_mfma_f32_16x16x32_bf16(W[4 * rb + 2 * ks + 1], frag[ks], gx[rb], 0, 0, 0); } }
#pragma unroll
    for (int rb = 0; rb < 4; ++rb) { const int chn = dir * 512 + 64 * c.n + 16 * rb + 4 * c.q;
        const f4 ba = *(LAS const f4*)(c.tab + 2560 + chn), bx = *(LAS const f4*)(c.tab + 3584 + chn), cl = *(LAS const f4*)(c.tab + 4608 + chn);
#pragma unroll
        for (int j = 0; j < 4; ++j) { const float r = sigmoidf_(ga[rb][j] + ba[j]), ii = sigmoidf_(gx[rb][j] + bx[j]);
            const float la = cl[j] * r, z = 2.f * la, av = fexp(la);
            const float om = (z > -0.0078125f) ? -z * (1.f + 0.5f * z) : __builtin_fmaf(-av, av, 1.f);
            LA[4 * rb + j] = la; AV[4 * rb + j] = av; B[4 * rb + j] = __builtin_amdgcn_sqrtf(om) * ii * xc[rb][j]; } }
}
__device__ __forceinline__ void scan_fwd(float (&A)[16], float (&B)[16]) {
#pragma unroll
    for (int k = 0; k < 16; ++k) { float a_ = A[k], b_ = B[k], ap, bp;
        ap = DPPF(1.f, a_, 0x111); bp = DPPF(0.f, b_, 0x111); b_ = a_ * bp + b_; a_ = a_ * ap;
        ap = DPPF(1.f, a_, 0x112); bp = DPPF(0.f, b_, 0x112); b_ = a_ * bp + b_; a_ = a_ * ap;
        ap = DPPF(1.f, a_, 0x114); bp = DPPF(0.f, b_, 0x114); b_ = a_ * bp + b_; a_ = a_ * ap;
        ap = DPPF(1.f, a_, 0x118); bp = DPPF(0.f, b_, 0x118); b_ = a_ * bp + b_; a_ = a_ * ap;
        A[k] = a_; B[k] = b_; }
}
__device__ __forceinline__ void scan_bwd(float (&A)[16], float (&B)[16]) {
#pragma unroll
    for (int k = 0; k < 16; ++k) { float a_ = A[k], b_ = B[k], ap, bp;
        ap = DPPF(1.f, a_, 0x101); bp = DPPF(0.f, b_, 0x101); b_ = a_ * bp + b_; a_ = a_ * ap;
        ap = DPPF(1.f, a_, 0x102); bp = DPPF(0.f, b_, 0x102); b_ = a_ * bp + b_; a_ = a_ * ap;
        ap = DPPF(1.f, a_, 0x104); bp = DPPF(0.f, b_, 0x104); b_ = a_ * bp + b_; a_ = a_ * ap;
        ap = DPPF(1.f, a_, 0x108); bp = DPPF(0.f, b_, 0x108); b_ = a_ * bp + b_; a_ = a_ * ap;
        A[k] = a_; B[k] = b_; }
}
#define DPPZ(src, ctrl) __builtin_bit_cast(float, __builtin_amdgcn_update_dpp(0, __builtin_bit_cast(int, (float)(src)), ctrl, 0xf, 0xf, true))
__device__ __forceinline__ float rowsum_fwd(float x) { x += DPPZ(x, 0x111); x += DPPZ(x, 0x112); x += DPPZ(x, 0x114); x += DPPZ(x, 0x118); return x; }
__device__ __forceinline__ float rowsum_bwd(float x) { x += DPPZ(x, 0x101); x += DPPZ(x, 0x102); x += DPPZ(x, 0x104); x += DPPZ(x, 0x108); return x; }
__device__ __forceinline__ void lru_tables(KA a, int l, LAS float* tab, int tid) {
    for (int e = tid; e < 5632; e += 512) { float v;
        if (e < 2048) v = a->in[9][l * 2048 + e];
        else if (e < 2560) v = a->in[10][l * 512 + (e - 2048)];
        else if (e < 3584) v = a->in[12][l * 1024 + (e - 2560)];
        else if (e < 4608) v = a->in[14][l * 1024 + (e - 3584)];
        else { const float lam = a->in[15][l * 1024 + (e - 4608)]; const float x = fexp(-lam); const float sp = x < 0.03f ? x * (1.f - x * (0.5f - x * (0.33333334f - x * 0.25f))) : (lam < -20.f ? -lam : __builtin_amdgcn_logf(1.f + x) * 0.6931471805599453f); v = -8.f * sp; }
        tab[e] = v; }
}
__device__ __forceinline__ void lru_l1_tile(KA a, int l, int b, int cid, int dir, LAS unsigned char* lds, int tid, int wid, int lane) {
    asm volatile("" : "+v"(lane), "+v"(tid));
    unsigned char* ws = a->ws;
    LAS float* tab = (LAS float*)(lds + L1_TAB_OFF); LAS float* scr = (LAS float*)(lds + L1_TAB_OFF + 22528) + wid * (16 * 68);
    LruCtx c; c.n = wid; c.tok = lane & 15; c.q = lane >> 4; c.tab = tab; c.scr = scr;
    const bool isctx = cid < 4; c.p0 = (isctx ? cid : cid - 4) * 64; c.T = isctx ? CTXL : SEQL;
    const int rowbase = isctx ? MLAT + b * CTXL + c.p0 : b * SEQL + c.p0;
    c.XLp = (const bf16r*)(ws + WS_XL) + (size_t)rowbase * 512 + c.n * 64;
    c.GWn = (const bf16r*)(ws + WS_GW) + (size_t)(l * 4) * 8 * 4096 + c.n * 4096;
    float* AGGA = (float*)(ws + WS_AGGA); float* AGGB = (float*)(ws + WS_AGGB);
    unsigned* LAB = (unsigned*)(ws + WS_LAB) + (size_t)(rowbase >> 4) * 8192 + 1024 * c.n + 16 * c.tok + 4 * c.q;
    const int bl = (lane & 48) | 15, bf_ = (lane & 48);
    {
        LAS float* rab = (LAS float*)(lds + L1_TAB_OFF + 22528 + 34816) + wid * 128 + c.q * 32;
#pragma unroll
        for (int k = 0; k < 16; ++k) { rab[2 * k] = 1.f; rab[2 * k + 1] = 0.f; }
        s8v W[16];
        lru_wload(c, dir, W);
        u4 rawc[8];
        lru_conv_load(c, 0, rawc);
#pragma unroll 1
        for (int s = 0; s < 4; ++s) {
            s8v frag[2]; f4 xc[4];
            lru_conv(c, s, rawc, frag, xc);
            __builtin_amdgcn_sched_barrier(0);
            lru_conv_load(c, s < 3 ? s + 1 : 3, rawc);
            __builtin_amdgcn_sched_barrier(0);
            float LAv[16], A[16], B[16];
            lru_gates(c, dir, W, frag, xc, LAv, A, B);
            unsigned* lp = LAB + (size_t)dir * MALL * 512 + (size_t)s * 8192;
#pragma unroll
            for (int rb = 0; rb < 4; ++rb) { u4 w; w.x = pkh2(LAv[4 * rb], B[4 * rb]); w.y = pkh2(LAv[4 * rb + 1], B[4 * rb + 1]); w.z = pkh2(LAv[4 * rb + 2], B[4 * rb + 2]); w.w = pkh2(LAv[4 * rb + 3], B[4 * rb + 3]); *(u4*)(lp + 256 * rb) = w; }
            if (dir == 0) scan_fwd(A, B); else scan_bwd(A, B);
#pragma unroll
            for (int k = 0; k < 16; ++k) {
                const float a_ = __shfl(A[k], dir ? bf_ : bl), b_ = __shfl(B[k], dir ? bf_ : bl);
                const float ra = rab[2 * k], rb_ = rab[2 * k + 1];
                if (dir == 0) { rab[2 * k + 1] = a_ * rb_ + b_; rab[2 * k] = a_ * ra; }
                else { rab[2 * k + 1] = ra * b_ + rb_; rab[2 * k] = ra * a_; } }
            LDS_WAIT();
        }
        if (c.tok == 0) { const size_t o = ((size_t)(b * 2 + dir) * NCH + cid) * 512 + 64 * c.n + 4 * c.q;
#pragma unroll
            for (int rb = 0; rb < 4; ++rb) { *(f4*)(AGGA + o + 16 * rb) = (f4){rab[8 * rb], rab[8 * rb + 2], rab[8 * rb + 4], rab[8 * rb + 6]}; *(f4*)(AGGB + o + 16 * rb) = (f4){rab[8 * rb + 1], rab[8 * rb + 3], rab[8 * rb + 5], rab[8 * rb + 7]}; } }
    }
    LDS_WAIT(); __syncthreads();
}
__device__ __forceinline__ void lru_l2_tile(KA a, int l, int b, int cid, LAS unsigned char* lds, int tid, int wid, int lane) {
    asm volatile("" : "+v"(lane));
    unsigned char* ws = a->ws;
    LAS float* part = (LAS float*)lds;
    LAS float* hfl = (LAS float*)(lds + 4096) + wid * 4096 + lane;
    const int n = wid, tok = lane & 15, q = lane >> 4;
    const bool isctx = cid < 4; const int p0 = (isctx ? cid : cid - 4) * 64;
    const int rowbase = isctx ? MLAT + b * CTXL + p0 : b * SEQL + p0;
    const float* AGGA = (const float*)(ws + WS_AGGA); const float* AGGB = (const float*)(ws + WS_AGGB);
    const unsigned* LAB = (const unsigned*)(ws + WS_LAB) + (size_t)(rowbase >> 4) * 8192 + 1024 * n + 16 * tok + 4 * q;
    const bf16r* GGp = (const bf16r*)(ws + WS_GG) + (size_t)(rowbase >> 4) * 8192 + 1024 * n + 16 * tok + 4 * q;
    const int bl = (lane & 48) | 15, bf_ = (lane & 48);
    float hin[16], hinb[16], A[16], B[16];
#pragma unroll 1
    for (int dir = 0; dir < 2; ++dir) {
        const float* ap_ = AGGA + ((size_t)(b * 2 + dir) * NCH) * 512 + 64 * n + 4 * q; const float* bp_ = AGGB + ((size_t)(b * 2 + dir) * NCH) * 512 + 64 * n + 4 * q;
#pragma unroll
        for (int k = 0; k < 16; ++k) { A[k] = 1.f; B[k] = 0.f; }
#pragma unroll
        for (int eb = 0; eb < 5; eb += 3) {
            f4 avv[3][4], bvv[3][4]; bool okv[3];
#pragma unroll
            for (int e2 = 0; e2 < 3; ++e2) { if (eb + e2 < 5) { const int o = 5 * tok + eb + e2; int ch; bool ok;
                if (dir == 0) { ch = o; ok = o < cid; } else { ch = o < 4 ? 3 - o : 71 - o; ok = isctx ? (o < 4 && ch > cid) : (o < 4 || (o < 68 && ch > cid)); }
                ch = ch < 0 ? 0 : (ch > NCH - 1 ? NCH - 1 : ch); okv[e2] = ok;
#pragma unroll
                for (int rb = 0; rb < 4; ++rb) { avv[e2][rb] = *(const f4*)(ap_ + (size_t)ch * 512 + 16 * rb); bvv[e2][rb] = *(const f4*)(bp_ + (size_t)ch * 512 + 16 * rb); } } }
            __builtin_amdgcn_sched_barrier(0);
#pragma unroll
            for (int e2 = 0; e2 < 3; ++e2) { if (eb + e2 < 5) {
#pragma unroll
                for (int rb = 0; rb < 4; ++rb) { f4 av = avv[e2][rb], bv = bvv[e2][rb];
                    if (!okv[e2]) { av = (f4){1.f, 1.f, 1.f, 1.f}; bv = (f4){0.f, 0.f, 0.f, 0.f}; }
#pragma unroll
                    for (int jj = 0; jj < 4; ++jj) { B[4 * rb + jj] = av[jj] * B[4 * rb + jj] + bv[jj]; A[4 * rb + jj] = av[jj] * A[4 * rb + jj]; } } } }
            __builtin_amdgcn_sched_barrier(0);
        }
        scan_fwd(A, B);
        if (dir == 0) {
#pragma unroll
            for (int k = 0; k < 16; ++k) hin[k] = __shfl(B[k], bl);
        } else {
#pragma unroll
            for (int k = 0; k < 16; ++k) hinb[k] = __shfl(B[k], bl);
        }
    }
    u4 wc_[4], wn_[4]; u2 gc_[4], gn_[4];
#pragma unroll
    for (int rb = 0; rb < 4; ++rb) { wc_[rb] = *(const u4*)(LAB + 256 * rb); gc_[rb] = (u2){0u, 0u}; gn_[rb] = (u2){0u, 0u}; }
#pragma unroll 1
    for (int st = 0; st < 8; ++st) {
        const int s = st < 4 ? st : 7 - st;
        { const int sn = st + 1 < 8 ? st + 1 : 7; const int s2 = sn < 4 ? sn : 7 - sn; const bool bw = sn >= 4;
          const unsigned* lp_ = LAB + (size_t)(bw ? MALL : 0) * 512 + (size_t)s2 * 8192; const bf16r* gp_ = GGp + (size_t)s2 * 8192;
#pragma unroll
          for (int rb = 0; rb < 4; ++rb) { wn_[rb] = *(const u4*)(lp_ + 256 * rb); gn_[rb] = *(const u2*)(gp_ + 256 * rb); } }
        __builtin_amdgcn_sched_barrier(0);
#pragma unroll
        for (int rb = 0; rb < 4; ++rb)
#pragma unroll
            for (int j = 0; j < 4; ++j) { A[4 * rb + j] = h2lo(wc_[rb][j]) * 1.4426950408889634f; B[4 * rb + j] = h2hi(wc_[rb][j]); }
        LAS float* hs = hfl + s * 1024;
        if (st < 4) {
#pragma unroll
            for (int k = 0; k < 16; ++k) { const float L = rowsum_fwd(A[k]); const float P = __builtin_amdgcn_exp2f(L); const float C = rowsum_fwd(B[k] * __builtin_amdgcn_exp2f(-L)); A[k] = P; B[k] = P * C; }
#pragma unroll
            for (int k = 0; k < 16; ++k) { const float h = A[k] * hin[k] + B[k]; hs[k * 64] = h; hin[k] = __shfl(h, bl); }
        } else {
            if (st == 4) {
#pragma unroll
                for (int k = 0; k < 16; ++k) hin[k] = hinb[k]; }
#pragma unroll
            for (int k = 0; k < 16; ++k) { const float L = rowsum_bwd(A[k]); const float P = __builtin_amdgcn_exp2f(L); const float C = rowsum_bwd(B[k] * __builtin_amdgcn_exp2f(-L)); A[k] = P; B[k] = P * C; }
            float sq = 0.f;
#pragma unroll
            for (int rb = 0; rb < 4; ++rb)
#pragma unroll
                for (int j = 0; j < 4; ++j) { const int k = 4 * rb + j; const float h = A[k] * hin[k] + B[k]; hin[k] = __shfl(h, bf_);
                    const float gg = (j & 1) ? bf_hi(gc_[rb][j >> 1]) : bf_lo(gc_[rb][j >> 1]);
                    const float r = (hs[k * 64] + h) * gg; hs[k * 64] = r; sq += r * r; }
            sq += __shfl_xor(sq, 16); sq += __shfl_xor(sq, 32); if (q == 0) part[wid * 64 + 16 * s + tok] = sq;
        }
#pragma unroll
        for (int rb = 0; rb < 4; ++rb) { wc_[rb] = wn_[rb]; gc_[rb] = gn_[rb]; }
    }
    LDS_WAIT(); __syncthreads();
    bf16r* MIX = (bf16r*)(ws + WS_MIX);
#pragma unroll 1
    for (int s = 0; s < 4; ++s) { float t = 0.f;
#pragma unroll
        for (int w = 0; w < 8; ++w) t += part[w * 64 + 16 * s + tok];
        const float rstd = rsqrtf(t * (1.f / 512.f) + EPSN);
        bf16r* mp = MIX + (size_t)(rowbase + 16 * s + tok) * DM + 512 + 64 * n + 4 * q;
        const LAS float* hs = hfl + s * 1024;
#pragma unroll
        for (int rb = 0; rb < 4; ++rb) { u2 w; w.x = pk2(hs[(4 * rb) * 64] * rstd, hs[(4 * rb + 1) * 64] * rstd); w.y = pk2(hs[(4 * rb + 2) * 64] * rstd, hs[(4 * rb + 3) * 64] * rstd); *(u2*)(mp + 16 * rb) = w; } }
    const bf16r* O = (const bf16r*)(ws + WS_O) + (size_t)(rowbase + wid * 8) * 512 + 8 * lane;
    u4 rawc = *(const u4*)O;
#pragma unroll 1
    for (int tt = 0; tt < 8; ++tt) {
        const u4 rawn = *(const u4*)(O + (size_t)(tt < 7 ? tt + 1 : 7) * 512);
        float v[8]; float ss = 0.f;
#pragma unroll
        for (int e = 0; e < 4; ++e) { v[2 * e] = bf_lo(rawc[e]); v[2 * e + 1] = bf_hi(rawc[e]); ss += v[2 * e] * v[2 * e] + v[2 * e + 1] * v[2 * e + 1]; }
        const float rstd = rsqrtf(wave_sum(ss) * (1.f / 512.f) + EPSN);
        u4 o; o.x = pk2(v[0] * rstd, v[1] * rstd); o.y = pk2(v[2] * rstd, v[3] * rstd); o.z = pk2(v[4] * rstd, v[5] * rstd); o.w = pk2(v[6] * rstd, v[7] * rstd);
        *(u4*)(MIX + (size_t)(rowbase + wid * 8 + tt) * DM + 8 * lane) = o;
        rawc = rawn; }
    LDS_WAIT(); __syncthreads();
}

#define GAS __attribute__((address_space(1)))
#define XB_TMO      128
#define XB_XCNT(j)  (256  + 64 * (j))
#define XB_XSUB(j)  (1280 + 64 * (j))
#define XB_XGEN(j)  (2304 + 64 * (j))
#define XB_TOP      3328
#define XB_TOPGEN   3392
#define XCD_BAR_WORDS 3456
#define XB_SPIN_CAP (1u << 18)

__device__ __forceinline__ unsigned xb_ld(unsigned* p)              { return __hip_atomic_load(p, __ATOMIC_RELAXED, __HIP_MEMORY_SCOPE_AGENT); }
__device__ __forceinline__ unsigned xb_add(unsigned* p, unsigned v) { return __hip_atomic_fetch_add(p, v, __ATOMIC_RELAXED, __HIP_MEMORY_SCOPE_AGENT); }
__device__ __forceinline__ unsigned xb_xcc_id() { return (unsigned)__builtin_amdgcn_s_getreg((3 << 11) | 20) & 0xFu; }
#define XB_SPIN(cond, bar) do { unsigned _sp = 0; while (cond) { __builtin_amdgcn_s_sleep(1); \
    if ((++_sp & 255u) == 0u) { if (xb_ld(&(bar)[XB_TMO])) break; if (_sp > XB_SPIN_CAP) { atomicAdd(&(bar)[XB_TMO], 1u); break; } } } } while (0)

struct XcdBarrier {
    unsigned* bar; unsigned x;
    volatile LAS unsigned* st;
};

__device__ __forceinline__ XcdBarrier xcd_barrier_post(unsigned* bar, volatile LAS unsigned* st) {
    XcdBarrier b; b.bar = bar; b.x = xb_xcc_id(); b.st = st;
    if (threadIdx.x == 0) (void)xb_add(&bar[XB_XCNT(b.x)], 1u);
    return b;
}
__device__ __forceinline__ void xcd_barrier_complete(unsigned* bar, unsigned x, unsigned& nloc, unsigned& nx) {
    const unsigned G = gridDim.x * gridDim.y * gridDim.z;
    unsigned sum, cnt, mine, sp = 0u;
    for (;;) {
        sum = 0u; cnt = 0u; mine = 0u;
#pragma unroll
        for (unsigned j = 0; j < 16; ++j) { const unsigned c = xb_ld(&bar[XB_XCNT(j)]); sum += c; cnt += (c > 0u) ? 1u : 0u; mine = (j == x) ? c : mine; }
        if (sum == G) break;
        __builtin_amdgcn_s_sleep(1);
        if ((++sp & 255u) == 0u) { if (xb_ld(&bar[XB_TMO])) break; if (sp > XB_SPIN_CAP) { atomicAdd(&bar[XB_TMO], 1u); break; } }
    }
    nloc = mine > 0u ? mine : 1u; nx = cnt > 0u ? cnt : 1u;
}

__device__ __forceinline__ void xcd_barrier(const XcdBarrier& b) {
    asm volatile("s_waitcnt vmcnt(0)" ::: "memory");
    __syncthreads();
    if (threadIdx.x == 0) {
        unsigned* bar = b.bar;
        __builtin_amdgcn_s_waitcnt(0);
        unsigned nloc = b.st[0], nx = b.st[1];
        if (nloc == 0u) { xcd_barrier_complete(bar, b.x, nloc, nx); b.st[0] = nloc; b.st[1] = nx; }
        const unsigned old = xb_add(&bar[XB_XSUB(b.x)], 1u);
        const unsigned gen = old / nloc;
        if (old + 1u == (gen + 1u) * nloc) {
            __builtin_amdgcn_fence(__ATOMIC_RELEASE, "agent");
            asm volatile("s_waitcnt vmcnt(0)" ::: "memory");
            const unsigned og = xb_add(&bar[XB_TOP], 1u);
            const unsigned tg = og / nx;
            if (og + 1u == (tg + 1u) * nx) xb_add(&bar[XB_TOPGEN], 1u);
            else XB_SPIN(xb_ld(&bar[XB_TOPGEN]) == tg, bar);
            __builtin_amdgcn_fence(__ATOMIC_ACQUIRE, "agent");
            xb_add(&bar[XB_XGEN(b.x)], 1u);
            asm volatile("s_waitcnt vmcnt(0)" ::: "memory");
        } else {
            XB_SPIN(xb_ld(&bar[XB_XGEN(b.x)]) == gen, bar);
            __builtin_amdgcn_fence(__ATOMIC_ACQUIRE, "agent");
            asm volatile("s_waitcnt vmcnt(0)" ::: "memory");
        }
    }
    __syncthreads();
}

#ifndef REP_PH
#define REP_PH -1
#endif
#ifndef REP_SKIP_L1
#define REP_SKIP_L1 0
#endif
#ifndef USE_XBAR
#define USE_XBAR 1
#endif
__global__ void __launch_bounds__(512, 2) mega(Args a_) {
    extern __shared__ __attribute__((aligned(16))) unsigned char lds_raw[];
    LAS unsigned char* lds = (LAS unsigned char*)lds_raw;
    const int G = gridDim.x, bx = blockIdx.x;
    const int vcu = (G % 8 == 0) ? (bx % 8) * (G / 8) + bx / 8 : bx;
    KA a = (KA)__builtin_amdgcn_kernarg_segment_ptr();
    volatile LAS unsigned* bst = (volatile LAS unsigned*)(lds + LDS_BYTES - 64);
    if (threadIdx.x < 2) bst[threadIdx.x] = 0u;
    __syncthreads();
    (void)xcd_barrier_post((unsigned*)a->ws, bst);
    int nsync = 0;
#define GRID_SYNC() do { if (!USE_XBAR || a->ph_lo < 0) cg::this_grid().sync();     else { XcdBarrier xb_; xb_.bar = (unsigned*)a->ws; xb_.x = xb_xcc_id(); xb_.st = (volatile LAS unsigned*)(lds + LDS_BYTES - 64); xcd_barrier(xb_); } ++nsync; } while (0)
    const int ph_hi = a->ph_hi;
    for (int ph = a->ph_lo; ph < ph_hi; ++ph) {
        asm volatile("" : "+s"(a));
        for (int rep = 0; rep < (ph == REP_PH ? 2 : 1); ++rep) {
        if (rep) GRID_SYNC();
#define TL const int tid = mk_tid(), lane = tid & 63, wid = __builtin_amdgcn_readfirstlane(tid >> 6); (void)tid; (void)lane; (void)wid
        unsigned char* ws = a->ws;
        float* MOD = (float*)(ws + WS_MOD); float* ctxres = (float*)(ws + WS_CTXRES);
        bf16r* HN = (bf16r*)(ws + WS_HN);
        if (ph == 0) { if (PON(8)) { TL; p0_phase(a, lds, tid, wid, lane, G); } }
        else if (ph == NPHASE - 1) { if (PON(9)) { TL; finalnorm_phase(a, wid, lane, G); } }
        else {
            const int l = (ph - 1) >> 3, sub = (ph - 1) & 7;
            unsigned char* wl = ws + WS_W + (size_t)l * W_LAYER;
            const bool ctx_out = l == 0;
            if (sub == 0) { if (PON(0)) { TL; prenorm_phase(a, l, 0, MALL, l == 0 ? 0 : 11, l == 0 ? a->in[2] : ctxres, wid, lane, G); } }
            else if (sub == 1) { if (PON(1)) {
                pg8::Gemm g{HN, (const bf16r*)(wl + W_IN), MALL, DIN, DM, 256, DM}; pg8::StaticOrder S; S.init(MALL, DIN, G, bx);
                EpiWin E{ws, a->in[7] + l * 64, a->in[8] + l * 64};
                pg8::gemm_phase<EpiWin, pg8::StaticOrder, true, true>(lds, g, S, E); }
            } else if (sub == 2) { if (PON(2)) { TL;
                const int nctx = ctx_out ? 4 : 0, cnt = 64 + nctx + ((rep && REP_SKIP_L1) ? 0 : 68);
                attn_body::bf16* Qb = (attn_body::bf16*)(ws + WS_Q); attn_body::bf16* Ob = (attn_body::bf16*)(ws + WS_O); const attn_body::bf16* Kb = (const attn_body::bf16*)(ws + WS_K); const attn_body::bf16* Vb = (const attn_body::bf16*)(ws + WS_V);
                LAS unsigned char* l3 = lds; asm volatile("" : "+s"(l3)); char* shm = (char*)l3;
                volatile LAS int* qw = (volatile LAS int*)(lds + LDS_BYTES - 32);
                unsigned* qctr = (unsigned*)ws + 3584 + (l * 2 + rep) * 8 * 64;
                const int hx = (int)(xb_xcc_id() & 7u);
                lru_tables(a, l, (LAS float*)(lds + L1_TAB_OFF), tid); __syncthreads();
                for (int li = 0; li < 8; ++li) { const int x = (hx + li) & 7; const int b = x >> 1, kvh = x & 1;
                    for (;;) {
                        __syncthreads();
                        if (tid == 0) *qw = (int)__hip_atomic_fetch_add(qctr + x * 64, 1u, __ATOMIC_RELAXED, __HIP_MEMORY_SCOPE_AGENT);
                        __syncthreads();
                        const int i = __builtin_amdgcn_readfirstlane(*qw);
                        if (i >= cnt) break;
                        if (i < 64 + nctx) {
                            const bool lat = i < 64; const int h = kvh * 4 + (lat ? (i >> 4) : (i - 64));
                            const size_t qo = (size_t)(lat ? b * SEQL + (i & 15) * 256 : MLAT + b * CTXL) * 512 + h * 64;
                            attn_body::attn_unit<8>(Qb + qo, Kb + (size_t)b * KVR * 128 + kvh * 64, Vb + (size_t)b * KVR * 128 + kvh * 64, Ob + qo, lat ? NCH : 4, shm);
                        } else { const int it = i - 64 - nctx, t = x * 34 + (it >> 1); lru_l1_tile(a, l, t / NCH, t % NCH, it & 1, lds, tid, wid, lane); }
                    }
                } }
            } else if (sub == 3) { if (PON(3)) { TL;
                const int nt = ctx_out ? 4 * NCH : 4 * 64;
                for (int t = vcu; t < nt; t += G) { int b, cid; if (ctx_out) { b = t / NCH; cid = t % NCH; } else { b = t >> 6; cid = 4 + (t & 63); }
                    lru_l2_tile(a, l, b, cid, lds, tid, wid, lane); } }
            } else if (sub == 4) { if (PON(4)) {
                { pg8::Gemm g{(const bf16r*)(ws + WS_MIX), (const bf16r*)(wl + W_OUT), MLAT, DM, DM, 256, DM}; pg8::StaticOrder S; S.init(MLAT, DM, G, bx);
                  EpiRes E{l == 0 ? a->in[0] : a->out, l == 0 ? a->in[2] : ctxres, a->out, ctxres, MOD + l * 5 * 6144 + 2 * 1024};
                  pg8::gemm_phase<EpiRes, pg8::StaticOrder, true, true>(lds, g, S, E); }
                if (ctx_out) {
                    pg8::Gemm g{(const bf16r*)(ws + WS_MIX), (const bf16r*)(wl + W_OUT), MALL, DM, 256, 256, DM}; SplitOrder S{64, 4, 256, G, bx};
                    EpiPart E{(float*)(ws + WS_PART), MOD + l * 5 * 6144 + 2 * 1024, 256};
                    pg8::gemm_phase<EpiPart, SplitOrder, true, true>(lds, g, S, E); } }
            } else if (sub == 5) { if (PON(5)) { TL; prenorm_phase(a, l, 1, ctx_out ? MALL : MLAT, ctx_out ? 4 : 0, ctx_out ? a->in[2] : ctxres, wid, lane, G); } }
            else if (sub == 6) { if (PON(6)) {
                const int mrows = ctx_out ? MALL : MLAT, nM = (mrows + 253) / 254;
                pg8::Gemm g{HN - DM, (const bf16r*)(wl + W_UP), nM * 256, DFF2, DM, 254, DM}; pg8::StaticOrder S; S.init(nM * 256, DFF2, G, bx);
                EpiUpConv E{(bf16r*)(ws + WS_ACT), a->in[20] + (size_t)l * 3 * DFF2, a->in[21] + (size_t)l * DFF2, mrows};
                for (int i = 0;; ++i) { pg8::Unit u; if (!S.next(i, u)) break; OneUnit S1{u}; pg8::gemm_phase<EpiUpConv, OneUnit, false, true>(lds, g, S1, E); } }
            } else { if (PON(7)) {
                { pg8::Gemm g{(const bf16r*)(ws + WS_ACT), (const bf16r*)(wl + W_DOWN), MLAT, DM, DFF, 256, DFF}; pg8::StaticOrder S; S.init(MLAT, DM, G, bx);
                  EpiRes E{a->out, ctxres, a->out, ctxres, MOD + l * 5 * 6144 + 5 * 1024};
                  pg8::gemm_phase<EpiRes, pg8::StaticOrder, true, true>(lds, g, S, E); }
                if (ctx_out) {
                    pg8::Gemm g{(const bf16r*)(ws + WS_ACT), (const bf16r*)(wl + W_DOWN), MALL, DM, 256, 256, DFF}; SplitOrder S{176, 11, 256, G, bx};
                    EpiPart E{(float*)(ws + WS_PART), MOD + l * 5 * 6144 + 5 * 1024, 256};
                    pg8::gemm_phase<EpiPart, SplitOrder, true, true>(lds, g, S, E); } }
            }
        }
        }
        if (ph + 1 < ph_hi) GRID_SYNC();
    }
}

extern "C" void kernel_launch(void* const* d_in, const int* in_sizes, int n_in, void* d_out, int out_size, void* d_ws, size_t ws_size, hipStream_t stream) {
    static int grid = 0;
    if (grid == 0) {
        int dev = 0, cus = 0, per_cu = 0;
        if (n_in != 24 || ws_size < 255 * MiB) { fprintf(stderr, "kernel_launch: unexpected n_in %d / ws %zu\n", n_in, ws_size); grid = -1; return; }
        hipGetDevice(&dev); hipDeviceGetAttribute(&cus, hipDeviceAttributeMultiprocessorCount, dev);
        if (hipFuncSetAttribute((const void*)mega, hipFuncAttributeMaxDynamicSharedMemorySize, LDS_BYTES) != hipSuccess) { fprintf(stderr, "kernel_launch: hipFuncSetAttribute failed\n"); grid = -1; return; }
        if (hipOccupancyMaxActiveBlocksPerMultiprocessor(&per_cu, (const void*)mega, 512, LDS_BYTES) != hipSuccess || per_cu < 1) { fprintf(stderr, "kernel_launch: occupancy query says %d\n", per_cu); per_cu = 1; }
        (void)hipGetLastError();
        grid = cus;
    }
    if (grid < 0) return;
    if (hipMemsetAsync(d_ws, 0, 32768, stream) != hipSuccess) { fprintf(stderr, "kernel_launch: memset failed\n"); return; }
    Args a{};
    for (int i = 0; i < 24; ++i) a.in[i] = (const float*)d_in[i];
    a.out = (float*)d_out; a.ws = (unsigned char*)d_ws;
#if MK_MULTI
    for (int ph = 0; ph < NPHASE; ++ph) { a.ph_lo = ph; a.ph_hi = ph + 1; hipLaunchKernelGGL(mega, dim3(grid), dim3(512), LDS_BYTES, stream, a); }
#else
    a.ph_lo = 0; a.ph_hi = NPHASE;
    void* args[] = {&a};
    hipError_t e = hipLaunchCooperativeKernel((const void*)mega, dim3(grid), dim3(512), args, LDS_BYTES, stream);
    if (e != hipSuccess) fprintf(stderr, "cooperative launch failed: %s (grid %d)\n", hipGetErrorString(e), grid);
#endif
}
```

```cpp
#include <hip/hip_runtime.h>
#include <hip/hip_cooperative_groups.h>
#include <cstdio>
#include <cstdint>
namespace cg = cooperative_groups;
#ifndef MK_MULTI
#define MK_MULTI 0
#endif
__device__ __forceinline__ int mk_tid() { int t = threadIdx.x; asm volatile("" : "+v"(t)); return t; }
namespace pg8 {
#define PG8_LAS __attribute__((address_space(3)))
typedef unsigned short bf16_t;
typedef short bf16x8 __attribute__((ext_vector_type(8)));
typedef float f32x4 __attribute__((ext_vector_type(4)));
typedef unsigned u32x4 __attribute__((ext_vector_type(4)));
constexpr int BM = 256, BK = 64, HALF = 128, HTB = HALF * BK * 2  , STAGE_BYTES = 8 * HTB, NXCD = 8, WGM = 8;

__host__ __device__ __forceinline__ int lds_byte(int r, int c) { const int st = (r >> 4) * 2 + (c >> 5), rr = r & 15, cc = c & 31, ob = rr * 64 + cc * 2; return st * 1024 + (ob ^ (((ob >> 9) & 1) << 5)); }
__host__ __device__ __forceinline__ void stage_rc(int b, int& R, int& C) { const int st = b / 1024, sb = b % 1024, swz = sb ^ (((sb >> 9) & 1) << 5); R = (st >> 1) * 16 + swz / 64; C = (st & 1) * 32 + (swz % 64) / 2; }
__host__ __device__ __forceinline__ int perm32(int rho) { const int n = rho >> 4, i = rho & 15; return 8 * (i >> 2) + 4 * n + (i & 3); }

struct Unit { int pm, pn, koff; };
struct Gemm { const bf16_t* A; const bf16_t* Bt; int M, N, K; int a_rows; int ldk; };

struct StaticOrder {
    int nM, nN, nwg, G, c;
    __host__ __device__ void init(int M, int N, int G_, int c_) { nM = M / BM; nN = N / BM; nwg = nM * nN; G = G_; c = c_; }
    __host__ __device__ bool next(int i, Unit& u) const {
        const long L = (long)i * G + c; if (L >= nwg) return false;
        int wgid = (int)L; { const int q = nwg / NXCD, r = nwg % NXCD, xcd = wgid % NXCD, off = wgid / NXCD; wgid = (xcd < r ? xcd * (q + 1) : r * (q + 1) + (xcd - r) * q) + off; }
        const int nig = WGM * nN, gid = wgid / nig, fm = gid * WGM, gsz = (nM - fm) < WGM ? (nM - fm) : WGM;
        u.pm = fm + ((wgid % nig) % gsz); u.pn = (wgid % nig) / gsz; u.koff = 0; return true;
    }
    __device__ __forceinline__ void a_ready(const Unit&) const {}
    __device__ __forceinline__ void done(const Unit&) const {}
};

__device__ __forceinline__ unsigned cvt_pk_bf16(float lo, float hi) { unsigned r; asm volatile("v_cvt_pk_bf16_f32 %0, %1, %2" : "=v"(r) : "v"(lo), "v"(hi)); return r; }
typedef float f32x2 __attribute__((ext_vector_type(2)));
__device__ __forceinline__ f32x2 gelu_pk(f32x2 v) {
    const f32x2 av = __builtin_elementwise_abs(v), d = av * 0.2316418882f + 1.0f;
    f32x2 t; t.x = __builtin_amdgcn_rcpf(d.x); t.y = __builtin_amdgcn_rcpf(d.y);
    f32x2 q = t * 0.5307027145f + (-0.7265760135f); q = q * t + 0.7107068705f; q = q * t + (-0.142248368f); q = q * t + 0.127414796f; q = q * t;
    const f32x2 s = (v * v) * (-0.72134752044f);
    f32x2 e; e.x = __builtin_amdgcn_exp2f(s.x); e.y = __builtin_amdgcn_exp2f(s.y);
    const f32x2 m = v * (q * e), r = v - m;
    f32x2 o; o.x = v.x < 0.f ? m.x : r.x; o.y = v.y < 0.f ? m.y : r.y; return o;
}

template <int ACT  > struct EpiBf16 {
    static constexpr bool PERM = true, AFTER_DRAIN = false; static_assert(ACT == 0 || ACT == 1, "EpiBf16: ACT is 0 (none) or 1 (gelu_pk)");
    bf16_t* O; int ldc; const float* bias; int split_cols; size_t split_stride; float scale0;
    __device__ __forceinline__ void operator()(const f32x4 (&acc)[2][2][4][2], const Unit& u, int wr, int wc, int fr, int fq) const {
        const int row0 = u.pm * BM + wr * 64 + fr; int colt = u.pn * BM; bf16_t* base = O;
        float sc = 1.f; if (split_cols) { const int t = colt / split_cols; base += (size_t)t * split_stride; colt -= t * split_cols; if (t == 0) sc = scale0; }
        const int col0 = colt + wc * 32 + 8 * fq, bcol0 = u.pn * BM + wc * 32 + 8 * fq;
        f32x4 bv[2][2];
#pragma unroll
        for (int bj = 0; bj < 2; ++bj)
#pragma unroll
            for (int n = 0; n < 2; ++n) bv[bj][n] = bias ? *(const f32x4*)(bias + bcol0 + bj * HALF + 4 * n) : (f32x4){0.f, 0.f, 0.f, 0.f};
#pragma unroll
        for (int ai = 0; ai < 2; ++ai)
#pragma unroll
            for (int m = 0; m < 4; ++m) { bf16_t* rowp = base + (size_t)(row0 + ai * HALF + m * 16) * ldc + col0;
#pragma unroll
                for (int bj = 0; bj < 2; ++bj) { f32x4 v0 = acc[ai][bj][m][0] + bv[bj][0], v1 = acc[ai][bj][m][1] + bv[bj][1];
                    if (ACT == 1) { f32x2 a = gelu_pk((f32x2){v0[0], v0[1]}), b = gelu_pk((f32x2){v0[2], v0[3]}), c = gelu_pk((f32x2){v1[0], v1[1]}), d = gelu_pk((f32x2){v1[2], v1[3]});
                        v0 = (f32x4){a.x, a.y, b.x, b.y}; v1 = (f32x4){c.x, c.y, d.x, d.y}; }
                    v0 = v0 * sc; v1 = v1 * sc; u32x4 w; w.x = cvt_pk_bf16(v0[0], v0[1]); w.y = cvt_pk_bf16(v0[2], v0[3]); w.z = cvt_pk_bf16(v1[0], v1[1]); w.w = cvt_pk_bf16(v1[2], v1[3]);
                    *(u32x4*)(rowp + bj * HALF) = w; } }
    }
};

template <class Epi, class Sched, bool ALIGN_EPI = false, bool SP2 = false>
__device__ __forceinline__ void gemm_phase(PG8_LAS unsigned char* lds, const Gemm g, const Sched& S, const Epi& E) {
    const int tid = mk_tid(), wid = __builtin_amdgcn_readfirstlane(tid >> 6), lane = tid & 63, wr = wid >> 2, wc = wid & 3, fr = lane & 15, fq = lane >> 4;
    const int K = g.K, nt = K / BK;
    unsigned voffA[2], voffB[2];
#pragma unroll
    for (int i = 0; i < 2; ++i) { int R, C; stage_rc(tid * 16 + i * 8192, R, C); const int Rb = Epi::PERM ? ((R & ~31) + perm32(R & 31)) : R;
        voffA[i] = (unsigned)(R * g.ldk + C) * 2u; voffB[i] = (unsigned)(Rb * g.ldk + C) * 2u; }
    const size_t kstep = (size_t)(BK * 2);
    const size_t hstep = (size_t)HALF * g.ldk * 2;
    const size_t tstep = 2 * hstep;
    const unsigned ldsw = (unsigned)wid * 1024u;
    const int aoff = lds_byte(wr * 64 + fr, fq * 8), boff = lds_byte(wc * 32 + fr, fq * 8);
#define PG8_SA(b, h) (((b) * 2 + (h)) * HTB)
#define PG8_SB(b, h) ((4 + (b) * 2 + (h)) * HTB)
#define PG8_STAGE(bufoff, gbase, voff) do { _Pragma("unroll") for (int _i = 0; _i < 2; ++_i) \
        __builtin_amdgcn_global_load_lds((const unsigned*)((const char*)(gbase) + (voff)[_i]), (PG8_LAS unsigned*)(lds + (bufoff) + ldsw + _i * 8192), 16, 0, 0); } while (0)
#define PG8_LDA(dst, b, h) do { _Pragma("unroll") for (int m = 0; m < 4; ++m) _Pragma("unroll") for (int k = 0; k < 2; ++k) dst[m][k] = *(const PG8_LAS bf16x8*)(lds + PG8_SA(b, h) + aoff + m * 2048 + k * 1024); } while (0)
#define PG8_LDB(dst, b, h) do { _Pragma("unroll") for (int n = 0; n < 2; ++n) _Pragma("unroll") for (int k = 0; k < 2; ++k) dst[n][k] = *(const PG8_LAS bf16x8*)(lds + PG8_SB(b, h) + boff + n * 2048 + k * 1024); } while (0)
#define PG8_MMA(ai, bj, At, Bt) do { __builtin_amdgcn_s_setprio(1); _Pragma("unroll") for (int m = 0; m < 4; ++m) _Pragma("unroll") for (int n = 0; n < 2; ++n) _Pragma("unroll") for (int k = 0; k < 2; ++k) \
        acc[ai][bj][m][n] = __builtin_amdgcn_mfma_f32_16x16x32_bf16(Bt[n][k], At[m][k], acc[ai][bj][m][n], 0, 0, 0); __builtin_amdgcn_s_setprio(0); } while (0)
#define PG8_WAIT_V(n) asm volatile("s_waitcnt vmcnt(" #n ")" ::: "memory")
#define PG8_WAIT_L(n) asm volatile("s_waitcnt lgkmcnt(" #n ")" ::: "memory")
#define PG8_BAR __builtin_amdgcn_s_barrier()
#define PG8_SCHED __builtin_amdgcn_sched_barrier(0)
    Unit cur, nxt; int ui = 0;
    if (!S.next(0, cur)) return;
    f32x4 acc[2][2][4][2];
#pragma unroll
    for (int a = 0; a < 2; ++a)
#pragma unroll
        for (int b = 0; b < 2; ++b)
#pragma unroll
            for (int m = 0; m < 4; ++m)
#pragma unroll
                for (int n = 0; n < 2; ++n) acc[a][b][m][n] = (f32x4){0.f, 0.f, 0.f, 0.f};
    bf16x8 At[4][2], B0[2][2], B1[2][2];
    const size_t atstep = (size_t)g.a_rows * g.ldk * 2; const char* cA = (const char*)g.A + (size_t)cur.pm * atstep + (size_t)cur.koff * 2; const char* cB = (const char*)g.Bt + (size_t)cur.pn * tstep + (size_t)cur.koff * 2;
    S.a_ready(cur);
    if constexpr (SP2) {
        PG8_STAGE(PG8_SB(0, 0), cB, voffB); PG8_STAGE(PG8_SB(0, 1), cB + hstep, voffB); PG8_STAGE(PG8_SA(0, 0), cA, voffA); PG8_STAGE(PG8_SA(0, 1), cA + hstep, voffA);
        if (wr == 1) PG8_BAR;
        PG8_WAIT_V(2); PG8_BAR;
        PG8_STAGE(PG8_SB(1, 0), cB + kstep, voffB); PG8_STAGE(PG8_SA(1, 0), cA + kstep, voffA); PG8_STAGE(PG8_SB(1, 1), cB + hstep + kstep, voffB);
        PG8_WAIT_V(6); PG8_BAR;
    } else {
        PG8_STAGE(PG8_SB(0, 0), cB, voffB); PG8_STAGE(PG8_SA(0, 0), cA, voffA); PG8_STAGE(PG8_SB(0, 1), cB + hstep, voffB); PG8_STAGE(PG8_SA(0, 1), cA + hstep, voffA);
        if (wr == 1) PG8_BAR;
        PG8_WAIT_V(4); PG8_BAR;
        PG8_STAGE(PG8_SB(1, 0), cB + kstep, voffB); PG8_STAGE(PG8_SA(1, 0), cA + kstep, voffA); PG8_STAGE(PG8_SB(1, 1), cB + hstep + kstep, voffB);
        PG8_WAIT_V(6); PG8_BAR;
    }
    for (;;) {
        const bool has_next = S.next(ui + 1, nxt);
        const char* nA = has_next ? (const char*)g.A + (size_t)nxt.pm * atstep + (size_t)nxt.koff * 2 : cA; const char* nB = has_next ? (const char*)g.Bt + (size_t)nxt.pn * tstep + (size_t)nxt.koff * 2 : cB;
        for (int t = 0; t < nt; t += 2) {
            const bool last = (t == nt - 2);
            const char* a1 = cA + (size_t)(t + 1) * kstep;
            const char* a2 = last ? nA : cA + (size_t)(t + 2) * kstep; const char* b2 = last ? nB : cB + (size_t)(t + 2) * kstep;
            const char* a3 = a2 + kstep; const char* b3 = b2 + kstep;
            if (last && has_next) S.a_ready(nxt);
            if constexpr (SP2) {
            PG8_LDB(B0, 0, 0); PG8_LDB(B1, 0, 1); PG8_SCHED; PG8_LDA(At, 0, 0); PG8_STAGE(PG8_SA(1, 1), a1 + hstep, voffA);
            PG8_WAIT_V(8); PG8_WAIT_L(0); PG8_BAR; PG8_MMA(0, 0, At, B0); PG8_MMA(0, 1, At, B1); PG8_BAR; PG8_SCHED;
            PG8_LDA(At, 0, 1); PG8_STAGE(PG8_SB(0, 0), b2, voffB); PG8_STAGE(PG8_SB(0, 1), b2 + hstep, voffB); PG8_STAGE(PG8_SA(0, 0), a2, voffA);
            PG8_WAIT_V(8); PG8_WAIT_L(0); PG8_BAR; PG8_MMA(1, 0, At, B0); PG8_MMA(1, 1, At, B1); PG8_BAR; PG8_SCHED;
            PG8_LDB(B0, 1, 0); PG8_LDB(B1, 1, 1); PG8_SCHED; PG8_LDA(At, 1, 0); PG8_STAGE(PG8_SA(0, 1), a2 + hstep, voffA);
            PG8_WAIT_V(8); PG8_WAIT_L(0); PG8_BAR; PG8_MMA(0, 0, At, B0); PG8_MMA(0, 1, At, B1); PG8_BAR; PG8_SCHED;
            PG8_LDA(At, 1, 1); PG8_STAGE(PG8_SB(1, 0), b3, voffB); PG8_STAGE(PG8_SB(1, 1), b3 + hstep, voffB); PG8_STAGE(PG8_SA(1, 0), a3, voffA);
            PG8_WAIT_V(8); PG8_WAIT_L(0); PG8_BAR; PG8_MMA(1, 0, At, B0); PG8_MMA(1, 1, At, B1); PG8_BAR; PG8_SCHED;
            } else {
            PG8_LDB(B0, 0, 0); PG8_SCHED; PG8_LDA(At, 0, 0); PG8_STAGE(PG8_SA(1, 1), a1 + hstep, voffA);
            PG8_WAIT_L(8); PG8_BAR; PG8_WAIT_L(0); PG8_MMA(0, 0, At, B0); PG8_BAR; PG8_SCHED;
            PG8_LDB(B1, 0, 1); PG8_STAGE(PG8_SB(0, 0), b2, voffB);
            PG8_BAR; PG8_WAIT_L(0); PG8_MMA(0, 1, At, B1); PG8_BAR;
            PG8_LDA(At, 0, 1); PG8_STAGE(PG8_SA(0, 0), a2, voffA);
            PG8_BAR; PG8_WAIT_L(0); PG8_MMA(1, 0, At, B0); PG8_BAR; PG8_SCHED;
            PG8_STAGE(PG8_SB(0, 1), b2 + hstep, voffB);
            PG8_WAIT_V(6); PG8_BAR; PG8_MMA(1, 1, At, B1); PG8_BAR;
            PG8_LDB(B0, 1, 0); PG8_SCHED; PG8_LDA(At, 1, 0); PG8_STAGE(PG8_SA(0, 1), a2 + hstep, voffA);
            PG8_WAIT_L(8); PG8_BAR; PG8_WAIT_L(0); PG8_MMA(0, 0, At, B0); PG8_BAR; PG8_SCHED;
            PG8_LDB(B1, 1, 1); PG8_STAGE(PG8_SB(1, 0), b3, voffB);
            PG8_BAR; PG8_WAIT_L(0); PG8_MMA(0, 1, At, B1); PG8_BAR;
            PG8_LDA(At, 1, 1); PG8_STAGE(PG8_SA(1, 0), a3, voffA);
            PG8_BAR; PG8_WAIT_L(0); PG8_MMA(1, 0, At, B0); PG8_BAR; PG8_SCHED;
            PG8_STAGE(PG8_SB(1, 1), b3 + hstep, voffB);
            PG8_WAIT_V(6); PG8_BAR; PG8_MMA(1, 1, At, B1); PG8_BAR;
            }
        }
        if constexpr (ALIGN_EPI) { if (wr == 0) PG8_BAR; }
        if constexpr (!Epi::AFTER_DRAIN) { const int l2_ = mk_tid() & 63; E(acc, cur, wr, wc, l2_ & 15, l2_ >> 4); S.done(cur); }
        if (!has_next) break;
#pragma unroll
        for (int a = 0; a < 2; ++a)
#pragma unroll
            for (int b = 0; b < 2; ++b)
#pragma unroll
                for (int m = 0; m < 4; ++m)
#pragma unroll
                    for (int n = 0; n < 2; ++n) acc[a][b][m][n] = (f32x4){0.f, 0.f, 0.f, 0.f};
        cur = nxt; cA = nA; cB = nB; ++ui;
        if constexpr (ALIGN_EPI) { if (wr == 1) PG8_BAR; }
    }
    PG8_WAIT_V(0);
    if constexpr (!ALIGN_EPI) { if (wr == 0) PG8_BAR; }
    PG8_BAR;
    if constexpr (Epi::AFTER_DRAIN) { const int l2_ = mk_tid() & 63; E.fused(acc, cur, wr, wc, l2_ & 15, l2_ >> 4, lds, wid, l2_); S.done(cur); }
#undef PG8_SA
#undef PG8_SB
#undef PG8_STAGE
#undef PG8_LDA
#undef PG8_LDB
#undef PG8_MMA
#undef PG8_WAIT_V
#undef PG8_WAIT_L
#undef PG8_BAR
#undef PG8_SCHED
}
}

#include <hip/hip_bf16.h>
#include <cmath>
namespace attn_body {
using bf16=__hip_bfloat16;
using bf16x8=__attribute__((ext_vector_type(8)))short;
using s16x4=__attribute__((ext_vector_type(4)))short;
using f32x16=__attribute__((ext_vector_type(16)))float;
using u32x4=__attribute__((ext_vector_type(4)))unsigned;
constexpr int D=64,QP=512,KVP=128;
constexpr int NW=8,QBLK=32,QB=QBLK*NW,KVBLK=64;
constexpr int ATTN_UNIT_ROWS=QB;
__device__ __forceinline__ int crow(int r,int hi){return (r&3)+8*(r>>2)+4*hi;}
#define SBAR() __builtin_amdgcn_sched_barrier(0)
__device__ __forceinline__ void cmask(f32x16&p0,f32x16&p1,int jb,int qrel,int hi){
  const float NEG=-INFINITY; int kb=64*jb+4*hi;
  #pragma unroll
  for(int r=0;r<16;++r){int kv=kb+(r&3)+8*(r>>2); if(kv>qrel)p0[r]=NEG; if(kv+32>qrel)p1[r]=NEG;}
}

constexpr int NSLOT=3, SLOTB=8192;
constexpr int LDS_K=0, LDS_V=NSLOT*SLOTB, LDS_WS=2*NSLOT*SLOTB, LDS_OST=LDS_WS+NW*64*4, LDS_BYTES=LDS_OST+NW*4096;
constexpr float C2=0.125f*1.4426950408889634f;
__device__ __forceinline__ void glds16(const void*gsrc,unsigned lds_dst){unsigned keep;
  asm volatile("s_mov_b32 %0, m0\n\ts_mov_b32 m0, %2\n\ts_nop 0\n\tglobal_load_lds_dwordx4 %1, off\n\ts_mov_b32 m0, %0":"=&s"(keep):"v"(gsrc),"s"(lds_dst):"memory");}
__device__ __forceinline__ float max3f(float a,float b,float c){float r;asm("v_max3_f32 %0, %1, %2, %3":"=v"(r):"v"(a),"v"(b),"v"(c));return r;}
__device__ __forceinline__ float max2f(float a,float b){float r;asm("v_max_f32_e32 %0, %1, %2":"=v"(r):"v"(a),"v"(b));return r;}
__device__ __forceinline__ float fadd_s(float a,float b){float r;asm("v_add_f32_e32 %0, %1, %2":"=v"(r):"v"(a),"v"(b));return r;}
__device__ __forceinline__ float fsub_s(float a,float b){float r;asm("v_sub_f32_e32 %0, %1, %2":"=v"(r):"v"(a),"v"(b));return r;}
typedef float f32x2_t __attribute__((ext_vector_type(2))); typedef __bf16 bf16x2_t __attribute__((ext_vector_type(2)));
__device__ __forceinline__ unsigned cvtpk_s(float lo,float hi){f32x2_t v={lo,hi};bf16x2_t b=__builtin_convertvector(v,bf16x2_t);return __builtin_bit_cast(unsigned,b);}
#define WAIT_BAR(N) asm volatile("s_waitcnt vmcnt(" #N ") lgkmcnt(0)\n\ts_barrier":::"memory")

__device__ __forceinline__ void qkt(f32x16&p0,f32x16&p1,const char*Kslot,const bf16x8*qr,const f32x16&negm,int r32,int hi){
  const char*kb=Kslot+hi*1024+r32*16;
  #pragma unroll
  for(int d0=0;d0<4;++d0){
    const bf16x8 b0=*reinterpret_cast<const bf16x8*>(kb+d0*2048);
    const bf16x8 b1=*reinterpret_cast<const bf16x8*>(kb+d0*2048+512);
    if(d0==0){p0=__builtin_amdgcn_mfma_f32_32x32x16_bf16(b0,qr[0],negm,0,0,0);p1=__builtin_amdgcn_mfma_f32_32x32x16_bf16(b1,qr[0],negm,0,0,0);}
    else{p0=__builtin_amdgcn_mfma_f32_32x32x16_bf16(b0,qr[d0],p0,0,0,0);p1=__builtin_amdgcn_mfma_f32_32x32x16_bf16(b1,qr[d0],p1,0,0,0);}}
}
typedef __attribute__((address_space(3))) const char* lds_cptr;
typedef short v4i16_t __attribute__((ext_vector_type(4)));
__device__ __forceinline__ void kload8(bf16x8*kf,lds_cptr kp){
  kf[0]=*(const __attribute__((address_space(3))) bf16x8*)(kp);      kf[1]=*(const __attribute__((address_space(3))) bf16x8*)(kp+512);
  kf[2]=*(const __attribute__((address_space(3))) bf16x8*)(kp+2048); kf[3]=*(const __attribute__((address_space(3))) bf16x8*)(kp+2560);
  kf[4]=*(const __attribute__((address_space(3))) bf16x8*)(kp+4096); kf[5]=*(const __attribute__((address_space(3))) bf16x8*)(kp+4608);
  kf[6]=*(const __attribute__((address_space(3))) bf16x8*)(kp+6144); kf[7]=*(const __attribute__((address_space(3))) bf16x8*)(kp+6656);
}
__device__ __forceinline__ void kload2(bf16x8*kf,lds_cptr kp,int j){ kf[2*j]=*(const __attribute__((address_space(3))) bf16x8*)(kp+j*2048); kf[2*j+1]=*(const __attribute__((address_space(3))) bf16x8*)(kp+j*2048+512); }
__device__ __forceinline__ s16x4 vtr(lds_cptr p){ return __builtin_bit_cast(s16x4,__builtin_amdgcn_ds_read_tr16_b64_v4i16((__attribute__((address_space(3))) v4i16_t*)p)); }
__device__ __forceinline__ float rowmax(const f32x16&p0,const f32x16&p1){
  float a=max3f(p0[0],p0[1],p1[0]),b=max3f(p0[2],p0[3],p1[1]);a=max3f(a,p1[2],p1[3]);
  #pragma unroll
  for(int r=4;r<16;r+=4){a=max3f(a,p0[r],p0[r+1]);b=max3f(b,p0[r+2],p0[r+3]);a=max3f(a,p1[r],p1[r+1]);b=max3f(b,p1[r+2],p1[r+3]);}
  const float m=max2f(a,b);
  auto rr=__builtin_amdgcn_permlane32_swap(__float_as_uint(m),__float_as_uint(m),false,false);
  return max2f(__uint_as_float(rr[0]),__uint_as_float(rr[1]));
}
__device__ __forceinline__ void pv(f32x16*o,int vb,bf16x8 pa0,bf16x8 pa1,bf16x8 pa2,bf16x8 pa3){
  #pragma unroll
  for(int d0=0;d0<2;++d0){s16x4 lo[4],hi[4];
    #pragma unroll
    for(int ks=0;ks<4;++ks){
      asm volatile("ds_read_b64_tr_b16 %0,%1 offset:%c2":"=&v"(lo[ks]):"v"(vb),"i"(d0*4096+ks*1024):"memory");
      asm volatile("ds_read_b64_tr_b16 %0,%1 offset:%c2":"=&v"(hi[ks]):"v"(vb),"i"(d0*4096+ks*1024+512):"memory");}
    asm volatile("s_waitcnt lgkmcnt(0)":::"memory");SBAR();
    #define PK(k) (bf16x8){lo[k][0],lo[k][1],lo[k][2],lo[k][3],hi[k][0],hi[k][1],hi[k][2],hi[k][3]}
    o[d0]=__builtin_amdgcn_mfma_f32_32x32x16_bf16(pa0,PK(0),o[d0],0,0,0);
    o[d0]=__builtin_amdgcn_mfma_f32_32x32x16_bf16(pa1,PK(1),o[d0],0,0,0);
    o[d0]=__builtin_amdgcn_mfma_f32_32x32x16_bf16(pa2,PK(2),o[d0],0,0,0);
    o[d0]=__builtin_amdgcn_mfma_f32_32x32x16_bf16(pa3,PK(3),o[d0],0,0,0);
    #undef PK
  }
}

#ifndef ATTN_STORE16
#define ATTN_STORE16(p,v) (*(u32x4*)(p)=(v))
#endif
template<int THRL> __device__ __forceinline__ void attn_unit(const bf16*Qu,const bf16*__restrict__ Kh,const bf16*__restrict__ Vh,bf16*Ou,const int NT,char*shm){
  const int tid=mk_tid(),lane=tid&63,r32=lane&31,hi=lane>>5; const int wid=__builtin_amdgcn_readfirstlane(tid>>6);
  const bf16*Qw=Qu+(long)(wid*QBLK)*QP;
  const unsigned lds0=(unsigned)(uintptr_t)shm;
  float*wsf=(float*)(shm+LDS_WS)+wid*64;
  const bf16*ksrc=Kh+(long)lane*KVP+wid*8;
  const bf16*vsrc=Vh+(long)(16*(wid&3)+(lane>>2))*KVP+(wid>>2)*32+(lane&3)*8;
  const unsigned kdst=lds0+LDS_K+wid*1024, vdst=lds0+LDS_V+wid*1024;
  #define DMA_K(t,slot) glds16(ksrc+(long)(t)*KVBLK*KVP,(unsigned)__builtin_amdgcn_readfirstlane(kdst+(slot)))
  #define DMA_V(t,slot) glds16(vsrc+(long)(t)*KVBLK*KVP,(unsigned)__builtin_amdgcn_readfirstlane(vdst+(slot)))
  const int vb0=(int)(lds0+LDS_V)+((lane>>4)&1)*32+(lane&3)*8+(4*hi+((lane&15)>>2))*64;
  const char*Kbase=shm+LDS_K; bf16x8 kf[8];
  const lds_cptr shm3=(lds_cptr)shm; const lds_cptr kp0=shm3+LDS_K+hi*1024+r32*16; const lds_cptr vp0=shm3+LDS_V+((lane>>4)&1)*32+(lane&3)*8+(4*hi+((lane&15)>>2))*64;
  DMA_K(0,0);DMA_V(0,0);DMA_K(1,SLOTB);
  bf16x8 qr[4];
  #pragma unroll
  for(int d0=0;d0<4;++d0)qr[d0]=*reinterpret_cast<const bf16x8*>(&Qw[(long)r32*QP+d0*16+hi*8]);
  float mhat=0.f,l_reg=0.f;f32x16 o[2];o[0]=f32x16{};o[1]=f32x16{};f32x16 negm=f32x16{};asm volatile("":"+v"(negm));
  #define CMASK(P0,P1,t) do{}while(0)
  bool resc=false;
  #define START(P0,P1) do{ const float rm=rowmax(P0,P1); resc=false; \
    { const float dl=rm; mhat=fadd_s(mhat,dl); \
      _Pragma("unroll") for(int r=0;r<16;++r){P0[r]=fsub_s(P0[r],dl);P1[r]=fsub_s(P1[r],dl);} \
      _Pragma("unroll") for(int r=0;r<16;++r)negm[r]=-mhat; asm volatile("":"+v"(negm)); } \
    _Pragma("unroll") for(int r=0;r<16;++r)P0[r]=__builtin_amdgcn_exp2f(P0[r]); }while(0)
  #define RESC() do{ if(resc){ asm volatile("s_waitcnt lgkmcnt(0)":::"memory"); \
      _Pragma("unroll") for(int d_=0;d_<2;++d_) _Pragma("unroll") for(int r=0;r<16;++r)o[d_][r]*=wsf[crow(r,hi)]; } }while(0)
  f32x16 pA0,pA1,pB0,pB1;
  int sl_prev=0,sl_cur=0,sl_next=SLOTB;
  #define ROT() do{sl_prev=sl_cur;sl_cur=sl_next;sl_next=(sl_next==(NSLOT-1)*SLOTB)?0:sl_next+SLOTB;}while(0)
  DMA_K(2,2*SLOTB);
  WAIT_BAR(3);
  qkt(pA0,pA1,Kbase,qr,negm,r32,hi);asm volatile("s_nop 15\n\ts_nop 7":"+v"(pA0),"+v"(pA1));CMASK(pA0,pA1,0);
  START(pA0,pA1);
  _Pragma("unroll") for(int r=0;r<16;++r)pA1[r]=__builtin_amdgcn_exp2f(pA1[r]);
  WAIT_BAR(0);
  DMA_K(3,0);DMA_V(1,SLOTB);
  ROT();
  kload8(kf,kp0+sl_cur);
  WAIT_BAR(2);
  s16x4 vlo[8],vhi[8]; u32x4 pw0,pw1,pw2,pw3;
  #define PKW(P,B) cvtpk_s(P[B],P[B+1])
  #define PAF(k) __builtin_bit_cast(bf16x8,pw##k)
  #define VFR(i) (bf16x8){vlo[i][0],vlo[i][1],vlo[i][2],vlo[i][3],vhi[i][0],vhi[i][1],vhi[i][2],vhi[i][3]}
  #define PIN(x) asm volatile("":"+v"(x))
  #define MX3(a,b,c) __builtin_fmaxf(__builtin_fmaxf((a),(b)),(c))
  #define GAPA(MF,A0,A1,A2,A3,W0,W1,PW) do{ MF; sacc+=A0; sacc+=A1; sacc+=A2; sacc+=A3; PIN(sacc); W0; W1; PIN(PW); SBAR(); }while(0)
  #define EX(v) __builtin_amdgcn_exp2f(v)
  #define GAPB(MF,X,B) do{ MF; X[B]=EX(X[B]); X[B+1]=EX(X[B+1]); X[B+2]=EX(X[B+2]); X[B+3]=EX(X[B+3]); PIN(X); SBAR(); }while(0)
  #define VRD(i) do{ vlo[i]=vtr(vp_+(((i)>>2)*4096+((i)&3)*1024)); vhi[i]=vtr(vp_+(((i)>>2)*4096+((i)&3)*1024+512)); }while(0)
  #define KRD(G,j) do{ if(G){ kload2(kf,kp0+sl_next,j); SBAR(); } }while(0)
  #define STEP(C0,C1,P0,P1,t,GK,GV,GL) do{ SBAR(); \
    const lds_cptr vp_=vp0+sl_prev; \
    VRD(0); SBAR(); float sacc=(P0[0]+P0[1]); \
    GAPA(C0=__builtin_amdgcn_mfma_f32_32x32x16_bf16(kf[0],qr[0],negm,0,0,0), P0[2],P0[3],P0[4],P0[5],     pw0[0]=PKW(P0,0), pw0[1]=PKW(P0,2), pw0); \
    VRD(4); SBAR(); GAPA(C1=__builtin_amdgcn_mfma_f32_32x32x16_bf16(kf[1],qr[0],negm,0,0,0), P0[6],P0[7],P0[8],P0[9],     pw0[2]=PKW(P0,4), pw0[3]=PKW(P0,6), pw0); \
    VRD(1); SBAR(); GAPA(C0=__builtin_amdgcn_mfma_f32_32x32x16_bf16(kf[2],qr[1],C0,0,0,0),   P0[10],P0[11],P0[12],P0[13], pw1[0]=PKW(P0,8), pw1[1]=PKW(P0,10), pw1); \
    VRD(5); SBAR(); GAPA(C1=__builtin_amdgcn_mfma_f32_32x32x16_bf16(kf[3],qr[1],C1,0,0,0),   P0[14],P0[15],P1[0],P1[1],   pw1[2]=PKW(P0,12),pw1[3]=PKW(P0,14), pw1); \
    VRD(2); SBAR(); GAPA(C0=__builtin_amdgcn_mfma_f32_32x32x16_bf16(kf[4],qr[2],C0,0,0,0),   P1[2],P1[3],P1[4],P1[5],     pw2[0]=PKW(P1,0), pw2[1]=PKW(P1,2), pw2); \
    VRD(6); SBAR(); GAPA(C1=__builtin_amdgcn_mfma_f32_32x32x16_bf16(kf[5],qr[2],C1,0,0,0),   P1[6],P1[7],P1[8],P1[9],     pw2[2]=PKW(P1,4), pw2[3]=PKW(P1,6), pw2); \
    VRD(3); SBAR(); GAPA(C0=__builtin_amdgcn_mfma_f32_32x32x16_bf16(kf[6],qr[3],C0,0,0,0),   P1[10],P1[11],P1[12],P1[13], pw3[0]=PKW(P1,8), pw3[1]=PKW(P1,10), pw3); \
    VRD(7); SBAR(); GAPA(C1=__builtin_amdgcn_mfma_f32_32x32x16_bf16(kf[7],qr[3],C1,0,0,0),   P1[14],P1[15],0.f,0.f,       pw3[2]=PKW(P1,12),pw3[3]=PKW(P1,14), pw3); \
    l_reg+=sacc; \
    if(GK){DMA_K((t)+3,sl_cur);} if(GV){DMA_V((t)+1,sl_next);} \
    CMASK(C0,C1,t); \
    { float a=MX3(C0[0],C0[1],C1[0]),b=MX3(C0[2],C0[3],C1[1]); a=MX3(a,C1[2],C1[3]); \
      _Pragma("unroll") for(int r=4;r<16;r+=4){a=MX3(a,C0[r],C0[r+1]);b=MX3(b,C0[r+2],C0[r+3]);a=MX3(a,C1[r],C1[r+1]);b=MX3(b,C1[r+2],C1[r+3]);} \
      float rm=__builtin_fmaxf(a,b); { auto rr=__builtin_amdgcn_permlane32_swap(__float_as_uint(rm),__float_as_uint(rm),false,false); rm=__builtin_fmaxf(__uint_as_float(rr[0]),__uint_as_float(rr[1])); } \
      resc=false; \
      if(__builtin_expect(__any(rm>(float)THRL),0)){ const float dl=__builtin_fmaxf(rm,0.f); mhat+=dl; \
        _Pragma("unroll") for(int r=0;r<16;++r){C0[r]-=dl;C1[r]-=dl;} \
        _Pragma("unroll") for(int r=0;r<16;++r)negm[r]=-mhat; asm volatile("":"+v"(negm)); \
        const float f=__builtin_amdgcn_exp2f(-dl); l_reg*=f; if(hi==0)wsf[r32]=f; resc=true; } } \
    SBAR(); \
    GAPB(o[0]=__builtin_amdgcn_mfma_f32_32x32x16_bf16(PAF(0),VFR(0),o[0],0,0,0), C0,0); \
    GAPB(o[1]=__builtin_amdgcn_mfma_f32_32x32x16_bf16(PAF(0),VFR(4),o[1],0,0,0), C0,4); \
    KRD(GL,0); GAPB(o[0]=__builtin_amdgcn_mfma_f32_32x32x16_bf16(PAF(1),VFR(1),o[0],0,0,0), C0,8); \
    KRD(GL,1); GAPB(o[1]=__builtin_amdgcn_mfma_f32_32x32x16_bf16(PAF(1),VFR(5),o[1],0,0,0), C0,12); \
    KRD(GL,2); GAPB(o[0]=__builtin_amdgcn_mfma_f32_32x32x16_bf16(PAF(2),VFR(2),o[0],0,0,0), C1,0); \
    KRD(GL,3); GAPB(o[1]=__builtin_amdgcn_mfma_f32_32x32x16_bf16(PAF(2),VFR(6),o[1],0,0,0), C1,4); \
    GAPB(o[0]=__builtin_amdgcn_mfma_f32_32x32x16_bf16(PAF(3),VFR(3),o[0],0,0,0), C1,8); \
    GAPB(o[1]=__builtin_amdgcn_mfma_f32_32x32x16_bf16(PAF(3),VFR(7),o[1],0,0,0), C1,12); \
    }while(0)
  int t=1;
  #undef CMASK
  #define CMASK(P0,P1,t) do{}while(0)
  for(;t+5<NT;t+=2){
    STEP(pB0,pB1,pA0,pA1,t,true,true,true);     WAIT_BAR(2); RESC(); ROT();
    STEP(pA0,pA1,pB0,pB1,t+1,true,true,true);   WAIT_BAR(2); RESC(); ROT();
  }
  #undef CMASK
  #define CMASK(P0,P1,t) do{}while(0)
  #define ENDW(tt) do{ if((tt)+3<NT){WAIT_BAR(2);} else if((tt)+2<NT){WAIT_BAR(1);} else {WAIT_BAR(0);} }while(0)
  for(;t+1<NT;t+=2){
    STEP(pB0,pB1,pA0,pA1,t,(t+3<NT),(t+1<NT),(t+1<NT));       ENDW(t);   RESC(); ROT();
    STEP(pA0,pA1,pB0,pB1,t+1,(t+4<NT),(t+2<NT),(t+2<NT));     ENDW(t+1); RESC(); ROT();
  }
  STEP(pB0,pB1,pA0,pA1,NT-1,false,false,false); RESC();
  { float sacc=pB0[0]+pB0[1]; _Pragma("unroll") for(int r=2;r<16;++r)sacc+=pB0[r]; _Pragma("unroll") for(int r=0;r<16;++r)sacc+=pB1[r]; l_reg+=sacc;
    pw0=(u32x4){PKW(pB0,0),PKW(pB0,2),PKW(pB0,4),PKW(pB0,6)};pw1=(u32x4){PKW(pB0,8),PKW(pB0,10),PKW(pB0,12),PKW(pB0,14)};pw2=(u32x4){PKW(pB1,0),PKW(pB1,2),PKW(pB1,4),PKW(pB1,6)};pw3=(u32x4){PKW(pB1,8),PKW(pB1,10),PKW(pB1,12),PKW(pB1,14)};
    SBAR(); pv(o,vb0+sl_cur,PAF(0),PAF(1),PAF(2),PAF(3)); }
  #undef PKW
  #undef PAF
  #undef VFR
  #undef PIN
  #undef MX3
  #undef GAPA
  #undef GAPB
  #undef EX
  #undef VRD
  #undef KRD
  #undef STEP
  #undef ENDW
  {auto rr=__builtin_amdgcn_permlane32_swap(__float_as_uint(l_reg),__float_as_uint(l_reg),false,false);l_reg=__uint_as_float(rr[0])+__uint_as_float(rr[1]);}
  if(hi==0)wsf[32+r32]=l_reg;asm volatile("s_waitcnt lgkmcnt(0)":::"memory");
  float rli[16];
  #pragma unroll
  for(int r=0;r<16;++r)rli[r]=__builtin_amdgcn_rcpf(wsf[32+crow(r,hi)]);
  bf16*Ow=Ou+(long)(wid*QBLK)*QP;
  { bf16*stg=(bf16*)(shm+LDS_OST)+wid*2048;
    #pragma unroll
    for(int r=0;r<16;++r){const int orow=crow(r,hi);
      #pragma unroll
      for(int d0=0;d0<2;++d0)stg[orow*64+d0*32+r32]=__float2bfloat16(o[d0][r]*rli[r]);}
    asm volatile("s_waitcnt lgkmcnt(0)":::"memory");
    #pragma unroll
    for(int i=0;i<4;++i){const int row=i*8+(lane>>3),ch=lane&7; const u32x4 v=*(const u32x4*)(stg+row*64+ch*8); ATTN_STORE16(Ow+(long)row*QP+ch*8,v);} }
  asm volatile("s_waitcnt lgkmcnt(0)\n\ts_barrier":::"memory");
  #undef DMA_K
  #undef DMA_V
  #undef CMASK
  #undef START
  #undef RESC
  #undef ROT
}
constexpr int ATTN_LDS_BYTES=LDS_BYTES;
#undef SBAR
#undef WAIT_BAR
}

#define LAS __attribute__((address_space(3)))
typedef unsigned short bf16r;
typedef float f4 __attribute__((ext_vector_type(4)));
typedef unsigned u4 __attribute__((ext_vector_type(4)));
typedef unsigned u2 __attribute__((ext_vector_type(2)));
typedef short s8v __attribute__((ext_vector_type(8)));

constexpr int DM = 1024, SEQL = 4096, CTXL = 256, MLAT = 16384, MCTX = 1024, MALL = 17408;
constexpr int DIN = 1792, DFF = 2816, DFF2 = 5632, KVR = 4352, NCH = 68;
constexpr float EPSN = 1e-6f;
constexpr size_t MiB = 1u << 20;
constexpr size_t WS_MOD = 1 * MiB, WS_COS = 2 * MiB, WS_SIN = 2 * MiB + 512 * 1024, WS_GW = 3 * MiB, WS_AGGA = 4 * MiB, WS_AGGB = 6 * MiB, WS_CTXRES = 8 * MiB;
constexpr size_t WS_W = 12 * MiB, W_LAYER = 22 * MiB, W_IN = 0, W_OUT = 3 * MiB + 512 * 1024, W_UP = 5 * MiB + 512 * 1024, W_DOWN = 16 * MiB + 512 * 1024;
constexpr size_t WS_HN = 56 * MiB + 4096;
constexpr size_t WS_Q = 92 * MiB, WS_K = 109 * MiB, WS_V = 114 * MiB, WS_XL = 119 * MiB, WS_GG = 136 * MiB, WS_MIX = 153 * MiB;
constexpr size_t WS_LAB = 187 * MiB;
constexpr size_t WS_O = WS_HN;
constexpr size_t WS_PART = 187 * MiB;
constexpr size_t WS_ACT = 92 * MiB;
constexpr int LDS_BYTES = 147456;
constexpr int NPHASE = 18;
constexpr int L1_TAB_OFF = 84992;
#ifndef PHM
#define PHM 0x3ff
#endif
#define PON(k) ((PHM >> (k)) & 1)

struct Args { const float* in[24]; float* out; unsigned char* ws; int ph_lo, ph_hi; };
typedef const __attribute__((address_space(4))) Args* KA;

#define LDS_WAIT() asm volatile("s_waitcnt lgkmcnt(0)" ::: "memory")
__device__ __forceinline__ unsigned pk2(float lo, float hi) { return attn_body::cvtpk_s(lo, hi); }
__device__ __forceinline__ float bf_lo(unsigned w) { return __builtin_bit_cast(float, w << 16); }
__device__ __forceinline__ float bf_hi(unsigned w) { return __builtin_bit_cast(float, w & 0xffff0000u); }
__device__ __forceinline__ float wave_sum(float v) {
#pragma unroll
    for (int o = 1; o < 64; o <<= 1) v += __shfl_xor(v, o);
    return v;
}
__device__ __forceinline__ float fexp(float x) { return __builtin_amdgcn_exp2f(x * 1.4426950408889634f); }
__device__ __forceinline__ float sigmoidf_(float x) { return __builtin_amdgcn_rcpf(1.f + fexp(-x)); }
__device__ __forceinline__ float gelu_tanh(float x) { const float z = 0.7978845608028654f * (x + 0.044715f * x * x * x); return x * sigmoidf_(2.f * z); }
__device__ __forceinline__ int kvrow(int row) { return row < MLAT ? (row >> 12) * KVR + CTXL + (row & 4095) : ((row - MLAT) >> 8) * KVR + ((row - MLAT) & 255); }

__device__ __forceinline__ int win_dst(int s) {
    if (s < 512) { const int h = s >> 6, d = s & 63; return (h >> 2) * 256 + (d >> 5) * 128 + (h & 3) * 32 + (d & 31); }
    if (s < 768) { const int t = s - 512, hh = t >> 6, d = t & 63; return 512 + (d >> 5) * 128 + hh * 32 + (d & 31); }
    return s;
}
__device__ __forceinline__ int wup_dst(int s) { return s < DFF ? (s >> 7) * 256 + (s & 127) : ((s - DFF) >> 7) * 256 + 128 + ((s - DFF) & 127); }

template <int MODE> __device__ __forceinline__ void p0_transpose_item(const float* W, int K, int N, bf16r* WT, const float* ksA, const float* ksB, LAS float* scr, int item, int lane) {
    const int nblk = N / 32, kb = item / nblk, nb = item % nblk, k0 = 64 * kb, n0 = 32 * nb;
    float tv[32];
#pragma unroll
    for (int i = 0; i < 32; ++i) { const int kk = 2 * i + (lane >> 5); tv[i] = W[(size_t)(k0 + kk) * N + n0 + (lane & 31)]; }
#pragma unroll
    for (int i = 0; i < 32; ++i) { const int kk = 2 * i + (lane >> 5); float v = tv[i];
        if (MODE == 3) { const int k = k0 + kk; v *= (k < 512 ? ksA[k] : ksB[k - 512]); }
        scr[kk * 33 + (lane & 31)] = v; }
    LDS_WAIT();
    const int c = lane & 7;
#pragma unroll
    for (int j = 0; j < 4; ++j) { const int n = (lane >> 3) + 8 * j; const LAS float* s = scr + (8 * c) * 33 + n;
        u4 o; o.x = pk2(s[0 * 33], s[1 * 33]); o.y = pk2(s[2 * 33], s[3 * 33]); o.z = pk2(s[4 * 33], s[5 * 33]); o.w = pk2(s[6 * 33], s[7 * 33]);
        const int sc = n0 + n; const int dst = MODE == 1 ? win_dst(sc) : MODE == 2 ? wup_dst(sc) : sc;
        *(u4*)(WT + (size_t)dst * K + k0 + 8 * c) = o; }
    LDS_WAIT();
}

__device__ __forceinline__ void p0_phase(KA a, LAS unsigned char* lds, int tid, int wid, int lane, int G) {
    unsigned char* ws = a->ws;
    float* MOD = (float*)(ws + WS_MOD);
    {
        LAS float* sc = (LAS float*)lds; LAS float* red = sc + 5 * 1024;
        bool have = false;
        for (int it = blockIdx.x; it < 192; it += G) {
            if (!have) { for (int e = tid; e < 5 * 1024; e += 512) { const int r = e >> 10, k = e & 1023; const float v = r < 4 ? a->in[1][r * 1024 + k] : a->in[3][k]; sc[e] = v * sigmoidf_(v); } have = true; }
            __syncthreads();
            const int l = it / 96, nb = it % 96;
            const float* wp = a->in[4] + (size_t)l * 1024 * 6144 + (size_t)(wid * 128) * 6144 + nb * 64 + lane;
            float acc[5] = {0.f, 0.f, 0.f, 0.f, 0.f};
#pragma unroll 32
            for (int k = 0; k < 128; ++k) { const float wv = wp[(size_t)k * 6144];
#pragma unroll
                for (int r = 0; r < 5; ++r) acc[r] += sc[r * 1024 + wid * 128 + k] * wv; }
#pragma unroll
            for (int r = 0; r < 5; ++r) red[(wid * 5 + r) * 64 + lane] = acc[r];
            __syncthreads();
            if (tid < 320) { const int r = tid >> 6, col = tid & 63; float s = a->in[5][l * 6144 + nb * 64 + col];
#pragma unroll
                for (int w = 0; w < 8; ++w) s += red[(w * 5 + r) * 64 + col];
                MOD[(l * 5 + r) * 6144 + nb * 64 + col] = s; }
        }
        __syncthreads();
    }
    {
        float* cosT = (float*)(ws + WS_COS); float* sinT = (float*)(ws + WS_SIN); bf16r* GW = (bf16r*)(ws + WS_GW);
        const int gt = blockIdx.x * 512 + tid, NT_ = G * 512;
        for (int e = gt; e < 4096 * 32; e += NT_) { const int t = e >> 5, j = e & 31; const float pos = (float)(j < 16 ? (t >> 6) : (t & 63));
            const float inv = powf(10000.0f, -(float)(j & 15) * (1.0f / 16.0f)); const float ang = pos * inv; cosT[e] = cosf(ang); sinT[e] = sinf(ang); }
        for (int e = gt; e < 2 * 2 * 2 * 8 * 64 * 64; e += NT_) {
            const int c = e & 63, d = (e >> 6) & 63, n = (e >> 12) & 7, mat = (e >> 15) & 1, dir = (e >> 16) & 1, l = e >> 17;
            const float* src = mat ? a->in[13] : a->in[11];
            GW[e] = (bf16r)(pk2(src[((((size_t)l * 2 + dir) * 8 + n) * 64 + c) * 64 + d], 0.f) & 0xffffu); }
    }
    {
        LAS float* scr = (LAS float*)lds + wid * (64 * 33 + 16);
        const int gw = blockIdx.x * 8 + wid, NGW = G * 8;
        constexpr int I_IN = 16 * 56, I_OUT = 16 * 32, I_UP = 16 * 176, I_DN = 44 * 32, I_L = I_IN + I_OUT + I_UP + I_DN;
        for (int it = gw; it < 2 * I_L; it += NGW) {
            const int l = it / I_L; int r = it % I_L;
            unsigned char* wl = ws + WS_W + (size_t)l * W_LAYER;
            if (r < I_IN) { p0_transpose_item<1>(a->in[6] + (size_t)l * DM * DIN, DM, DIN, (bf16r*)(wl + W_IN), nullptr, nullptr, scr, r, lane); continue; } r -= I_IN;
            if (r < I_OUT) { p0_transpose_item<3>(a->in[18] + (size_t)l * DM * DM, DM, DM, (bf16r*)(wl + W_OUT), a->in[16] + l * 512, a->in[17] + l * 512, scr, r, lane); continue; } r -= I_OUT;
            if (r < I_UP) { p0_transpose_item<2>(a->in[19] + (size_t)l * DM * DFF2, DM, DFF2, (bf16r*)(wl + W_UP), nullptr, nullptr, scr, r, lane); continue; } r -= I_UP;
            p0_transpose_item<0>(a->in[22] + (size_t)l * DFF * DM, DFF, DM, (bf16r*)(wl + W_DOWN), nullptr, nullptr, scr, r, lane);
        }
    }
}

__device__ __forceinline__ void prenorm_phase(KA a, int l, int which, int nrows, int nsplit, const float* ctx_src, int wid, int lane, int G) {
    const float* MOD = (const float*)(a->ws + WS_MOD); bf16r* HN = (bf16r*)(a->ws + WS_HN);
    float* ctxres = (float*)(a->ws + WS_CTXRES); const float* PART = (const float*)(a->ws + WS_PART);
    const int gw = blockIdx.x * 8 + wid, NGW = G * 8;
    const bool from_in = (l == 0 && which == 0);
    for (int row = gw; row < nrows; row += 2 * NGW) {
        const int row2 = row + NGW; const bool has2 = row2 < nrows; const int r2 = has2 ? row2 : row;
        const float* lat = from_in ? a->in[0] : a->out;
        const float* s0 = row < MLAT ? lat + (size_t)row * DM : ctx_src + (size_t)(row - MLAT) * DM;
        const float* s1 = r2 < MLAT ? lat + (size_t)r2 * DM : ctx_src + (size_t)(r2 - MLAT) * DM;
        const float* md0 = MOD + (l * 5 + (row < MLAT ? (row >> 12) : 4)) * 6144 + (which ? 3 * 1024 : 0);
        const float* md1 = MOD + (l * 5 + (r2 < MLAT ? (r2 >> 12) : 4)) * 6144 + (which ? 3 * 1024 : 0);
        f4 v0[4], v1[4];
#pragma unroll
        for (int j = 0; j < 4; ++j) { v0[j] = *(const f4*)(s0 + 4 * (lane + 64 * j)); v1[j] = *(const f4*)(s1 + 4 * (lane + 64 * j)); }
        if (nsplit > 0) {
            if (row >= MLAT) { const float* pp = PART + (size_t)(row - MLAT) * DM + 4 * lane;
                for (int ks = 0; ks < nsplit; ks += 4) {
                    f4 t_[4][4]; float wk_[4];
#pragma unroll
                    for (int kk = 0; kk < 4; ++kk) { const int k2 = ks + kk < nsplit ? ks + kk : nsplit - 1; wk_[kk] = ks + kk < nsplit ? 1.f : 0.f;
#pragma unroll
                        for (int j = 0; j < 4; ++j) t_[kk][j] = *(const f4*)(pp + (size_t)k2 * MCTX * DM + 256 * j); }
                    __builtin_amdgcn_sched_barrier(0);
#pragma unroll
                    for (int kk = 0; kk < 4; ++kk)
#pragma unroll
                        for (int j = 0; j < 4; ++j) v0[j] += t_[kk][j] * wk_[kk];
                }
#pragma unroll
                for (int j = 0; j < 4; ++j) *(f4*)(ctxres + (size_t)(row - MLAT) * DM + 4 * (lane + 64 * j)) = v0[j]; }
            if (has2 && row2 >= MLAT) { const float* pp = PART + (size_t)(row2 - MLAT) * DM + 4 * lane;
                for (int ks = 0; ks < nsplit; ks += 4) {
                    f4 t_[4][4]; float wk_[4];
#pragma unroll
                    for (int kk = 0; kk < 4; ++kk) { const int k2 = ks + kk < nsplit ? ks + kk : nsplit - 1; wk_[kk] = ks + kk < nsplit ? 1.f : 0.f;
#pragma unroll
                        for (int j = 0; j < 4; ++j) t_[kk][j] = *(const f4*)(pp + (size_t)k2 * MCTX * DM + 256 * j); }
                    __builtin_amdgcn_sched_barrier(0);
#pragma unroll
                    for (int kk = 0; kk < 4; ++kk)
#pragma unroll
                        for (int j = 0; j < 4; ++j) v1[j] += t_[kk][j] * wk_[kk];
                }
#pragma unroll
                for (int j = 0; j < 4; ++j) *(f4*)(ctxres + (size_t)(row2 - MLAT) * DM + 4 * (lane + 64 * j)) = v1[j]; }
        }
        float ss0 = 0.f, ss1 = 0.f;
#pragma unroll
        for (int j = 0; j < 4; ++j) { ss0 += (v0[j].x * v0[j].x + v0[j].y * v0[j].y) + (v0[j].z * v0[j].z + v0[j].w * v0[j].w); ss1 += (v1[j].x * v1[j].x + v1[j].y * v1[j].y) + (v1[j].z * v1[j].z + v1[j].w * v1[j].w); }
#pragma unroll
        for (int o = 1; o < 64; o <<= 1) { ss0 += __shfl_xor(ss0, o); ss1 += __shfl_xor(ss1, o); }
        const float rs0 = rsqrtf(ss0 * (1.f / DM) + EPSN), rs1 = rsqrtf(ss1 * (1.f / DM) + EPSN);
#pragma unroll
        for (int j = 0; j < 4; ++j) { const int col = 4 * (lane + 64 * j);
            { const f4 sh = *(const f4*)(md0 + col), sc = *(const f4*)(md0 + 1024 + col); const f4 h = v0[j] * rs0 * (sc + 1.f) + sh; u2 w; w.x = pk2(h.x, h.y); w.y = pk2(h.z, h.w); *(u2*)(HN + (size_t)row * DM + col) = w; }
            if (has2) { const f4 sh = *(const f4*)(md1 + col), sc = *(const f4*)(md1 + 1024 + col); const f4 h = v1[j] * rs1 * (sc + 1.f) + sh; u2 w; w.x = pk2(h.x, h.y); w.y = pk2(h.z, h.w); *(u2*)(HN + (size_t)row2 * DM + col) = w; } }
    }
}
__device__ __forceinline__ void finalnorm_phase(KA a, int wid, int lane, int G) {
    const float* fw = a->in[23];
    const int gw = blockIdx.x * 8 + wid, NGW = G * 8;
    f4 wv[4];
#pragma unroll
    for (int j = 0; j < 4; ++j) wv[j] = *(const f4*)(fw + 4 * (lane + 64 * j));
    for (int row = gw; row < MLAT; row += 2 * NGW) {
        const int row2 = row + NGW; const bool has2 = row2 < MLAT;
        float* p0 = a->out + (size_t)row * DM; float* p1 = a->out + (size_t)(has2 ? row2 : row) * DM;
        f4 v0[4], v1[4]; float ss0 = 0.f, ss1 = 0.f;
#pragma unroll
        for (int j = 0; j < 4; ++j) { v0[j] = *(const f4*)(p0 + 4 * (lane + 64 * j)); v1[j] = *(const f4*)(p1 + 4 * (lane + 64 * j)); }
#pragma unroll
        for (int j = 0; j < 4; ++j) { ss0 += (v0[j].x * v0[j].x + v0[j].y * v0[j].y) + (v0[j].z * v0[j].z + v0[j].w * v0[j].w); ss1 += (v1[j].x * v1[j].x + v1[j].y * v1[j].y) + (v1[j].z * v1[j].z + v1[j].w * v1[j].w); }
#pragma unroll
        for (int o = 1; o < 64; o <<= 1) { ss0 += __shfl_xor(ss0, o); ss1 += __shfl_xor(ss1, o); }
        const float rs0 = rsqrtf(ss0 * (1.f / DM) + EPSN), rs1 = rsqrtf(ss1 * (1.f / DM) + EPSN);
#pragma unroll
        for (int j = 0; j < 4; ++j) { *(f4*)(p0 + 4 * (lane + 64 * j)) = v0[j] * rs0 * wv[j]; if (has2) *(f4*)(p1 + 4 * (lane + 64 * j)) = v1[j] * rs1 * wv[j]; }
    }
}

struct EpiWin {
    static constexpr bool PERM = true, AFTER_DRAIN = false;
    unsigned char* ws_; const float *qw, *kw;
    __device__ __forceinline__ void operator()(const pg8::f32x4 (&acc)[2][2][4][2], const pg8::Unit& u, int wr, int wc, int fr, int fq) const {
        bf16r* const Q = (bf16r*)(ws_ + WS_Q); bf16r* const Kb = (bf16r*)(ws_ + WS_K); bf16r* const Vb = (bf16r*)(ws_ + WS_V); bf16r* const XL = (bf16r*)(ws_ + WS_XL); bf16r* const GG = (bf16r*)(ws_ + WS_GG);
        const float* const cosT = (const float*)(ws_ + WS_COS); const float* const sinT = (const float*)(ws_ + WS_SIN);
        const int pn = u.pn, row0 = u.pm * 256 + wr * 64 + fr;
        if (pn >= 3) {
            const bool isg = pn >= 5; bf16r* dst = isg ? GG : XL; const int cb = (pn - (isg ? 5 : 3)) * 256 + wc * 32 + 8 * fq;
#pragma unroll
            for (int ai = 0; ai < 2; ++ai)
#pragma unroll
                for (int m = 0; m < 4; ++m) { const int row = row0 + ai * 128 + m * 16;
#pragma unroll
                    for (int bj = 0; bj < 2; ++bj)
#pragma unroll
                        for (int n = 0; n < 2; ++n) { pg8::f32x4 v = acc[ai][bj][m][n];
                            if (isg) { v[0] = gelu_tanh(v[0]); v[1] = gelu_tanh(v[1]); v[2] = gelu_tanh(v[2]); v[3] = gelu_tanh(v[3]); }
                            u2 w; w.x = pk2(v[0], v[1]); w.y = pk2(v[2], v[3]);
                            const int col = cb + bj * 128 + n * 4;
                            if (isg) *(u2*)(dst + (size_t)(row >> 4) * 8192 + (col >> 6) * 1024 + ((col >> 4) & 3) * 256 + (row & 15) * 16 + (col & 15)) = w;
                            else *(u2*)(dst + (size_t)row * 512 + col) = w; } }
            return;
        }
        if (pn == 2 && wc >= 2) {
#pragma unroll
            for (int ai = 0; ai < 2; ++ai)
#pragma unroll
                for (int m = 0; m < 4; ++m) { const int row = row0 + ai * 128 + m * 16; bf16r* base = Vb + (size_t)kvrow(row) * 128 + (wc - 2) * 64 + 8 * fq;
#pragma unroll
                    for (int bj = 0; bj < 2; ++bj)
#pragma unroll
                        for (int n = 0; n < 2; ++n) { const pg8::f32x4 v = acc[ai][bj][m][n]; u2 w; w.x = pk2(v[0], v[1]); w.y = pk2(v[2], v[3]);
                            *(u2*)(base + 32 * bj + 4 * n) = w; } }
            return;
        }
        const bool isk = pn == 2; const float* nw = isk ? kw : qw;
        pg8::f32x4 wv[2][2];
#pragma unroll
        for (int bj = 0; bj < 2; ++bj)
#pragma unroll
            for (int n = 0; n < 2; ++n) wv[bj][n] = *(const pg8::f32x4*)(nw + 32 * bj + 8 * fq + 4 * n);
        const float osc = isk ? 1.f : attn_body::C2;
#pragma unroll
        for (int am = 0; am < 4; ++am) { const int ai = am >> 1, m0 = (am & 1) * 2;
            pg8::f32x4 csv[2][2], snv[2][2];
            const bool lat_ = (row0 + ai * 128) < MLAT;
#pragma unroll
            for (int mm = 0; mm < 2; ++mm) { const int t = (row0 + ai * 128 + (m0 + mm) * 16) & 4095;
#pragma unroll
                for (int n = 0; n < 2; ++n) { csv[mm][n] = *(const pg8::f32x4*)(cosT + t * 32 + 8 * fq + 4 * n); snv[mm][n] = *(const pg8::f32x4*)(sinT + t * 32 + 8 * fq + 4 * n); } }
            __builtin_amdgcn_sched_barrier(0);
#pragma unroll
            for (int mm = 0; mm < 2; ++mm) { const int m = m0 + mm; const int row = row0 + ai * 128 + m * 16;
                float ss = 0.f;
#pragma unroll
                for (int bj = 0; bj < 2; ++bj)
#pragma unroll
                    for (int n = 0; n < 2; ++n) { const pg8::f32x4 v = acc[ai][bj][m][n]; ss += (v[0] * v[0] + v[1] * v[1]) + (v[2] * v[2] + v[3] * v[3]); }
                ss += __shfl_xor(ss, 16); ss += __shfl_xor(ss, 32);
                const float rstd = rsqrtf(ss * (1.f / 64.f) + EPSN) * osc;
                pg8::f32x4 y[2][2];
#pragma unroll
                for (int bj = 0; bj < 2; ++bj)
#pragma unroll
                    for (int n = 0; n < 2; ++n) y[bj][n] = acc[ai][bj][m][n] * rstd * wv[bj][n];
                if (lat_) {
#pragma unroll
                    for (int n = 0; n < 2; ++n) { const pg8::f32x4 cs = csv[mm][n], sn = snv[mm][n];
                        const pg8::f32x4 o0 = y[0][n] * cs - y[1][n] * sn, o1 = y[1][n] * cs + y[0][n] * sn; y[0][n] = o0; y[1][n] = o1; } }
                bf16r* base = isk ? Kb + (size_t)kvrow(row) * 128 + wc * 64 + 8 * fq : Q + (size_t)row * 512 + (4 * pn + wc) * 64 + 8 * fq;
#pragma unroll
                for (int bj = 0; bj < 2; ++bj)
#pragma unroll
                    for (int n = 0; n < 2; ++n) { u2 w; w.x = pk2(y[bj][n][0], y[bj][n][1]); w.y = pk2(y[bj][n][2], y[bj][n][3]); *(u2*)(base + 32 * bj + 4 * n) = w; }
            }
            __builtin_amdgcn_sched_barrier(0);
        }
    }
};
struct EpiRes {
    static constexpr bool PERM = false, AFTER_DRAIN = false;
    const float *base_lat, *base_ctx; float *out_lat, *out_ctx; const float* gate;
    __device__ __forceinline__ void operator()(const pg8::f32x4 (&acc)[2][2][4][2], const pg8::Unit& u, int wr, int wc, int fr, int fq) const {
        const int pm = u.pm; const bool isctx = pm >= 64;
        const float* base = isctx ? base_ctx + (size_t)(pm - 64) * 256 * DM : base_lat + (size_t)pm * 256 * DM;
        float* out = isctx ? out_ctx + (size_t)(pm - 64) * 256 * DM : out_lat + (size_t)pm * 256 * DM;
        const float* gt = gate + (isctx ? 4 : (pm >> 4)) * 6144;
        const int col0 = u.pn * 256 + wc * 32 + 4 * fq;
        pg8::f32x4 gv[2][2];
#pragma unroll
        for (int bj = 0; bj < 2; ++bj)
#pragma unroll
            for (int n = 0; n < 2; ++n) gv[bj][n] = *(const pg8::f32x4*)(gt + col0 + bj * 128 + n * 16);
#pragma unroll
        for (int am = 0; am < 4; ++am) {
            const int ai = am >> 1, m0 = (am & 1) * 2;
            pg8::f32x4 bs[2][2][2];
#pragma unroll
            for (int mm = 0; mm < 2; ++mm) { const size_t ro = (size_t)(ai * 128 + wr * 64 + (m0 + mm) * 16 + fr) * DM + col0;
#pragma unroll
                for (int bj = 0; bj < 2; ++bj)
#pragma unroll
                    for (int n = 0; n < 2; ++n) bs[mm][bj][n] = *(const pg8::f32x4*)(base + ro + bj * 128 + n * 16); }
            __builtin_amdgcn_sched_barrier(0);
#pragma unroll
            for (int mm = 0; mm < 2; ++mm) { const size_t ro = (size_t)(ai * 128 + wr * 64 + (m0 + mm) * 16 + fr) * DM + col0;
#pragma unroll
                for (int bj = 0; bj < 2; ++bj)
#pragma unroll
                    for (int n = 0; n < 2; ++n) *(pg8::f32x4*)(out + ro + bj * 128 + n * 16) = bs[mm][bj][n] + gv[bj][n] * acc[ai][bj][m0 + mm][n]; }
            __builtin_amdgcn_sched_barrier(0);
        }
    }
};
struct EpiUpConv {
    static constexpr bool PERM = true, AFTER_DRAIN = true;
    bf16r* ACT; const float* cw; const float* cb; int mrows;
    __device__ __forceinline__ void fused(pg8::f32x4 (&acc)[2][2][4][2], const pg8::Unit& u, int wr, int wc, int fr, int fq, PG8_LAS unsigned char* lds, int wid, int lane) const {
        constexpr int PITCH = 544;
#pragma unroll
        for (int ai = 0; ai < 2; ++ai)
#pragma unroll
            for (int m = 0; m < 4; ++m) { const int lr = ai * 128 + wr * 64 + m * 16 + fr;
#pragma unroll
                for (int bj = 0; bj < 2; ++bj)
#pragma unroll
                    for (int n = 0; n < 2; ++n) { const pg8::f32x4 v = acc[ai][bj][m][n]; u2 w; w.x = pk2(v[0], v[1]); w.y = pk2(v[2], v[3]);
                        *(PG8_LAS u2*)(lds + lr * PITCH + (bj * 128 + wc * 32 + 8 * fq + 4 * n) * 2) = w; } }
        LDS_WAIT(); __syncthreads();
        const int tid = wid * 64 + lane, cgp = tid & 15, rr = tid >> 4;
        const int ch = u.pn * 128 + 8 * cgp;
        float wg[3][8], wvv[3][8], bg[8], bv[8];
#pragma unroll
        for (int k = 0; k < 3; ++k)
#pragma unroll
            for (int h = 0; h < 2; ++h) { const f4 t0 = *(const f4*)(cw + k * DFF2 + ch + 4 * h), t1 = *(const f4*)(cw + k * DFF2 + DFF + ch + 4 * h);
                wg[k][4 * h] = t0.x; wg[k][4 * h + 1] = t0.y; wg[k][4 * h + 2] = t0.z; wg[k][4 * h + 3] = t0.w; wvv[k][4 * h] = t1.x; wvv[k][4 * h + 1] = t1.y; wvv[k][4 * h + 2] = t1.z; wvv[k][4 * h + 3] = t1.w; }
#pragma unroll
        for (int h = 0; h < 2; ++h) { const f4 t0 = *(const f4*)(cb + ch + 4 * h), t1 = *(const f4*)(cb + DFF + ch + 4 * h);
            bg[4 * h] = t0.x; bg[4 * h + 1] = t0.y; bg[4 * h + 2] = t0.z; bg[4 * h + 3] = t0.w; bv[4 * h] = t1.x; bv[4 * h + 1] = t1.y; bv[4 * h + 2] = t1.z; bv[4 * h + 3] = t1.w; }
        const int row_first = u.pm * 254 - 1, lr0 = 1 + 8 * rr;
        PG8_LAS const unsigned char* up = lds + 16 * cgp;
        u4 pg_ = *(PG8_LAS const u4*)(up + (lr0 - 1) * PITCH), pv_ = *(PG8_LAS const u4*)(up + (lr0 - 1) * PITCH + 256);
        u4 cg_ = *(PG8_LAS const u4*)(up + lr0 * PITCH), cv_ = *(PG8_LAS const u4*)(up + lr0 * PITCH + 256);
#pragma unroll
        for (int i = 0; i < 8; ++i) { const int lr = lr0 + i;
            if (lr <= 254) {
                const u4 ng_ = *(PG8_LAS const u4*)(up + (lr + 1) * PITCH), nv_ = *(PG8_LAS const u4*)(up + (lr + 1) * PITCH + 256);
                const int r = row_first + lr;
                if (r < mrows) {
                    const int p = r < MLAT ? (r & 4095) : ((r - MLAT) & 255), T = r < MLAT ? SEQL : CTXL;
                    const bool hp = p > 0, hn = p < T - 1;
                    const u4 z4 = (u4){0u, 0u, 0u, 0u};
                    const u4 pgm = hp ? pg_ : z4, pvm = hp ? pv_ : z4, ngm = hn ? ng_ : z4, nvm = hn ? nv_ : z4;
                    unsigned ow[4];
#pragma unroll
                    for (int e2 = 0; e2 < 4; ++e2) {
                        float o2[2];
#pragma unroll
                        for (int hh = 0; hh < 2; ++hh) { const int e = 2 * e2 + hh;
                            const float gp = hh ? bf_hi(pgm[e2]) : bf_lo(pgm[e2]), gc = hh ? bf_hi(cg_[e2]) : bf_lo(cg_[e2]), gn = hh ? bf_hi(ngm[e2]) : bf_lo(ngm[e2]);
                            const float vp = hh ? bf_hi(pvm[e2]) : bf_lo(pvm[e2]), vc = hh ? bf_hi(cv_[e2]) : bf_lo(cv_[e2]), vn = hh ? bf_hi(nvm[e2]) : bf_lo(nvm[e2]);
                            const float g = bg[e] + wg[1][e] * gc + wg[0][e] * gp + wg[2][e] * gn;
                            const float v = bv[e] + wvv[1][e] * vc + wvv[0][e] * vp + wvv[2][e] * vn;
                            o2[hh] = g * sigmoidf_(g) * v; }
                        ow[e2] = pk2(o2[0], o2[1]); }
                    u4 o; o.x = ow[0]; o.y = ow[1]; o.z = ow[2]; o.w = ow[3];
                    *(u4*)(ACT + (size_t)r * DFF + ch) = o;
                }
                pg_ = cg_; pv_ = cv_; cg_ = ng_; cv_ = nv_;
            } }
        LDS_WAIT(); __syncthreads();
    }
};
struct SplitOrder { int nsub, S, kslice, G, c;
    __device__ __forceinline__ bool next(int i, pg8::Unit& u) const { const int x = c + i * G; if (x >= nsub) return false; const int ks = x % S, t = x / S; u.pm = 64 + (t >> 2); u.pn = t & 3; u.koff = ks * kslice; return true; }
    __device__ __forceinline__ void a_ready(const pg8::Unit&) const {}
    __device__ __forceinline__ void done(const pg8::Unit&) const {} };
struct EpiPart {
    static constexpr bool PERM = false, AFTER_DRAIN = false;
    float* part; const float* gate; int kslice;
    __device__ __forceinline__ void operator()(const pg8::f32x4 (&acc)[2][2][4][2], const pg8::Unit& u, int wr, int wc, int fr, int fq) const {
        asm volatile("" : "+v"(fr), "+v"(fq));
        float* out = part + ((size_t)(u.koff / kslice) * MCTX + (size_t)(u.pm - 64) * 256) * DM;
        const float* gt = gate + 4 * 6144;
        const int col0 = u.pn * 256 + wc * 32 + 4 * fq;
        pg8::f32x4 gv[2][2];
#pragma unroll
        for (int bj = 0; bj < 2; ++bj)
#pragma unroll
            for (int n = 0; n < 2; ++n) gv[bj][n] = *(const pg8::f32x4*)(gt + col0 + bj * 128 + n * 16);
#pragma unroll
        for (int ai = 0; ai < 2; ++ai)
#pragma unroll
            for (int m = 0; m < 4; ++m) { const size_t ro = (size_t)(ai * 128 + wr * 64 + m * 16 + fr) * DM + col0;
#pragma unroll
                for (int bj = 0; bj < 2; ++bj)
#pragma unroll
                    for (int n = 0; n < 2; ++n) *(pg8::f32x4*)(out + ro + bj * 128 + n * 16) = gv[bj][n] * acc[ai][bj][m][n]; }
    }
};
struct OneUnit { pg8::Unit u;
    __device__ __forceinline__ bool next(int i, pg8::Unit& o) const { if (i) return false; o = u; return true; }
    __device__ __forceinline__ void a_ready(const pg8::Unit&) const {}
    __device__ __forceinline__ void done(const pg8::Unit&) const {} };

#define DPPF(old, src, ctrl) __builtin_bit_cast(float, __builtin_amdgcn_update_dpp(__builtin_bit_cast(int, (float)(old)), __builtin_bit_cast(int, (float)(src)), ctrl, 0xf, 0xf, false))
struct LruCtx { const bf16r* XLp; const bf16r* GWn; LAS const float* tab; LAS float* scr; int p0, T, n, tok, q; };
typedef _Float16 h2v __attribute__((ext_vector_type(2)));
__device__ __forceinline__ unsigned pkh2(float lo, float hi) { return __builtin_bit_cast(unsigned, __builtin_amdgcn_cvt_pkrtz(lo, hi)); }
__device__ __forceinline__ float h2lo(unsigned w) { return (float)__builtin_bit_cast(h2v, w).x; }
__device__ __forceinline__ float h2hi(unsigned w) { return (float)__builtin_bit_cast(h2v, w).y; }
__device__ __forceinline__ void lru_conv_load(const LruCtx& c, int s, u4 (&raw)[8]) {
    const int i = 16 * s + c.tok, p = c.p0 + i;
#pragma unroll
    for (int ks = 0; ks < 2; ++ks)
#pragma unroll
        for (int k = 0; k < 4; ++k) { const int pp = p + k - 2; const bool ok = pp >= 0 && pp < c.T;
            raw[4 * ks + k] = *(const u4*)(c.XLp + (ptrdiff_t)(ok ? i + k - 2 : i) * 512 + 32 * ks + 8 * c.q); }
}
__device__ __forceinline__ void lru_conv(const LruCtx& c, int s, const u4 (&raw)[8], s8v (&frag)[2], f4 (&xc)[4]) {
    const int i = 16 * s + c.tok, p = c.p0 + i;
    float xb[2][8];
#pragma unroll
    for (int ks = 0; ks < 2; ++ks) { const int c0 = 32 * ks + 8 * c.q, chn = 64 * c.n + c0;
#pragma unroll
        for (int h = 0; h < 2; ++h) { const f4 t = *(LAS const f4*)(c.tab + 2048 + chn + 4 * h); xb[ks][4 * h] = t.x; xb[ks][4 * h + 1] = t.y; xb[ks][4 * h + 2] = t.z; xb[ks][4 * h + 3] = t.w; }
#pragma unroll
        for (int k = 0; k < 4; ++k) { const int pp = p + k - 2; const bool ok = pp >= 0 && pp < c.T;
            const u4 rw = raw[4 * ks + k];
#pragma unroll
            for (int h = 0; h < 2; ++h) { f4 w = *(LAS const f4*)(c.tab + k * 512 + chn + 4 * h); if (!ok) w = (f4){0.f, 0.f, 0.f, 0.f};
                xb[ks][4 * h] += w.x * bf_lo(rw[2 * h]); xb[ks][4 * h + 1] += w.y * bf_hi(rw[2 * h]); xb[ks][4 * h + 2] += w.z * bf_lo(rw[2 * h + 1]); xb[ks][4 * h + 3] += w.w * bf_hi(rw[2 * h + 1]); } } }
#pragma unroll
    for (int ks = 0; ks < 2; ++ks) { LAS float* sp = c.scr + c.tok * 68 + 32 * ks + 8 * c.q;
        *(LAS f4*)sp = (f4){xb[ks][0], xb[ks][1], xb[ks][2], xb[ks][3]}; *(LAS f4*)(sp + 4) = (f4){xb[ks][4], xb[ks][5], xb[ks][6], xb[ks][7]};
        u4 w; w.x = pk2(xb[ks][0], xb[ks][1]); w.y = pk2(xb[ks][2], xb[ks][3]); w.z = pk2(xb[ks][4], xb[ks][5]); w.w = pk2(xb[ks][6], xb[ks][7]); frag[ks] = __builtin_bit_cast(s8v, w); }
    LDS_WAIT();
#pragma unroll
    for (int rb = 0; rb < 4; ++rb) xc[rb] = *(LAS const f4*)(c.scr + c.tok * 68 + 16 * rb + 4 * c.q);
    LDS_WAIT();
}
__device__ __forceinline__ void lru_wload(const LruCtx& c, int dir, s8v (&W)[16]) {
    const bf16r* gwa = c.GWn + (size_t)(dir * 2) * 8 * 4096, *gwx = gwa + 8 * 4096;
#pragma unroll
    for (int rb = 0; rb < 4; ++rb)
#pragma unroll
        for (int ks = 0; ks < 2; ++ks) { const int off = (16 * rb + c.tok) * 64 + 32 * ks + 8 * c.q; W[4 * rb + 2 * ks] = *(const s8v*)(gwa + off); W[4 * rb + 2 * ks + 1] = *(const s8v*)(gwx + off); }
}
__device__ __forceinline__ void lru_gates(const LruCtx& c, int dir, const s8v (&W)[16], const s8v (&frag)[2], const f4 (&xc)[4], float (&LA)[16], float (&AV)[16], float (&B)[16]) {
    f4 ga[4], gx[4];
#pragma unroll
    for (int rb = 0; rb < 4; ++rb) { ga[rb] = (f4){0.f, 0.f, 0.f, 0.f}; gx[rb] = (f4){0.f, 0.f, 0.f, 0.f};
#pragma unroll
        for (int ks = 0; ks < 2; ++ks) {
            ga[rb] = __builtin_amdgcn_mfma_f32_16x16x32_bf16(W[4 * rb + 2 * ks], frag[ks], ga[rb], 0, 0, 0);
            gx[rb] = __builtin_amdgcn_mfma_f32_16x16x32_bf16(W[4 * rb + 2 * ks + 1], frag[ks], gx[rb], 0, 0, 0); } }
#pragma unroll
    for (int rb = 0; rb < 4; ++rb) { const int chn = dir * 512 + 64 * c.n + 16 * rb + 4 * c.q;
        const f4 ba = *(LAS const f4*)(c.tab + 2560 + chn), bx = *(LAS const f4*)(c.tab + 3584 + chn), cl = *(LAS const f4*)(c.tab + 4608 + chn);
#pragma unroll
        for (int j = 0; j < 4; ++j) { const float r = sigmoidf_(ga[rb][j] + ba[j]), ii = sigmoidf_(gx[rb][j] + bx[j]);
            const float la = cl[j] * r, z = 1.3862943611198906f * la, av = __builtin_amdgcn_exp2f(la);
            const float om = (z > -0.0078125f) ? -z * (1.f + 0.5f * z) : __builtin_fmaf(-av, av, 1.f);
            LA[4 * rb + j] = la; AV[4 * rb + j] = av; B[4 * rb + j] = __builtin_amdgcn_sqrtf(om) * ii * xc[rb][j]; } }
}
__device__ __forceinline__ void scan_fwd(float (&A)[16], float (&B)[16]) {
#pragma unroll
    for (int k = 0; k < 16; ++k) { float a_ = A[k], b_ = B[k], ap, bp;
        ap = DPPF(1.f, a_, 0x111); bp = DPPF(0.f, b_, 0x111); b_ = a_ * bp + b_; a_ = a_ * ap;
        ap = DPPF(1.f, a_, 0x112); bp = DPPF(0.f, b_, 0x112); b_ = a_ * bp + b_; a_ = a_ * ap;
        ap = DPPF(1.f, a_, 0x114); bp = DPPF(0.f, b_, 0x114); b_ = a_ * bp + b_; a_ = a_ * ap;
        ap = DPPF(1.f, a_, 0x118); bp = DPPF(0.f, b_, 0x118); b_ = a_ * bp + b_; a_ = a_ * ap;
        A[k] = a_; B[k] = b_; }
}
__device__ __forceinline__ void scan_bwd(float (&A)[16], float (&B)[16]) {
#pragma unroll
    for (int k = 0; k < 16; ++k) { float a_ = A[k], b_ = B[k], ap, bp;
        ap = DPPF(1.f, a_, 0x101); bp = DPPF(0.f, b_, 0x101); b_ = a_ * bp + b_; a_ = a_ * ap;
        ap = DPPF(1.f, a_, 0x102); bp = DPPF(0.f, b_, 0x102); b_ = a_ * bp + b_; a_ = a_ * ap;
        ap = DPPF(1.f, a_, 0x104); bp = DPPF(0.f, b_, 0x104); b_ = a_ * bp + b_; a_ = a_ * ap;
        ap = DPPF(1.f, a_, 0x108); bp = DPPF(0.f, b_, 0x108); b_ = a_ * bp + b_; a_ = a_ * ap;
        A[k] = a_; B[k] = b_; }
}
#define DPPZ(src, ctrl) __builtin_bit_cast(float, __builtin_amdgcn_update_dpp(0, __builtin_bit_cast(int, (float)(src)), ctrl, 0xf, 0xf, true))
__device__ __forceinline__ float rowsum_fwd(float x) { x += DPPZ(x, 0x111); x += DPPZ(x, 0x112); x += DPPZ(x, 0x114); x += DPPZ(x, 0x118); return x; }
__device__ __forceinline__ float rowsum_bwd(float x) { x += DPPZ(x, 0x101); x += DPPZ(x, 0x102); x += DPPZ(x, 0x104); x += DPPZ(x, 0x108); return x; }
__device__ __forceinline__ void lru_tables(KA a, int l, LAS float* tab, int tid) {
    for (int e = tid; e < 5632; e += 512) { float v;
        if (e < 2048) v = a->in[9][l * 2048 + e];
        else if (e < 2560) v = a->in[10][l * 512 + (e - 2048)];
        else if (e < 3584) v = a->in[12][l * 1024 + (e - 2560)];
        else if (e < 4608) v = a->in[14][l * 1024 + (e - 3584)];
        else { const float lam = a->in[15][l * 1024 + (e - 4608)]; const float x = fexp(-lam); const float sp = x < 0.03f ? x * (1.f - x * (0.5f - x * (0.33333334f - x * 0.25f))) : (lam < -20.f ? -lam : __builtin_amdgcn_logf(1.f + x) * 0.6931471805599453f); v = -8.f * sp * 1.4426950408889634f; }
        tab[e] = v; }
}
__device__ __forceinline__ void lru_l1_tile(KA a, int l, int b, int cid, int dir, LAS unsigned char* lds, int tid, int wid, int lane) {
    asm volatile("" : "+v"(lane), "+v"(tid));
    unsigned char* ws = a->ws;
    LAS float* tab = (LAS float*)(lds + L1_TAB_OFF); LAS float* scr = (LAS float*)(lds + L1_TAB_OFF + 22528) + wid * (16 * 68);
    LruCtx c; c.n = wid; c.tok = lane & 15; c.q = lane >> 4; c.tab = tab; c.scr = scr;
    const bool isctx = cid < 4; c.p0 = (isctx ? cid : cid - 4) * 64; c.T = isctx ? CTXL : SEQL;
    const int rowbase = isctx ? MLAT + b * CTXL + c.p0 : b * SEQL + c.p0;
    c.XLp = (const bf16r*)(ws + WS_XL) + (size_t)rowbase * 512 + c.n * 64;
    c.GWn = (const bf16r*)(ws + WS_GW) + (size_t)(l * 4) * 8 * 4096 + c.n * 4096;
    float* AGGA = (float*)(ws + WS_AGGA); float* AGGB = (float*)(ws + WS_AGGB);
    unsigned* LAB = (unsigned*)(ws + WS_LAB) + (size_t)(rowbase >> 4) * 8192 + 1024 * c.n + 16 * c.tok + 4 * c.q;
    const int bl = (lane & 48) | 15, bf_ = (lane & 48);
    {
        LAS float* rab = (LAS float*)(lds + L1_TAB_OFF + 22528 + 34816) + wid * 128 + c.q * 32;
#pragma unroll
        for (int k = 0; k < 16; ++k) { rab[2 * k] = 1.f; rab[2 * k + 1] = 0.f; }
        s8v W[16];
        lru_wload(c, dir, W);
        u4 rawc[8];
        lru_conv_load(c, 0, rawc);
#pragma unroll 1
        for (int s = 0; s < 4; ++s) {
            s8v frag[2]; f4 xc[4];
            lru_conv(c, s, rawc, frag, xc);
            __builtin_amdgcn_sched_barrier(0);
            lru_conv_load(c, s < 3 ? s + 1 : 3, rawc);
            __builtin_amdgcn_sched_barrier(0);
            float LAv[16], A[16], B[16];
            lru_gates(c, dir, W, frag, xc, LAv, A, B);
            unsigned* lp = LAB + (size_t)dir * MALL * 512 + (size_t)s * 8192;
#pragma unroll
            for (int rb = 0; rb < 4; ++rb) { u4 w; w.x = pkh2(LAv[4 * rb], B[4 * rb]); w.y = pkh2(LAv[4 * rb + 1], B[4 * rb + 1]); w.z = pkh2(LAv[4 * rb + 2], B[4 * rb + 2]); w.w = pkh2(LAv[4 * rb + 3], B[4 * rb + 3]); *(u4*)(lp + 256 * rb) = w; }
            if (dir == 0) scan_fwd(A, B); else scan_bwd(A, B);
#pragma unroll
            for (int k = 0; k < 16; ++k) {
                const float a_ = __shfl(A[k], dir ? bf_ : bl), b_ = __shfl(B[k], dir ? bf_ : bl);
                const float ra = rab[2 * k], rb_ = rab[2 * k + 1];
                if (dir == 0) { rab[2 * k + 1] = a_ * rb_ + b_; rab[2 * k] = a_ * ra; }
                else { rab[2 * k + 1] = ra * b_ + rb_; rab[2 * k] = ra * a_; } }
            LDS_WAIT();
        }
        if (c.tok == 0) { const size_t o = ((size_t)(b * 2 + dir) * NCH + cid) * 512 + 64 * c.n + 4 * c.q;
#pragma unroll
            for (int rb = 0; rb < 4; ++rb) { *(f4*)(AGGA + o + 16 * rb) = (f4){rab[8 * rb], rab[8 * rb + 2], rab[8 * rb + 4], rab[8 * rb + 6]}; *(f4*)(AGGB + o + 16 * rb) = (f4){rab[8 * rb + 1], rab[8 * rb + 3], rab[8 * rb + 5], rab[8 * rb + 7]}; } }
    }
    LDS_WAIT(); __syncthreads();
}
__device__ __forceinline__ void lru_l2_tile(KA a, int l, int b, int cid, LAS unsigned char* lds, int tid, int wid, int lane) {
    asm volatile("" : "+v"(lane));
    unsigned char* ws = a->ws;
    LAS float* part = (LAS float*)lds;
    LAS float* hfl = (LAS float*)(lds + 4096) + wid * 4096 + lane;
    const int n = wid, tok = lane & 15, q = lane >> 4;
    const bool isctx = cid < 4; const int p0 = (isctx ? cid : cid - 4) * 64;
    const int rowbase = isctx ? MLAT + b * CTXL + p0 : b * SEQL + p0;
    const float* AGGA = (const float*)(ws + WS_AGGA); const float* AGGB = (const float*)(ws + WS_AGGB);
    const unsigned* LAB = (const unsigned*)(ws + WS_LAB) + (size_t)(rowbase >> 4) * 8192 + 1024 * n + 16 * tok + 4 * q;
    const bf16r* GGp = (const bf16r*)(ws + WS_GG) + (size_t)(rowbase >> 4) * 8192 + 1024 * n + 16 * tok + 4 * q;
    const int bl = (lane & 48) | 15, bf_ = (lane & 48);
    float hin[16], hinb[16], A[16], B[16];
#pragma unroll 1
    for (int dir = 0; dir < 2; ++dir) {
        const float* ap_ = AGGA + ((size_t)(b * 2 + dir) * NCH) * 512 + 64 * n + 4 * q; const float* bp_ = AGGB + ((size_t)(b * 2 + dir) * NCH) * 512 + 64 * n + 4 * q;
#pragma unroll
        for (int k = 0; k < 16; ++k) { A[k] = 1.f; B[k] = 0.f; }
#pragma unroll
        for (int eb = 0; eb < 5; eb += 3) {
            f4 avv[3][4], bvv[3][4]; bool okv[3];
#pragma unroll
            for (int e2 = 0; e2 < 3; ++e2) { if (eb + e2 < 5) { const int o = 5 * tok + eb + e2; int ch; bool ok;
                if (dir == 0) { ch = o; ok = o < cid; } else { ch = o < 4 ? 3 - o : 71 - o; ok = isctx ? (o < 4 && ch > cid) : (o < 4 || (o < 68 && ch > cid)); }
                ch = ch < 0 ? 0 : (ch > NCH - 1 ? NCH - 1 : ch); okv[e2] = ok;
#pragma unroll
                for (int rb = 0; rb < 4; ++rb) { avv[e2][rb] = *(const f4*)(ap_ + (size_t)ch * 512 + 16 * rb); bvv[e2][rb] = *(const f4*)(bp_ + (size_t)ch * 512 + 16 * rb); } } }
            __builtin_amdgcn_sched_barrier(0);
#pragma unroll
            for (int e2 = 0; e2 < 3; ++e2) { if (eb + e2 < 5) {
#pragma unroll
                for (int rb = 0; rb < 4; ++rb) { f4 av = avv[e2][rb], bv = bvv[e2][rb];
                    if (!okv[e2]) { av = (f4){1.f, 1.f, 1.f, 1.f}; bv = (f4){0.f, 0.f, 0.f, 0.f}; }
#pragma unroll
                    for (int jj = 0; jj < 4; ++jj) { B[4 * rb + jj] = av[jj] * B[4 * rb + jj] + bv[jj]; A[4 * rb + jj] = av[jj] * A[4 * rb + jj]; } } } }
            __builtin_amdgcn_sched_barrier(0);
        }
        scan_fwd(A, B);
        if (dir == 0) {
#pragma unroll
            for (int k = 0; k < 16; ++k) hin[k] = __shfl(B[k], bl);
        } else {
#pragma unroll
            for (int k = 0; k < 16; ++k) hinb[k] = __shfl(B[k], bl);
        }
    }
    u4 wc_[4], wn_[4]; u2 gc_[4], gn_[4];
#pragma unroll
    for (int rb = 0; rb < 4; ++rb) { wc_[rb] = *(const u4*)(LAB + 256 * rb); gc_[rb] = (u2){0u, 0u}; gn_[rb] = (u2){0u, 0u}; }
#pragma unroll 1
    for (int st = 0; st < 8; ++st) {
        const int s = st < 4 ? st : 7 - st;
        { const int sn = st + 1 < 8 ? st + 1 : 7; const int s2 = sn < 4 ? sn : 7 - sn; const bool bw = sn >= 4;
          const unsigned* lp_ = LAB + (size_t)(bw ? MALL : 0) * 512 + (size_t)s2 * 8192; const bf16r* gp_ = GGp + (size_t)s2 * 8192;
#pragma unroll
          for (int rb = 0; rb < 4; ++rb) { wn_[rb] = *(const u4*)(lp_ + 256 * rb); gn_[rb] = *(const u2*)(gp_ + 256 * rb); } }
        __builtin_amdgcn_sched_barrier(0);
#pragma unroll
        for (int rb = 0; rb < 4; ++rb)
#pragma unroll
            for (int j = 0; j < 4; ++j) { A[4 * rb + j] = h2lo(wc_[rb][j]); B[4 * rb + j] = h2hi(wc_[rb][j]); }
        LAS float* hs = hfl + s * 1024;
        if (st < 4) {
#pragma unroll
            for (int k = 0; k < 16; ++k) { const float L = rowsum_fwd(A[k]); const float P = __builtin_amdgcn_exp2f(L); const float C = rowsum_fwd(B[k] * __builtin_amdgcn_exp2f(-L)); A[k] = P; B[k] = P * C; }
#pragma unroll
            for (int k = 0; k < 16; ++k) { const float h = A[k] * hin[k] + B[k]; hs[k * 64] = h; hin[k] = __shfl(h, bl); }
        } else {
            if (st == 4) {
#pragma unroll
                for (int k = 0; k < 16; ++k) hin[k] = hinb[k]; }
#pragma unroll
            for (int k = 0; k < 16; ++k) { const float L = rowsum_bwd(A[k]); const float P = __builtin_amdgcn_exp2f(L); const float C = rowsum_bwd(B[k] * __builtin_amdgcn_exp2f(-L)); A[k] = P; B[k] = P * C; }
            float sq = 0.f;
#pragma unroll
            for (int rb = 0; rb < 4; ++rb)
#pragma unroll
                for (int j = 0; j < 4; ++j) { const int k = 4 * rb + j; const float h = A[k] * hin[k] + B[k]; hin[k] = __shfl(h, bf_);
                    const float gg = (j & 1) ? bf_hi(gc_[rb][j >> 1]) : bf_lo(gc_[rb][j >> 1]);
                    const float r = (hs[k * 64] + h) * gg; hs[k * 64] = r; sq += r * r; }
            sq += __shfl_xor(sq, 16); sq += __shfl_xor(sq, 32); if (q == 0) part[wid * 64 + 16 * s + tok] = sq;
        }
#pragma unroll
        for (int rb = 0; rb < 4; ++rb) { wc_[rb] = wn_[rb]; gc_[rb] = gn_[rb]; }
    }
    LDS_WAIT(); __syncthreads();
    bf16r* MIX = (bf16r*)(ws + WS_MIX);
#pragma unroll 1
    for (int s = 0; s < 4; ++s) { float t = 0.f;
#pragma unroll
        for (int w = 0; w < 8; ++w) t += part[w * 64 + 16 * s + tok];
        const float rstd = rsqrtf(t * (1.f / 512.f) + EPSN);
        bf16r* mp = MIX + (size_t)(rowbase + 16 * s + tok) * DM + 512 + 64 * n + 4 * q;
        const LAS float* hs = hfl + s * 1024;
#pragma unroll
        for (int rb = 0; rb < 4; ++rb) { u2 w; w.x = pk2(hs[(4 * rb) * 64] * rstd, hs[(4 * rb + 1) * 64] * rstd); w.y = pk2(hs[(4 * rb + 2) * 64] * rstd, hs[(4 * rb + 3) * 64] * rstd); *(u2*)(mp + 16 * rb) = w; } }
    const bf16r* O = (const bf16r*)(ws + WS_O) + (size_t)(rowbase + wid * 8) * 512 + 8 * lane;
    u4 rawc = *(const u4*)O;
#pragma unroll 1
    for (int tt = 0; tt < 8; ++tt) {
        const u4 rawn = *(const u4*)(O + (size_t)(tt < 7 ? tt + 1 : 7) * 512);
        float v[8]; float ss = 0.f;
#pragma unroll
        for (int e = 0; e < 4; ++e) { v[2 * e] = bf_lo(rawc[e]); v[2 * e + 1] = bf_hi(rawc[e]); ss += v[2 * e] * v[2 * e] + v[2 * e + 1] * v[2 * e + 1]; }
        const float rstd = rsqrtf(wave_sum(ss) * (1.f / 512.f) + EPSN);
        u4 o; o.x = pk2(v[0] * rstd, v[1] * rstd); o.y = pk2(v[2] * rstd, v[3] * rstd); o.z = pk2(v[4] * rstd, v[5] * rstd); o.w = pk2(v[6] * rstd, v[7] * rstd);
        *(u4*)(MIX + (size_t)(rowbase + wid * 8 + tt) * DM + 8 * lane) = o;
        rawc = rawn; }
    LDS_WAIT(); __syncthreads();
}

#define GAS __attribute__((address_space(1)))
#define XB_TMO      128
#define XB_XCNT(j)  (256  + 64 * (j))
#define XB_XSUB(j)  (1280 + 64 * (j))
#define XB_XGEN(j)  (2304 + 64 * (j))
#define XB_TOP      3328
#define XB_TOPGEN   3392
#define XCD_BAR_WORDS 3456
#define XB_SPIN_CAP (1u << 18)

__device__ __forceinline__ unsigned xb_ld(unsigned* p)              { return __hip_atomic_load(p, __ATOMIC_RELAXED, __HIP_MEMORY_SCOPE_AGENT); }
__device__ __forceinline__ unsigned xb_add(unsigned* p, unsigned v) { return __hip_atomic_fetch_add(p, v, __ATOMIC_RELAXED, __HIP_MEMORY_SCOPE_AGENT); }
__device__ __forceinline__ unsigned xb_xcc_id() { return (unsigned)__builtin_amdgcn_s_getreg((3 << 11) | 20) & 0xFu; }
#define XB_SPIN(cond, bar) do { unsigned _sp = 0; while (cond) { __builtin_amdgcn_s_sleep(1); \
    if ((++_sp & 255u) == 0u) { if (xb_ld(&(bar)[XB_TMO])) break; if (_sp > XB_SPIN_CAP) { atomicAdd(&(bar)[XB_TMO], 1u); break; } } } } while (0)

struct XcdBarrier {
    unsigned* bar; unsigned x;
    volatile LAS unsigned* st;
};

__device__ __forceinline__ XcdBarrier xcd_barrier_post(unsigned* bar, volatile LAS unsigned* st) {
    XcdBarrier b; b.bar = bar; b.x = xb_xcc_id(); b.st = st;
    if (threadIdx.x == 0) (void)xb_add(&bar[XB_XCNT(b.x)], 1u);
    return b;
}
__device__ __forceinline__ void xcd_barrier_complete(unsigned* bar, unsigned x, unsigned& nloc, unsigned& nx) {
    const unsigned G = gridDim.x * gridDim.y * gridDim.z;
    unsigned sum, cnt, mine, sp = 0u;
    for (;;) {
        sum = 0u; cnt = 0u; mine = 0u;
#pragma unroll
        for (unsigned j = 0; j < 16; ++j) { const unsigned c = xb_ld(&bar[XB_XCNT(j)]); sum += c; cnt += (c > 0u) ? 1u : 0u; mine = (j == x) ? c : mine; }
        if (sum == G) break;
        __builtin_amdgcn_s_sleep(1);
        if ((++sp & 255u) == 0u) { if (xb_ld(&bar[XB_TMO])) break; if (sp > XB_SPIN_CAP) { atomicAdd(&bar[XB_TMO], 1u); break; } }
    }
    nloc = mine > 0u ? mine : 1u; nx = cnt > 0u ? cnt : 1u;
}

__device__ __forceinline__ void xcd_barrier(const XcdBarrier& b) {
    asm volatile("s_waitcnt vmcnt(0)" ::: "memory");
    __syncthreads();
    if (threadIdx.x == 0) {
        unsigned* bar = b.bar;
        __builtin_amdgcn_s_waitcnt(0);
        unsigned nloc = b.st[0], nx = b.st[1];
        if (nloc == 0u) { xcd_barrier_complete(bar, b.x, nloc, nx); b.st[0] = nloc; b.st[1] = nx; }
        const unsigned old = xb_add(&bar[XB_XSUB(b.x)], 1u);
        const unsigned gen = old / nloc;
        if (old + 1u == (gen + 1u) * nloc) {
            __builtin_amdgcn_fence(__ATOMIC_RELEASE, "agent");
            asm volatile("s_waitcnt vmcnt(0)" ::: "memory");
            const unsigned og = xb_add(&bar[XB_TOP], 1u);
            const unsigned tg = og / nx;
            if (og + 1u == (tg + 1u) * nx) xb_add(&bar[XB_TOPGEN], 1u);
            else XB_SPIN(xb_ld(&bar[XB_TOPGEN]) == tg, bar);
            __builtin_amdgcn_fence(__ATOMIC_ACQUIRE, "agent");
            xb_add(&bar[XB_XGEN(b.x)], 1u);
            asm volatile("s_waitcnt vmcnt(0)" ::: "memory");
        } else {
            XB_SPIN(xb_ld(&bar[XB_XGEN(b.x)]) == gen, bar);
            __builtin_amdgcn_fence(__ATOMIC_ACQUIRE, "agent");
            asm volatile("s_waitcnt vmcnt(0)" ::: "memory");
        }
    }
    __syncthreads();
}

#ifndef REP_PH
#define REP_PH -1
#endif
#ifndef REP_SKIP_L1
#define REP_SKIP_L1 0
#endif
#ifndef USE_XBAR
#define USE_XBAR 1
#endif
__global__ void __launch_bounds__(512, 2) mega(Args a_) {
    extern __shared__ __attribute__((aligned(16))) unsigned char lds_raw[];
    LAS unsigned char* lds = (LAS unsigned char*)lds_raw;
    const int G = gridDim.x, bx = blockIdx.x;
    const int vcu = (G % 8 == 0) ? (bx % 8) * (G / 8) + bx / 8 : bx;
    KA a = (KA)__builtin_amdgcn_kernarg_segment_ptr();
    volatile LAS unsigned* bst = (volatile LAS unsigned*)(lds + LDS_BYTES - 64);
    if (threadIdx.x < 2) bst[threadIdx.x] = 0u;
    __syncthreads();
    (void)xcd_barrier_post((unsigned*)a->ws, bst);
    int nsync = 0;
#define GRID_SYNC() do { if (!USE_XBAR || a->ph_lo < 0) cg::this_grid().sync();     else { XcdBarrier xb_; xb_.bar = (unsigned*)a->ws; xb_.x = xb_xcc_id(); xb_.st = (volatile LAS unsigned*)(lds + LDS_BYTES - 64); xcd_barrier(xb_); } ++nsync; } while (0)
    const int ph_hi = a->ph_hi;
    for (int ph = a->ph_lo; ph < ph_hi; ++ph) {
        asm volatile("" : "+s"(a));
        for (int rep = 0; rep < (ph == REP_PH ? 2 : 1); ++rep) {
        if (rep) GRID_SYNC();
#define TL const int tid = mk_tid(), lane = tid & 63, wid = __builtin_amdgcn_readfirstlane(tid >> 6); (void)tid; (void)lane; (void)wid
        unsigned char* ws = a->ws;
        float* MOD = (float*)(ws + WS_MOD); float* ctxres = (float*)(ws + WS_CTXRES);
        bf16r* HN = (bf16r*)(ws + WS_HN);
        if (ph == 0) { if (PON(8)) { TL; p0_phase(a, lds, tid, wid, lane, G); } }
        else if (ph == NPHASE - 1) { if (PON(9)) { TL; finalnorm_phase(a, wid, lane, G); } }
        else {
            const int l = (ph - 1) >> 3, sub = (ph - 1) & 7;
            unsigned char* wl = ws + WS_W + (size_t)l * W_LAYER;
            const bool ctx_out = l == 0;
            if (sub == 0) { if (PON(0)) { TL; prenorm_phase(a, l, 0, MALL, l == 0 ? 0 : 11, l == 0 ? a->in[2] : ctxres, wid, lane, G); } }
            else if (sub == 1) { if (PON(1)) {
                pg8::Gemm g{HN, (const bf16r*)(wl + W_IN), MALL, DIN, DM, 256, DM}; pg8::StaticOrder S; S.init(MALL, DIN, G, bx);
                EpiWin E{ws, a->in[7] + l * 64, a->in[8] + l * 64};
                pg8::gemm_phase<EpiWin, pg8::StaticOrder, true, true>(lds, g, S, E); }
            } else if (sub == 2) { if (PON(2)) { TL;
                const int nctx = ctx_out ? 4 : 0, cnt = 64 + nctx + ((rep && REP_SKIP_L1) ? 0 : 68);
                attn_body::bf16* Qb = (attn_body::bf16*)(ws + WS_Q); attn_body::bf16* Ob = (attn_body::bf16*)(ws + WS_O); const attn_body::bf16* Kb = (const attn_body::bf16*)(ws + WS_K); const attn_body::bf16* Vb = (const attn_body::bf16*)(ws + WS_V);
                LAS unsigned char* l3 = lds; asm volatile("" : "+s"(l3)); char* shm = (char*)l3;
                volatile LAS int* qw = (volatile LAS int*)(lds + LDS_BYTES - 32);
                unsigned* qctr = (unsigned*)ws + 3584 + (l * 2 + rep) * 8 * 64;
                const int hx = (int)(xb_xcc_id() & 7u);
                lru_tables(a, l, (LAS float*)(lds + L1_TAB_OFF), tid); __syncthreads();
                for (int li = 0; li < 8; ++li) { const int x = (hx + li) & 7; const int b = x >> 1, kvh = x & 1;
                    for (;;) {
                        __syncthreads();
                        if (tid == 0) *qw = (int)__hip_atomic_fetch_add(qctr + x * 64, 1u, __ATOMIC_RELAXED, __HIP_MEMORY_SCOPE_AGENT);
                        __syncthreads();
                        const int i = __builtin_amdgcn_readfirstlane(*qw);
                        if (i >= cnt) break;
                        if (i < 64 + nctx) {
                            const bool lat = i < 64; const int h = kvh * 4 + (lat ? (i >> 4) : (i - 64));
                            const size_t qo = (size_t)(lat ? b * SEQL + (i & 15) * 256 : MLAT + b * CTXL) * 512 + h * 64;
                            attn_body::attn_unit<8>(Qb + qo, Kb + (size_t)b * KVR * 128 + kvh * 64, Vb + (size_t)b * KVR * 128 + kvh * 64, Ob + qo, lat ? NCH : 4, shm);
                        } else { const int it = i - 64 - nctx, t = x * 34 + (it >> 1); lru_l1_tile(a, l, t / NCH, t % NCH, it & 1, lds, tid, wid, lane); }
                    }
                } }
            } else if (sub == 3) { if (PON(3)) { TL;
                const int nt = ctx_out ? 4 * NCH : 4 * 64;
                for (int t = vcu; t < nt; t += G) { int b, cid; if (ctx_out) { b = t / NCH; cid = t % NCH; } else { b = t >> 6; cid = 4 + (t & 63); }
                    lru_l2_tile(a, l, b, cid, lds, tid, wid, lane); } }
            } else if (sub == 4) { if (PON(4)) {
                { pg8::Gemm g{(const bf16r*)(ws + WS_MIX), (const bf16r*)(wl + W_OUT), MLAT, DM, DM, 256, DM}; pg8::StaticOrder S; S.init(MLAT, DM, G, bx);
                  EpiRes E{l == 0 ? a->in[0] : a->out, l == 0 ? a->in[2] : ctxres, a->out, ctxres, MOD + l * 5 * 6144 + 2 * 1024};
                  pg8::gemm_phase<EpiRes, pg8::StaticOrder, true, true>(lds, g, S, E); }
                if (ctx_out) {
                    pg8::Gemm g{(const bf16r*)(ws + WS_MIX), (const bf16r*)(wl + W_OUT), MALL, DM, 256, 256, DM}; SplitOrder S{64, 4, 256, G, bx};
                    EpiPart E{(float*)(ws + WS_PART), MOD + l * 5 * 6144 + 2 * 1024, 256};
                    pg8::gemm_phase<EpiPart, SplitOrder, true, true>(lds, g, S, E); } }
            } else if (sub == 5) { if (PON(5)) { TL; prenorm_phase(a, l, 1, ctx_out ? MALL : MLAT, ctx_out ? 4 : 0, ctx_out ? a->in[2] : ctxres, wid, lane, G); } }
            else if (sub == 6) { if (PON(6)) {
                const int mrows = ctx_out ? MALL : MLAT, nM = (mrows + 253) / 254;
                pg8::Gemm g{HN - DM, (const bf16r*)(wl + W_UP), nM * 256, DFF2, DM, 254, DM}; pg8::StaticOrder S; S.init(nM * 256, DFF2, G, bx);
                EpiUpConv E{(bf16r*)(ws + WS_ACT), a->in[20] + (size_t)l * 3 * DFF2, a->in[21] + (size_t)l * DFF2, mrows};
                for (int i = 0;; ++i) { pg8::Unit u; if (!S.next(i, u)) break; OneUnit S1{u}; pg8::gemm_phase<EpiUpConv, OneUnit, false, true>(lds, g, S1, E); } }
            } else { if (PON(7)) {
                { pg8::Gemm g{(const bf16r*)(ws + WS_ACT), (const bf16r*)(wl + W_DOWN), MLAT, DM, DFF, 256, DFF}; pg8::StaticOrder S; S.init(MLAT, DM, G, bx);
                  EpiRes E{a->out, ctxres, a->out, ctxres, MOD + l * 5 * 6144 + 5 * 1024};
                  pg8::gemm_phase<EpiRes, pg8::StaticOrder, true, true>(lds, g, S, E); }
                if (ctx_out) {
                    pg8::Gemm g{(const bf16r*)(ws + WS_ACT), (const bf16r*)(wl + W_DOWN), MALL, DM, 256, 256, DFF}; SplitOrder S{176, 11, 256, G, bx};
                    EpiPart E{(float*)(ws + WS_PART), MOD + l * 5 * 6144 + 5 * 1024, 256};
                    pg8::gemm_phase<EpiPart, SplitOrder, true, true>(lds, g, S, E); } }
            }
        }
        }
        if (ph + 1 < ph_hi) GRID_SYNC();
    }
}

extern "C" void kernel_launch(void* const* d_in, const int* in_sizes, int n_in, void* d_out, int out_size, void* d_ws, size_t ws_size, hipStream_t stream) {
    static int grid = 0;
    if (grid == 0) {
        int dev = 0, cus = 0, per_cu = 0;
        if (n_in != 24 || ws_size < 255 * MiB) { fprintf(stderr, "kernel_launch: unexpected n_in %d / ws %zu\n", n_in, ws_size); grid = -1; return; }
        hipGetDevice(&dev); hipDeviceGetAttribute(&cus, hipDeviceAttributeMultiprocessorCount, dev);
        if (hipFuncSetAttribute((const void*)mega, hipFuncAttributeMaxDynamicSharedMemorySize, LDS_BYTES) != hipSuccess) { fprintf(stderr, "kernel_launch: hipFuncSetAttribute failed\n"); grid = -1; return; }
        if (hipOccupancyMaxActiveBlocksPerMultiprocessor(&per_cu, (const void*)mega, 512, LDS_BYTES) != hipSuccess || per_cu < 1) { fprintf(stderr, "kernel_launch: occupancy query says %d\n", per_cu); per_cu = 1; }
        (void)hipGetLastError();
        grid = cus;
    }
    if (grid < 0) return;
    if (hipMemsetAsync(d_ws, 0, 32768, stream) != hipSuccess) { fprintf(stderr, "kernel_launch: memset failed\n"); return; }
    Args a{};
    for (int i = 0; i < 24; ++i) a.in[i] = (const float*)d_in[i];
    a.out = (float*)d_out; a.ws = (unsigned char*)d_ws;
#if MK_MULTI
    for (int ph = 0; ph < NPHASE; ++ph) { a.ph_lo = ph; a.ph_hi = ph + 1; hipLaunchKernelGGL(mega, dim3(grid), dim3(512), LDS_BYTES, stream, a); }
#else
    a.ph_lo = 0; a.ph_hi = NPHASE;
    void* args[] = {&a};
    hipError_t e = hipLaunchCooperativeKernel((const void*)mega, dim3(grid), dim3(512), args, LDS_BYTES, stream);
    if (e != hipSuccess) fprintf(stderr, "cooperative launch failed: %s (grid %d)\n", hipGetErrorString(e), grid);
#endif
}
```

```cpp
#include <hip/hip_runtime.h>
#include <hip/hip_cooperative_groups.h>
#include <cstdio>
#include <cstdint>
namespace cg = cooperative_groups;
#ifndef MK_MULTI
#define MK_MULTI 0
#endif
__device__ __forceinline__ int mk_tid() { int t = threadIdx.x; asm volatile("" : "+v"(t)); return t; }
namespace pg8 {
#define PG8_LAS __attribute__((address_space(3)))
typedef unsigned short bf16_t;
typedef short bf16x8 __attribute__((ext_vector_type(8)));
typedef float f32x4 __attribute__((ext_vector_type(4)));
typedef unsigned u32x4 __attribute__((ext_vector_type(4)));
constexpr int BM = 256, BK = 64, HALF = 128, HTB = HALF * BK * 2  , STAGE_BYTES = 8 * HTB, NXCD = 8, WGM = 8;

__host__ __device__ __forceinline__ int lds_byte(int r, int c) { const int st = (r >> 4) * 2 + (c >> 5), rr = r & 15, cc = c & 31, ob = rr * 64 + cc * 2; return st * 1024 + (ob ^ (((ob >> 9) & 1) << 5)); }
__host__ __device__ __forceinline__ void stage_rc(int b, int& R, int& C) { const int st = b / 1024, sb = b % 1024, swz = sb ^ (((sb >> 9) & 1) << 5); R = (st >> 1) * 16 + swz / 64; C = (st & 1) * 32 + (swz % 64) / 2; }
__host__ __device__ __forceinline__ int perm32(int rho) { const int n = rho >> 4, i = rho & 15; return 8 * (i >> 2) + 4 * n + (i & 3); }

struct Unit { int pm, pn, koff; };
struct Gemm { const bf16_t* A; const bf16_t* Bt; int M, N, K; int a_rows; int ldk; };

struct StaticOrder {
    int nM, nN, nwg, G, c;
    __host__ __device__ void init(int M, int N, int G_, int c_) { nM = M / BM; nN = N / BM; nwg = nM * nN; G = G_; c = c_; }
    __host__ __device__ bool next(int i, Unit& u) const {
        const long L = (long)i * G + c; if (L >= nwg) return false;
        int wgid = (int)L; { const int q = nwg / NXCD, r = nwg % NXCD, xcd = wgid % NXCD, off = wgid / NXCD; wgid = (xcd < r ? xcd * (q + 1) : r * (q + 1) + (xcd - r) * q) + off; }
        const int nig = WGM * nN, gid = wgid / nig, fm = gid * WGM, gsz = (nM - fm) < WGM ? (nM - fm) : WGM;
        u.pm = fm + ((wgid % nig) % gsz); u.pn = (wgid % nig) / gsz; u.koff = 0; return true;
    }
    __device__ __forceinline__ void a_ready(const Unit&) const {}
    __device__ __forceinline__ void done(const Unit&) const {}
};

__device__ __forceinline__ unsigned cvt_pk_bf16(float lo, float hi) { unsigned r; asm volatile("v_cvt_pk_bf16_f32 %0, %1, %2" : "=v"(r) : "v"(lo), "v"(hi)); return r; }
typedef float f32x2 __attribute__((ext_vector_type(2)));
__device__ __forceinline__ f32x2 gelu_pk(f32x2 v) {
    const f32x2 av = __builtin_elementwise_abs(v), d = av * 0.2316418882f + 1.0f;
    f32x2 t; t.x = __builtin_amdgcn_rcpf(d.x); t.y = __builtin_amdgcn_rcpf(d.y);
    f32x2 q = t * 0.5307027145f + (-0.7265760135f); q = q * t + 0.7107068705f; q = q * t + (-0.142248368f); q = q * t + 0.127414796f; q = q * t;
    const f32x2 s = (v * v) * (-0.72134752044f);
    f32x2 e; e.x = __builtin_amdgcn_exp2f(s.x); e.y = __builtin_amdgcn_exp2f(s.y);
    const f32x2 m = v * (q * e), r = v - m;
    f32x2 o; o.x = v.x < 0.f ? m.x : r.x; o.y = v.y < 0.f ? m.y : r.y; return o;
}

template <int ACT  > struct EpiBf16 {
    static constexpr bool PERM = true, AFTER_DRAIN = false; static_assert(ACT == 0 || ACT == 1, "EpiBf16: ACT is 0 (none) or 1 (gelu_pk)");
    bf16_t* O; int ldc; const float* bias; int split_cols; size_t split_stride; float scale0;
    __device__ __forceinline__ void operator()(const f32x4 (&acc)[2][2][4][2], const Unit& u, int wr, int wc, int fr, int fq) const {
        const int row0 = u.pm * BM + wr * 64 + fr; int colt = u.pn * BM; bf16_t* base = O;
        float sc = 1.f; if (split_cols) { const int t = colt / split_cols; base += (size_t)t * split_stride; colt -= t * split_cols; if (t == 0) sc = scale0; }
        const int col0 = colt + wc * 32 + 8 * fq, bcol0 = u.pn * BM + wc * 32 + 8 * fq;
        f32x4 bv[2][2];
#pragma unroll
        for (int bj = 0; bj < 2; ++bj)
#pragma unroll
            for (int n = 0; n < 2; ++n) bv[bj][n] = bias ? *(const f32x4*)(bias + bcol0 + bj * HALF + 4 * n) : (f32x4){0.f, 0.f, 0.f, 0.f};
#pragma unroll
        for (int ai = 0; ai < 2; ++ai)
#pragma unroll
            for (int m = 0; m < 4; ++m) { bf16_t* rowp = base + (size_t)(row0 + ai * HALF + m * 16) * ldc + col0;
#pragma unroll
                for (int bj = 0; bj < 2; ++bj) { f32x4 v0 = acc[ai][bj][m][0] + bv[bj][0], v1 = acc[ai][bj][m][1] + bv[bj][1];
                    if (ACT == 1) { f32x2 a = gelu_pk((f32x2){v0[0], v0[1]}), b = gelu_pk((f32x2){v0[2], v0[3]}), c = gelu_pk((f32x2){v1[0], v1[1]}), d = gelu_pk((f32x2){v1[2], v1[3]});
                        v0 = (f32x4){a.x, a.y, b.x, b.y}; v1 = (f32x4){c.x, c.y, d.x, d.y}; }
                    v0 = v0 * sc; v1 = v1 * sc; u32x4 w; w.x = cvt_pk_bf16(v0[0], v0[1]); w.y = cvt_pk_bf16(v0[2], v0[3]); w.z = cvt_pk_bf16(v1[0], v1[1]); w.w = cvt_pk_bf16(v1[2], v1[3]);
                    *(u32x4*)(rowp + bj * HALF) = w; } }
    }
};

template <class Epi, class Sched, bool ALIGN_EPI = false, bool SP2 = false>
__device__ __forceinline__ void gemm_phase(PG8_LAS unsigned char* lds, const Gemm g, const Sched& S, const Epi& E) {
    const int tid = mk_tid(), wid = __builtin_amdgcn_readfirstlane(tid >> 6), lane = tid & 63, wr = wid >> 2, wc = wid & 3, fr = lane & 15, fq = lane >> 4;
    const int K = g.K, nt = K / BK;
    unsigned voffA[2], voffB[2];
#pragma unroll
    for (int i = 0; i < 2; ++i) { int R, C; stage_rc(tid * 16 + i * 8192, R, C); const int Rb = Epi::PERM ? ((R & ~31) + perm32(R & 31)) : R;
        voffA[i] = (unsigned)(R * g.ldk + C) * 2u; voffB[i] = (unsigned)(Rb * g.ldk + C) * 2u; }
    const size_t kstep = (size_t)(BK * 2);
    const size_t hstep = (size_t)HALF * g.ldk * 2;
    const size_t tstep = 2 * hstep;
    const unsigned ldsw = (unsigned)wid * 1024u;
    const int aoff = lds_byte(wr * 64 + fr, fq * 8), boff = lds_byte(wc * 32 + fr, fq * 8);
#define PG8_SA(b, h) (((b) * 2 + (h)) * HTB)
#define PG8_SB(b, h) ((4 + (b) * 2 + (h)) * HTB)
#define PG8_STAGE(bufoff, gbase, voff) do { _Pragma("unroll") for (int _i = 0; _i < 2; ++_i) \
        __builtin_amdgcn_global_load_lds((const unsigned*)((const char*)(gbase) + (voff)[_i]), (PG8_LAS unsigned*)(lds + (bufoff) + ldsw + _i * 8192), 16, 0, 0); } while (0)
#define PG8_LDA(dst, b, h) do { _Pragma("unroll") for (int m = 0; m < 4; ++m) _Pragma("unroll") for (int k = 0; k < 2; ++k) dst[m][k] = *(const PG8_LAS bf16x8*)(lds + PG8_SA(b, h) + aoff + m * 2048 + k * 1024); } while (0)
#define PG8_LDB(dst, b, h) do { _Pragma("unroll") for (int n = 0; n < 2; ++n) _Pragma("unroll") for (int k = 0; k < 2; ++k) dst[n][k] = *(const PG8_LAS bf16x8*)(lds + PG8_SB(b, h) + boff + n * 2048 + k * 1024); } while (0)
#define PG8_MMA(ai, bj, At, Bt) do { __builtin_amdgcn_s_setprio(1); _Pragma("unroll") for (int m = 0; m < 4; ++m) _Pragma("unroll") for (int n = 0; n < 2; ++n) _Pragma("unroll") for (int k = 0; k < 2; ++k) \
        acc[ai][bj][m][n] = __builtin_amdgcn_mfma_f32_16x16x32_bf16(Bt[n][k], At[m][k], acc[ai][bj][m][n], 0, 0, 0); __builtin_amdgcn_s_setprio(0); } while (0)
#define PG8_WAIT_V(n) asm volatile("s_waitcnt vmcnt(" #n ")" ::: "memory")
#define PG8_WAIT_L(n) asm volatile("s_waitcnt lgkmcnt(" #n ")" ::: "memory")
#define PG8_BAR __builtin_amdgcn_s_barrier()
#define PG8_SCHED __builtin_amdgcn_sched_barrier(0)
    Unit cur, nxt; int ui = 0;
    if (!S.next(0, cur)) return;
    f32x4 acc[2][2][4][2];
#pragma unroll
    for (int a = 0; a < 2; ++a)
#pragma unroll
        for (int b = 0; b < 2; ++b)
#pragma unroll
            for (int m = 0; m < 4; ++m)
#pragma unroll
                for (int n = 0; n < 2; ++n) acc[a][b][m][n] = (f32x4){0.f, 0.f, 0.f, 0.f};
    bf16x8 At[4][2], B0[2][2], B1[2][2];
    const size_t atstep = (size_t)g.a_rows * g.ldk * 2; const char* cA = (const char*)g.A + (size_t)cur.pm * atstep + (size_t)cur.koff * 2; const char* cB = (const char*)g.Bt + (size_t)cur.pn * tstep + (size_t)cur.koff * 2;
    S.a_ready(cur);
    if constexpr (SP2) {
        PG8_STAGE(PG8_SB(0, 0), cB, voffB); PG8_STAGE(PG8_SB(0, 1), cB + hstep, voffB); PG8_STAGE(PG8_SA(0, 0), cA, voffA); PG8_STAGE(PG8_SA(0, 1), cA + hstep, voffA);
        if (wr == 1) PG8_BAR;
        PG8_WAIT_V(2); PG8_BAR;
        PG8_STAGE(PG8_SB(1, 0), cB + kstep, voffB); PG8_STAGE(PG8_SA(1, 0), cA + kstep, voffA); PG8_STAGE(PG8_SB(1, 1), cB + hstep + kstep, voffB);
        PG8_WAIT_V(6); PG8_BAR;
    } else {
        PG8_STAGE(PG8_SB(0, 0), cB, voffB); PG8_STAGE(PG8_SA(0, 0), cA, voffA); PG8_STAGE(PG8_SB(0, 1), cB + hstep, voffB); PG8_STAGE(PG8_SA(0, 1), cA + hstep, voffA);
        if (wr == 1) PG8_BAR;
        PG8_WAIT_V(4); PG8_BAR;
        PG8_STAGE(PG8_SB(1, 0), cB + kstep, voffB); PG8_STAGE(PG8_SA(1, 0), cA + kstep, voffA); PG8_STAGE(PG8_SB(1, 1), cB + hstep + kstep, voffB);
        PG8_WAIT_V(6); PG8_BAR;
    }
    for (;;) {
        const bool has_next = S.next(ui + 1, nxt);
        const char* nA = has_next ? (const char*)g.A + (size_t)nxt.pm * atstep + (size_t)nxt.koff * 2 : cA; const char* nB = has_next ? (const char*)g.Bt + (size_t)nxt.pn * tstep + (size_t)nxt.koff * 2 : cB;
        for (int t = 0; t < nt; t += 2) {
            const bool last = (t == nt - 2);
            const char* a1 = cA + (size_t)(t + 1) * kstep;
            const char* a2 = last ? nA : cA + (size_t)(t + 2) * kstep; const char* b2 = last ? nB : cB + (size_t)(t + 2) * kstep;
            const char* a3 = a2 + kstep; const char* b3 = b2 + kstep;
            if (last && has_next) S.a_ready(nxt);
            if constexpr (SP2) {
            PG8_LDB(B0, 0, 0); PG8_LDB(B1, 0, 1); PG8_SCHED; PG8_LDA(At, 0, 0); PG8_STAGE(PG8_SA(1, 1), a1 + hstep, voffA);
            PG8_WAIT_V(8); PG8_WAIT_L(0); PG8_BAR; PG8_MMA(0, 0, At, B0); PG8_MMA(0, 1, At, B1); PG8_BAR; PG8_SCHED;
            PG8_LDA(At, 0, 1); PG8_STAGE(PG8_SB(0, 0), b2, voffB); PG8_STAGE(PG8_SB(0, 1), b2 + hstep, voffB); PG8_STAGE(PG8_SA(0, 0), a2, voffA);
            PG8_WAIT_V(8); PG8_WAIT_L(0); PG8_BAR; PG8_MMA(1, 0, At, B0); PG8_MMA(1, 1, At, B1); PG8_BAR; PG8_SCHED;
            PG8_LDB(B0, 1, 0); PG8_LDB(B1, 1, 1); PG8_SCHED; PG8_LDA(At, 1, 0); PG8_STAGE(PG8_SA(0, 1), a2 + hstep, voffA);
            PG8_WAIT_V(8); PG8_WAIT_L(0); PG8_BAR; PG8_MMA(0, 0, At, B0); PG8_MMA(0, 1, At, B1); PG8_BAR; PG8_SCHED;
            PG8_LDA(At, 1, 1); PG8_STAGE(PG8_SB(1, 0), b3, voffB); PG8_STAGE(PG8_SB(1, 1), b3 + hstep, voffB); PG8_STAGE(PG8_SA(1, 0), a3, voffA);
            PG8_WAIT_V(8); PG8_WAIT_L(0); PG8_BAR; PG8_MMA(1, 0, At, B0); PG8_MMA(1, 1, At, B1); PG8_BAR; PG8_SCHED;
            } else {
            PG8_LDB(B0, 0, 0); PG8_SCHED; PG8_LDA(At, 0, 0); PG8_STAGE(PG8_SA(1, 1), a1 + hstep, voffA);
            PG8_WAIT_L(8); PG8_BAR; PG8_WAIT_L(0); PG8_MMA(0, 0, At, B0); PG8_BAR; PG8_SCHED;
            PG8_LDB(B1, 0, 1); PG8_STAGE(PG8_SB(0, 0), b2, voffB);
            PG8_BAR; PG8_WAIT_L(0); PG8_MMA(0, 1, At, B1); PG8_BAR;
            PG8_LDA(At, 0, 1); PG8_STAGE(PG8_SA(0, 0), a2, voffA);
            PG8_BAR; PG8_WAIT_L(0); PG8_MMA(1, 0, At, B0); PG8_BAR; PG8_SCHED;
            PG8_STAGE(PG8_SB(0, 1), b2 + hstep, voffB);
            PG8_WAIT_V(6); PG8_BAR; PG8_MMA(1, 1, At, B1); PG8_BAR;
            PG8_LDB(B0, 1, 0); PG8_SCHED; PG8_LDA(At, 1, 0); PG8_STAGE(PG8_SA(0, 1), a2 + hstep, voffA);
            PG8_WAIT_L(8); PG8_BAR; PG8_WAIT_L(0); PG8_MMA(0, 0, At, B0); PG8_BAR; PG8_SCHED;
            PG8_LDB(B1, 1, 1); PG8_STAGE(PG8_SB(1, 0), b3, voffB);
            PG8_BAR; PG8_WAIT_L(0); PG8_MMA(0, 1, At, B1); PG8_BAR;
            PG8_LDA(At, 1, 1); PG8_STAGE(PG8_SA(1, 0), a3, voffA);
            PG8_BAR; PG8_WAIT_L(0); PG8_MMA(1, 0, At, B0); PG8_BAR; PG8_SCHED;
            PG8_STAGE(PG8_SB(1, 1), b3 + hstep, voffB);
            PG8_WAIT_V(6); PG8_BAR; PG8_MMA(1, 1, At, B1); PG8_BAR;
            }
        }
        if constexpr (ALIGN_EPI) { if (wr == 0) PG8_BAR; }
        if constexpr (!Epi::AFTER_DRAIN) { const int l2_ = mk_tid() & 63; E(acc, cur, wr, wc, l2_ & 15, l2_ >> 4); S.done(cur); }
        if (!has_next) break;
#pragma unroll
        for (int a = 0; a < 2; ++a)
#pragma unroll
            for (int b = 0; b < 2; ++b)
#pragma unroll
                for (int m = 0; m < 4; ++m)
#pragma unroll
                    for (int n = 0; n < 2; ++n) acc[a][b][m][n] = (f32x4){0.f, 0.f, 0.f, 0.f};
        cur = nxt; cA = nA; cB = nB; ++ui;
        if constexpr (ALIGN_EPI) { if (wr == 1) PG8_BAR; }
    }
    PG8_WAIT_V(0);
    if constexpr (!ALIGN_EPI) { if (wr == 0) PG8_BAR; }
    PG8_BAR;
    if constexpr (Epi::AFTER_DRAIN) { const int l2_ = mk_tid() & 63; E.fused(acc, cur, wr, wc, l2_ & 15, l2_ >> 4, lds, wid, l2_); S.done(cur); }
#undef PG8_SA
#undef PG8_SB
#undef PG8_STAGE
#undef PG8_LDA
#undef PG8_LDB
#undef PG8_MMA
#undef PG8_WAIT_V
#undef PG8_WAIT_L
#undef PG8_BAR
#undef PG8_SCHED
}
}

#include <hip/hip_bf16.h>
#include <cmath>
namespace attn_body {
using bf16=__hip_bfloat16;
using bf16x8=__attribute__((ext_vector_type(8)))short;
using s16x4=__attribute__((ext_vector_type(4)))short;
using f32x16=__attribute__((ext_vector_type(16)))float;
using u32x4=__attribute__((ext_vector_type(4)))unsigned;
constexpr int D=64,QP=512,KVP=128;
constexpr int NW=8,QBLK=32,QB=QBLK*NW,KVBLK=64;
constexpr int ATTN_UNIT_ROWS=QB;
__device__ __forceinline__ int crow(int r,int hi){return (r&3)+8*(r>>2)+4*hi;}
#define SBAR() __builtin_amdgcn_sched_barrier(0)
__device__ __forceinline__ void cmask(f32x16&p0,f32x16&p1,int jb,int qrel,int hi){
  const float NEG=-INFINITY; int kb=64*jb+4*hi;
  #pragma unroll
  for(int r=0;r<16;++r){int kv=kb+(r&3)+8*(r>>2); if(kv>qrel)p0[r]=NEG; if(kv+32>qrel)p1[r]=NEG;}
}

constexpr int NSLOT=3, SLOTB=8192;
constexpr int LDS_K=0, LDS_V=NSLOT*SLOTB, LDS_WS=2*NSLOT*SLOTB, LDS_OST=LDS_WS+NW*64*4, LDS_BYTES=LDS_OST+NW*4096;
constexpr float C2=0.125f*1.4426950408889634f;
__device__ __forceinline__ void glds16(const void*gsrc,unsigned lds_dst){unsigned keep;
  asm volatile("s_mov_b32 %0, m0\n\ts_mov_b32 m0, %2\n\ts_nop 0\n\tglobal_load_lds_dwordx4 %1, off\n\ts_mov_b32 m0, %0":"=&s"(keep):"v"(gsrc),"s"(lds_dst):"memory");}
__device__ __forceinline__ float max3f(float a,float b,float c){float r;asm("v_max3_f32 %0, %1, %2, %3":"=v"(r):"v"(a),"v"(b),"v"(c));return r;}
__device__ __forceinline__ float max2f(float a,float b){float r;asm("v_max_f32_e32 %0, %1, %2":"=v"(r):"v"(a),"v"(b));return r;}
__device__ __forceinline__ float fadd_s(float a,float b){float r;asm("v_add_f32_e32 %0, %1, %2":"=v"(r):"v"(a),"v"(b));return r;}
__device__ __forceinline__ float fsub_s(float a,float b){float r;asm("v_sub_f32_e32 %0, %1, %2":"=v"(r):"v"(a),"v"(b));return r;}
typedef float f32x2_t __attribute__((ext_vector_type(2))); typedef __bf16 bf16x2_t __attribute__((ext_vector_type(2)));
__device__ __forceinline__ unsigned cvtpk_s(float lo,float hi){f32x2_t v={lo,hi};bf16x2_t b=__builtin_convertvector(v,bf16x2_t);return __builtin_bit_cast(unsigned,b);}
#define WAIT_BAR(N) asm volatile("s_waitcnt vmcnt(" #N ") lgkmcnt(0)\n\ts_barrier":::"memory")

__device__ __forceinline__ void qkt(f32x16&p0,f32x16&p1,const char*Kslot,const bf16x8*qr,const f32x16&negm,int r32,int hi){
  const char*kb=Kslot+hi*1024+r32*16;
  #pragma unroll
  for(int d0=0;d0<4;++d0){
    const bf16x8 b0=*reinterpret_cast<const bf16x8*>(kb+d0*2048);
    const bf16x8 b1=*reinterpret_cast<const bf16x8*>(kb+d0*2048+512);
    if(d0==0){p0=__builtin_amdgcn_mfma_f32_32x32x16_bf16(b0,qr[0],negm,0,0,0);p1=__builtin_amdgcn_mfma_f32_32x32x16_bf16(b1,qr[0],negm,0,0,0);}
    else{p0=__builtin_amdgcn_mfma_f32_32x32x16_bf16(b0,qr[d0],p0,0,0,0);p1=__builtin_amdgcn_mfma_f32_32x32x16_bf16(b1,qr[d0],p1,0,0,0);}}
}
typedef __attribute__((address_space(3))) const char* lds_cptr;
typedef short v4i16_t __attribute__((ext_vector_type(4)));
__device__ __forceinline__ void kload8(bf16x8*kf,lds_cptr kp){
  kf[0]=*(const __attribute__((address_space(3))) bf16x8*)(kp);      kf[1]=*(const __attribute__((address_space(3))) bf16x8*)(kp+512);
  kf[2]=*(const __attribute__((address_space(3))) bf16x8*)(kp+2048); kf[3]=*(const __attribute__((address_space(3))) bf16x8*)(kp+2560);
  kf[4]=*(const __attribute__((address_space(3))) bf16x8*)(kp+4096); kf[5]=*(const __attribute__((address_space(3))) bf16x8*)(kp+4608);
  kf[6]=*(const __attribute__((address_space(3))) bf16x8*)(kp+6144); kf[7]=*(const __attribute__((address_space(3))) bf16x8*)(kp+6656);
}
__device__ __forceinline__ void kload2(bf16x8*kf,lds_cptr kp,int j){ kf[2*j]=*(const __attribute__((address_space(3))) bf16x8*)(kp+j*2048); kf[2*j+1]=*(const __attribute__((address_space(3))) bf16x8*)(kp+j*2048+512); }
__device__ __forceinline__ s16x4 vtr(lds_cptr p){ return __builtin_bit_cast(s16x4,__builtin_amdgcn_ds_read_tr16_b64_v4i16((__attribute__((address_space(3))) v4i16_t*)p)); }
__device__ __forceinline__ float rowmax(const f32x16&p0,const f32x16&p1){
  float a=max3f(p0[0],p0[1],p1[0]),b=max3f(p0[2],p0[3],p1[1]);a=max3f(a,p1[2],p1[3]);
  #pragma unroll
  for(int r=4;r<16;r+=4){a=max3f(a,p0[r],p0[r+1]);b=max3f(b,p0[r+2],p0[r+3]);a=max3f(a,p1[r],p1[r+1]);b=max3f(b,p1[r+2],p1[r+3]);}
  const float m=max2f(a,b);
  auto rr=__builtin_amdgcn_permlane32_swap(__float_as_uint(m),__float_as_uint(m),false,false);
  return max2f(__uint_as_float(rr[0]),__uint_as_float(rr[1]));
}
__device__ __forceinline__ void pv(f32x16*o,int vb,bf16x8 pa0,bf16x8 pa1,bf16x8 pa2,bf16x8 pa3){
  #pragma unroll
  for(int d0=0;d0<2;++d0){s16x4 lo[4],hi[4];
    #pragma unroll
    for(int ks=0;ks<4;++ks){
      asm volatile("ds_read_b64_tr_b16 %0,%1 offset:%c2":"=&v"(lo[ks]):"v"(vb),"i"(d0*4096+ks*1024):"memory");
      asm volatile("ds_read_b64_tr_b16 %0,%1 offset:%c2":"=&v"(hi[ks]):"v"(vb),"i"(d0*4096+ks*1024+512):"memory");}
    asm volatile("s_waitcnt lgkmcnt(0)":::"memory");SBAR();
    #define PK(k) (bf16x8){lo[k][0],lo[k][1],lo[k][2],lo[k][3],hi[k][0],hi[k][1],hi[k][2],hi[k][3]}
    o[d0]=__builtin_amdgcn_mfma_f32_32x32x16_bf16(pa0,PK(0),o[d0],0,0,0);
    o[d0]=__builtin_amdgcn_mfma_f32_32x32x16_bf16(pa1,PK(1),o[d0],0,0,0);
    o[d0]=__builtin_amdgcn_mfma_f32_32x32x16_bf16(pa2,PK(2),o[d0],0,0,0);
    o[d0]=__builtin_amdgcn_mfma_f32_32x32x16_bf16(pa3,PK(3),o[d0],0,0,0);
    #undef PK
  }
}

#ifndef ATTN_STORE16
#define ATTN_STORE16(p,v) (*(u32x4*)(p)=(v))
#endif
template<int THRL> __device__ __forceinline__ void attn_unit(const bf16*Qu,const bf16*__restrict__ Kh,const bf16*__restrict__ Vh,bf16*Ou,const int NT,char*shm){
  const int tid=mk_tid(),lane=tid&63,r32=lane&31,hi=lane>>5; const int wid=__builtin_amdgcn_readfirstlane(tid>>6);
  const bf16*Qw=Qu+(long)(wid*QBLK)*QP;
  const unsigned lds0=(unsigned)(uintptr_t)shm;
  float*wsf=(float*)(shm+LDS_WS)+wid*64;
  const bf16*ksrc=Kh+(long)lane*KVP+wid*8;
  const bf16*vsrc=Vh+(long)(16*(wid&3)+(lane>>2))*KVP+(wid>>2)*32+(lane&3)*8;
  const unsigned kdst=lds0+LDS_K+wid*1024, vdst=lds0+LDS_V+wid*1024;
  #define DMA_K(t,slot) glds16(ksrc+(long)(t)*KVBLK*KVP,(unsigned)__builtin_amdgcn_readfirstlane(kdst+(slot)))
  #define DMA_V(t,slot) glds16(vsrc+(long)(t)*KVBLK*KVP,(unsigned)__builtin_amdgcn_readfirstlane(vdst+(slot)))
  const int vb0=(int)(lds0+LDS_V)+((lane>>4)&1)*32+(lane&3)*8+(4*hi+((lane&15)>>2))*64;
  const char*Kbase=shm+LDS_K; bf16x8 kf[8];
  const lds_cptr shm3=(lds_cptr)shm; const lds_cptr kp0=shm3+LDS_K+hi*1024+r32*16; const lds_cptr vp0=shm3+LDS_V+((lane>>4)&1)*32+(lane&3)*8+(4*hi+((lane&15)>>2))*64;
  DMA_K(0,0);DMA_V(0,0);DMA_K(1,SLOTB);
  bf16x8 qr[4];
  #pragma unroll
  for(int d0=0;d0<4;++d0)qr[d0]=*reinterpret_cast<const bf16x8*>(&Qw[(long)r32*QP+d0*16+hi*8]);
  float mhat=0.f,l_reg=0.f;f32x16 o[2];o[0]=f32x16{};o[1]=f32x16{};f32x16 negm=f32x16{};asm volatile("":"+v"(negm));
  #define CMASK(P0,P1,t) do{}while(0)
  bool resc=false;
  #define START(P0,P1) do{ const float rm=rowmax(P0,P1); resc=false; \
    { const float dl=rm; mhat=fadd_s(mhat,dl); \
      _Pragma("unroll") for(int r=0;r<16;++r){P0[r]=fsub_s(P0[r],dl);P1[r]=fsub_s(P1[r],dl);} \
      _Pragma("unroll") for(int r=0;r<16;++r)negm[r]=-mhat; asm volatile("":"+v"(negm)); } \
    _Pragma("unroll") for(int r=0;r<16;++r)P0[r]=__builtin_amdgcn_exp2f(P0[r]); }while(0)
  #define RESC() do{ if(resc){ asm volatile("s_waitcnt lgkmcnt(0)":::"memory"); \
      _Pragma("unroll") for(int d_=0;d_<2;++d_) _Pragma("unroll") for(int r=0;r<16;++r)o[d_][r]*=wsf[crow(r,hi)]; } }while(0)
  f32x16 pA0,pA1,pB0,pB1;
  int sl_prev=0,sl_cur=0,sl_next=SLOTB;
  #define ROT() do{sl_prev=sl_cur;sl_cur=sl_next;sl_next=(sl_next==(NSLOT-1)*SLOTB)?0:sl_next+SLOTB;}while(0)
  DMA_K(2,2*SLOTB);
  WAIT_BAR(3);
  qkt(pA0,pA1,Kbase,qr,negm,r32,hi);asm volatile("s_nop 15\n\ts_nop 7":"+v"(pA0),"+v"(pA1));CMASK(pA0,pA1,0);
  START(pA0,pA1);
  _Pragma("unroll") for(int r=0;r<16;++r)pA1[r]=__builtin_amdgcn_exp2f(pA1[r]);
  WAIT_BAR(0);
  DMA_K(3,0);DMA_V(1,SLOTB);
  ROT();
  kload8(kf,kp0+sl_cur);
  WAIT_BAR(2);
  s16x4 vlo[8],vhi[8]; u32x4 pw0,pw1,pw2,pw3;
  #define PKW(P,B) cvtpk_s(P[B],P[B+1])
  #define PAF(k) __builtin_bit_cast(bf16x8,pw##k)
  #define VFR(i) (bf16x8){vlo[i][0],vlo[i][1],vlo[i][2],vlo[i][3],vhi[i][0],vhi[i][1],vhi[i][2],vhi[i][3]}
  #define PIN(x) asm volatile("":"+v"(x))
  #define MX3(a,b,c) __builtin_fmaxf(__builtin_fmaxf((a),(b)),(c))
  #define GAPA(MF,A0,A1,A2,A3,W0,W1,PW) do{ MF; sacc+=A0; sacc+=A1; sacc+=A2; sacc+=A3; PIN(sacc); W0; W1; PIN(PW); SBAR(); }while(0)
  #define EX(v) __builtin_amdgcn_exp2f(v)
  #define GAPB(MF,X,B) do{ MF; X[B]=EX(X[B]); X[B+1]=EX(X[B+1]); X[B+2]=EX(X[B+2]); X[B+3]=EX(X[B+3]); PIN(X); SBAR(); }while(0)
  #define VRD(i) do{ vlo[i]=vtr(vp_+(((i)>>2)*4096+((i)&3)*1024)); vhi[i]=vtr(vp_+(((i)>>2)*4096+((i)&3)*1024+512)); }while(0)
  #define KRD(G,j) do{ if(G){ kload2(kf,kp0+sl_next,j); SBAR(); } }while(0)
  #define STEP(C0,C1,P0,P1,t,GK,GV,GL) do{ SBAR(); \
    const lds_cptr vp_=vp0+sl_prev; \
    VRD(0); SBAR(); float sacc=(P0[0]+P0[1]); \
    GAPA(C0=__builtin_amdgcn_mfma_f32_32x32x16_bf16(kf[0],qr[0],negm,0,0,0), P0[2],P0[3],P0[4],P0[5],     pw0[0]=PKW(P0,0), pw0[1]=PKW(P0,2), pw0); \
    VRD(4); SBAR(); GAPA(C1=__builtin_amdgcn_mfma_f32_32x32x16_bf16(kf[1],qr[0],negm,0,0,0), P0[6],P0[7],P0[8],P0[9],     pw0[2]=PKW(P0,4), pw0[3]=PKW(P0,6), pw0); \
    VRD(1); SBAR(); GAPA(C0=__builtin_amdgcn_mfma_f32_32x32x16_bf16(kf[2],qr[1],C0,0,0,0),   P0[10],P0[11],P0[12],P0[13], pw1[0]=PKW(P0,8), pw1[1]=PKW(P0,10), pw1); \
    VRD(5); SBAR(); GAPA(C1=__builtin_amdgcn_mfma_f32_32x32x16_bf16(kf[3],qr[1],C1,0,0,0),   P0[14],P0[15],P1[0],P1[1],   pw1[2]=PKW(P0,12),pw1[3]=PKW(P0,14), pw1); \
    VRD(2); SBAR(); GAPA(C0=__builtin_amdgcn_mfma_f32_32x32x16_bf16(kf[4],qr[2],C0,0,0,0),   P1[2],P1[3],P1[4],P1[5],     pw2[0]=PKW(P1,0), pw2[1]=PKW(P1,2), pw2); \
    VRD(6); SBAR(); GAPA(C1=__builtin_amdgcn_mfma_f32_32x32x16_bf16(kf[5],qr[2],C1,0,0,0),   P1[6],P1[7],P1[8],P1[9],     pw2[2]=PKW(P1,4), pw2[3]=PKW(P1,6), pw2); \
    VRD(3); SBAR(); GAPA(C0=__builtin_amdgcn_mfma_f32_32x32x16_bf16(kf[6],qr[3],C0,0,0,0),   P1[10],P1[11],P1[12],P1[13], pw3[0]=PKW(P1,8), pw3[1]=PKW(P1,10), pw3); \
    VRD(7); SBAR(); GAPA(C1=__builtin_amdgcn_mfma_f32_32x32x16_bf16(kf[7],qr[3],C1,0,0,0),   P1[14],P1[15],0.f,0.f,       pw3[2]=PKW(P1,12),pw3[3]=PKW(P1,14), pw3); \
    l_reg+=sacc; \
    if(GK){DMA_K((t)+3,sl_cur);} if(GV){DMA_V((t)+1,sl_next);} \
    CMASK(C0,C1,t); \
    { float a=MX3(C0[0],C0[1],C1[0]),b=MX3(C0[2],C0[3],C1[1]); a=MX3(a,C1[2],C1[3]); \
      _Pragma("unroll") for(int r=4;r<16;r+=4){a=MX3(a,C0[r],C0[r+1]);b=MX3(b,C0[r+2],C0[r+3]);a=MX3(a,C1[r],C1[r+1]);b=MX3(b,C1[r+2],C1[r+3]);} \
      float rm=__builtin_fmaxf(a,b); { auto rr=__builtin_amdgcn_permlane32_swap(__float_as_uint(rm),__float_as_uint(rm),false,false); rm=__builtin_fmaxf(__uint_as_float(rr[0]),__uint_as_float(rr[1])); } \
      resc=false; \
      if(__builtin_expect(__any(rm>(float)THRL),0)){ const float dl=__builtin_fmaxf(rm,0.f); mhat+=dl; \
        _Pragma("unroll") for(int r=0;r<16;++r){C0[r]-=dl;C1[r]-=dl;} \
        _Pragma("unroll") for(int r=0;r<16;++r)negm[r]=-mhat; asm volatile("":"+v"(negm)); \
        const float f=__builtin_amdgcn_exp2f(-dl); l_reg*=f; if(hi==0)wsf[r32]=f; resc=true; } } \
    SBAR(); \
    GAPB(o[0]=__builtin_amdgcn_mfma_f32_32x32x16_bf16(PAF(0),VFR(0),o[0],0,0,0), C0,0); \
    GAPB(o[1]=__builtin_amdgcn_mfma_f32_32x32x16_bf16(PAF(0),VFR(4),o[1],0,0,0), C0,4); \
    KRD(GL,0); GAPB(o[0]=__builtin_amdgcn_mfma_f32_32x32x16_bf16(PAF(1),VFR(1),o[0],0,0,0), C0,8); \
    KRD(GL,1); GAPB(o[1]=__builtin_amdgcn_mfma_f32_32x32x16_bf16(PAF(1),VFR(5),o[1],0,0,0), C0,12); \
    KRD(GL,2); GAPB(o[0]=__builtin_amdgcn_mfma_f32_32x32x16_bf16(PAF(2),VFR(2),o[0],0,0,0), C1,0); \
    KRD(GL,3); GAPB(o[1]=__builtin_amdgcn_mfma_f32_32x32x16_bf16(PAF(2),VFR(6),o[1],0,0,0), C1,4); \
    GAPB(o[0]=__builtin_amdgcn_mfma_f32_32x32x16_bf16(PAF(3),VFR(3),o[0],0,0,0), C1,8); \
    GAPB(o[1]=__builtin_amdgcn_mfma_f32_32x32x16_bf16(PAF(3),VFR(7),o[1],0,0,0), C1,12); \
    }while(0)
  int t=1;
  #undef CMASK
  #define CMASK(P0,P1,t) do{}while(0)
  for(;t+5<NT;t+=2){
    STEP(pB0,pB1,pA0,pA1,t,true,true,true);     WAIT_BAR(2); RESC(); ROT();
    STEP(pA0,pA1,pB0,pB1,t+1,true,true,true);   WAIT_BAR(2); RESC(); ROT();
  }
  #undef CMASK
  #define CMASK(P0,P1,t) do{}while(0)
  #define ENDW(tt) do{ if((tt)+3<NT){WAIT_BAR(2);} else if((tt)+2<NT){WAIT_BAR(1);} else {WAIT_BAR(0);} }while(0)
  for(;t+1<NT;t+=2){
    STEP(pB0,pB1,pA0,pA1,t,(t+3<NT),(t+1<NT),(t+1<NT));       ENDW(t);   RESC(); ROT();
    STEP(pA0,pA1,pB0,pB1,t+1,(t+4<NT),(t+2<NT),(t+2<NT));     ENDW(t+1); RESC(); ROT();
  }
  STEP(pB0,pB1,pA0,pA1,NT-1,false,false,false); RESC();
  { float sacc=pB0[0]+pB0[1]; _Pragma("unroll") for(int r=2;r<16;++r)sacc+=pB0[r]; _Pragma("unroll") for(int r=0;r<16;++r)sacc+=pB1[r]; l_reg+=sacc;
    pw0=(u32x4){PKW(pB0,0),PKW(pB0,2),PKW(pB0,4),PKW(pB0,6)};pw1=(u32x4){PKW(pB0,8),PKW(pB0,10),PKW(pB0,12),PKW(pB0,14)};pw2=(u32x4){PKW(pB1,0),PKW(pB1,2),PKW(pB1,4),PKW(pB1,6)};pw3=(u32x4){PKW(pB1,8),PKW(pB1,10),PKW(pB1,12),PKW(pB1,14)};
    SBAR(); pv(o,vb0+sl_cur,PAF(0),PAF(1),PAF(2),PAF(3)); }
  #undef PKW
  #undef PAF
  #undef VFR
  #undef PIN
  #undef MX3
  #undef GAPA
  #undef GAPB
  #undef EX
  #undef VRD
  #undef KRD
  #undef STEP
  #undef ENDW
  {auto rr=__builtin_amdgcn_permlane32_swap(__float_as_uint(l_reg),__float_as_uint(l_reg),false,false);l_reg=__uint_as_float(rr[0])+__uint_as_float(rr[1]);}
  if(hi==0)wsf[32+r32]=l_reg;asm volatile("s_waitcnt lgkmcnt(0)":::"memory");
  float rli[16];
  #pragma unroll
  for(int r=0;r<16;++r)rli[r]=__builtin_amdgcn_rcpf(wsf[32+crow(r,hi)]);
  bf16*Ow=Ou+(long)(wid*QBLK)*QP;
  { bf16*stg=(bf16*)(shm+LDS_OST)+wid*2048;
    #pragma unroll
    for(int r=0;r<16;++r){const int orow=crow(r,hi);
      #pragma unroll
      for(int d0=0;d0<2;++d0)stg[orow*64+d0*32+r32]=__float2bfloat16(o[d0][r]*rli[r]);}
    asm volatile("s_waitcnt lgkmcnt(0)":::"memory");
    #pragma unroll
    for(int i=0;i<4;++i){const int row=i*8+(lane>>3),ch=lane&7; const u32x4 v=*(const u32x4*)(stg+row*64+ch*8); ATTN_STORE16(Ow+(long)row*QP+ch*8,v);} }
  asm volatile("s_waitcnt lgkmcnt(0)\n\ts_barrier":::"memory");
  #undef DMA_K
  #undef DMA_V
  #undef CMASK
  #undef START
  #undef RESC
  #undef ROT
}
constexpr int ATTN_LDS_BYTES=LDS_BYTES;
#undef SBAR
#undef WAIT_BAR
}

#define LAS __attribute__((address_space(3)))
typedef unsigned short bf16r;
typedef float f4 __attribute__((ext_vector_type(4)));
typedef unsigned u4 __attribute__((ext_vector_type(4)));
typedef unsigned u2 __attribute__((ext_vector_type(2)));
typedef short s8v __attribute__((ext_vector_type(8)));

constexpr int DM = 1024, SEQL = 4096, CTXL = 256, MLAT = 16384, MCTX = 1024, MALL = 17408;
constexpr int DIN = 1792, DFF = 2816, DFF2 = 5632, KVR = 4352, NCH = 68;
constexpr float EPSN = 1e-6f;
constexpr size_t MiB = 1u << 20;
constexpr size_t WS_MOD = 1 * MiB, WS_COS = 2 * MiB, WS_SIN = 2 * MiB + 512 * 1024, WS_GW = 3 * MiB, WS_AGGA = 4 * MiB, WS_AGGB = 6 * MiB, WS_CTXRES = 8 * MiB;
constexpr size_t WS_W = 12 * MiB, W_LAYER = 22 * MiB, W_IN = 0, W_OUT = 3 * MiB + 512 * 1024, W_UP = 5 * MiB + 512 * 1024, W_DOWN = 16 * MiB + 512 * 1024;
constexpr size_t WS_HN = 56 * MiB + 4096;
constexpr size_t WS_Q = 92 * MiB, WS_K = 109 * MiB, WS_V = 114 * MiB, WS_XL = 119 * MiB, WS_GG = 136 * MiB, WS_MIX = 153 * MiB;
constexpr size_t WS_LAB = 187 * MiB;
constexpr size_t WS_O = WS_HN;
constexpr size_t WS_PART = 187 * MiB;
constexpr size_t WS_ACT = 92 * MiB;
constexpr int LDS_BYTES = 147456;
constexpr int NPHASE = 18;
constexpr int L1_TAB_OFF = 84992;
#ifndef PHM
#define PHM 0x3ff
#endif
#define PON(k) ((PHM >> (k)) & 1)

struct Args { const float* in[24]; float* out; unsigned char* ws; int ph_lo, ph_hi; };
typedef const __attribute__((address_space(4))) Args* KA;

#define LDS_WAIT() asm volatile("s_waitcnt lgkmcnt(0)" ::: "memory")
__device__ __forceinline__ unsigned pk2(float lo, float hi) { return attn_body::cvtpk_s(lo, hi); }
__device__ __forceinline__ float bf_lo(unsigned w) { return __builtin_bit_cast(float, w << 16); }
__device__ __forceinline__ float bf_hi(unsigned w) { return __builtin_bit_cast(float, w & 0xffff0000u); }
__device__ __forceinline__ float wave_sum(float v) {
#pragma unroll
    for (int o = 1; o < 64; o <<= 1) v += __shfl_xor(v, o);
    return v;
}
__device__ __forceinline__ float fexp(float x) { return __builtin_amdgcn_exp2f(x * 1.4426950408889634f); }
__device__ __forceinline__ float sigmoidf_(float x) { return __builtin_amdgcn_rcpf(1.f + fexp(-x)); }
__device__ __forceinline__ float gelu_tanh(float x) { const float z = 0.7978845608028654f * (x + 0.044715f * x * x * x); return x * sigmoidf_(2.f * z); }
__device__ __forceinline__ int kvrow(int row) { return row < MLAT ? (row >> 12) * KVR + CTXL + (row & 4095) : ((row - MLAT) >> 8) * KVR + ((row - MLAT) & 255); }

__device__ __forceinline__ int win_dst(int s) {
    if (s < 512) { const int h = s >> 6, d = s & 63; return (h >> 2) * 256 + (d >> 5) * 128 + (h & 3) * 32 + (d & 31); }
    if (s < 768) { const int t = s - 512, hh = t >> 6, d = t & 63; return 512 + (d >> 5) * 128 + hh * 32 + (d & 31); }
    return s;
}
__device__ __forceinline__ int wup_dst(int s) { return s < DFF ? (s >> 7) * 256 + (s & 127) : ((s - DFF) >> 7) * 256 + 128 + ((s - DFF) & 127); }

template <int MODE> __device__ __forceinline__ void p0_transpose_item(const float* W, int K, int N, bf16r* WT, const float* ksA, const float* ksB, LAS float* scr, int item, int lane) {
    const int nblk = N / 32, kb = item / nblk, nb = item % nblk, k0 = 64 * kb, n0 = 32 * nb;
    float tv[32];
#pragma unroll
    for (int i = 0; i < 32; ++i) { const int kk = 2 * i + (lane >> 5); tv[i] = __builtin_nontemporal_load(W + (size_t)(k0 + kk) * N + n0 + (lane & 31)); }
#pragma unroll
    for (int i = 0; i < 32; ++i) { const int kk = 2 * i + (lane >> 5); float v = tv[i];
        if (MODE == 3) { const int k = k0 + kk; v *= (k < 512 ? ksA[k] : ksB[k - 512]); }
        scr[kk * 33 + (lane & 31)] = v; }
    LDS_WAIT();
    const int c = lane & 7;
#pragma unroll
    for (int j = 0; j < 4; ++j) { const int n = (lane >> 3) + 8 * j; const LAS float* s = scr + (8 * c) * 33 + n;
        u4 o; o.x = pk2(s[0 * 33], s[1 * 33]); o.y = pk2(s[2 * 33], s[3 * 33]); o.z = pk2(s[4 * 33], s[5 * 33]); o.w = pk2(s[6 * 33], s[7 * 33]);
        const int sc = n0 + n; const int dst = MODE == 1 ? win_dst(sc) : MODE == 2 ? wup_dst(sc) : sc;
        *(u4*)(WT + (size_t)dst * K + k0 + 8 * c) = o; }
    LDS_WAIT();
}

__device__ __forceinline__ void p0_phase(KA a, LAS unsigned char* lds, int tid, int wid, int lane, int G) {
    unsigned char* ws = a->ws;
    float* MOD = (float*)(ws + WS_MOD);
    {
        LAS float* sc = (LAS float*)lds; LAS float* red = sc + 5 * 1024;
        bool have = false;
        for (int it = blockIdx.x; it < 192; it += G) {
            if (!have) { for (int e = tid; e < 5 * 1024; e += 512) { const int r = e >> 10, k = e & 1023; const float v = r < 4 ? a->in[1][r * 1024 + k] : a->in[3][k]; sc[e] = v * sigmoidf_(v); } have = true; }
            __syncthreads();
            const int l = it / 96, nb = it % 96;
            const float* wp = a->in[4] + (size_t)l * 1024 * 6144 + (size_t)(wid * 128) * 6144 + nb * 64 + lane;
            float acc[5] = {0.f, 0.f, 0.f, 0.f, 0.f};
#pragma unroll 32
            for (int k = 0; k < 128; ++k) { const float wv = __builtin_nontemporal_load(wp + (size_t)k * 6144);
#pragma unroll
                for (int r = 0; r < 5; ++r) acc[r] += sc[r * 1024 + wid * 128 + k] * wv; }
#pragma unroll
            for (int r = 0; r < 5; ++r) red[(wid * 5 + r) * 64 + lane] = acc[r];
            __syncthreads();
            if (tid < 320) { const int r = tid >> 6, col = tid & 63; float s = a->in[5][l * 6144 + nb * 64 + col];
#pragma unroll
                for (int w = 0; w < 8; ++w) s += red[(w * 5 + r) * 64 + col];
                MOD[(l * 5 + r) * 6144 + nb * 64 + col] = s; }
        }
        __syncthreads();
    }
    {
        float* cosT = (float*)(ws + WS_COS); float* sinT = (float*)(ws + WS_SIN); bf16r* GW = (bf16r*)(ws + WS_GW);
        const int gt = blockIdx.x * 512 + tid, NT_ = G * 512;
        for (int e = gt; e < 4096 * 32; e += NT_) { const int t = e >> 5, j = e & 31; const float pos = (float)(j < 16 ? (t >> 6) : (t & 63));
            const float inv = powf(10000.0f, -(float)(j & 15) * (1.0f / 16.0f)); const float ang = pos * inv; cosT[e] = cosf(ang); sinT[e] = sinf(ang); }
        for (int e = gt; e < 2 * 2 * 2 * 8 * 64 * 64; e += NT_) {
            const int c = e & 63, d = (e >> 6) & 63, n = (e >> 12) & 7, mat = (e >> 15) & 1, dir = (e >> 16) & 1, l = e >> 17;
            const float* src = mat ? a->in[13] : a->in[11];
            GW[e] = (bf16r)(pk2(src[((((size_t)l * 2 + dir) * 8 + n) * 64 + c) * 64 + d], 0.f) & 0xffffu); }
    }
    {
        LAS float* scr = (LAS float*)lds + wid * (64 * 33 + 16);
        const int gw = blockIdx.x * 8 + wid, NGW = G * 8;
        constexpr int I_IN = 16 * 56, I_OUT = 16 * 32, I_UP = 16 * 176, I_DN = 44 * 32, I_L = I_IN + I_OUT + I_UP + I_DN;
        for (int it = gw; it < 2 * I_L; it += NGW) {
            const int l = it / I_L; int r = it % I_L;
            unsigned char* wl = ws + WS_W + (size_t)l * W_LAYER;
            if (r < I_IN) { p0_transpose_item<1>(a->in[6] + (size_t)l * DM * DIN, DM, DIN, (bf16r*)(wl + W_IN), nullptr, nullptr, scr, r, lane); continue; } r -= I_IN;
            if (r < I_OUT) { p0_transpose_item<3>(a->in[18] + (size_t)l * DM * DM, DM, DM, (bf16r*)(wl + W_OUT), a->in[16] + l * 512, a->in[17] + l * 512, scr, r, lane); continue; } r -= I_OUT;
            if (r < I_UP) { p0_transpose_item<2>(a->in[19] + (size_t)l * DM * DFF2, DM, DFF2, (bf16r*)(wl + W_UP), nullptr, nullptr, scr, r, lane); continue; } r -= I_UP;
            p0_transpose_item<0>(a->in[22] + (size_t)l * DFF * DM, DFF, DM, (bf16r*)(wl + W_DOWN), nullptr, nullptr, scr, r, lane);
        }
    }
}

__device__ __forceinline__ void prenorm_phase(KA a, int l, int which, int nrows, int nsplit, const float* ctx_src, int wid, int lane, int G) {
    const float* MOD = (const float*)(a->ws + WS_MOD); bf16r* HN = (bf16r*)(a->ws + WS_HN);
    float* ctxres = (float*)(a->ws + WS_CTXRES); const float* PART = (const float*)(a->ws + WS_PART);
    const int gw = blockIdx.x * 8 + wid, NGW = G * 8;
    const bool from_in = (l == 0 && which == 0);
    for (int row = gw; row < nrows; row += 2 * NGW) {
        const int row2 = row + NGW; const bool has2 = row2 < nrows; const int r2 = has2 ? row2 : row;
        const float* lat = from_in ? a->in[0] : a->out;
        const float* s0 = row < MLAT ? lat + (size_t)row * DM : ctx_src + (size_t)(row - MLAT) * DM;
        const float* s1 = r2 < MLAT ? lat + (size_t)r2 * DM : ctx_src + (size_t)(r2 - MLAT) * DM;
        const float* md0 = MOD + (l * 5 + (row < MLAT ? (row >> 12) : 4)) * 6144 + (which ? 3 * 1024 : 0);
        const float* md1 = MOD + (l * 5 + (r2 < MLAT ? (r2 >> 12) : 4)) * 6144 + (which ? 3 * 1024 : 0);
        f4 v0[4], v1[4];
#pragma unroll
        for (int j = 0; j < 4; ++j) { v0[j] = *(const f4*)(s0 + 4 * (lane + 64 * j)); v1[j] = *(const f4*)(s1 + 4 * (lane + 64 * j)); }
        if (nsplit > 0) {
            if (row >= MLAT) { const float* pp = PART + (size_t)(row - MLAT) * DM + 4 * lane;
                for (int ks = 0; ks < nsplit; ks += 4) {
                    f4 t_[4][4]; float wk_[4];
#pragma unroll
                    for (int kk = 0; kk < 4; ++kk) { const int k2 = ks + kk < nsplit ? ks + kk : nsplit - 1; wk_[kk] = ks + kk < nsplit ? 1.f : 0.f;
#pragma unroll
                        for (int j = 0; j < 4; ++j) t_[kk][j] = *(const f4*)(pp + (size_t)k2 * MCTX * DM + 256 * j); }
                    __builtin_amdgcn_sched_barrier(0);
#pragma unroll
                    for (int kk = 0; kk < 4; ++kk)
#pragma unroll
                        for (int j = 0; j < 4; ++j) v0[j] += t_[kk][j] * wk_[kk];
                }
#pragma unroll
                for (int j = 0; j < 4; ++j) *(f4*)(ctxres + (size_t)(row - MLAT) * DM + 4 * (lane + 64 * j)) = v0[j]; }
            if (has2 && row2 >= MLAT) { const float* pp = PART + (size_t)(row2 - MLAT) * DM + 4 * lane;
                for (int ks = 0; ks < nsplit; ks += 4) {
                    f4 t_[4][4]; float wk_[4];
#pragma unroll
                    for (int kk = 0; kk < 4; ++kk) { const int k2 = ks + kk < nsplit ? ks + kk : nsplit - 1; wk_[kk] = ks + kk < nsplit ? 1.f : 0.f;
#pragma unroll
                        for (int j = 0; j < 4; ++j) t_[kk][j] = *(const f4*)(pp + (size_t)k2 * MCTX * DM + 256 * j); }
                    __builtin_amdgcn_sched_barrier(0);
#pragma unroll
                    for (int kk = 0; kk < 4; ++kk)
#pragma unroll
                        for (int j = 0; j < 4; ++j) v1[j] += t_[kk][j] * wk_[kk];
                }
#pragma unroll
                for (int j = 0; j < 4; ++j) *(f4*)(ctxres + (size_t)(row2 - MLAT) * DM + 4 * (lane + 64 * j)) = v1[j]; }
        }
        float ss0 = 0.f, ss1 = 0.f;
#pragma unroll
        for (int j = 0; j < 4; ++j) { ss0 += (v0[j].x * v0[j].x + v0[j].y * v0[j].y) + (v0[j].z * v0[j].z + v0[j].w * v0[j].w); ss1 += (v1[j].x * v1[j].x + v1[j].y * v1[j].y) + (v1[j].z * v1[j].z + v1[j].w * v1[j].w); }
#pragma unroll
        for (int o = 1; o < 64; o <<= 1) { ss0 += __shfl_xor(ss0, o); ss1 += __shfl_xor(ss1, o); }
        const float rs0 = rsqrtf(ss0 * (1.f / DM) + EPSN), rs1 = rsqrtf(ss1 * (1.f / DM) + EPSN);
#pragma unroll
        for (int j = 0; j < 4; ++j) { const int col = 4 * (lane + 64 * j);
            { const f4 sh = *(const f4*)(md0 + col), sc = *(const f4*)(md0 + 1024 + col); const f4 h = v0[j] * rs0 * (sc + 1.f) + sh; u2 w; w.x = pk2(h.x, h.y); w.y = pk2(h.z, h.w); *(u2*)(HN + (size_t)row * DM + col) = w; }
            if (has2) { const f4 sh = *(const f4*)(md1 + col), sc = *(const f4*)(md1 + 1024 + col); const f4 h = v1[j] * rs1 * (sc + 1.f) + sh; u2 w; w.x = pk2(h.x, h.y); w.y = pk2(h.z, h.w); *(u2*)(HN + (size_t)row2 * DM + col) = w; } }
    }
}
__device__ __forceinline__ void finalnorm_phase(KA a, int wid, int lane, int G) {
    const float* fw = a->in[23];
    const int gw = blockIdx.x * 8 + wid, NGW = G * 8;
    f4 wv[4];
#pragma unroll
    for (int j = 0; j < 4; ++j) wv[j] = *(const f4*)(fw + 4 * (lane + 64 * j));
    for (int row = gw; row < MLAT; row += 2 * NGW) {
        const int row2 = row + NGW; const bool has2 = row2 < MLAT;
        float* p0 = a->out + (size_t)row * DM; float* p1 = a->out + (size_t)(has2 ? row2 : row) * DM;
        f4 v0[4], v1[4]; float ss0 = 0.f, ss1 = 0.f;
#pragma unroll
        for (int j = 0; j < 4; ++j) { v0[j] = *(const f4*)(p0 + 4 * (lane + 64 * j)); v1[j] = *(const f4*)(p1 + 4 * (lane + 64 * j)); }
#pragma unroll
        for (int j = 0; j < 4; ++j) { ss0 += (v0[j].x * v0[j].x + v0[j].y * v0[j].y) + (v0[j].z * v0[j].z + v0[j].w * v0[j].w); ss1 += (v1[j].x * v1[j].x + v1[j].y * v1[j].y) + (v1[j].z * v1[j].z + v1[j].w * v1[j].w); }
#pragma unroll
        for (int o = 1; o < 64; o <<= 1) { ss0 += __shfl_xor(ss0, o); ss1 += __shfl_xor(ss1, o); }
        const float rs0 = rsqrtf(ss0 * (1.f / DM) + EPSN), rs1 = rsqrtf(ss1 * (1.f / DM) + EPSN);
#pragma unroll
        for (int j = 0; j < 4; ++j) { __builtin_nontemporal_store(v0[j] * rs0 * wv[j], (f4*)(p0 + 4 * (lane + 64 * j))); if (has2) __builtin_nontemporal_store(v1[j] * rs1 * wv[j], (f4*)(p1 + 4 * (lane + 64 * j))); }
    }
}

struct EpiWin {
    static constexpr bool PERM = true, AFTER_DRAIN = false;
    unsigned char* ws_; const float *qw, *kw;
    __device__ __forceinline__ void operator()(const pg8::f32x4 (&acc)[2][2][4][2], const pg8::Unit& u, int wr, int wc, int fr, int fq) const {
        bf16r* const Q = (bf16r*)(ws_ + WS_Q); bf16r* const Kb = (bf16r*)(ws_ + WS_K); bf16r* const Vb = (bf16r*)(ws_ + WS_V); bf16r* const XL = (bf16r*)(ws_ + WS_XL); bf16r* const GG = (bf16r*)(ws_ + WS_GG);
        const float* const cosT = (const float*)(ws_ + WS_COS); const float* const sinT = (const float*)(ws_ + WS_SIN);
        const int pn = u.pn, row0 = u.pm * 256 + wr * 64 + fr;
        if (pn >= 3) {
            const bool isg = pn >= 5; bf16r* dst = isg ? GG : XL; const int cb = (pn - (isg ? 5 : 3)) * 256 + wc * 32 + 8 * fq;
#pragma unroll
            for (int ai = 0; ai < 2; ++ai)
#pragma unroll
                for (int m = 0; m < 4; ++m) { const int row = row0 + ai * 128 + m * 16;
#pragma unroll
                    for (int bj = 0; bj < 2; ++bj)
#pragma unroll
                        for (int n = 0; n < 2; ++n) { pg8::f32x4 v = acc[ai][bj][m][n];
                            if (isg) { v[0] = gelu_tanh(v[0]); v[1] = gelu_tanh(v[1]); v[2] = gelu_tanh(v[2]); v[3] = gelu_tanh(v[3]); }
                            u2 w; w.x = pk2(v[0], v[1]); w.y = pk2(v[2], v[3]);
                            const int col = cb + bj * 128 + n * 4;
                            if (isg) *(u2*)(dst + (size_t)(row >> 4) * 8192 + (col >> 6) * 1024 + ((col >> 4) & 3) * 256 + (row & 15) * 16 + (col & 15)) = w;
                            else *(u2*)(dst + (size_t)row * 512 + col) = w; } }
            return;
        }
        if (pn == 2 && wc >= 2) {
#pragma unroll
            for (int ai = 0; ai < 2; ++ai)
#pragma unroll
                for (int m = 0; m < 4; ++m) { const int row = row0 + ai * 128 + m * 16; bf16r* base = Vb + (size_t)kvrow(row) * 128 + (wc - 2) * 64 + 8 * fq;
#pragma unroll
                    for (int bj = 0; bj < 2; ++bj)
#pragma unroll
                        for (int n = 0; n < 2; ++n) { const pg8::f32x4 v = acc[ai][bj][m][n]; u2 w; w.x = pk2(v[0], v[1]); w.y = pk2(v[2], v[3]);
                            *(u2*)(base + 32 * bj + 4 * n) = w; } }
            return;
        }
        const bool isk = pn == 2; const float* nw = isk ? kw : qw;
        pg8::f32x4 wv[2][2];
#pragma unroll
        for (int bj = 0; bj < 2; ++bj)
#pragma unroll
            for (int n = 0; n < 2; ++n) wv[bj][n] = *(const pg8::f32x4*)(nw + 32 * bj + 8 * fq + 4 * n);
        const float osc = isk ? 1.f : attn_body::C2;
#pragma unroll
        for (int am = 0; am < 4; ++am) { const int ai = am >> 1, m0 = (am & 1) * 2;
            pg8::f32x4 csv[2][2], snv[2][2];
            const bool lat_ = (row0 + ai * 128) < MLAT;
#pragma unroll
            for (int mm = 0; mm < 2; ++mm) { const int t = (row0 + ai * 128 + (m0 + mm) * 16) & 4095;
#pragma unroll
                for (int n = 0; n < 2; ++n) { csv[mm][n] = *(const pg8::f32x4*)(cosT + t * 32 + 8 * fq + 4 * n); snv[mm][n] = *(const pg8::f32x4*)(sinT + t * 32 + 8 * fq + 4 * n); } }
            __builtin_amdgcn_sched_barrier(0);
#pragma unroll
            for (int mm = 0; mm < 2; ++mm) { const int m = m0 + mm; const int row = row0 + ai * 128 + m * 16;
                float ss = 0.f;
#pragma unroll
                for (int bj = 0; bj < 2; ++bj)
#pragma unroll
                    for (int n = 0; n < 2; ++n) { const pg8::f32x4 v = acc[ai][bj][m][n]; ss += (v[0] * v[0] + v[1] * v[1]) + (v[2] * v[2] + v[3] * v[3]); }
                ss += __shfl_xor(ss, 16); ss += __shfl_xor(ss, 32);
                const float rstd = rsqrtf(ss * (1.f / 64.f) + EPSN) * osc;
                pg8::f32x4 y[2][2];
#pragma unroll
                for (int bj = 0; bj < 2; ++bj)
#pragma unroll
                    for (int n = 0; n < 2; ++n) y[bj][n] = acc[ai][bj][m][n] * rstd * wv[bj][n];
                if (lat_) {
#pragma unroll
                    for (int n = 0; n < 2; ++n) { const pg8::f32x4 cs = csv[mm][n], sn = snv[mm][n];
                        const pg8::f32x4 o0 = y[0][n] * cs - y[1][n] * sn, o1 = y[1][n] * cs + y[0][n] * sn; y[0][n] = o0; y[1][n] = o1; } }
                bf16r* base = isk ? Kb + (size_t)kvrow(row) * 128 + wc * 64 + 8 * fq : Q + (size_t)row * 512 + (4 * pn + wc) * 64 + 8 * fq;
#pragma unroll
                for (int bj = 0; bj < 2; ++bj)
#pragma unroll
                    for (int n = 0; n < 2; ++n) { u2 w; w.x = pk2(y[bj][n][0], y[bj][n][1]); w.y = pk2(y[bj][n][2], y[bj][n][3]); *(u2*)(base + 32 * bj + 4 * n) = w; }
            }
            __builtin_amdgcn_sched_barrier(0);
        }
    }
};
struct EpiRes {
    static constexpr bool PERM = false, AFTER_DRAIN = false;
    const float *base_lat, *base_ctx; float *out_lat, *out_ctx; const float* gate;
    __device__ __forceinline__ void operator()(const pg8::f32x4 (&acc)[2][2][4][2], const pg8::Unit& u, int wr, int wc, int fr, int fq) const {
        const int pm = u.pm; const bool isctx = pm >= 64;
        const float* base = isctx ? base_ctx + (size_t)(pm - 64) * 256 * DM : base_lat + (size_t)pm * 256 * DM;
        float* out = isctx ? out_ctx + (size_t)(pm - 64) * 256 * DM : out_lat + (size_t)pm * 256 * DM;
        const float* gt = gate + (isctx ? 4 : (pm >> 4)) * 6144;
        const int col0 = u.pn * 256 + wc * 32 + 4 * fq;
        pg8::f32x4 gv[2][2];
#pragma unroll
        for (int bj = 0; bj < 2; ++bj)
#pragma unroll
            for (int n = 0; n < 2; ++n) gv[bj][n] = *(const pg8::f32x4*)(gt + col0 + bj * 128 + n * 16);
#pragma unroll
        for (int am = 0; am < 4; ++am) {
            const int ai = am >> 1, m0 = (am & 1) * 2;
            pg8::f32x4 bs[2][2][2];
#pragma unroll
            for (int mm = 0; mm < 2; ++mm) { const size_t ro = (size_t)(ai * 128 + wr * 64 + (m0 + mm) * 16 + fr) * DM + col0;
#pragma unroll
                for (int bj = 0; bj < 2; ++bj)
#pragma unroll
                    for (int n = 0; n < 2; ++n) bs[mm][bj][n] = *(const pg8::f32x4*)(base + ro + bj * 128 + n * 16); }
            __builtin_amdgcn_sched_barrier(0);
#pragma unroll
            for (int mm = 0; mm < 2; ++mm) { const size_t ro = (size_t)(ai * 128 + wr * 64 + (m0 + mm) * 16 + fr) * DM + col0;
#pragma unroll
                for (int bj = 0; bj < 2; ++bj)
#pragma unroll
                    for (int n = 0; n < 2; ++n) *(pg8::f32x4*)(out + ro + bj * 128 + n * 16) = bs[mm][bj][n] + gv[bj][n] * acc[ai][bj][m0 + mm][n]; }
            __builtin_amdgcn_sched_barrier(0);
        }
    }
};
struct EpiUpConv {
    static constexpr bool PERM = true, AFTER_DRAIN = true;
    bf16r* ACT; const float* cw; const float* cb; int mrows;
    __device__ __forceinline__ void fused(pg8::f32x4 (&acc)[2][2][4][2], const pg8::Unit& u, int wr, int wc, int fr, int fq, PG8_LAS unsigned char* lds, int wid, int lane) const {
        constexpr int PITCH = 544;
#pragma unroll
        for (int ai = 0; ai < 2; ++ai)
#pragma unroll
            for (int m = 0; m < 4; ++m) { const int lr = ai * 128 + wr * 64 + m * 16 + fr;
#pragma unroll
                for (int bj = 0; bj < 2; ++bj)
#pragma unroll
                    for (int n = 0; n < 2; ++n) { const pg8::f32x4 v = acc[ai][bj][m][n]; u2 w; w.x = pk2(v[0], v[1]); w.y = pk2(v[2], v[3]);
                        *(PG8_LAS u2*)(lds + lr * PITCH + (bj * 128 + wc * 32 + 8 * fq + 4 * n) * 2) = w; } }
        LDS_WAIT(); __syncthreads();
        const int tid = wid * 64 + lane, cgp = tid & 15, rr = tid >> 4;
        const int ch = u.pn * 128 + 8 * cgp;
        float wg[3][8], wvv[3][8], bg[8], bv[8];
#pragma unroll
        for (int k = 0; k < 3; ++k)
#pragma unroll
            for (int h = 0; h < 2; ++h) { const f4 t0 = *(const f4*)(cw + k * DFF2 + ch + 4 * h), t1 = *(const f4*)(cw + k * DFF2 + DFF + ch + 4 * h);
                wg[k][4 * h] = t0.x; wg[k][4 * h + 1] = t0.y; wg[k][4 * h + 2] = t0.z; wg[k][4 * h + 3] = t0.w; wvv[k][4 * h] = t1.x; wvv[k][4 * h + 1] = t1.y; wvv[k][4 * h + 2] = t1.z; wvv[k][4 * h + 3] = t1.w; }
#pragma unroll
        for (int h = 0; h < 2; ++h) { const f4 t0 = *(const f4*)(cb + ch + 4 * h), t1 = *(const f4*)(cb + DFF + ch + 4 * h);
            bg[4 * h] = t0.x; bg[4 * h + 1] = t0.y; bg[4 * h + 2] = t0.z; bg[4 * h + 3] = t0.w; bv[4 * h] = t1.x; bv[4 * h + 1] = t1.y; bv[4 * h + 2] = t1.z; bv[4 * h + 3] = t1.w; }
        const int row_first = u.pm * 254 - 1, lr0 = 1 + 8 * rr;
        PG8_LAS const unsigned char* up = lds + 16 * cgp;
        u4 pg_ = *(PG8_LAS const u4*)(up + (lr0 - 1) * PITCH), pv_ = *(PG8_LAS const u4*)(up + (lr0 - 1) * PITCH + 256);
        u4 cg_ = *(PG8_LAS const u4*)(up + lr0 * PITCH), cv_ = *(PG8_LAS const u4*)(up + lr0 * PITCH + 256);
#pragma unroll
        for (int i = 0; i < 8; ++i) { const int lr = lr0 + i;
            if (lr <= 254) {
                const u4 ng_ = *(PG8_LAS const u4*)(up + (lr + 1) * PITCH), nv_ = *(PG8_LAS const u4*)(up + (lr + 1) * PITCH + 256);
                const int r = row_first + lr;
                if (r < mrows) {
                    const int p = r < MLAT ? (r & 4095) : ((r - MLAT) & 255), T = r < MLAT ? SEQL : CTXL;
                    const bool hp = p > 0, hn = p < T - 1;
                    const u4 z4 = (u4){0u, 0u, 0u, 0u};
                    const u4 pgm = hp ? pg_ : z4, pvm = hp ? pv_ : z4, ngm = hn ? ng_ : z4, nvm = hn ? nv_ : z4;
                    unsigned ow[4];
#pragma unroll
                    for (int e2 = 0; e2 < 4; ++e2) {
                        float o2[2];
#pragma unroll
                        for (int hh = 0; hh < 2; ++hh) { const int e = 2 * e2 + hh;
                            const float gp = hh ? bf_hi(pgm[e2]) : bf_lo(pgm[e2]), gc = hh ? bf_hi(cg_[e2]) : bf_lo(cg_[e2]), gn = hh ? bf_hi(ngm[e2]) : bf_lo(ngm[e2]);
                            const float vp = hh ? bf_hi(pvm[e2]) : bf_lo(pvm[e2]), vc = hh ? bf_hi(cv_[e2]) : bf_lo(cv_[e2]), vn = hh ? bf_hi(nvm[e2]) : bf_lo(nvm[e2]);
                            const float g = bg[e] + wg[1][e] * gc + wg[0][e] * gp + wg[2][e] * gn;
                            const float v = bv[e] + wvv[1][e] * vc + wvv[0][e] * vp + wvv[2][e] * vn;
                            o2[hh] = g * sigmoidf_(g) * v; }
                        ow[e2] = pk2(o2[0], o2[1]); }
                    u4 o; o.x = ow[0]; o.y = ow[1]; o.z = ow[2]; o.w = ow[3];
                    *(u4*)(ACT + (size_t)r * DFF + ch) = o;
                }
                pg_ = cg_; pv_ = cv_; cg_ = ng_; cv_ = nv_;
            } }
        LDS_WAIT(); __syncthreads();
    }
};
struct SplitOrder { int nsub, S, kslice, G, c;
    __device__ __forceinline__ bool next(int i, pg8::Unit& u) const { const int x = c + i * G; if (x >= nsub) return false; const int ks = x % S, t = x / S; u.pm = 64 + (t >> 2); u.pn = t & 3; u.koff = ks * kslice; return true; }
    __device__ __forceinline__ void a_ready(const pg8::Unit&) const {}
    __device__ __forceinline__ void done(const pg8::Unit&) const {} };
struct EpiPart {
    static constexpr bool PERM = false, AFTER_DRAIN = false;
    float* part; const float* gate; int kslice;
    __device__ __forceinline__ void operator()(const pg8::f32x4 (&acc)[2][2][4][2], const pg8::Unit& u, int wr, int wc, int fr, int fq) const {
        asm volatile("" : "+v"(fr), "+v"(fq));
        float* out = part + ((size_t)(u.koff / kslice) * MCTX + (size_t)(u.pm - 64) * 256) * DM;
        const float* gt = gate + 4 * 6144;
        const int col0 = u.pn * 256 + wc * 32 + 4 * fq;
        pg8::f32x4 gv[2][2];
#pragma unroll
        for (int bj = 0; bj < 2; ++bj)
#pragma unroll
            for (int n = 0; n < 2; ++n) gv[bj][n] = *(const pg8::f32x4*)(gt + col0 + bj * 128 + n * 16);
#pragma unroll
        for (int ai = 0; ai < 2; ++ai)
#pragma unroll
            for (int m = 0; m < 4; ++m) { const size_t ro = (size_t)(ai * 128 + wr * 64 + m * 16 + fr) * DM + col0;
#pragma unroll
                for (int bj = 0; bj < 2; ++bj)
#pragma unroll
                    for (int n = 0; n < 2; ++n) *(pg8::f32x4*)(out + ro + bj * 128 + n * 16) = gv[bj][n] * acc[ai][bj][m][n]; }
    }
};
struct OneUnit { pg8::Unit u;
    __device__ __forceinline__ bool next(int i, pg8::Unit& o) const { if (i) return false; o = u; return true; }
    __device__ __forceinline__ void a_ready(const pg8::Unit&) const {}
    __device__ __forceinline__ void done(const pg8::Unit&) const {} };

#define DPPF(old, src, ctrl) __builtin_bit_cast(float, __builtin_amdgcn_update_dpp(__builtin_bit_cast(int, (float)(old)), __builtin_bit_cast(int, (float)(src)), ctrl, 0xf, 0xf, false))
struct LruCtx { const bf16r* XLp; const bf16r* GWn; LAS const float* tab; LAS float* scr; int p0, T, n, tok, q; };
typedef _Float16 h2v __attribute__((ext_vector_type(2)));
__device__ __forceinline__ unsigned pkh2(float lo, float hi) { return __builtin_bit_cast(unsigned, __builtin_amdgcn_cvt_pkrtz(lo, hi)); }
__device__ __forceinline__ float h2lo(unsigned w) { return (float)__builtin_bit_cast(h2v, w).x; }
__device__ __forceinline__ float h2hi(unsigned w) { return (float)__builtin_bit_cast(h2v, w).y; }
__device__ __forceinline__ void lru_conv_load(const LruCtx& c, int s, u4 (&raw)[8]) {
    const int i = 16 * s + c.tok, p = c.p0 + i;
#pragma unroll
    for (int ks = 0; ks < 2; ++ks)
#pragma unroll
        for (int k = 0; k < 4; ++k) { const int pp = p + k - 2; const bool ok = pp >= 0 && pp < c.T;
            raw[4 * ks + k] = *(const u4*)(c.XLp + (ptrdiff_t)(ok ? i + k - 2 : i) * 512 + 32 * ks + 8 * c.q); }
}
__device__ __forceinline__ void lru_conv(const LruCtx& c, int s, const u4 (&raw)[8], s8v (&frag)[2], f4 (&xc)[4]) {
    const int i = 16 * s + c.tok, p = c.p0 + i;
    float xb[2][8];
#pragma unroll
    for (int ks = 0; ks < 2; ++ks) { const int c0 = 32 * ks + 8 * c.q, chn = 64 * c.n + c0;
#pragma unroll
        for (int h = 0; h < 2; ++h) { const f4 t = *(LAS const f4*)(c.tab + 2048 + chn + 4 * h); xb[ks][4 * h] = t.x; xb[ks][4 * h + 1] = t.y; xb[ks][4 * h + 2] = t.z; xb[ks][4 * h + 3] = t.w; }
#pragma unroll
        for (int k = 0; k < 4; ++k) { const int pp = p + k - 2; const bool ok = pp >= 0 && pp < c.T;
            const u4 rw = raw[4 * ks + k];
#pragma unroll
            for (int h = 0; h < 2; ++h) { f4 w = *(LAS const f4*)(c.tab + k * 512 + chn + 4 * h); if (!ok) w = (f4){0.f, 0.f, 0.f, 0.f};
                xb[ks][4 * h] += w.x * bf_lo(rw[2 * h]); xb[ks][4 * h + 1] += w.y * bf_hi(rw[2 * h]); xb[ks][4 * h + 2] += w.z * bf_lo(rw[2 * h + 1]); xb[ks][4 * h + 3] += w.w * bf_hi(rw[2 * h + 1]); } } }
#pragma unroll
    for (int ks = 0; ks < 2; ++ks) { LAS float* sp = c.scr + c.tok * 68 + 32 * ks + 8 * c.q;
        *(LAS f4*)sp = (f4){xb[ks][0], xb[ks][1], xb[ks][2], xb[ks][3]}; *(LAS f4*)(sp + 4) = (f4){xb[ks][4], xb[ks][5], xb[ks][6], xb[ks][7]};
        u4 w; w.x = pk2(xb[ks][0], xb[ks][1]); w.y = pk2(xb[ks][2], xb[ks][3]); w.z = pk2(xb[ks][4], xb[ks][5]); w.w = pk2(xb[ks][6], xb[ks][7]); frag[ks] = __builtin_bit_cast(s8v, w); }
    LDS_WAIT();
#pragma unroll
    for (int rb = 0; rb < 4; ++rb) xc[rb] = *(LAS const f4*)(c.scr + c.tok * 68 + 16 * rb + 4 * c.q);
    LDS_WAIT();
}
__device__ __forceinline__ void lru_wload(const LruCtx& c, int dir, s8v (&W)[16]) {
    const bf16r* gwa = c.GWn + (size_t)(dir * 2) * 8 * 4096, *gwx = gwa + 8 * 4096;
#pragma unroll
    for (int rb = 0; rb < 4; ++rb)
#pragma unroll
        for (int ks = 0; ks < 2; ++ks) { const int off = (16 * rb + c.tok) * 64 + 32 * ks + 8 * c.q; W[4 * rb + 2 * ks] = *(const s8v*)(gwa + off); W[4 * rb + 2 * ks + 1] = *(const s8v*)(gwx + off); }
}
__device__ __forceinline__ void lru_gates(const LruCtx& c, int dir, const s8v (&W)[16], const s8v (&frag)[2], const f4 (&xc)[4], float (&LA)[16], float (&AV)[16], float (&B)[16]) {
    f4 ga[4], gx[4];
#pragma unroll
    for (int rb = 0; rb < 4; ++rb) { ga[rb] = (f4){0.f, 0.f, 0.f, 0.f}; gx[rb] = (f4){0.f, 0.f, 0.f, 0.f};
#pragma unroll
        for (int ks = 0; ks < 2; ++ks) {
            ga[rb] = __builtin_amdgcn_mfma_f32_16x16x32_bf16(W[4 * rb + 2 * ks], frag[ks], ga[rb], 0, 0, 0);
            gx[rb] = __builtin_amdgcn_mfma_f32_16x16x32_bf16(W[4 * rb + 2 * ks + 1], frag[ks], gx[rb], 0, 0, 0); } }
#pragma unroll
    for (int rb = 0; rb < 4; ++rb) { const int chn = dir * 512 + 64 * c.n + 16 * rb + 4 * c.q;
        const f4 ba = *(LAS const f4*)(c.tab + 2560 + chn), bx = *(LAS const f4*)(c.tab + 3584 + chn), cl = *(LAS const f4*)(c.tab + 4608 + chn);
#pragma unroll
        for (int j = 0; j < 4; ++j) { const float r = sigmoidf_(ga[rb][j] + ba[j]), ii = sigmoidf_(gx[rb][j] + bx[j]);
            const float la = cl[j] * r, z = 1.3862943611198906f * la, av = __builtin_amdgcn_exp2f(la);
            const float om = (z > -0.0078125f) ? -z * (1.f + 0.5f * z) : __builtin_fmaf(-av, av, 1.f);
            LA[4 * rb + j] = la; AV[4 * rb + j] = av; B[4 * rb + j] = __builtin_amdgcn_sqrtf(om) * ii * xc[rb][j]; } }
}
__device__ __forceinline__ void scan_fwd(float (&A)[16], float (&B)[16]) {
#pragma unroll
    for (int k = 0; k < 16; ++k) { float a_ = A[k], b_ = B[k], ap, bp;
        ap = DPPF(1.f, a_, 0x111); bp = DPPF(0.f, b_, 0x111); b_ = a_ * bp + b_; a_ = a_ * ap;
        ap = DPPF(1.f, a_, 0x112); bp = DPPF(0.f, b_, 0x112); b_ = a_ * bp + b_; a_ = a_ * ap;
        ap = DPPF(1.f, a_, 0x114); bp = DPPF(0.f, b_, 0x114); b_ = a_ * bp + b_; a_ = a_ * ap;
        ap = DPPF(1.f, a_, 0x118); bp = DPPF(0.f, b_, 0x118); b_ = a_ * bp + b_; a_ = a_ * ap;
        A[k] = a_; B[k] = b_; }
}
__device__ __forceinline__ void scan_bwd(float (&A)[16], float (&B)[16]) {
#pragma unroll
    for (int k = 0; k < 16; ++k) { float a_ = A[k], b_ = B[k], ap, bp;
        ap = DPPF(1.f, a_, 0x101); bp = DPPF(0.f, b_, 0x101); b_ = a_ * bp + b_; a_ = a_ * ap;
        ap = DPPF(1.f, a_, 0x102); bp = DPPF(0.f, b_, 0x102); b_ = a_ * bp + b_; a_ = a_ * ap;
        ap = DPPF(1.f, a_, 0x104); bp = DPPF(0.f, b_, 0x104); b_ = a_ * bp + b_; a_ = a_ * ap;
        ap = DPPF(1.f, a_, 0x108); bp = DPPF(0.f, b_, 0x108); b_ = a_ * bp + b_; a_ = a_ * ap;
        A[k] = a_; B[k] = b_; }
}
#define DPPZ(src, ctrl) __builtin_bit_cast(float, __builtin_amdgcn_update_dpp(0, __builtin_bit_cast(int, (float)(src)), ctrl, 0xf, 0xf, true))
__device__ __forceinline__ float rowsum_fwd(float x) { x += DPPZ(x, 0x111); x += DPPZ(x, 0x112); x += DPPZ(x, 0x114); x += DPPZ(x, 0x118); return x; }
__device__ __forceinline__ float rowsum_bwd(float x) { x += DPPZ(x, 0x101); x += DPPZ(x, 0x102); x += DPPZ(x, 0x104); x += DPPZ(x, 0x108); return x; }
__device__ __forceinline__ void lru_tables(KA a, int l, LAS float* tab, int tid) {
    for (int e = tid; e < 5632; e += 512) { float v;
        if (e < 2048) v = a->in[9][l * 2048 + e];
        else if (e < 2560) v = a->in[10][l * 512 + (e - 2048)];
        else if (e < 3584) v = a->in[12][l * 1024 + (e - 2560)];
        else if (e < 4608) v = a->in[14][l * 1024 + (e - 3584)];
        else { const float lam = a->in[15][l * 1024 + (e - 4608)]; const float x = fexp(-lam); const float sp = x < 0.03f ? x * (1.f - x * (0.5f - x * (0.33333334f - x * 0.25f))) : (lam < -20.f ? -lam : __builtin_amdgcn_logf(1.f + x) * 0.6931471805599453f); v = -8.f * sp * 1.4426950408889634f; }
        tab[e] = v; }
}
__device__ __forceinline__ void lru_l1_tile(KA a, int l, int b, int cid, int dir, LAS unsigned char* lds, int tid, int wid, int lane) {
    asm volatile("" : "+v"(lane), "+v"(tid));
    unsigned char* ws = a->ws;
    LAS float* tab = (LAS float*)(lds + L1_TAB_OFF); LAS float* scr = (LAS float*)(lds + L1_TAB_OFF + 22528) + wid * (16 * 68);
    LruCtx c; c.n = wid; c.tok = lane & 15; c.q = lane >> 4; c.tab = tab; c.scr = scr;
    const bool isctx = cid < 4; c.p0 = (isctx ? cid : cid - 4) * 64; c.T = isctx ? CTXL : SEQL;
    const int rowbase = isctx ? MLAT + b * CTXL + c.p0 : b * SEQL + c.p0;
    c.XLp = (const bf16r*)(ws + WS_XL) + (size_t)rowbase * 512 + c.n * 64;
    c.GWn = (const bf16r*)(ws + WS_GW) + (size_t)(l * 4) * 8 * 4096 + c.n * 4096;
    float* AGGA = (float*)(ws + WS_AGGA); float* AGGB = (float*)(ws + WS_AGGB);
    unsigned* LAB = (unsigned*)(ws + WS_LAB) + (size_t)(rowbase >> 4) * 8192 + 1024 * c.n + 16 * c.tok + 4 * c.q;
    const int bl = (lane & 48) | 15, bf_ = (lane & 48);
    {
        LAS float* rab = (LAS float*)(lds + L1_TAB_OFF + 22528 + 34816) + wid * 128 + c.q * 32;
#pragma unroll
        for (int k = 0; k < 16; ++k) { rab[2 * k] = 1.f; rab[2 * k + 1] = 0.f; }
        s8v W[16];
        lru_wload(c, dir, W);
        u4 rawc[8];
        lru_conv_load(c, 0, rawc);
#pragma unroll 1
        for (int s = 0; s < 4; ++s) {
            s8v frag[2]; f4 xc[4];
            lru_conv(c, s, rawc, frag, xc);
            __builtin_amdgcn_sched_barrier(0);
            lru_conv_load(c, s < 3 ? s + 1 : 3, rawc);
            __builtin_amdgcn_sched_barrier(0);
            float LAv[16], A[16], B[16];
            lru_gates(c, dir, W, frag, xc, LAv, A, B);
            unsigned* lp = LAB + (size_t)dir * MALL * 512 + (size_t)s * 8192;
#pragma unroll
            for (int rb = 0; rb < 4; ++rb) { u4 w; w.x = pkh2(LAv[4 * rb], B[4 * rb]); w.y = pkh2(LAv[4 * rb + 1], B[4 * rb + 1]); w.z = pkh2(LAv[4 * rb + 2], B[4 * rb + 2]); w.w = pkh2(LAv[4 * rb + 3], B[4 * rb + 3]); *(u4*)(lp + 256 * rb) = w; }
            if (dir == 0) scan_fwd(A, B); else scan_bwd(A, B);
#pragma unroll
            for (int k = 0; k < 16; ++k) {
                const float a_ = __shfl(A[k], dir ? bf_ : bl), b_ = __shfl(B[k], dir ? bf_ : bl);
                const float ra = rab[2 * k], rb_ = rab[2 * k + 1];
                if (dir == 0) { rab[2 * k + 1] = a_ * rb_ + b_; rab[2 * k] = a_ * ra; }
                else { rab[2 * k + 1] = ra * b_ + rb_; rab[2 * k] = ra * a_; } }
            LDS_WAIT();
        }
        if (c.tok == 0) { const size_t o = ((size_t)(b * 2 + dir) * NCH + cid) * 512 + 64 * c.n + 4 * c.q;
#pragma unroll
            for (int rb = 0; rb < 4; ++rb) { *(f4*)(AGGA + o + 16 * rb) = (f4){rab[8 * rb], rab[8 * rb + 2], rab[8 * rb + 4], rab[8 * rb + 6]}; *(f4*)(AGGB + o + 16 * rb) = (f4){rab[8 * rb + 1], rab[8 * rb + 3], rab[8 * rb + 5], rab[8 * rb + 7]}; } }
    }
    LDS_WAIT(); __syncthreads();
}
__device__ __forceinline__ void lru_l2_tile(KA a, int l, int b, int cid, LAS unsigned char* lds, int tid, int wid, int lane) {
    asm volatile("" : "+v"(lane));
    unsigned char* ws = a->ws;
    LAS float* part = (LAS float*)lds;
    LAS float* hfl = (LAS float*)(lds + 4096) + wid * 4096 + lane;
    const int n = wid, tok = lane & 15, q = lane >> 4;
    const bool isctx = cid < 4; const int p0 = (isctx ? cid : cid - 4) * 64;
    const int rowbase = isctx ? MLAT + b * CTXL + p0 : b * SEQL + p0;
    const float* AGGA = (const float*)(ws + WS_AGGA); const float* AGGB = (const float*)(ws + WS_AGGB);
    const unsigned* LAB = (const unsigned*)(ws + WS_LAB) + (size_t)(rowbase >> 4) * 8192 + 1024 * n + 16 * tok + 4 * q;
    const bf16r* GGp = (const bf16r*)(ws + WS_GG) + (size_t)(rowbase >> 4) * 8192 + 1024 * n + 16 * tok + 4 * q;
    const int bl = (lane & 48) | 15, bf_ = (lane & 48);
    float hin[16], hinb[16], A[16], B[16];
#pragma unroll 1
    for (int dir = 0; dir < 2; ++dir) {
        const float* ap_ = AGGA + ((size_t)(b * 2 + dir) * NCH) * 512 + 64 * n + 4 * q; const float* bp_ = AGGB + ((size_t)(b * 2 + dir) * NCH) * 512 + 64 * n + 4 * q;
#pragma unroll
        for (int k = 0; k < 16; ++k) { A[k] = 1.f; B[k] = 0.f; }
#pragma unroll
        for (int eb = 0; eb < 5; eb += 3) {
            f4 avv[3][4], bvv[3][4]; bool okv[3];
#pragma unroll
            for (int e2 = 0; e2 < 3; ++e2) { if (eb + e2 < 5) { const int o = 5 * tok + eb + e2; int ch; bool ok;
                if (dir == 0) { ch = o; ok = o < cid; } else { ch = o < 4 ? 3 - o : 71 - o; ok = isctx ? (o < 4 && ch > cid) : (o < 4 || (o < 68 && ch > cid)); }
                ch = ch < 0 ? 0 : (ch > NCH - 1 ? NCH - 1 : ch); okv[e2] = ok;
#pragma unroll
                for (int rb = 0; rb < 4; ++rb) { avv[e2][rb] = *(const f4*)(ap_ + (size_t)ch * 512 + 16 * rb); bvv[e2][rb] = *(const f4*)(bp_ + (size_t)ch * 512 + 16 * rb); } } }
            __builtin_amdgcn_sched_barrier(0);
#pragma unroll
            for (int e2 = 0; e2 < 3; ++e2) { if (eb + e2 < 5) {
#pragma unroll
                for (int rb = 0; rb < 4; ++rb) { f4 av = avv[e2][rb], bv = bvv[e2][rb];
                    if (!okv[e2]) { av = (f4){1.f, 1.f, 1.f, 1.f}; bv = (f4){0.f, 0.f, 0.f, 0.f}; }
#pragma unroll
                    for (int jj = 0; jj < 4; ++jj) { B[4 * rb + jj] = av[jj] * B[4 * rb + jj] + bv[jj]; A[4 * rb + jj] = av[jj] * A[4 * rb + jj]; } } } }
            __builtin_amdgcn_sched_barrier(0);
        }
        scan_fwd(A, B);
        if (dir == 0) {
#pragma unroll
            for (int k = 0; k < 16; ++k) hin[k] = __shfl(B[k], bl);
        } else {
#pragma unroll
            for (int k = 0; k < 16; ++k) hinb[k] = __shfl(B[k], bl);
        }
    }
    u4 wc_[4], wn_[4]; u2 gc_[4], gn_[4];
#pragma unroll
    for (int rb = 0; rb < 4; ++rb) { wc_[rb] = *(const u4*)(LAB + 256 * rb); gc_[rb] = (u2){0u, 0u}; gn_[rb] = (u2){0u, 0u}; }
#pragma unroll 1
    for (int st = 0; st < 8; ++st) {
        const int s = st < 4 ? st : 7 - st;
        { const int sn = st + 1 < 8 ? st + 1 : 7; const int s2 = sn < 4 ? sn : 7 - sn; const bool bw = sn >= 4;
          const unsigned* lp_ = LAB + (size_t)(bw ? MALL : 0) * 512 + (size_t)s2 * 8192; const bf16r* gp_ = GGp + (size_t)s2 * 8192;
#pragma unroll
          for (int rb = 0; rb < 4; ++rb) { wn_[rb] = *(const u4*)(lp_ + 256 * rb); gn_[rb] = *(const u2*)(gp_ + 256 * rb); } }
        __builtin_amdgcn_sched_barrier(0);
#pragma unroll
        for (int rb = 0; rb < 4; ++rb)
#pragma unroll
            for (int j = 0; j < 4; ++j) { A[4 * rb + j] = h2lo(wc_[rb][j]); B[4 * rb + j] = h2hi(wc_[rb][j]); }
        LAS float* hs = hfl + s * 1024;
        if (st < 4) {
#pragma unroll
            for (int k = 0; k < 16; ++k) { const float L = rowsum_fwd(A[k]); const float P = __builtin_amdgcn_exp2f(L); const float C = rowsum_fwd(B[k] * __builtin_amdgcn_exp2f(-L)); A[k] = P; B[k] = P * C; }
#pragma unroll
            for (int k = 0; k < 16; ++k) { const float h = A[k] * hin[k] + B[k]; hs[k * 64] = h; hin[k] = __shfl(h, bl); }
        } else {
            if (st == 4) {
#pragma unroll
                for (int k = 0; k < 16; ++k) hin[k] = hinb[k]; }
#pragma unroll
            for (int k = 0; k < 16; ++k) { const float L = rowsum_bwd(A[k]); const float P = __builtin_amdgcn_exp2f(L); const float C = rowsum_bwd(B[k] * __builtin_amdgcn_exp2f(-L)); A[k] = P; B[k] = P * C; }
            float sq = 0.f;
#pragma unroll
            for (int rb = 0; rb < 4; ++rb)
#pragma unroll
                for (int j = 0; j < 4; ++j) { const int k = 4 * rb + j; const float h = A[k] * hin[k] + B[k]; hin[k] = __shfl(h, bf_);
                    const float gg = (j & 1) ? bf_hi(gc_[rb][j >> 1]) : bf_lo(gc_[rb][j >> 1]);
                    const float r = (hs[k * 64] + h) * gg; hs[k * 64] = r; sq += r * r; }
            sq += __shfl_xor(sq, 16); sq += __shfl_xor(sq, 32); if (q == 0) part[wid * 64 + 16 * s + tok] = sq;
        }
#pragma unroll
        for (int rb = 0; rb < 4; ++rb) { wc_[rb] = wn_[rb]; gc_[rb] = gn_[rb]; }
    }
    LDS_WAIT(); __syncthreads();
    bf16r* MIX = (bf16r*)(ws + WS_MIX);
#pragma unroll 1
    for (int s = 0; s < 4; ++s) { float t = 0.f;
#pragma unroll
        for (int w = 0; w < 8; ++w) t += part[w * 64 + 16 * s + tok];
        const float rstd = rsqrtf(t * (1.f / 512.f) + EPSN);
        bf16r* mp = MIX + (size_t)(rowbase + 16 * s + tok) * DM + 512 + 64 * n + 4 * q;
        const LAS float* hs = hfl + s * 1024;
#pragma unroll
        for (int rb = 0; rb < 4; ++rb) { u2 w; w.x = pk2(hs[(4 * rb) * 64] * rstd, hs[(4 * rb + 1) * 64] * rstd); w.y = pk2(hs[(4 * rb + 2) * 64] * rstd, hs[(4 * rb + 3) * 64] * rstd); *(u2*)(mp + 16 * rb) = w; } }
    const bf16r* O = (const bf16r*)(ws + WS_O) + (size_t)(rowbase + wid * 8) * 512 + 8 * lane;
    u4 rawc = *(const u4*)O;
#pragma unroll 1
    for (int tt = 0; tt < 8; ++tt) {
        const u4 rawn = *(const u4*)(O + (size_t)(tt < 7 ? tt + 1 : 7) * 512);
        float v[8]; float ss = 0.f;
#pragma unroll
        for (int e = 0; e < 4; ++e) { v[2 * e] = bf_lo(rawc[e]); v[2 * e + 1] = bf_hi(rawc[e]); ss += v[2 * e] * v[2 * e] + v[2 * e + 1] * v[2 * e + 1]; }
        const float rstd = rsqrtf(wave_sum(ss) * (1.f / 512.f) + EPSN);
        u4 o; o.x = pk2(v[0] * rstd, v[1] * rstd); o.y = pk2(v[2] * rstd, v[3] * rstd); o.z = pk2(v[4] * rstd, v[5] * rstd); o.w = pk2(v[6] * rstd, v[7] * rstd);
        *(u4*)(MIX + (size_t)(rowbase + wid * 8 + tt) * DM + 8 * lane) = o;
        rawc = rawn; }
    LDS_WAIT(); __syncthreads();
}

#define GAS __attribute__((address_space(1)))
#define XB_TMO      128
#define XB_XCNT(j)  (256  + 64 * (j))
#define XB_XSUB(j)  (1280 + 64 * (j))
#define XB_XGEN(j)  (2304 + 64 * (j))
#define XB_TOP      3328
#define XB_TOPGEN   3392
#define XCD_BAR_WORDS 3456
#define XB_SPIN_CAP (1u << 18)

__device__ __forceinline__ unsigned xb_ld(unsigned* p)              { return __hip_atomic_load(p, __ATOMIC_RELAXED, __HIP_MEMORY_SCOPE_AGENT); }
__device__ __forceinline__ unsigned xb_add(unsigned* p, unsigned v) { return __hip_atomic_fetch_add(p, v, __ATOMIC_RELAXED, __HIP_MEMORY_SCOPE_AGENT); }
__device__ __forceinline__ unsigned xb_xcc_id() { return (unsigned)__builtin_amdgcn_s_getreg((3 << 11) | 20) & 0xFu; }
#define XB_SPIN(cond, bar) do { unsigned _sp = 0; while (cond) { __builtin_amdgcn_s_sleep(1); \
    if ((++_sp & 255u) == 0u) { if (xb_ld(&(bar)[XB_TMO])) break; if (_sp > XB_SPIN_CAP) { atomicAdd(&(bar)[XB_TMO], 1u); break; } } } } while (0)

struct XcdBarrier {
    unsigned* bar; unsigned x;
    volatile LAS unsigned* st;
};

__device__ __forceinline__ XcdBarrier xcd_barrier_post(unsigned* bar, volatile LAS unsigned* st) {
    XcdBarrier b; b.bar = bar; b.x = xb_xcc_id(); b.st = st;
    if (threadIdx.x == 0) (void)xb_add(&bar[XB_XCNT(b.x)], 1u);
    return b;
}
__device__ __forceinline__ void xcd_barrier_complete(unsigned* bar, unsigned x, unsigned& nloc, unsigned& nx) {
    const unsigned G = gridDim.x * gridDim.y * gridDim.z;
    unsigned sum, cnt, mine, sp = 0u;
    for (;;) {
        sum = 0u; cnt = 0u; mine = 0u;
#pragma unroll
        for (unsigned j = 0; j < 16; ++j) { const unsigned c = xb_ld(&bar[XB_XCNT(j)]); sum += c; cnt += (c > 0u) ? 1u : 0u; mine = (j == x) ? c : mine; }
        if (sum == G) break;
        __builtin_amdgcn_s_sleep(1);
        if ((++sp & 255u) == 0u) { if (xb_ld(&bar[XB_TMO])) break; if (sp > XB_SPIN_CAP) { atomicAdd(&bar[XB_TMO], 1u); break; } }
    }
    nloc = mine > 0u ? mine : 1u; nx = cnt > 0u ? cnt : 1u;
}

__device__ __forceinline__ void xcd_barrier(const XcdBarrier& b) {
    asm volatile("s_waitcnt vmcnt(0)" ::: "memory");
    __syncthreads();
    if (threadIdx.x == 0) {
        unsigned* bar = b.bar;
        __builtin_amdgcn_s_waitcnt(0);
        unsigned nloc = b.st[0], nx = b.st[1];
        if (nloc == 0u) { xcd_barrier_complete(bar, b.x, nloc, nx); b.st[0] = nloc; b.st[1] = nx; }
        const unsigned old = xb_add(&bar[XB_XSUB(b.x)], 1u);
        const unsigned gen = old / nloc;
        if (old + 1u == (gen + 1u) * nloc) {
            __builtin_amdgcn_fence(__ATOMIC_RELEASE, "agent");
            asm volatile("s_waitcnt vmcnt(0)" ::: "memory");
            const unsigned og = xb_add(&bar[XB_TOP], 1u);
            const unsigned tg = og / nx;
            if (og + 1u == (tg + 1u) * nx) xb_add(&bar[XB_TOPGEN], 1u);
            else XB_SPIN(xb_ld(&bar[XB_TOPGEN]) == tg, bar);
            __builtin_amdgcn_fence(__ATOMIC_ACQUIRE, "agent");
            xb_add(&bar[XB_XGEN(b.x)], 1u);
            asm volatile("s_waitcnt vmcnt(0)" ::: "memory");
        } else {
            XB_SPIN(xb_ld(&bar[XB_XGEN(b.x)]) == gen, bar);
            __builtin_amdgcn_fence(__ATOMIC_ACQUIRE, "agent");
            asm volatile("s_waitcnt vmcnt(0)" ::: "memory");
        }
    }
    __syncthreads();
}

#ifndef REP_PH
#define REP_PH -1
#endif
#ifndef REP_SKIP_L1
#define REP_SKIP_L1 0
#endif
#ifndef USE_XBAR
#define USE_XBAR 1
#endif
__global__ void __launch_bounds__(512, 2) mega(Args a_) {
    extern __shared__ __attribute__((aligned(16))) unsigned char lds_raw[];
    LAS unsigned char* lds = (LAS unsigned char*)lds_raw;
    const int G = gridDim.x, bx = blockIdx.x;
    const int vcu = (G % 8 == 0) ? (bx % 8) * (G / 8) + bx / 8 : bx;
    KA a = (KA)__builtin_amdgcn_kernarg_segment_ptr();
    volatile LAS unsigned* bst = (volatile LAS unsigned*)(lds + LDS_BYTES - 64);
    if (threadIdx.x < 2) bst[threadIdx.x] = 0u;
    __syncthreads();
    (void)xcd_barrier_post((unsigned*)a->ws, bst);
    int nsync = 0;
#define GRID_SYNC() do { if (!USE_XBAR || a->ph_lo < 0) cg::this_grid().sync();     else { XcdBarrier xb_; xb_.bar = (unsigned*)a->ws; xb_.x = xb_xcc_id(); xb_.st = (volatile LAS unsigned*)(lds + LDS_BYTES - 64); xcd_barrier(xb_); } ++nsync; } while (0)
    const int ph_hi = a->ph_hi;
    for (int ph = a->ph_lo; ph < ph_hi; ++ph) {
        asm volatile("" : "+s"(a));
        for (int rep = 0; rep < (ph == REP_PH ? 2 : 1); ++rep) {
        if (rep) GRID_SYNC();
#define TL const int tid = mk_tid(), lane = tid & 63, wid = __builtin_amdgcn_readfirstlane(tid >> 6); (void)tid; (void)lane; (void)wid
        unsigned char* ws = a->ws;
        float* MOD = (float*)(ws + WS_MOD); float* ctxres = (float*)(ws + WS_CTXRES);
        bf16r* HN = (bf16r*)(ws + WS_HN);
        if (ph == 0) { if (PON(8)) { TL; p0_phase(a, lds, tid, wid, lane, G); } }
        else if (ph == NPHASE - 1) { if (PON(9)) { TL; finalnorm_phase(a, wid, lane, G); } }
        else {
            const int l = (ph - 1) >> 3, sub = (ph - 1) & 7;
            unsigned char* wl = ws + WS_W + (size_t)l * W_LAYER;
            const bool ctx_out = l == 0;
            if (sub == 0) { if (PON(0)) { TL; prenorm_phase(a, l, 0, MALL, l == 0 ? 0 : 11, l == 0 ? a->in[2] : ctxres, wid, lane, G); } }
            else if (sub == 1) { if (PON(1)) {
                pg8::Gemm g{HN, (const bf16r*)(wl + W_IN), MALL, DIN, DM, 256, DM}; pg8::StaticOrder S; S.init(MALL, DIN, G, bx);
                EpiWin E{ws, a->in[7] + l * 64, a->in[8] + l * 64};
                pg8::gemm_phase<EpiWin, pg8::StaticOrder, true, true>(lds, g, S, E); }
            } else if (sub == 2) { if (PON(2)) { TL;
                const int nctx = ctx_out ? 4 : 0, cnt = 64 + nctx + ((rep && REP_SKIP_L1) ? 0 : 68);
                attn_body::bf16* Qb = (attn_body::bf16*)(ws + WS_Q); attn_body::bf16* Ob = (attn_body::bf16*)(ws + WS_O); const attn_body::bf16* Kb = (const attn_body::bf16*)(ws + WS_K); const attn_body::bf16* Vb = (const attn_body::bf16*)(ws + WS_V);
                LAS unsigned char* l3 = lds; asm volatile("" : "+s"(l3)); char* shm = (char*)l3;
                volatile LAS int* qw = (volatile LAS int*)(lds + LDS_BYTES - 32);
                unsigned* qctr = (unsigned*)ws + 3584 + (l * 2 + rep) * 8 * 64;
                const int hx = (int)(xb_xcc_id() & 7u);
                lru_tables(a, l, (LAS float*)(lds + L1_TAB_OFF), tid); __syncthreads();
                for (int li = 0; li < 8; ++li) { const int x = (hx + li) & 7; const int b = x >> 1, kvh = x & 1;
                    for (;;) {
                        __syncthreads();
                        if (tid == 0) *qw = (int)__hip_atomic_fetch_add(qctr + x * 64, 1u, __ATOMIC_RELAXED, __HIP_MEMORY_SCOPE_AGENT);
                        __syncthreads();
                        const int i = __builtin_amdgcn_readfirstlane(*qw);
                        if (i >= cnt) break;
                        if (i < 64 + nctx) {
                            const bool lat = i < 64; const int h = kvh * 4 + (lat ? (i >> 4) : (i - 64));
                            const size_t qo = (size_t)(lat ? b * SEQL + (i & 15) * 256 : MLAT + b * CTXL) * 512 + h * 64;
                            attn_body::attn_unit<8>(Qb + qo, Kb + (size_t)b * KVR * 128 + kvh * 64, Vb + (size_t)b * KVR * 128 + kvh * 64, Ob + qo, lat ? NCH : 4, shm);
                        } else { const int it = i - 64 - nctx, t = x * 34 + (it >> 1); lru_l1_tile(a, l, t / NCH, t % NCH, it & 1, lds, tid, wid, lane); }
                    }
                } }
            } else if (sub == 3) { if (PON(3)) { TL;
                const int nt = ctx_out ? 4 * NCH : 4 * 64;
                for (int t = vcu; t < nt; t += G) { int b, cid; if (ctx_out) { b = t / NCH; cid = t % NCH; } else { b = t >> 6; cid = 4 + (t & 63); }
                    lru_l2_tile(a, l, b, cid, lds, tid, wid, lane); } }
            } else if (sub == 4) { if (PON(4)) {
                { pg8::Gemm g{(const bf16r*)(ws + WS_MIX), (const bf16r*)(wl + W_OUT), MLAT, DM, DM, 256, DM}; pg8::StaticOrder S; S.init(MLAT, DM, G, bx);
                  EpiRes E{l == 0 ? a->in[0] : a->out, l == 0 ? a->in[2] : ctxres, a->out, ctxres, MOD + l * 5 * 6144 + 2 * 1024};
                  pg8::gemm_phase<EpiRes, pg8::StaticOrder, true, true>(lds, g, S, E); }
                if (ctx_out) {
                    pg8::Gemm g{(const bf16r*)(ws + WS_MIX), (const bf16r*)(wl + W_OUT), MALL, DM, 256, 256, DM}; SplitOrder S{64, 4, 256, G, bx};
                    EpiPart E{(float*)(ws + WS_PART), MOD + l * 5 * 6144 + 2 * 1024, 256};
                    pg8::gemm_phase<EpiPart, SplitOrder, true, true>(lds, g, S, E); } }
            } else if (sub == 5) { if (PON(5)) { TL; prenorm_phase(a, l, 1, ctx_out ? MALL : MLAT, ctx_out ? 4 : 0, ctx_out ? a->in[2] : ctxres, wid, lane, G); } }
            else if (sub == 6) { if (PON(6)) {
                const int mrows = ctx_out ? MALL : MLAT, nM = (mrows + 253) / 254;
                pg8::Gemm g{HN - DM, (const bf16r*)(wl + W_UP), nM * 256, DFF2, DM, 254, DM}; pg8::StaticOrder S; S.init(nM * 256, DFF2, G, bx);
                EpiUpConv E{(bf16r*)(ws + WS_ACT), a->in[20] + (size_t)l * 3 * DFF2, a->in[21] + (size_t)l * DFF2, mrows};
                for (int i = 0;; ++i) { pg8::Unit u; if (!S.next(i, u)) break; OneUnit S1{u}; pg8::gemm_phase<EpiUpConv, OneUnit, false, true>(lds, g, S1, E); } }
            } else { if (PON(7)) {
                { pg8::Gemm g{(const bf16r*)(ws + WS_ACT), (const bf16r*)(wl + W_DOWN), MLAT, DM, DFF, 256, DFF}; pg8::StaticOrder S; S.init(MLAT, DM, G, bx);
                  EpiRes E{a->out, ctxres, a->out, ctxres, MOD + l * 5 * 6144 + 5 * 1024};
                  pg8::gemm_phase<EpiRes, pg8::StaticOrder, true, true>(lds, g, S, E); }
                if (ctx_out) {
                    pg8::Gemm g{(const bf16r*)(ws + WS_ACT), (const bf16r*)(wl + W_DOWN), MALL, DM, 256, 256, DFF}; SplitOrder S{176, 11, 256, G, bx};
                    EpiPart E{(float*)(ws + WS_PART), MOD + l * 5 * 6144 + 5 * 1024, 256};
                    pg8::gemm_phase<EpiPart, SplitOrder, true, true>(lds, g, S, E); } }
            }
        }
        }
        if (ph + 1 < ph_hi) GRID_SYNC();
    }
}

extern "C" void kernel_launch(void* const* d_in, const int* in_sizes, int n_in, void* d_out, int out_size, void* d_ws, size_t ws_size, hipStream_t stream) {
    static int grid = 0;
    if (grid == 0) {
        int dev = 0, cus = 0, per_cu = 0;
        if (n_in != 24 || ws_size < 255 * MiB) { fprintf(stderr, "kernel_launch: unexpected n_in %d / ws %zu\n", n_in, ws_size); grid = -1; return; }
        hipGetDevice(&dev); hipDeviceGetAttribute(&cus, hipDeviceAttributeMultiprocessorCount, dev);
        if (hipFuncSetAttribute((const void*)mega, hipFuncAttributeMaxDynamicSharedMemorySize, LDS_BYTES) != hipSuccess) { fprintf(stderr, "kernel_launch: hipFuncSetAttribute failed\n"); grid = -1; return; }
        if (hipOccupancyMaxActiveBlocksPerMultiprocessor(&per_cu, (const void*)mega, 512, LDS_BYTES) != hipSuccess || per_cu < 1) { fprintf(stderr, "kernel_launch: occupancy query says %d\n", per_cu); per_cu = 1; }
        (void)hipGetLastError();
        grid = cus;
    }
    if (grid < 0) return;
    if (hipMemsetAsync(d_ws, 0, 32768, stream) != hipSuccess) { fprintf(stderr, "kernel_launch: memset failed\n"); return; }
    Args a{};
    for (int i = 0; i < 24; ++i) a.in[i] = (const float*)d_in[i];
    a.out = (float*)d_out; a.ws = (unsigned char*)d_ws;
#if MK_MULTI
    for (int ph = 0; ph < NPHASE; ++ph) { a.ph_lo = ph; a.ph_hi = ph + 1; hipLaunchKernelGGL(mega, dim3(grid), dim3(512), LDS_BYTES, stream, a); }
#else
    a.ph_lo = 0; a.ph_hi = NPHASE;
    void* args[] = {&a};
    hipError_t e = hipLaunchCooperativeKernel((const void*)mega, dim3(grid), dim3(512), args, LDS_BYTES, stream);
    if (e != hipSuccess) fprintf(stderr, "cooperative launch failed: %s (grid %d)\n", hipGetErrorString(e), grid);
#endif
}
```

```cpp
#include <hip/hip_runtime.h>
#include <hip/hip_cooperative_groups.h>
#include <cstdio>
#include <cstdint>
namespace cg = cooperative_groups;
#ifndef MK_MULTI
#define MK_MULTI 0
#endif
__device__ __forceinline__ int mk_tid() { int t = threadIdx.x; asm volatile("" : "+v"(t)); return t; }
namespace pg8 {
#define PG8_LAS __attribute__((address_space(3)))
typedef unsigned short bf16_t;
typedef short bf16x8 __attribute__((ext_vector_type(8)));
typedef float f32x4 __attribute__((ext_vector_type(4)));
typedef unsigned u32x4 __attribute__((ext_vector_type(4)));
constexpr int BM = 256, BK = 64, HALF = 128, HTB = HALF * BK * 2  , STAGE_BYTES = 8 * HTB, NXCD = 8, WGM = 8;

__host__ __device__ __forceinline__ int lds_byte(int r, int c) { const int st = (r >> 4) * 2 + (c >> 5), rr = r & 15, cc = c & 31, ob = rr * 64 + cc * 2; return st * 1024 + (ob ^ (((ob >> 9) & 1) << 5)); }
__host__ __device__ __forceinline__ void stage_rc(int b, int& R, int& C) { const int st = b / 1024, sb = b % 1024, swz = sb ^ (((sb >> 9) & 1) << 5); R = (st >> 1) * 16 + swz / 64; C = (st & 1) * 32 + (swz % 64) / 2; }
__host__ __device__ __forceinline__ int perm32(int rho) { const int n = rho >> 4, i = rho & 15; return 8 * (i >> 2) + 4 * n + (i & 3); }

struct Unit { int pm, pn, koff; };
struct Gemm { const bf16_t* A; const bf16_t* Bt; int M, N, K; int a_rows; int ldk; };

struct StaticOrder {
    int nM, nN, nwg, G, c;
    __host__ __device__ void init(int M, int N, int G_, int c_) { nM = M / BM; nN = N / BM; nwg = nM * nN; G = G_; c = c_; }
    __host__ __device__ bool next(int i, Unit& u) const {
        const long L = (long)i * G + c; if (L >= nwg) return false;
        int wgid = (int)L; { const int q = nwg / NXCD, r = nwg % NXCD, xcd = wgid % NXCD, off = wgid / NXCD; wgid = (xcd < r ? xcd * (q + 1) : r * (q + 1) + (xcd - r) * q) + off; }
        const int nig = WGM * nN, gid = wgid / nig, fm = gid * WGM, gsz = (nM - fm) < WGM ? (nM - fm) : WGM;
        u.pm = fm + ((wgid % nig) % gsz); u.pn = (wgid % nig) / gsz; u.koff = 0; return true;
    }
    __device__ __forceinline__ void a_ready(const Unit&) const {}
    __device__ __forceinline__ void done(const Unit&) const {}
};

__device__ __forceinline__ unsigned cvt_pk_bf16(float lo, float hi) { unsigned r; asm volatile("v_cvt_pk_bf16_f32 %0, %1, %2" : "=v"(r) : "v"(lo), "v"(hi)); return r; }
typedef float f32x2 __attribute__((ext_vector_type(2)));
__device__ __forceinline__ f32x2 gelu_pk(f32x2 v) {
    const f32x2 av = __builtin_elementwise_abs(v), d = av * 0.2316418882f + 1.0f;
    f32x2 t; t.x = __builtin_amdgcn_rcpf(d.x); t.y = __builtin_amdgcn_rcpf(d.y);
    f32x2 q = t * 0.5307027145f + (-0.7265760135f); q = q * t + 0.7107068705f; q = q * t + (-0.142248368f); q = q * t + 0.127414796f; q = q * t;
    const f32x2 s = (v * v) * (-0.72134752044f);
    f32x2 e; e.x = __builtin_amdgcn_exp2f(s.x); e.y = __builtin_amdgcn_exp2f(s.y);
    const f32x2 m = v * (q * e), r = v - m;
    f32x2 o; o.x = v.x < 0.f ? m.x : r.x; o.y = v.y < 0.f ? m.y : r.y; return o;
}

template <int ACT  > struct EpiBf16 {
    static constexpr bool PERM = true, AFTER_DRAIN = false; static_assert(ACT == 0 || ACT == 1, "EpiBf16: ACT is 0 (none) or 1 (gelu_pk)");
    bf16_t* O; int ldc; const float* bias; int split_cols; size_t split_stride; float scale0;
    __device__ __forceinline__ void operator()(const f32x4 (&acc)[2][2][4][2], const Unit& u, int wr, int wc, int fr, int fq) const {
        const int row0 = u.pm * BM + wr * 64 + fr; int colt = u.pn * BM; bf16_t* base = O;
        float sc = 1.f; if (split_cols) { const int t = colt / split_cols; base += (size_t)t * split_stride; colt -= t * split_cols; if (t == 0) sc = scale0; }
        const int col0 = colt + wc * 32 + 8 * fq, bcol0 = u.pn * BM + wc * 32 + 8 * fq;
        f32x4 bv[2][2];
#pragma unroll
        for (int bj = 0; bj < 2; ++bj)
#pragma unroll
            for (int n = 0; n < 2; ++n) bv[bj][n] = bias ? *(const f32x4*)(bias + bcol0 + bj * HALF + 4 * n) : (f32x4){0.f, 0.f, 0.f, 0.f};
#pragma unroll
        for (int ai = 0; ai < 2; ++ai)
#pragma unroll
            for (int m = 0; m < 4; ++m) { bf16_t* rowp = base + (size_t)(row0 + ai * HALF + m * 16) * ldc + col0;
#pragma unroll
                for (int bj = 0; bj < 2; ++bj) { f32x4 v0 = acc[ai][bj][m][0] + bv[bj][0], v1 = acc[ai][bj][m][1] + bv[bj][1];
                    if (ACT == 1) { f32x2 a = gelu_pk((f32x2){v0[0], v0[1]}), b = gelu_pk((f32x2){v0[2], v0[3]}), c = gelu_pk((f32x2){v1[0], v1[1]}), d = gelu_pk((f32x2){v1[2], v1[3]});
                        v0 = (f32x4){a.x, a.y, b.x, b.y}; v1 = (f32x4){c.x, c.y, d.x, d.y}; }
                    v0 = v0 * sc; v1 = v1 * sc; u32x4 w; w.x = cvt_pk_bf16(v0[0], v0[1]); w.y = cvt_pk_bf16(v0[2], v0[3]); w.z = cvt_pk_bf16(v1[0], v1[1]); w.w = cvt_pk_bf16(v1[2], v1[3]);
                    *(u32x4*)(rowp + bj * HALF) = w; } }
    }
};

template <class Epi, class Sched, bool ALIGN_EPI = false, bool SP2 = false>
__device__ __forceinline__ void gemm_phase(PG8_LAS unsigned char* lds, const Gemm g, const Sched& S, const Epi& E) {
    const int tid = mk_tid(), wid = __builtin_amdgcn_readfirstlane(tid >> 6), lane = tid & 63, wr = wid >> 2, wc = wid & 3, fr = lane & 15, fq = lane >> 4;
    const int K = g.K, nt = K / BK;
    unsigned voffA[2], voffB[2];
#pragma unroll
    for (int i = 0; i < 2; ++i) { int R, C; stage_rc(tid * 16 + i * 8192, R, C); const int Rb = Epi::PERM ? ((R & ~31) + perm32(R & 31)) : R;
        voffA[i] = (unsigned)(R * g.ldk + C) * 2u; voffB[i] = (unsigned)(Rb * g.ldk + C) * 2u; }
    const size_t kstep = (size_t)(BK * 2);
    const size_t hstep = (size_t)HALF * g.ldk * 2;
    const size_t tstep = 2 * hstep;
    const unsigned ldsw = (unsigned)wid * 1024u;
    const int aoff = lds_byte(wr * 64 + fr, fq * 8), boff = lds_byte(wc * 32 + fr, fq * 8);
#define PG8_SA(b, h) (((b) * 2 + (h)) * HTB)
#define PG8_SB(b, h) ((4 + (b) * 2 + (h)) * HTB)
#define PG8_STAGE(bufoff, gbase, voff) do { _Pragma("unroll") for (int _i = 0; _i < 2; ++_i) \
        __builtin_amdgcn_global_load_lds((const unsigned*)((const char*)(gbase) + (voff)[_i]), (PG8_LAS unsigned*)(lds + (bufoff) + ldsw + _i * 8192), 16, 0, 0); } while (0)
#define PG8_LDA(dst, b, h) do { _Pragma("unroll") for (int m = 0; m < 4; ++m) _Pragma("unroll") for (int k = 0; k < 2; ++k) dst[m][k] = *(const PG8_LAS bf16x8*)(lds + PG8_SA(b, h) + aoff + m * 2048 + k * 1024); } while (0)
#define PG8_LDB(dst, b, h) do { _Pragma("unroll") for (int n = 0; n < 2; ++n) _Pragma("unroll") for (int k = 0; k < 2; ++k) dst[n][k] = *(const PG8_LAS bf16x8*)(lds + PG8_SB(b, h) + boff + n * 2048 + k * 1024); } while (0)
#define PG8_MMA(ai, bj, At, Bt) do { __builtin_amdgcn_s_setprio(1); _Pragma("unroll") for (int m = 0; m < 4; ++m) _Pragma("unroll") for (int n = 0; n < 2; ++n) _Pragma("unroll") for (int k = 0; k < 2; ++k) \
        acc[ai][bj][m][n] = __builtin_amdgcn_mfma_f32_16x16x32_bf16(Bt[n][k], At[m][k], acc[ai][bj][m][n], 0, 0, 0); __builtin_amdgcn_s_setprio(0); } while (0)
#define PG8_WAIT_V(n) asm volatile("s_waitcnt vmcnt(" #n ")" ::: "memory")
#define PG8_WAIT_L(n) asm volatile("s_waitcnt lgkmcnt(" #n ")" ::: "memory")
#define PG8_BAR __builtin_amdgcn_s_barrier()
#define PG8_SCHED __builtin_amdgcn_sched_barrier(0)
    Unit cur, nxt; int ui = 0;
    if (!S.next(0, cur)) return;
    f32x4 acc[2][2][4][2];
#pragma unroll
    for (int a = 0; a < 2; ++a)
#pragma unroll
        for (int b = 0; b < 2; ++b)
#pragma unroll
            for (int m = 0; m < 4; ++m)
#pragma unroll
                for (int n = 0; n < 2; ++n) acc[a][b][m][n] = (f32x4){0.f, 0.f, 0.f, 0.f};
    bf16x8 At[4][2], B0[2][2], B1[2][2];
    const size_t atstep = (size_t)g.a_rows * g.ldk * 2; const char* cA = (const char*)g.A + (size_t)cur.pm * atstep + (size_t)cur.koff * 2; const char* cB = (const char*)g.Bt + (size_t)cur.pn * tstep + (size_t)cur.koff * 2;
    S.a_ready(cur);
    if constexpr (SP2) {
        PG8_STAGE(PG8_SB(0, 0), cB, voffB); PG8_STAGE(PG8_SB(0, 1), cB + hstep, voffB); PG8_STAGE(PG8_SA(0, 0), cA, voffA); PG8_STAGE(PG8_SA(0, 1), cA + hstep, voffA);
        if (wr == 1) PG8_BAR;
        PG8_WAIT_V(2); PG8_BAR;
        PG8_STAGE(PG8_SB(1, 0), cB + kstep, voffB); PG8_STAGE(PG8_SA(1, 0), cA + kstep, voffA); PG8_STAGE(PG8_SB(1, 1), cB + hstep + kstep, voffB);
        PG8_WAIT_V(6); PG8_BAR;
    } else {
        PG8_STAGE(PG8_SB(0, 0), cB, voffB); PG8_STAGE(PG8_SA(0, 0), cA, voffA); PG8_STAGE(PG8_SB(0, 1), cB + hstep, voffB); PG8_STAGE(PG8_SA(0, 1), cA + hstep, voffA);
        if (wr == 1) PG8_BAR;
        PG8_WAIT_V(4); PG8_BAR;
        PG8_STAGE(PG8_SB(1, 0), cB + kstep, voffB); PG8_STAGE(PG8_SA(1, 0), cA + kstep, voffA); PG8_STAGE(PG8_SB(1, 1), cB + hstep + kstep, voffB);
        PG8_WAIT_V(6); PG8_BAR;
    }
    for (;;) {
        const bool has_next = S.next(ui + 1, nxt);
        const char* nA = has_next ? (const char*)g.A + (size_t)nxt.pm * atstep + (size_t)nxt.koff * 2 : cA; const char* nB = has_next ? (const char*)g.Bt + (size_t)nxt.pn * tstep + (size_t)nxt.koff * 2 : cB;
        for (int t = 0; t < nt; t += 2) {
            const bool last = (t == nt - 2);
            const char* a1 = cA + (size_t)(t + 1) * kstep;
            const char* a2 = last ? nA : cA + (size_t)(t + 2) * kstep; const char* b2 = last ? nB : cB + (size_t)(t + 2) * kstep;
            const char* a3 = a2 + kstep; const char* b3 = b2 + kstep;
            if (last && has_next) S.a_ready(nxt);
            if constexpr (SP2) {
            PG8_LDB(B0, 0, 0); PG8_LDB(B1, 0, 1); PG8_SCHED; PG8_LDA(At, 0, 0); PG8_STAGE(PG8_SA(1, 1), a1 + hstep, voffA);
            PG8_WAIT_V(8); PG8_WAIT_L(0); PG8_BAR; PG8_MMA(0, 0, At, B0); PG8_MMA(0, 1, At, B1); PG8_BAR; PG8_SCHED;
            PG8_LDA(At, 0, 1); PG8_STAGE(PG8_SB(0, 0), b2, voffB); PG8_STAGE(PG8_SB(0, 1), b2 + hstep, voffB); PG8_STAGE(PG8_SA(0, 0), a2, voffA);
            PG8_WAIT_V(8); PG8_WAIT_L(0); PG8_BAR; PG8_MMA(1, 0, At, B0); PG8_MMA(1, 1, At, B1); PG8_BAR; PG8_SCHED;
            PG8_LDB(B0, 1, 0); PG8_LDB(B1, 1, 1); PG8_SCHED; PG8_LDA(At, 1, 0); PG8_STAGE(PG8_SA(0, 1), a2 + hstep, voffA);
            PG8_WAIT_V(8); PG8_WAIT_L(0); PG8_BAR; PG8_MMA(0, 0, At, B0); PG8_MMA(0, 1, At, B1); PG8_BAR; PG8_SCHED;
            PG8_LDA(At, 1, 1); PG8_STAGE(PG8_SB(1, 0), b3, voffB); PG8_STAGE(PG8_SB(1, 1), b3 + hstep, voffB); PG8_STAGE(PG8_SA(1, 0), a3, voffA);
            PG8_WAIT_V(8); PG8_WAIT_L(0); PG8_BAR; PG8_MMA(1, 0, At, B0); PG8_MMA(1, 1, At, B1); PG8_BAR; PG8_SCHED;
            } else {
            PG8_LDB(B0, 0, 0); PG8_SCHED; PG8_LDA(At, 0, 0); PG8_STAGE(PG8_SA(1, 1), a1 + hstep, voffA);
            PG8_WAIT_L(8); PG8_BAR; PG8_WAIT_L(0); PG8_MMA(0, 0, At, B0); PG8_BAR; PG8_SCHED;
            PG8_LDB(B1, 0, 1); PG8_STAGE(PG8_SB(0, 0), b2, voffB);
            PG8_BAR; PG8_WAIT_L(0); PG8_MMA(0, 1, At, B1); PG8_BAR;
            PG8_LDA(At, 0, 1); PG8_STAGE(PG8_SA(0, 0), a2, voffA);
            PG8_BAR; PG8_WAIT_L(0); PG8_MMA(1, 0, At, B0); PG8_BAR; PG8_SCHED;
            PG8_STAGE(PG8_SB(0, 1), b2 + hstep, voffB);
            PG8_WAIT_V(6); PG8_BAR; PG8_MMA(1, 1, At, B1); PG8_BAR;
            PG8_LDB(B0, 1, 0); PG8_SCHED; PG8_LDA(At, 1, 0); PG8_STAGE(PG8_SA(0, 1), a2 + hstep, voffA);
            PG8_WAIT_L(8); PG8_BAR; PG8_WAIT_L(0); PG8_MMA(0, 0, At, B0); PG8_BAR; PG8_SCHED;
            PG8_LDB(B1, 1, 1); PG8_STAGE(PG8_SB(1, 0), b3, voffB);
            PG8_BAR; PG8_WAIT_L(0); PG8_MMA(0, 1, At, B1); PG8_BAR;
            PG8_LDA(At, 1, 1); PG8_STAGE(PG8_SA(1, 0), a3, voffA);
            PG8_BAR; PG8_WAIT_L(0); PG8_MMA(1, 0, At, B0); PG8_BAR; PG8_SCHED;
            PG8_STAGE(PG8_SB(1, 1), b3 + hstep, voffB);
            PG8_WAIT_V(6); PG8_BAR; PG8_MMA(1, 1, At, B1); PG8_BAR;
            }
        }
        if constexpr (ALIGN_EPI) { if (wr == 0) PG8_BAR; }
        if constexpr (!Epi::AFTER_DRAIN) { const int l2_ = mk_tid() & 63; E(acc, cur, wr, wc, l2_ & 15, l2_ >> 4); S.done(cur); }
        if (!has_next) break;
#pragma unroll
        for (int a = 0; a < 2; ++a)
#pragma unroll
            for (int b = 0; b < 2; ++b)
#pragma unroll
                for (int m = 0; m < 4; ++m)
#pragma unroll
                    for (int n = 0; n < 2; ++n) acc[a][b][m][n] = (f32x4){0.f, 0.f, 0.f, 0.f};
        cur = nxt; cA = nA; cB = nB; ++ui;
        if constexpr (ALIGN_EPI) { if (wr == 1) PG8_BAR; }
    }
    PG8_WAIT_V(0);
    if constexpr (!ALIGN_EPI) { if (wr == 0) PG8_BAR; }
    PG8_BAR;
    if constexpr (Epi::AFTER_DRAIN) { const int l2_ = mk_tid() & 63; E.fused(acc, cur, wr, wc, l2_ & 15, l2_ >> 4, lds, wid, l2_); S.done(cur); }
#undef PG8_SA
#undef PG8_SB
#undef PG8_STAGE
#undef PG8_LDA
#undef PG8_LDB
#undef PG8_MMA
#undef PG8_WAIT_V
#undef PG8_WAIT_L
#undef PG8_BAR
#undef PG8_SCHED
}
}

#include <hip/hip_bf16.h>
#include <cmath>
namespace attn_body {
using bf16=__hip_bfloat16;
using bf16x8=__attribute__((ext_vector_type(8)))short;
using s16x4=__attribute__((ext_vector_type(4)))short;
using f32x16=__attribute__((ext_vector_type(16)))float;
using u32x4=__attribute__((ext_vector_type(4)))unsigned;
constexpr int D=64,QP=512,KVP=128;
constexpr int NW=8,QBLK=32,QB=QBLK*NW,KVBLK=64;
constexpr int ATTN_UNIT_ROWS=QB;
__device__ __forceinline__ int crow(int r,int hi){return (r&3)+8*(r>>2)+4*hi;}
#define SBAR() __builtin_amdgcn_sched_barrier(0)
__device__ __forceinline__ void cmask(f32x16&p0,f32x16&p1,int jb,int qrel,int hi){
  const float NEG=-INFINITY; int kb=64*jb+4*hi;
  #pragma unroll
  for(int r=0;r<16;++r){int kv=kb+(r&3)+8*(r>>2); if(kv>qrel)p0[r]=NEG; if(kv+32>qrel)p1[r]=NEG;}
}

constexpr int NSLOT=3, SLOTB=8192;
constexpr int LDS_K=0, LDS_V=NSLOT*SLOTB, LDS_WS=2*NSLOT*SLOTB, LDS_OST=LDS_WS+NW*64*4, LDS_BYTES=LDS_OST+NW*4096;
constexpr float C2=0.125f*1.4426950408889634f;
__device__ __forceinline__ void glds16(const void*gsrc,unsigned lds_dst){unsigned keep;
  asm volatile("s_mov_b32 %0, m0\n\ts_mov_b32 m0, %2\n\ts_nop 0\n\tglobal_load_lds_dwordx4 %1, off\n\ts_mov_b32 m0, %0":"=&s"(keep):"v"(gsrc),"s"(lds_dst):"memory");}
__device__ __forceinline__ float max3f(float a,float b,float c){float r;asm("v_max3_f32 %0, %1, %2, %3":"=v"(r):"v"(a),"v"(b),"v"(c));return r;}
__device__ __forceinline__ float max2f(float a,float b){float r;asm("v_max_f32_e32 %0, %1, %2":"=v"(r):"v"(a),"v"(b));return r;}
__device__ __forceinline__ float fadd_s(float a,float b){float r;asm("v_add_f32_e32 %0, %1, %2":"=v"(r):"v"(a),"v"(b));return r;}
__device__ __forceinline__ float fsub_s(float a,float b){float r;asm("v_sub_f32_e32 %0, %1, %2":"=v"(r):"v"(a),"v"(b));return r;}
typedef float f32x2_t __attribute__((ext_vector_type(2))); typedef __bf16 bf16x2_t __attribute__((ext_vector_type(2)));
__device__ __forceinline__ unsigned cvtpk_s(float lo,float hi){f32x2_t v={lo,hi};bf16x2_t b=__builtin_convertvector(v,bf16x2_t);return __builtin_bit_cast(unsigned,b);}
#define WAIT_BAR(N) asm volatile("s_waitcnt vmcnt(" #N ") lgkmcnt(0)\n\ts_barrier":::"memory")

__device__ __forceinline__ void qkt(f32x16&p0,f32x16&p1,const char*Kslot,const bf16x8*qr,const f32x16&negm,int r32,int hi){
  const char*kb=Kslot+hi*1024+r32*16;
  #pragma unroll
  for(int d0=0;d0<4;++d0){
    const bf16x8 b0=*reinterpret_cast<const bf16x8*>(kb+d0*2048);
    const bf16x8 b1=*reinterpret_cast<const bf16x8*>(kb+d0*2048+512);
    if(d0==0){p0=__builtin_amdgcn_mfma_f32_32x32x16_bf16(b0,qr[0],negm,0,0,0);p1=__builtin_amdgcn_mfma_f32_32x32x16_bf16(b1,qr[0],negm,0,0,0);}
    else{p0=__builtin_amdgcn_mfma_f32_32x32x16_bf16(b0,qr[d0],p0,0,0,0);p1=__builtin_amdgcn_mfma_f32_32x32x16_bf16(b1,qr[d0],p1,0,0,0);}}
}
typedef __attribute__((address_space(3))) const char* lds_cptr;
typedef short v4i16_t __attribute__((ext_vector_type(4)));
__device__ __forceinline__ void kload8(bf16x8*kf,lds_cptr kp){
  kf[0]=*(const __attribute__((address_space(3))) bf16x8*)(kp);      kf[1]=*(const __attribute__((address_space(3))) bf16x8*)(kp+512);
  kf[2]=*(const __attribute__((address_space(3))) bf16x8*)(kp+2048); kf[3]=*(const __attribute__((address_space(3))) bf16x8*)(kp+2560);
  kf[4]=*(const __attribute__((address_space(3))) bf16x8*)(kp+4096); kf[5]=*(const __attribute__((address_space(3))) bf16x8*)(kp+4608);
  kf[6]=*(const __attribute__((address_space(3))) bf16x8*)(kp+6144); kf[7]=*(const __attribute__((address_space(3))) bf16x8*)(kp+6656);
}
__device__ __forceinline__ void kload2(bf16x8*kf,lds_cptr kp,int j){ kf[2*j]=*(const __attribute__((address_space(3))) bf16x8*)(kp+j*2048); kf[2*j+1]=*(const __attribute__((address_space(3))) bf16x8*)(kp+j*2048+512); }
__device__ __forceinline__ s16x4 vtr(lds_cptr p){ return __builtin_bit_cast(s16x4,__builtin_amdgcn_ds_read_tr16_b64_v4i16((__attribute__((address_space(3))) v4i16_t*)p)); }
__device__ __forceinline__ float rowmax(const f32x16&p0,const f32x16&p1){
  float a=max3f(p0[0],p0[1],p1[0]),b=max3f(p0[2],p0[3],p1[1]);a=max3f(a,p1[2],p1[3]);
  #pragma unroll
  for(int r=4;r<16;r+=4){a=max3f(a,p0[r],p0[r+1]);b=max3f(b,p0[r+2],p0[r+3]);a=max3f(a,p1[r],p1[r+1]);b=max3f(b,p1[r+2],p1[r+3]);}
  const float m=max2f(a,b);
  auto rr=__builtin_amdgcn_permlane32_swap(__float_as_uint(m),__float_as_uint(m),false,false);
  return max2f(__uint_as_float(rr[0]),__uint_as_float(rr[1]));
}
__device__ __forceinline__ void pv(f32x16*o,int vb,bf16x8 pa0,bf16x8 pa1,bf16x8 pa2,bf16x8 pa3){
  #pragma unroll
  for(int d0=0;d0<2;++d0){s16x4 lo[4],hi[4];
    #pragma unroll
    for(int ks=0;ks<4;++ks){
      asm volatile("ds_read_b64_tr_b16 %0,%1 offset:%c2":"=&v"(lo[ks]):"v"(vb),"i"(d0*4096+ks*1024):"memory");
      asm volatile("ds_read_b64_tr_b16 %0,%1 offset:%c2":"=&v"(hi[ks]):"v"(vb),"i"(d0*4096+ks*1024+512):"memory");}
    asm volatile("s_waitcnt lgkmcnt(0)":::"memory");SBAR();
    #define PK(k) (bf16x8){lo[k][0],lo[k][1],lo[k][2],lo[k][3],hi[k][0],hi[k][1],hi[k][2],hi[k][3]}
    o[d0]=__builtin_amdgcn_mfma_f32_32x32x16_bf16(pa0,PK(0),o[d0],0,0,0);
    o[d0]=__builtin_amdgcn_mfma_f32_32x32x16_bf16(pa1,PK(1),o[d0],0,0,0);
    o[d0]=__builtin_amdgcn_mfma_f32_32x32x16_bf16(pa2,PK(2),o[d0],0,0,0);
    o[d0]=__builtin_amdgcn_mfma_f32_32x32x16_bf16(pa3,PK(3),o[d0],0,0,0);
    #undef PK
  }
}

#ifndef ATTN_STORE16
#define ATTN_STORE16(p,v) (*(u32x4*)(p)=(v))
#endif
template<int THRL> __device__ __forceinline__ void attn_unit(const bf16*Qu,const bf16*__restrict__ Kh,const bf16*__restrict__ Vh,bf16*Ou,const int NT,char*shm){
  const int tid=mk_tid(),lane=tid&63,r32=lane&31,hi=lane>>5; const int wid=__builtin_amdgcn_readfirstlane(tid>>6);
  const bf16*Qw=Qu+(long)(wid*QBLK)*QP;
  const unsigned lds0=(unsigned)(uintptr_t)shm;
  float*wsf=(float*)(shm+LDS_WS)+wid*64;
  const bf16*ksrc=Kh+(long)lane*KVP+wid*8;
  const bf16*vsrc=Vh+(long)(16*(wid&3)+(lane>>2))*KVP+(wid>>2)*32+(lane&3)*8;
  const unsigned kdst=lds0+LDS_K+wid*1024, vdst=lds0+LDS_V+wid*1024;
  #define DMA_K(t,slot) glds16(ksrc+(long)(t)*KVBLK*KVP,(unsigned)__builtin_amdgcn_readfirstlane(kdst+(slot)))
  #define DMA_V(t,slot) glds16(vsrc+(long)(t)*KVBLK*KVP,(unsigned)__builtin_amdgcn_readfirstlane(vdst+(slot)))
  const int vb0=(int)(lds0+LDS_V)+((lane>>4)&1)*32+(lane&3)*8+(4*hi+((lane&15)>>2))*64;
  const char*Kbase=shm+LDS_K; bf16x8 kf[8];
  const lds_cptr shm3=(lds_cptr)shm; const lds_cptr kp0=shm3+LDS_K+hi*1024+r32*16; const lds_cptr vp0=shm3+LDS_V+((lane>>4)&1)*32+(lane&3)*8+(4*hi+((lane&15)>>2))*64;
  DMA_K(0,0);DMA_V(0,0);DMA_K(1,SLOTB);
  bf16x8 qr[4];
  #pragma unroll
  for(int d0=0;d0<4;++d0)qr[d0]=*reinterpret_cast<const bf16x8*>(&Qw[(long)r32*QP+d0*16+hi*8]);
  float mhat=0.f,l_reg=0.f;f32x16 o[2];o[0]=f32x16{};o[1]=f32x16{};f32x16 negm=f32x16{};asm volatile("":"+v"(negm));
  #define CMASK(P0,P1,t) do{}while(0)
  bool resc=false;
  #define START(P0,P1) do{ const float rm=rowmax(P0,P1); resc=false; \
    { const float dl=rm; mhat=fadd_s(mhat,dl); \
      _Pragma("unroll") for(int r=0;r<16;++r){P0[r]=fsub_s(P0[r],dl);P1[r]=fsub_s(P1[r],dl);} \
      _Pragma("unroll") for(int r=0;r<16;++r)negm[r]=-mhat; asm volatile("":"+v"(negm)); } \
    _Pragma("unroll") for(int r=0;r<16;++r)P0[r]=__builtin_amdgcn_exp2f(P0[r]); }while(0)
  #define RESC() do{ if(resc){ asm volatile("s_waitcnt lgkmcnt(0)":::"memory"); \
      _Pragma("unroll") for(int d_=0;d_<2;++d_) _Pragma("unroll") for(int r=0;r<16;++r)o[d_][r]*=wsf[crow(r,hi)]; } }while(0)
  f32x16 pA0,pA1,pB0,pB1;
  int sl_prev=0,sl_cur=0,sl_next=SLOTB;
  #define ROT() do{sl_prev=sl_cur;sl_cur=sl_next;sl_next=(sl_next==(NSLOT-1)*SLOTB)?0:sl_next+SLOTB;}while(0)
  DMA_K(2,2*SLOTB);
  WAIT_BAR(3);
  qkt(pA0,pA1,Kbase,qr,negm,r32,hi);asm volatile("s_nop 15\n\ts_nop 7":"+v"(pA0),"+v"(pA1));CMASK(pA0,pA1,0);
  START(pA0,pA1);
  _Pragma("unroll") for(int r=0;r<16;++r)pA1[r]=__builtin_amdgcn_exp2f(pA1[r]);
  WAIT_BAR(0);
  DMA_K(3,0);DMA_V(1,SLOTB);
  ROT();
  kload8(kf,kp0+sl_cur);
  WAIT_BAR(2);
  s16x4 vlo[8],vhi[8]; u32x4 pw0,pw1,pw2,pw3;
  #define PKW(P,B) cvtpk_s(P[B],P[B+1])
  #define PAF(k) __builtin_bit_cast(bf16x8,pw##k)
  #define VFR(i) (bf16x8){vlo[i][0],vlo[i][1],vlo[i][2],vlo[i][3],vhi[i][0],vhi[i][1],vhi[i][2],vhi[i][3]}
  #define PIN(x) asm volatile("":"+v"(x))
  #define MX3(a,b,c) __builtin_fmaxf(__builtin_fmaxf((a),(b)),(c))
  #define GAPA(MF,A0,A1,A2,A3,W0,W1,PW) do{ MF; sacc+=A0; sacc+=A1; sacc+=A2; sacc+=A3; PIN(sacc); W0; W1; PIN(PW); SBAR(); }while(0)
  #define EX(v) __builtin_amdgcn_exp2f(v)
  #define GAPB(MF,X,B) do{ MF; X[B]=EX(X[B]); X[B+1]=EX(X[B+1]); X[B+2]=EX(X[B+2]); X[B+3]=EX(X[B+3]); PIN(X); SBAR(); }while(0)
  #define VRD(i) do{ vlo[i]=vtr(vp_+(((i)>>2)*4096+((i)&3)*1024)); vhi[i]=vtr(vp_+(((i)>>2)*4096+((i)&3)*1024+512)); }while(0)
  #define KRD(G,j) do{ if(G){ kload2(kf,kp0+sl_next,j); SBAR(); } }while(0)
  #define STEP(C0,C1,P0,P1,t,GK,GV,GL) do{ SBAR(); \
    const lds_cptr vp_=vp0+sl_prev; \
    VRD(0); SBAR(); float sacc=(P0[0]+P0[1]); \
    GAPA(C0=__builtin_amdgcn_mfma_f32_32x32x16_bf16(kf[0],qr[0],negm,0,0,0), P0[2],P0[3],P0[4],P0[5],     pw0[0]=PKW(P0,0), pw0[1]=PKW(P0,2), pw0); \
    VRD(4); SBAR(); GAPA(C1=__builtin_amdgcn_mfma_f32_32x32x16_bf16(kf[1],qr[0],negm,0,0,0), P0[6],P0[7],P0[8],P0[9],     pw0[2]=PKW(P0,4), pw0[3]=PKW(P0,6), pw0); \
    VRD(1); SBAR(); GAPA(C0=__builtin_amdgcn_mfma_f32_32x32x16_bf16(kf[2],qr[1],C0,0,0,0),   P0[10],P0[11],P0[12],P0[13], pw1[0]=PKW(P0,8), pw1[1]=PKW(P0,10), pw1); \
    VRD(5); SBAR(); GAPA(C1=__builtin_amdgcn_mfma_f32_32x32x16_bf16(kf[3],qr[1],C1,0,0,0),   P0[14],P0[15],P1[0],P1[1],   pw1[2]=PKW(P0,12),pw1[3]=PKW(P0,14), pw1); \
    VRD(2); SBAR(); GAPA(C0=__builtin_amdgcn_mfma_f32_32x32x16_bf16(kf[4],qr[2],C0,0,0,0),   P1[2],P1[3],P1[4],P1[5],     pw2[0]=PKW(P1,0), pw2[1]=PKW(P1,2), pw2); \
    VRD(6); SBAR(); GAPA(C1=__builtin_amdgcn_mfma_f32_32x32x16_bf16(kf[5],qr[2],C1,0,0,0),   P1[6],P1[7],P1[8],P1[9],     pw2[2]=PKW(P1,4), pw2[3]=PKW(P1,6), pw2); \
    VRD(3); SBAR(); GAPA(C0=__builtin_amdgcn_mfma_f32_32x32x16_bf16(kf[6],qr[3],C0,0,0,0),   P1[10],P1[11],P1[12],P1[13], pw3[0]=PKW(P1,8), pw3[1]=PKW(P1,10), pw3); \
    VRD(7); SBAR(); GAPA(C1=__builtin_amdgcn_mfma_f32_32x32x16_bf16(kf[7],qr[3],C1,0,0,0),   P1[14],P1[15],0.f,0.f,       pw3[2]=PKW(P1,12),pw3[3]=PKW(P1,14), pw3); \
    l_reg+=sacc; \
    if(GK){DMA_K((t)+3,sl_cur);} if(GV){DMA_V((t)+1,sl_next);} \
    CMASK(C0,C1,t); \
    { float a=MX3(C0[0],C0[1],C1[0]),b=MX3(C0[2],C0[3],C1[1]); a=MX3(a,C1[2],C1[3]); \
      _Pragma("unroll") for(int r=4;r<16;r+=4){a=MX3(a,C0[r],C0[r+1]);b=MX3(b,C0[r+2],C0[r+3]);a=MX3(a,C1[r],C1[r+1]);b=MX3(b,C1[r+2],C1[r+3]);} \
      float rm=__builtin_fmaxf(a,b); { auto rr=__builtin_amdgcn_permlane32_swap(__float_as_uint(rm),__float_as_uint(rm),false,false); rm=__builtin_fmaxf(__uint_as_float(rr[0]),__uint_as_float(rr[1])); } \
      resc=false; \
      if(__builtin_expect(__any(rm>(float)THRL),0)){ const float dl=__builtin_fmaxf(rm,0.f); mhat+=dl; \
        _Pragma("unroll") for(int r=0;r<16;++r){C0[r]-=dl;C1[r]-=dl;} \
        _Pragma("unroll") for(int r=0;r<16;++r)negm[r]=-mhat; asm volatile("":"+v"(negm)); \
        const float f=__builtin_amdgcn_exp2f(-dl); l_reg*=f; if(hi==0)wsf[r32]=f; resc=true; } } \
    SBAR(); \
    GAPB(o[0]=__builtin_amdgcn_mfma_f32_32x32x16_bf16(PAF(0),VFR(0),o[0],0,0,0), C0,0); \
    GAPB(o[1]=__builtin_amdgcn_mfma_f32_32x32x16_bf16(PAF(0),VFR(4),o[1],0,0,0), C0,4); \
    KRD(GL,0); GAPB(o[0]=__builtin_amdgcn_mfma_f32_32x32x16_bf16(PAF(1),VFR(1),o[0],0,0,0), C0,8); \
    KRD(GL,1); GAPB(o[1]=__builtin_amdgcn_mfma_f32_32x32x16_bf16(PAF(1),VFR(5),o[1],0,0,0), C0,12); \
    KRD(GL,2); GAPB(o[0]=__builtin_amdgcn_mfma_f32_32x32x16_bf16(PAF(2),VFR(2),o[0],0,0,0), C1,0); \
    KRD(GL,3); GAPB(o[1]=__builtin_amdgcn_mfma_f32_32x32x16_bf16(PAF(2),VFR(6),o[1],0,0,0), C1,4); \
    GAPB(o[0]=__builtin_amdgcn_mfma_f32_32x32x16_bf16(PAF(3),VFR(3),o[0],0,0,0), C1,8); \
    GAPB(o[1]=__builtin_amdgcn_mfma_f32_32x32x16_bf16(PAF(3),VFR(7),o[1],0,0,0), C1,12); \
    }while(0)
  int t=1;
  #undef CMASK
  #define CMASK(P0,P1,t) do{}while(0)
  for(;t+5<NT;t+=2){
    STEP(pB0,pB1,pA0,pA1,t,true,true,true);     WAIT_BAR(2); RESC(); ROT();
    STEP(pA0,pA1,pB0,pB1,t+1,true,true,true);   WAIT_BAR(2); RESC(); ROT();
  }
  #undef CMASK
  #define CMASK(P0,P1,t) do{}while(0)
  #define ENDW(tt) do{ if((tt)+3<NT){WAIT_BAR(2);} else if((tt)+2<NT){WAIT_BAR(1);} else {WAIT_BAR(0);} }while(0)
  for(;t+1<NT;t+=2){
    STEP(pB0,pB1,pA0,pA1,t,(t+3<NT),(t+1<NT),(t+1<NT));       ENDW(t);   RESC(); ROT();
    STEP(pA0,pA1,pB0,pB1,t+1,(t+4<NT),(t+2<NT),(t+2<NT));     ENDW(t+1); RESC(); ROT();
  }
  STEP(pB0,pB1,pA0,pA1,NT-1,false,false,false); RESC();
  { float sacc=pB0[0]+pB0[1]; _Pragma("unroll") for(int r=2;r<16;++r)sacc+=pB0[r]; _Pragma("unroll") for(int r=0;r<16;++r)sacc+=pB1[r]; l_reg+=sacc;
    pw0=(u32x4){PKW(pB0,0),PKW(pB0,2),PKW(pB0,4),PKW(pB0,6)};pw1=(u32x4){PKW(pB0,8),PKW(pB0,10),PKW(pB0,12),PKW(pB0,14)};pw2=(u32x4){PKW(pB1,0),PKW(pB1,2),PKW(pB1,4),PKW(pB1,6)};pw3=(u32x4){PKW(pB1,8),PKW(pB1,10),PKW(pB1,12),PKW(pB1,14)};
    SBAR(); pv(o,vb0+sl_cur,PAF(0),PAF(1),PAF(2),PAF(3)); }
  #undef PKW
  #undef PAF
  #undef VFR
  #undef PIN
  #undef MX3
  #undef GAPA
  #undef GAPB
  #undef EX
  #undef VRD
  #undef KRD
  #undef STEP
  #undef ENDW
  {auto rr=__builtin_amdgcn_permlane32_swap(__float_as_uint(l_reg),__float_as_uint(l_reg),false,false);l_reg=__uint_as_float(rr[0])+__uint_as_float(rr[1]);}
  if(hi==0)wsf[32+r32]=l_reg;asm volatile("s_waitcnt lgkmcnt(0)":::"memory");
  float rli[16];
  #pragma unroll
  for(int r=0;r<16;++r)rli[r]=__builtin_amdgcn_rcpf(wsf[32+crow(r,hi)]);
  bf16*Ow=Ou+(long)(wid*QBLK)*QP;
  { bf16*stg=(bf16*)(shm+LDS_OST)+wid*2048;
    #pragma unroll
    for(int r=0;r<16;++r){const int orow=crow(r,hi);
      #pragma unroll
      for(int d0=0;d0<2;++d0)stg[orow*64+d0*32+r32]=__float2bfloat16(o[d0][r]*rli[r]);}
    asm volatile("s_waitcnt lgkmcnt(0)":::"memory");
    #pragma unroll
    for(int i=0;i<4;++i){const int row=i*8+(lane>>3),ch=lane&7; const u32x4 v=*(const u32x4*)(stg+row*64+ch*8); ATTN_STORE16(Ow+(long)row*QP+ch*8,v);} }
  asm volatile("s_waitcnt lgkmcnt(0)\n\ts_barrier":::"memory");
  #undef DMA_K
  #undef DMA_V
  #undef CMASK
  #undef START
  #undef RESC
  #undef ROT
}
constexpr int ATTN_LDS_BYTES=LDS_BYTES;
#undef SBAR
#undef WAIT_BAR
}

#define LAS __attribute__((address_space(3)))
typedef unsigned short bf16r;
typedef float f4 __attribute__((ext_vector_type(4)));
typedef unsigned u4 __attribute__((ext_vector_type(4)));
typedef unsigned u2 __attribute__((ext_vector_type(2)));
typedef short s8v __attribute__((ext_vector_type(8)));

constexpr int DM = 1024, SEQL = 4096, CTXL = 256, MLAT = 16384, MCTX = 1024, MALL = 17408;
constexpr int DIN = 1792, DFF = 2816, DFF2 = 5632, KVR = 4352, NCH = 68;
constexpr float EPSN = 1e-6f;
constexpr size_t MiB = 1u << 20;
constexpr size_t WS_MOD = 1 * MiB, WS_COS = 2 * MiB, WS_SIN = 2 * MiB + 512 * 1024, WS_GW = 3 * MiB, WS_AGGA = 4 * MiB, WS_AGGB = 6 * MiB, WS_CTXRES = 8 * MiB;
constexpr size_t WS_W = 12 * MiB, W_LAYER = 22 * MiB, W_IN = 0, W_OUT = 3 * MiB + 512 * 1024, W_UP = 5 * MiB + 512 * 1024, W_DOWN = 16 * MiB + 512 * 1024;
constexpr size_t WS_HN = 56 * MiB + 4096;
constexpr size_t WS_Q = 92 * MiB, WS_K = 109 * MiB, WS_V = 114 * MiB, WS_XL = 119 * MiB, WS_GG = 136 * MiB, WS_MIX = 153 * MiB;
constexpr size_t WS_LAB = 187 * MiB;
constexpr size_t WS_O = WS_HN;
constexpr size_t WS_PART = 187 * MiB;
constexpr size_t WS_ACT = 92 * MiB;
constexpr int LDS_BYTES = 147456;
constexpr int NPHASE = 18;
constexpr int L1_TAB_OFF = 84992;
#ifndef PHM
#define PHM 0x3ff
#endif
#define PON(k) ((PHM >> (k)) & 1)

struct Args { const float* in[24]; float* out; unsigned char* ws; int ph_lo, ph_hi; };
typedef const __attribute__((address_space(4))) Args* KA;

#define LDS_WAIT() asm volatile("s_waitcnt lgkmcnt(0)" ::: "memory")
__device__ __forceinline__ unsigned pk2(float lo, float hi) { return attn_body::cvtpk_s(lo, hi); }
__device__ __forceinline__ float bf_lo(unsigned w) { return __builtin_bit_cast(float, w << 16); }
__device__ __forceinline__ float bf_hi(unsigned w) { return __builtin_bit_cast(float, w & 0xffff0000u); }
__device__ __forceinline__ float wave_sum(float v) {
#pragma unroll
    for (int o = 1; o < 64; o <<= 1) v += __shfl_xor(v, o);
    return v;
}
__device__ __forceinline__ float fexp(float x) { return __builtin_amdgcn_exp2f(x * 1.4426950408889634f); }
__device__ __forceinline__ float sigmoidf_(float x) { return __builtin_amdgcn_rcpf(1.f + fexp(-x)); }
__device__ __forceinline__ float gelu_tanh(float x) { const float z = 0.7978845608028654f * (x + 0.044715f * x * x * x); return x * sigmoidf_(2.f * z); }
__device__ __forceinline__ int kvrow(int row) { return row < MLAT ? (row >> 12) * KVR + CTXL + (row & 4095) : ((row - MLAT) >> 8) * KVR + ((row - MLAT) & 255); }

__device__ __forceinline__ int win_dst(int s) {
    if (s < 512) { const int h = s >> 6, d = s & 63; return (h >> 2) * 256 + (d >> 5) * 128 + (h & 3) * 32 + (d & 31); }
    if (s < 768) { const int t = s - 512, hh = t >> 6, d = t & 63; return 512 + (d >> 5) * 128 + hh * 32 + (d & 31); }
    return s;
}
__device__ __forceinline__ int wup_dst(int s) { return s < DFF ? (s >> 7) * 256 + (s & 127) : ((s - DFF) >> 7) * 256 + 128 + ((s - DFF) & 127); }

template <int MODE> __device__ __forceinline__ void p0_transpose_item(const float* W, int K, int N, bf16r* WT, const float* ksA, const float* ksB, LAS float* scr, int item, int lane) {
    const int nblk = N / 32, kb = item / nblk, nb = item % nblk, k0 = 64 * kb, n0 = 32 * nb;
    float tv[32];
#pragma unroll
    for (int i = 0; i < 32; ++i) { const int kk = 2 * i + (lane >> 5); tv[i] = __builtin_nontemporal_load(W + (size_t)(k0 + kk) * N + n0 + (lane & 31)); }
#pragma unroll
    for (int i = 0; i < 32; ++i) { const int kk = 2 * i + (lane >> 5); float v = tv[i];
        if (MODE == 3) { const int k = k0 + kk; v *= (k < 512 ? ksA[k] : ksB[k - 512]); }
        scr[kk * 33 + (lane & 31)] = v; }
    LDS_WAIT();
    const int c = lane & 7;
#pragma unroll
    for (int j = 0; j < 4; ++j) { const int n = (lane >> 3) + 8 * j; const LAS float* s = scr + (8 * c) * 33 + n;
        u4 o; o.x = pk2(s[0 * 33], s[1 * 33]); o.y = pk2(s[2 * 33], s[3 * 33]); o.z = pk2(s[4 * 33], s[5 * 33]); o.w = pk2(s[6 * 33], s[7 * 33]);
        const int sc = n0 + n; const int dst = MODE == 1 ? win_dst(sc) : MODE == 2 ? wup_dst(sc) : sc;
        *(u4*)(WT + (size_t)dst * K + k0 + 8 * c) = o; }
    LDS_WAIT();
}

__device__ __forceinline__ void p0_phase(KA a, LAS unsigned char* lds, int tid, int wid, int lane, int G) {
    unsigned char* ws = a->ws;
    float* MOD = (float*)(ws + WS_MOD);
    {
        LAS float* sc = (LAS float*)lds; LAS float* red = sc + 5 * 1024;
        bool have = false;
        for (int it = blockIdx.x; it < 192; it += G) {
            if (!have) { for (int e = tid; e < 5 * 1024; e += 512) { const int r = e >> 10, k = e & 1023; const float v = r < 4 ? a->in[1][r * 1024 + k] : a->in[3][k]; sc[e] = v * sigmoidf_(v); } have = true; }
            __syncthreads();
            const int l = it / 96, nb = it % 96;
            const float* wp = a->in[4] + (size_t)l * 1024 * 6144 + (size_t)(wid * 128) * 6144 + nb * 64 + lane;
            float acc[5] = {0.f, 0.f, 0.f, 0.f, 0.f};
#pragma unroll 32
            for (int k = 0; k < 128; ++k) { const float wv = __builtin_nontemporal_load(wp + (size_t)k * 6144);
#pragma unroll
                for (int r = 0; r < 5; ++r) acc[r] += sc[r * 1024 + wid * 128 + k] * wv; }
#pragma unroll
            for (int r = 0; r < 5; ++r) red[(wid * 5 + r) * 64 + lane] = acc[r];
            __syncthreads();
            if (tid < 320) { const int r = tid >> 6, col = tid & 63; float s = a->in[5][l * 6144 + nb * 64 + col];
#pragma unroll
                for (int w = 0; w < 8; ++w) s += red[(w * 5 + r) * 64 + col];
                MOD[(l * 5 + r) * 6144 + nb * 64 + col] = s; }
        }
        __syncthreads();
    }
    {
        float* cosT = (float*)(ws + WS_COS); float* sinT = (float*)(ws + WS_SIN); bf16r* GW = (bf16r*)(ws + WS_GW);
        const int gt = blockIdx.x * 512 + tid, NT_ = G * 512;
        for (int e = gt; e < 4096 * 32; e += NT_) { const int t = e >> 5, j = e & 31; const float pos = (float)(j < 16 ? (t >> 6) : (t & 63));
            const float inv = powf(10000.0f, -(float)(j & 15) * (1.0f / 16.0f)); const float ang = pos * inv; cosT[e] = cosf(ang); sinT[e] = sinf(ang); }
        for (int e = gt; e < 2 * 2 * 2 * 8 * 64 * 64; e += NT_) {
            const int c = e & 63, d = (e >> 6) & 63, n = (e >> 12) & 7, mat = (e >> 15) & 1, dir = (e >> 16) & 1, l = e >> 17;
            const float* src = mat ? a->in[13] : a->in[11];
            GW[e] = (bf16r)(pk2(src[((((size_t)l * 2 + dir) * 8 + n) * 64 + c) * 64 + d], 0.f) & 0xffffu); }
    }
    {
        LAS float* scr = (LAS float*)lds + wid * (64 * 33 + 16);
        const int gw = blockIdx.x * 8 + wid, NGW = G * 8;
        constexpr int I_IN = 16 * 56, I_OUT = 16 * 32, I_UP = 16 * 176, I_DN = 44 * 32, I_L = I_IN + I_OUT + I_UP + I_DN;
        for (int it = gw; it < 2 * I_L; it += NGW) {
            const int l = it / I_L; int r = it % I_L;
            unsigned char* wl = ws + WS_W + (size_t)l * W_LAYER;
            if (r < I_IN) { p0_transpose_item<1>(a->in[6] + (size_t)l * DM * DIN, DM, DIN, (bf16r*)(wl + W_IN), nullptr, nullptr, scr, r, lane); continue; } r -= I_IN;
            if (r < I_OUT) { p0_transpose_item<3>(a->in[18] + (size_t)l * DM * DM, DM, DM, (bf16r*)(wl + W_OUT), a->in[16] + l * 512, a->in[17] + l * 512, scr, r, lane); continue; } r -= I_OUT;
            if (r < I_UP) { p0_transpose_item<2>(a->in[19] + (size_t)l * DM * DFF2, DM, DFF2, (bf16r*)(wl + W_UP), nullptr, nullptr, scr, r, lane); continue; } r -= I_UP;
            p0_transpose_item<0>(a->in[22] + (size_t)l * DFF * DM, DFF, DM, (bf16r*)(wl + W_DOWN), nullptr, nullptr, scr, r, lane);
        }
    }
}

__device__ __forceinline__ void prenorm_phase(KA a, int l, int which, int nrows, int nsplit, const float* ctx_src, int wid, int lane, int G) {
    const float* MOD = (const float*)(a->ws + WS_MOD); bf16r* HN = (bf16r*)(a->ws + WS_HN);
    float* ctxres = (float*)(a->ws + WS_CTXRES); const float* PART = (const float*)(a->ws + WS_PART);
    const int gw = blockIdx.x * 8 + wid, NGW = G * 8;
    const bool from_in = (l == 0 && which == 0);
    for (int row = gw; row < nrows; row += 2 * NGW) {
        const int row2 = row + NGW; const bool has2 = row2 < nrows; const int r2 = has2 ? row2 : row;
        const float* lat = from_in ? a->in[0] : a->out;
        const float* s0 = row < MLAT ? lat + (size_t)row * DM : ctx_src + (size_t)(row - MLAT) * DM;
        const float* s1 = r2 < MLAT ? lat + (size_t)r2 * DM : ctx_src + (size_t)(r2 - MLAT) * DM;
        const float* md0 = MOD + (l * 5 + (row < MLAT ? (row >> 12) : 4)) * 6144 + (which ? 3 * 1024 : 0);
        const float* md1 = MOD + (l * 5 + (r2 < MLAT ? (r2 >> 12) : 4)) * 6144 + (which ? 3 * 1024 : 0);
        f4 v0[4], v1[4];
#pragma unroll
        for (int j = 0; j < 4; ++j) { v0[j] = *(const f4*)(s0 + 4 * (lane + 64 * j)); v1[j] = *(const f4*)(s1 + 4 * (lane + 64 * j)); }
        if (nsplit > 0) {
            if (row >= MLAT) { const float* pp = PART + (size_t)(row - MLAT) * DM + 4 * lane;
                for (int ks = 0; ks < nsplit; ks += 4) {
                    f4 t_[4][4]; float wk_[4];
#pragma unroll
                    for (int kk = 0; kk < 4; ++kk) { const int k2 = ks + kk < nsplit ? ks + kk : nsplit - 1; wk_[kk] = ks + kk < nsplit ? 1.f : 0.f;
#pragma unroll
                        for (int j = 0; j < 4; ++j) t_[kk][j] = *(const f4*)(pp + (size_t)k2 * MCTX * DM + 256 * j); }
                    __builtin_amdgcn_sched_barrier(0);
#pragma unroll
                    for (int kk = 0; kk < 4; ++kk)
#pragma unroll
                        for (int j = 0; j < 4; ++j) v0[j] += t_[kk][j] * wk_[kk];
                }
#pragma unroll
                for (int j = 0; j < 4; ++j) *(f4*)(ctxres + (size_t)(row - MLAT) * DM + 4 * (lane + 64 * j)) = v0[j]; }
            if (has2 && row2 >= MLAT) { const float* pp = PART + (size_t)(row2 - MLAT) * DM + 4 * lane;
                for (int ks = 0; ks < nsplit; ks += 4) {
                    f4 t_[4][4]; float wk_[4];
#pragma unroll
                    for (int kk = 0; kk < 4; ++kk) { const int k2 = ks + kk < nsplit ? ks + kk : nsplit - 1; wk_[kk] = ks + kk < nsplit ? 1.f : 0.f;
#pragma unroll
                        for (int j = 0; j < 4; ++j) t_[kk][j] = *(const f4*)(pp + (size_t)k2 * MCTX * DM + 256 * j); }
                    __builtin_amdgcn_sched_barrier(0);
#pragma unroll
                    for (int kk = 0; kk < 4; ++kk)
#pragma unroll
                        for (int j = 0; j < 4; ++j) v1[j] += t_[kk][j] * wk_[kk];
                }
#pragma unroll
                for (int j = 0; j < 4; ++j) *(f4*)(ctxres + (size_t)(row2 - MLAT) * DM + 4 * (lane + 64 * j)) = v1[j]; }
        }
        float ss0 = 0.f, ss1 = 0.f;
#pragma unroll
        for (int j = 0; j < 4; ++j) { ss0 += (v0[j].x * v0[j].x + v0[j].y * v0[j].y) + (v0[j].z * v0[j].z + v0[j].w * v0[j].w); ss1 += (v1[j].x * v1[j].x + v1[j].y * v1[j].y) + (v1[j].z * v1[j].z + v1[j].w * v1[j].w); }
#pragma unroll
        for (int o = 1; o < 64; o <<= 1) { ss0 += __shfl_xor(ss0, o); ss1 += __shfl_xor(ss1, o); }
        const float rs0 = rsqrtf(ss0 * (1.f / DM) + EPSN), rs1 = rsqrtf(ss1 * (1.f / DM) + EPSN);
#pragma unroll
        for (int j = 0; j < 4; ++j) { const int col = 4 * (lane + 64 * j);
            { const f4 sh = *(const f4*)(md0 + col), sc = *(const f4*)(md0 + 1024 + col); const f4 h = v0[j] * rs0 * (sc + 1.f) + sh; u2 w; w.x = pk2(h.x, h.y); w.y = pk2(h.z, h.w); *(u2*)(HN + (size_t)row * DM + col) = w; }
            if (has2) { const f4 sh = *(const f4*)(md1 + col), sc = *(const f4*)(md1 + 1024 + col); const f4 h = v1[j] * rs1 * (sc + 1.f) + sh; u2 w; w.x = pk2(h.x, h.y); w.y = pk2(h.z, h.w); *(u2*)(HN + (size_t)row2 * DM + col) = w; } }
    }
}
__device__ __forceinline__ void finalnorm_phase(KA a, int wid, int lane, int G) {
    const float* fw = a->in[23];
    const int gw = blockIdx.x * 8 + wid, NGW = G * 8;
    f4 wv[4];
#pragma unroll
    for (int j = 0; j < 4; ++j) wv[j] = *(const f4*)(fw + 4 * (lane + 64 * j));
    for (int row = gw; row < MLAT; row += 2 * NGW) {
        const int row2 = row + NGW; const bool has2 = row2 < MLAT;
        float* p0 = a->out + (size_t)row * DM; float* p1 = a->out + (size_t)(has2 ? row2 : row) * DM;
        f4 v0[4], v1[4]; float ss0 = 0.f, ss1 = 0.f;
#pragma unroll
        for (int j = 0; j < 4; ++j) { v0[j] = *(const f4*)(p0 + 4 * (lane + 64 * j)); v1[j] = *(const f4*)(p1 + 4 * (lane + 64 * j)); }
#pragma unroll
        for (int j = 0; j < 4; ++j) { ss0 += (v0[j].x * v0[j].x + v0[j].y * v0[j].y) + (v0[j].z * v0[j].z + v0[j].w * v0[j].w); ss1 += (v1[j].x * v1[j].x + v1[j].y * v1[j].y) + (v1[j].z * v1[j].z + v1[j].w * v1[j].w); }
#pragma unroll
        for (int o = 1; o < 64; o <<= 1) { ss0 += __shfl_xor(ss0, o); ss1 += __shfl_xor(ss1, o); }
        const float rs0 = rsqrtf(ss0 * (1.f / DM) + EPSN), rs1 = rsqrtf(ss1 * (1.f / DM) + EPSN);
#pragma unroll
        for (int j = 0; j < 4; ++j) { __builtin_nontemporal_store(v0[j] * rs0 * wv[j], (f4*)(p0 + 4 * (lane + 64 * j))); if (has2) __builtin_nontemporal_store(v1[j] * rs1 * wv[j], (f4*)(p1 + 4 * (lane + 64 * j))); }
    }
}

struct EpiWin {
    static constexpr bool PERM = true, AFTER_DRAIN = false;
    unsigned char* ws_; const float *qw, *kw;
    __device__ __forceinline__ void operator()(const pg8::f32x4 (&acc)[2][2][4][2], const pg8::Unit& u, int wr, int wc, int fr, int fq) const {
        bf16r* const Q = (bf16r*)(ws_ + WS_Q); bf16r* const Kb = (bf16r*)(ws_ + WS_K); bf16r* const Vb = (bf16r*)(ws_ + WS_V); bf16r* const XL = (bf16r*)(ws_ + WS_XL); bf16r* const GG = (bf16r*)(ws_ + WS_GG);
        const float* const cosT = (const float*)(ws_ + WS_COS); const float* const sinT = (const float*)(ws_ + WS_SIN);
        const int pn = u.pn, row0 = u.pm * 256 + wr * 64 + fr;
        if (pn >= 3) {
            const bool isg = pn >= 5; bf16r* dst = isg ? GG : XL; const int cb = (pn - (isg ? 5 : 3)) * 256 + wc * 32 + 8 * fq;
#pragma unroll
            for (int ai = 0; ai < 2; ++ai)
#pragma unroll
                for (int m = 0; m < 4; ++m) { const int row = row0 + ai * 128 + m * 16;
#pragma unroll
                    for (int bj = 0; bj < 2; ++bj)
#pragma unroll
                        for (int n = 0; n < 2; ++n) { pg8::f32x4 v = acc[ai][bj][m][n];
                            if (isg) { v[0] = gelu_tanh(v[0]); v[1] = gelu_tanh(v[1]); v[2] = gelu_tanh(v[2]); v[3] = gelu_tanh(v[3]); }
                            u2 w; w.x = pk2(v[0], v[1]); w.y = pk2(v[2], v[3]);
                            const int col = cb + bj * 128 + n * 4;
                            if (isg) *(u2*)(dst + (size_t)(row >> 4) * 8192 + (col >> 6) * 1024 + ((col >> 4) & 3) * 256 + (row & 15) * 16 + (col & 15)) = w;
                            else *(u2*)(dst + (size_t)row * 512 + col) = w; } }
            return;
        }
        if (pn == 2 && wc >= 2) {
#pragma unroll
            for (int ai = 0; ai < 2; ++ai)
#pragma unroll
                for (int m = 0; m < 4; ++m) { const int row = row0 + ai * 128 + m * 16; bf16r* base = Vb + (size_t)kvrow(row) * 128 + (wc - 2) * 64 + 8 * fq;
#pragma unroll
                    for (int bj = 0; bj < 2; ++bj)
#pragma unroll
                        for (int n = 0; n < 2; ++n) { const pg8::f32x4 v = acc[ai][bj][m][n]; u2 w; w.x = pk2(v[0], v[1]); w.y = pk2(v[2], v[3]);
                            *(u2*)(base + 32 * bj + 4 * n) = w; } }
            return;
        }
        const bool isk = pn == 2; const float* nw = isk ? kw : qw;
        pg8::f32x4 wv[2][2];
#pragma unroll
        for (int bj = 0; bj < 2; ++bj)
#pragma unroll
            for (int n = 0; n < 2; ++n) wv[bj][n] = *(const pg8::f32x4*)(nw + 32 * bj + 8 * fq + 4 * n);
        const float osc = isk ? 1.f : attn_body::C2;
#pragma unroll
        for (int am = 0; am < 4; ++am) { const int ai = am >> 1, m0 = (am & 1) * 2;
            pg8::f32x4 csv[2][2], snv[2][2];
            const bool lat_ = (row0 + ai * 128) < MLAT;
#pragma unroll
            for (int mm = 0; mm < 2; ++mm) { const int t = (row0 + ai * 128 + (m0 + mm) * 16) & 4095;
#pragma unroll
                for (int n = 0; n < 2; ++n) { csv[mm][n] = *(const pg8::f32x4*)(cosT + t * 32 + 8 * fq + 4 * n); snv[mm][n] = *(const pg8::f32x4*)(sinT + t * 32 + 8 * fq + 4 * n); } }
            __builtin_amdgcn_sched_barrier(0);
#pragma unroll
            for (int mm = 0; mm < 2; ++mm) { const int m = m0 + mm; const int row = row0 + ai * 128 + m * 16;
                float ss = 0.f;
#pragma unroll
                for (int bj = 0; bj < 2; ++bj)
#pragma unroll
                    for (int n = 0; n < 2; ++n) { const pg8::f32x4 v = acc[ai][bj][m][n]; ss += (v[0] * v[0] + v[1] * v[1]) + (v[2] * v[2] + v[3] * v[3]); }
                ss += __shfl_xor(ss, 16); ss += __shfl_xor(ss, 32);
                const float rstd = rsqrtf(ss * (1.f / 64.f) + EPSN) * osc;
                pg8::f32x4 y[2][2];
#pragma unroll
                for (int bj = 0; bj < 2; ++bj)
#pragma unroll
                    for (int n = 0; n < 2; ++n) y[bj][n] = acc[ai][bj][m][n] * rstd * wv[bj][n];
                if (lat_) {
#pragma unroll
                    for (int n = 0; n < 2; ++n) { const pg8::f32x4 cs = csv[mm][n], sn = snv[mm][n];
                        const pg8::f32x4 o0 = y[0][n] * cs - y[1][n] * sn, o1 = y[1][n] * cs + y[0][n] * sn; y[0][n] = o0; y[1][n] = o1; } }
                bf16r* base = isk ? Kb + (size_t)kvrow(row) * 128 + wc * 64 + 8 * fq : Q + (size_t)row * 512 + (4 * pn + wc) * 64 + 8 * fq;
#pragma unroll
                for (int bj = 0; bj < 2; ++bj)
#pragma unroll
                    for (int n = 0; n < 2; ++n) { u2 w; w.x = pk2(y[bj][n][0], y[bj][n][1]); w.y = pk2(y[bj][n][2], y[bj][n][3]); *(u2*)(base + 32 * bj + 4 * n) = w; }
            }
            __builtin_amdgcn_sched_barrier(0);
        }
    }
};
struct EpiRes {
    static constexpr bool PERM = false, AFTER_DRAIN = false;
    const float *base_lat, *base_ctx; float *out_lat, *out_ctx; const float* gate;
    __device__ __forceinline__ void operator()(const pg8::f32x4 (&acc)[2][2][4][2], const pg8::Unit& u, int wr, int wc, int fr, int fq) const {
        const int pm = u.pm; const bool isctx = pm >= 64;
        const float* base = isctx ? base_ctx + (size_t)(pm - 64) * 256 * DM : base_lat + (size_t)pm * 256 * DM;
        float* out = isctx ? out_ctx + (size_t)(pm - 64) * 256 * DM : out_lat + (size_t)pm * 256 * DM;
        const float* gt = gate + (isctx ? 4 : (pm >> 4)) * 6144;
        const int col0 = u.pn * 256 + wc * 32 + 4 * fq;
        pg8::f32x4 gv[2][2];
#pragma unroll
        for (int bj = 0; bj < 2; ++bj)
#pragma unroll
            for (int n = 0; n < 2; ++n) gv[bj][n] = *(const pg8::f32x4*)(gt + col0 + bj * 128 + n * 16);
#pragma unroll
        for (int am = 0; am < 4; ++am) {
            const int ai = am >> 1, m0 = (am & 1) * 2;
            pg8::f32x4 bs[2][2][2];
#pragma unroll
            for (int mm = 0; mm < 2; ++mm) { const size_t ro = (size_t)(ai * 128 + wr * 64 + (m0 + mm) * 16 + fr) * DM + col0;
#pragma unroll
                for (int bj = 0; bj < 2; ++bj)
#pragma unroll
                    for (int n = 0; n < 2; ++n) bs[mm][bj][n] = *(const pg8::f32x4*)(base + ro + bj * 128 + n * 16); }
            __builtin_amdgcn_sched_barrier(0);
#pragma unroll
            for (int mm = 0; mm < 2; ++mm) { const size_t ro = (size_t)(ai * 128 + wr * 64 + (m0 + mm) * 16 + fr) * DM + col0;
#pragma unroll
                for (int bj = 0; bj < 2; ++bj)
#pragma unroll
                    for (int n = 0; n < 2; ++n) *(pg8::f32x4*)(out + ro + bj * 128 + n * 16) = bs[mm][bj][n] + gv[bj][n] * acc[ai][bj][m0 + mm][n]; }
            __builtin_amdgcn_sched_barrier(0);
        }
    }
};
struct EpiUpConv {
    static constexpr bool PERM = true, AFTER_DRAIN = true;
    bf16r* ACT; const float* cw; const float* cb; int mrows;
    __device__ __forceinline__ void fused(pg8::f32x4 (&acc)[2][2][4][2], const pg8::Unit& u, int wr, int wc, int fr, int fq, PG8_LAS unsigned char* lds, int wid, int lane) const {
        constexpr int PITCH = 544;
#pragma unroll
        for (int ai = 0; ai < 2; ++ai)
#pragma unroll
            for (int m = 0; m < 4; ++m) { const int lr = ai * 128 + wr * 64 + m * 16 + fr;
#pragma unroll
                for (int bj = 0; bj < 2; ++bj)
#pragma unroll
                    for (int n = 0; n < 2; ++n) { const pg8::f32x4 v = acc[ai][bj][m][n]; u2 w; w.x = pk2(v[0], v[1]); w.y = pk2(v[2], v[3]);
                        *(PG8_LAS u2*)(lds + lr * PITCH + (bj * 128 + wc * 32 + 8 * fq + 4 * n) * 2) = w; } }
        LDS_WAIT(); __syncthreads();
        const int tid = wid * 64 + lane, cgp = tid & 15, rr = tid >> 4;
        const int ch = u.pn * 128 + 8 * cgp;
        float wg[3][8], wvv[3][8], bg[8], bv[8];
#pragma unroll
        for (int k = 0; k < 3; ++k)
#pragma unroll
            for (int h = 0; h < 2; ++h) { const f4 t0 = *(const f4*)(cw + k * DFF2 + ch + 4 * h), t1 = *(const f4*)(cw + k * DFF2 + DFF + ch + 4 * h);
                wg[k][4 * h] = t0.x; wg[k][4 * h + 1] = t0.y; wg[k][4 * h + 2] = t0.z; wg[k][4 * h + 3] = t0.w; wvv[k][4 * h] = t1.x; wvv[k][4 * h + 1] = t1.y; wvv[k][4 * h + 2] = t1.z; wvv[k][4 * h + 3] = t1.w; }
#pragma unroll
        for (int h = 0; h < 2; ++h) { const f4 t0 = *(const f4*)(cb + ch + 4 * h), t1 = *(const f4*)(cb + DFF + ch + 4 * h);
            bg[4 * h] = t0.x; bg[4 * h + 1] = t0.y; bg[4 * h + 2] = t0.z; bg[4 * h + 3] = t0.w; bv[4 * h] = t1.x; bv[4 * h + 1] = t1.y; bv[4 * h + 2] = t1.z; bv[4 * h + 3] = t1.w; }
        const int row_first = u.pm * 254 - 1, lr0 = 1 + 8 * rr;
        PG8_LAS const unsigned char* up = lds + 16 * cgp;
        u4 pg_ = *(PG8_LAS const u4*)(up + (lr0 - 1) * PITCH), pv_ = *(PG8_LAS const u4*)(up + (lr0 - 1) * PITCH + 256);
        u4 cg_ = *(PG8_LAS const u4*)(up + lr0 * PITCH), cv_ = *(PG8_LAS const u4*)(up + lr0 * PITCH + 256);
#pragma unroll
        for (int i = 0; i < 8; ++i) { const int lr = lr0 + i;
            if (lr <= 254) {
                const u4 ng_ = *(PG8_LAS const u4*)(up + (lr + 1) * PITCH), nv_ = *(PG8_LAS const u4*)(up + (lr + 1) * PITCH + 256);
                const int r = row_first + lr;
                if (r < mrows) {
                    const int p = r < MLAT ? (r & 4095) : ((r - MLAT) & 255), T = r < MLAT ? SEQL : CTXL;
                    const bool hp = p > 0, hn = p < T - 1;
                    const u4 z4 = (u4){0u, 0u, 0u, 0u};
                    const u4 pgm = hp ? pg_ : z4, pvm = hp ? pv_ : z4, ngm = hn ? ng_ : z4, nvm = hn ? nv_ : z4;
                    unsigned ow[4];
#pragma unroll
                    for (int e2 = 0; e2 < 4; ++e2) {
                        float o2[2];
#pragma unroll
                        for (int hh = 0; hh < 2; ++hh) { const int e = 2 * e2 + hh;
                            const float gp = hh ? bf_hi(pgm[e2]) : bf_lo(pgm[e2]), gc = hh ? bf_hi(cg_[e2]) : bf_lo(cg_[e2]), gn = hh ? bf_hi(ngm[e2]) : bf_lo(ngm[e2]);
                            const float vp = hh ? bf_hi(pvm[e2]) : bf_lo(pvm[e2]), vc = hh ? bf_hi(cv_[e2]) : bf_lo(cv_[e2]), vn = hh ? bf_hi(nvm[e2]) : bf_lo(nvm[e2]);
                            const float g = bg[e] + wg[1][e] * gc + wg[0][e] * gp + wg[2][e] * gn;
                            const float v = bv[e] + wvv[1][e] * vc + wvv[0][e] * vp + wvv[2][e] * vn;
                            o2[hh] = g * sigmoidf_(g) * v; }
                        ow[e2] = pk2(o2[0], o2[1]); }
                    u4 o; o.x = ow[0]; o.y = ow[1]; o.z = ow[2]; o.w = ow[3];
                    __builtin_nontemporal_store(o, (u4*)(ACT + (size_t)r * DFF + ch));
                }
                pg_ = cg_; pv_ = cv_; cg_ = ng_; cv_ = nv_;
            } }
        LDS_WAIT(); __syncthreads();
    }
};
struct SplitOrder { int nsub, S, kslice, G, c;
    __device__ __forceinline__ bool next(int i, pg8::Unit& u) const { const int x = c + i * G; if (x >= nsub) return false; const int ks = x % S, t = x / S; u.pm = 64 + (t >> 2); u.pn = t & 3; u.koff = ks * kslice; return true; }
    __device__ __forceinline__ void a_ready(const pg8::Unit&) const {}
    __device__ __forceinline__ void done(const pg8::Unit&) const {} };
struct EpiPart {
    static constexpr bool PERM = false, AFTER_DRAIN = false;
    float* part; const float* gate; int kslice;
    __device__ __forceinline__ void operator()(const pg8::f32x4 (&acc)[2][2][4][2], const pg8::Unit& u, int wr, int wc, int fr, int fq) const {
        asm volatile("" : "+v"(fr), "+v"(fq));
        float* out = part + ((size_t)(u.koff / kslice) * MCTX + (size_t)(u.pm - 64) * 256) * DM;
        const float* gt = gate + 4 * 6144;
        const int col0 = u.pn * 256 + wc * 32 + 4 * fq;
        pg8::f32x4 gv[2][2];
#pragma unroll
        for (int bj = 0; bj < 2; ++bj)
#pragma unroll
            for (int n = 0; n < 2; ++n) gv[bj][n] = *(const pg8::f32x4*)(gt + col0 + bj * 128 + n * 16);
#pragma unroll
        for (int ai = 0; ai < 2; ++ai)
#pragma unroll
            for (int m = 0; m < 4; ++m) { const size_t ro = (size_t)(ai * 128 + wr * 64 + m * 16 + fr) * DM + col0;
#pragma unroll
                for (int bj = 0; bj < 2; ++bj)
#pragma unroll
                    for (int n = 0; n < 2; ++n) *(pg8::f32x4*)(out + ro + bj * 128 + n * 16) = gv[bj][n] * acc[ai][bj][m][n]; }
    }
};
struct OneUnit { pg8::Unit u;
    __device__ __forceinline__ bool next(int i, pg8::Unit& o) const { if (i) return false; o = u; return true; }
    __device__ __forceinline__ void a_ready(const pg8::Unit&) const {}
    __device__ __forceinline__ void done(const pg8::Unit&) const {} };

#define DPPF(old, src, ctrl) __builtin_bit_cast(float, __builtin_amdgcn_update_dpp(__builtin_bit_cast(int, (float)(old)), __builtin_bit_cast(int, (float)(src)), ctrl, 0xf, 0xf, false))
struct LruCtx { const bf16r* XLp; const bf16r* GWn; LAS const float* tab; LAS float* scr; int p0, T, n, tok, q; };
typedef _Float16 h2v __attribute__((ext_vector_type(2)));
__device__ __forceinline__ unsigned pkh2(float lo, float hi) { return __builtin_bit_cast(unsigned, __builtin_amdgcn_cvt_pkrtz(lo, hi)); }
__device__ __forceinline__ float h2lo(unsigned w) { return (float)__builtin_bit_cast(h2v, w).x; }
__device__ __forceinline__ float h2hi(unsigned w) { return (float)__builtin_bit_cast(h2v, w).y; }
__device__ __forceinline__ void lru_conv_load(const LruCtx& c, int s, u4 (&raw)[8]) {
    const int i = 16 * s + c.tok, p = c.p0 + i;
#pragma unroll
    for (int ks = 0; ks < 2; ++ks)
#pragma unroll
        for (int k = 0; k < 4; ++k) { const int pp = p + k - 2; const bool ok = pp >= 0 && pp < c.T;
            raw[4 * ks + k] = *(const u4*)(c.XLp + (ptrdiff_t)(ok ? i + k - 2 : i) * 512 + 32 * ks + 8 * c.q); }
}
__device__ __forceinline__ void lru_conv(const LruCtx& c, int s, const u4 (&raw)[8], s8v (&frag)[2], f4 (&xc)[4]) {
    const int i = 16 * s + c.tok, p = c.p0 + i;
    float xb[2][8];
#pragma unroll
    for (int ks = 0; ks < 2; ++ks) { const int c0 = 32 * ks + 8 * c.q, chn = 64 * c.n + c0;
#pragma unroll
        for (int h = 0; h < 2; ++h) { const f4 t = *(LAS const f4*)(c.tab + 2048 + chn + 4 * h); xb[ks][4 * h] = t.x; xb[ks][4 * h + 1] = t.y; xb[ks][4 * h + 2] = t.z; xb[ks][4 * h + 3] = t.w; }
#pragma unroll
        for (int k = 0; k < 4; ++k) { const int pp = p + k - 2; const bool ok = pp >= 0 && pp < c.T;
            const u4 rw = raw[4 * ks + k];
#pragma unroll
            for (int h = 0; h < 2; ++h) { f4 w = *(LAS const f4*)(c.tab + k * 512 + chn + 4 * h); if (!ok) w = (f4){0.f, 0.f, 0.f, 0.f};
                xb[ks][4 * h] += w.x * bf_lo(rw[2 * h]); xb[ks][4 * h + 1] += w.y * bf_hi(rw[2 * h]); xb[ks][4 * h + 2] += w.z * bf_lo(rw[2 * h + 1]); xb[ks][4 * h + 3] += w.w * bf_hi(rw[2 * h + 1]); } } }
#pragma unroll
    for (int ks = 0; ks < 2; ++ks) { LAS float* sp = c.scr + c.tok * 68 + 32 * ks + 8 * c.q;
        *(LAS f4*)sp = (f4){xb[ks][0], xb[ks][1], xb[ks][2], xb[ks][3]}; *(LAS f4*)(sp + 4) = (f4){xb[ks][4], xb[ks][5], xb[ks][6], xb[ks][7]};
        u4 w; w.x = pk2(xb[ks][0], xb[ks][1]); w.y = pk2(xb[ks][2], xb[ks][3]); w.z = pk2(xb[ks][4], xb[ks][5]); w.w = pk2(xb[ks][6], xb[ks][7]); frag[ks] = __builtin_bit_cast(s8v, w); }
    LDS_WAIT();
#pragma unroll
    for (int rb = 0; rb < 4; ++rb) xc[rb] = *(LAS const f4*)(c.scr + c.tok * 68 + 16 * rb + 4 * c.q);
    LDS_WAIT();
}
__device__ __forceinline__ void lru_wload(const LruCtx& c, int dir, s8v (&W)[16]) {
    const bf16r* gwa = c.GWn + (size_t)(dir * 2) * 8 * 4096, *gwx = gwa + 8 * 4096;
#pragma unroll
    for (int rb = 0; rb < 4; ++rb)
#pragma unroll
        for (int ks = 0; ks < 2; ++ks) { const int off = (16 * rb + c.tok) * 64 + 32 * ks + 8 * c.q; W[4 * rb + 2 * ks] = *(const s8v*)(gwa + off); W[4 * rb + 2 * ks + 1] = *(const s8v*)(gwx + off); }
}
__device__ __forceinline__ void lru_gates(const LruCtx& c, int dir, const s8v (&W)[16], const s8v (&frag)[2], const f4 (&xc)[4], float (&LA)[16], float (&AV)[16], float (&B)[16]) {
    f4 ga[4], gx[4];
#pragma unroll
    for (int rb = 0; rb < 4; ++rb) { ga[rb] = (f4){0.f, 0.f, 0.f, 0.f}; gx[rb] = (f4){0.f, 0.f, 0.f, 0.f};
#pragma unroll
        for (int ks = 0; ks < 2; ++ks) {
            ga[rb] = __builtin_amdgcn_mfma_f32_16x16x32_bf16(W[4 * rb + 2 * ks], frag[ks], ga[rb], 0, 0, 0);
            gx[rb] = __builtin_amdgcn_mfma_f32_16x16x32_bf16(W[4 * rb + 2 * ks + 1], frag[ks], gx[rb], 0, 0, 0); } }
#pragma unroll
    for (int rb = 0; rb < 4; ++rb) { const int chn = dir * 512 + 64 * c.n + 16 * rb + 4 * c.q;
        const f4 ba = *(LAS const f4*)(c.tab + 2560 + chn), bx = *(LAS const f4*)(c.tab + 3584 + chn), cl = *(LAS const f4*)(c.tab + 4608 + chn);
#pragma unroll
        for (int j = 0; j < 4; ++j) { const float r = sigmoidf_(ga[rb][j] + ba[j]), ii = sigmoidf_(gx[rb][j] + bx[j]);
            const float la = cl[j] * r, z = 1.3862943611198906f * la, av = __builtin_amdgcn_exp2f(la);
            const float om = (z > -0.0078125f) ? -z * (1.f + 0.5f * z) : __builtin_fmaf(-av, av, 1.f);
            LA[4 * rb + j] = la; AV[4 * rb + j] = av; B[4 * rb + j] = __builtin_amdgcn_sqrtf(om) * ii * xc[rb][j]; } }
}
__device__ __forceinline__ void scan_fwd(float (&A)[16], float (&B)[16]) {
#pragma unroll
    for (int k = 0; k < 16; ++k) { float a_ = A[k], b_ = B[k], ap, bp;
        ap = DPPF(1.f, a_, 0x111); bp = DPPF(0.f, b_, 0x111); b_ = a_ * bp + b_; a_ = a_ * ap;
        ap = DPPF(1.f, a_, 0x112); bp = DPPF(0.f, b_, 0x112); b_ = a_ * bp + b_; a_ = a_ * ap;
        ap = DPPF(1.f, a_, 0x114); bp = DPPF(0.f, b_, 0x114); b_ = a_ * bp + b_; a_ = a_ * ap;
        ap = DPPF(1.f, a_, 0x118); bp = DPPF(0.f, b_, 0x118); b_ = a_ * bp + b_; a_ = a_ * ap;
        A[k] = a_; B[k] = b_; }
}
__device__ __forceinline__ void scan_bwd(float (&A)[16], float (&B)[16]) {
#pragma unroll
    for (int k = 0; k < 16; ++k) { float a_ = A[k], b_ = B[k], ap, bp;
        ap = DPPF(1.f, a_, 0x101); bp = DPPF(0.f, b_, 0x101); b_ = a_ * bp + b_; a_ = a_ * ap;
        ap = DPPF(1.f, a_, 0x102); bp = DPPF(0.f, b_, 0x102); b_ = a_ * bp + b_; a_ = a_ * ap;
        ap = DPPF(1.f, a_, 0x104); bp = DPPF(0.f, b_, 0x104); b_ = a_ * bp + b_; a_ = a_ * ap;
        ap = DPPF(1.f, a_, 0x108); bp = DPPF(0.f, b_, 0x108); b_ = a_ * bp + b_; a_ = a_ * ap;
        A[k] = a_; B[k] = b_; }
}
#define DPPZ(src, ctrl) __builtin_bit_cast(float, __builtin_amdgcn_update_dpp(0, __builtin_bit_cast(int, (float)(src)), ctrl, 0xf, 0xf, true))
__device__ __forceinline__ float rowsum_fwd(float x) { x += DPPZ(x, 0x111); x += DPPZ(x, 0x112); x += DPPZ(x, 0x114); x += DPPZ(x, 0x118); return x; }
__device__ __forceinline__ float rowsum_bwd(float x) { x += DPPZ(x, 0x101); x += DPPZ(x, 0x102); x += DPPZ(x, 0x104); x += DPPZ(x, 0x108); return x; }
__device__ __forceinline__ void lru_tables(KA a, int l, LAS float* tab, int tid) {
    for (int e = tid; e < 5632; e += 512) { float v;
        if (e < 2048) v = a->in[9][l * 2048 + e];
        else if (e < 2560) v = a->in[10][l * 512 + (e - 2048)];
        else if (e < 3584) v = a->in[12][l * 1024 + (e - 2560)];
        else if (e < 4608) v = a->in[14][l * 1024 + (e - 3584)];
        else { const float lam = a->in[15][l * 1024 + (e - 4608)]; const float x = fexp(-lam); const float sp = x < 0.03f ? x * (1.f - x * (0.5f - x * (0.33333334f - x * 0.25f))) : (lam < -20.f ? -lam : __builtin_amdgcn_logf(1.f + x) * 0.6931471805599453f); v = -8.f * sp * 1.4426950408889634f; }
        tab[e] = v; }
}
__device__ __forceinline__ void lru_l1_tile(KA a, int l, int b, int cid, int dir, LAS unsigned char* lds, int tid, int wid, int lane) {
    asm volatile("" : "+v"(lane), "+v"(tid));
    unsigned char* ws = a->ws;
    LAS float* tab = (LAS float*)(lds + L1_TAB_OFF); LAS float* scr = (LAS float*)(lds + L1_TAB_OFF + 22528) + wid * (16 * 68);
    LruCtx c; c.n = wid; c.tok = lane & 15; c.q = lane >> 4; c.tab = tab; c.scr = scr;
    const bool isctx = cid < 4; c.p0 = (isctx ? cid : cid - 4) * 64; c.T = isctx ? CTXL : SEQL;
    const int rowbase = isctx ? MLAT + b * CTXL + c.p0 : b * SEQL + c.p0;
    c.XLp = (const bf16r*)(ws + WS_XL) + (size_t)rowbase * 512 + c.n * 64;
    c.GWn = (const bf16r*)(ws + WS_GW) + (size_t)(l * 4) * 8 * 4096 + c.n * 4096;
    float* AGGA = (float*)(ws + WS_AGGA); float* AGGB = (float*)(ws + WS_AGGB);
    unsigned* LAB = (unsigned*)(ws + WS_LAB) + (size_t)(rowbase >> 4) * 8192 + 1024 * c.n + 16 * c.tok + 4 * c.q;
    const int bl = (lane & 48) | 15, bf_ = (lane & 48);
    {
        LAS float* rab = (LAS float*)(lds + L1_TAB_OFF + 22528 + 34816) + wid * 128 + c.q * 32;
#pragma unroll
        for (int k = 0; k < 16; ++k) { rab[2 * k] = 1.f; rab[2 * k + 1] = 0.f; }
        s8v W[16];
        lru_wload(c, dir, W);
        u4 rawc[8];
        lru_conv_load(c, 0, rawc);
#pragma unroll 1
        for (int s = 0; s < 4; ++s) {
            s8v frag[2]; f4 xc[4];
            lru_conv(c, s, rawc, frag, xc);
            __builtin_amdgcn_sched_barrier(0);
            lru_conv_load(c, s < 3 ? s + 1 : 3, rawc);
            __builtin_amdgcn_sched_barrier(0);
            float LAv[16], A[16], B[16];
            lru_gates(c, dir, W, frag, xc, LAv, A, B);
            unsigned* lp = LAB + (size_t)dir * MALL * 512 + (size_t)s * 8192;
#pragma unroll
            for (int rb = 0; rb < 4; ++rb) { u4 w; w.x = pkh2(LAv[4 * rb], B[4 * rb]); w.y = pkh2(LAv[4 * rb + 1], B[4 * rb + 1]); w.z = pkh2(LAv[4 * rb + 2], B[4 * rb + 2]); w.w = pkh2(LAv[4 * rb + 3], B[4 * rb + 3]); *(u4*)(lp + 256 * rb) = w; }
            if (dir == 0) scan_fwd(A, B); else scan_bwd(A, B);
#pragma unroll
            for (int k = 0; k < 16; ++k) {
                const float a_ = __shfl(A[k], dir ? bf_ : bl), b_ = __shfl(B[k], dir ? bf_ : bl);
                const float ra = rab[2 * k], rb_ = rab[2 * k + 1];
                if (dir == 0) { rab[2 * k + 1] = a_ * rb_ + b_; rab[2 * k] = a_ * ra; }
                else { rab[2 * k + 1] = ra * b_ + rb_; rab[2 * k] = ra * a_; } }
            LDS_WAIT();
        }
        if (c.tok == 0) { const size_t o = ((size_t)(b * 2 + dir) * NCH + cid) * 512 + 64 * c.n + 4 * c.q;
#pragma unroll
            for (int rb = 0; rb < 4; ++rb) { *(f4*)(AGGA + o + 16 * rb) = (f4){rab[8 * rb], rab[8 * rb + 2], rab[8 * rb + 4], rab[8 * rb + 6]}; *(f4*)(AGGB + o + 16 * rb) = (f4){rab[8 * rb + 1], rab[8 * rb + 3], rab[8 * rb + 5], rab[8 * rb + 7]}; } }
    }
    LDS_WAIT(); __syncthreads();
}
__device__ __forceinline__ void lru_l2_tile(KA a, int l, int b, int cid, LAS unsigned char* lds, int tid, int wid, int lane) {
    asm volatile("" : "+v"(lane));
    unsigned char* ws = a->ws;
    LAS float* part = (LAS float*)lds;
    LAS float* hfl = (LAS float*)(lds + 4096) + wid * 4096 + lane;
    const int n = wid, tok = lane & 15, q = lane >> 4;
    const bool isctx = cid < 4; const int p0 = (isctx ? cid : cid - 4) * 64;
    const int rowbase = isctx ? MLAT + b * CTXL + p0 : b * SEQL + p0;
    const float* AGGA = (const float*)(ws + WS_AGGA); const float* AGGB = (const float*)(ws + WS_AGGB);
    const unsigned* LAB = (const unsigned*)(ws + WS_LAB) + (size_t)(rowbase >> 4) * 8192 + 1024 * n + 16 * tok + 4 * q;
    const bf16r* GGp = (const bf16r*)(ws + WS_GG) + (size_t)(rowbase >> 4) * 8192 + 1024 * n + 16 * tok + 4 * q;
    const int bl = (lane & 48) | 15, bf_ = (lane & 48);
    float hin[16], hinb[16], A[16], B[16];
#pragma unroll 1
    for (int dir = 0; dir < 2; ++dir) {
        const float* ap_ = AGGA + ((size_t)(b * 2 + dir) * NCH) * 512 + 64 * n + 4 * q; const float* bp_ = AGGB + ((size_t)(b * 2 + dir) * NCH) * 512 + 64 * n + 4 * q;
#pragma unroll
        for (int k = 0; k < 16; ++k) { A[k] = 1.f; B[k] = 0.f; }
#pragma unroll
        for (int eb = 0; eb < 5; eb += 3) {
            f4 avv[3][4], bvv[3][4]; bool okv[3];
#pragma unroll
            for (int e2 = 0; e2 < 3; ++e2) { if (eb + e2 < 5) { const int o = 5 * tok + eb + e2; int ch; bool ok;
                if (dir == 0) { ch = o; ok = o < cid; } else { ch = o < 4 ? 3 - o : 71 - o; ok = isctx ? (o < 4 && ch > cid) : (o < 4 || (o < 68 && ch > cid)); }
                ch = ch < 0 ? 0 : (ch > NCH - 1 ? NCH - 1 : ch); okv[e2] = ok;
#pragma unroll
                for (int rb = 0; rb < 4; ++rb) { avv[e2][rb] = *(const f4*)(ap_ + (size_t)ch * 512 + 16 * rb); bvv[e2][rb] = *(const f4*)(bp_ + (size_t)ch * 512 + 16 * rb); } } }
            __builtin_amdgcn_sched_barrier(0);
#pragma unroll
            for (int e2 = 0; e2 < 3; ++e2) { if (eb + e2 < 5) {
#pragma unroll
                for (int rb = 0; rb < 4; ++rb) { f4 av = avv[e2][rb], bv = bvv[e2][rb];
                    if (!okv[e2]) { av = (f4){1.f, 1.f, 1.f, 1.f}; bv = (f4){0.f, 0.f, 0.f, 0.f}; }
#pragma unroll
                    for (int jj = 0; jj < 4; ++jj) { B[4 * rb + jj] = av[jj] * B[4 * rb + jj] + bv[jj]; A[4 * rb + jj] = av[jj] * A[4 * rb + jj]; } } } }
            __builtin_amdgcn_sched_barrier(0);
        }
        scan_fwd(A, B);
        if (dir == 0) {
#pragma unroll
            for (int k = 0; k < 16; ++k) hin[k] = __shfl(B[k], bl);
        } else {
#pragma unroll
            for (int k = 0; k < 16; ++k) hinb[k] = __shfl(B[k], bl);
        }
    }
    u4 wc_[4], wn_[4]; u2 gc_[4], gn_[4];
#pragma unroll
    for (int rb = 0; rb < 4; ++rb) { wc_[rb] = *(const u4*)(LAB + 256 * rb); gc_[rb] = (u2){0u, 0u}; gn_[rb] = (u2){0u, 0u}; }
#pragma unroll 1
    for (int st = 0; st < 8; ++st) {
        const int s = st < 4 ? st : 7 - st;
        { const int sn = st + 1 < 8 ? st + 1 : 7; const int s2 = sn < 4 ? sn : 7 - sn; const bool bw = sn >= 4;
          const unsigned* lp_ = LAB + (size_t)(bw ? MALL : 0) * 512 + (size_t)s2 * 8192; const bf16r* gp_ = GGp + (size_t)s2 * 8192;
#pragma unroll
          for (int rb = 0; rb < 4; ++rb) { wn_[rb] = *(const u4*)(lp_ + 256 * rb); gn_[rb] = *(const u2*)(gp_ + 256 * rb); } }
        __builtin_amdgcn_sched_barrier(0);
#pragma unroll
        for (int rb = 0; rb < 4; ++rb)
#pragma unroll
            for (int j = 0; j < 4; ++j) { A[4 * rb + j] = h2lo(wc_[rb][j]); B[4 * rb + j] = h2hi(wc_[rb][j]); }
        LAS float* hs = hfl + s * 1024;
        if (st < 4) {
#pragma unroll
            for (int k = 0; k < 16; ++k) { const float L = rowsum_fwd(A[k]); const float P = __builtin_amdgcn_exp2f(L); const float C = rowsum_fwd(B[k] * __builtin_amdgcn_exp2f(-L)); A[k] = P; B[k] = P * C; }
#pragma unroll
            for (int k = 0; k < 16; ++k) { const float h = A[k] * hin[k] + B[k]; hs[k * 64] = h; hin[k] = __shfl(h, bl); }
        } else {
            if (st == 4) {
#pragma unroll
                for (int k = 0; k < 16; ++k) hin[k] = hinb[k]; }
#pragma unroll
            for (int k = 0; k < 16; ++k) { const float L = rowsum_bwd(A[k]); const float P = __builtin_amdgcn_exp2f(L); const float C = rowsum_bwd(B[k] * __builtin_amdgcn_exp2f(-L)); A[k] = P; B[k] = P * C; }
            float sq = 0.f;
#pragma unroll
            for (int rb = 0; rb < 4; ++rb)
#pragma unroll
                for (int j = 0; j < 4; ++j) { const int k = 4 * rb + j; const float h = A[k] * hin[k] + B[k]; hin[k] = __shfl(h, bf_);
                    const float gg = (j & 1) ? bf_hi(gc_[rb][j >> 1]) : bf_lo(gc_[rb][j >> 1]);
                    const float r = (hs[k * 64] + h) * gg; hs[k * 64] = r; sq += r * r; }
            sq += __shfl_xor(sq, 16); sq += __shfl_xor(sq, 32); if (q == 0) part[wid * 64 + 16 * s + tok] = sq;
        }
#pragma unroll
        for (int rb = 0; rb < 4; ++rb) { wc_[rb] = wn_[rb]; gc_[rb] = gn_[rb]; }
    }
    LDS_WAIT(); __syncthreads();
    bf16r* MIX = (bf16r*)(ws + WS_MIX);
#pragma unroll 1
    for (int s = 0; s < 4; ++s) { float t = 0.f;
#pragma unroll
        for (int w = 0; w < 8; ++w) t += part[w * 64 + 16 * s + tok];
        const float rstd = rsqrtf(t * (1.f / 512.f) + EPSN);
        bf16r* mp = MIX + (size_t)(rowbase + 16 * s + tok) * DM + 512 + 64 * n + 4 * q;
        const LAS float* hs = hfl + s * 1024;
#pragma unroll
        for (int rb = 0; rb < 4; ++rb) { u2 w; w.x = pk2(hs[(4 * rb) * 64] * rstd, hs[(4 * rb + 1) * 64] * rstd); w.y = pk2(hs[(4 * rb + 2) * 64] * rstd, hs[(4 * rb + 3) * 64] * rstd); *(u2*)(mp + 16 * rb) = w; } }
    const bf16r* O = (const bf16r*)(ws + WS_O) + (size_t)(rowbase + wid * 8) * 512 + 8 * lane;
    u4 rawc = *(const u4*)O;
#pragma unroll 1
    for (int tt = 0; tt < 8; ++tt) {
        const u4 rawn = *(const u4*)(O + (size_t)(tt < 7 ? tt + 1 : 7) * 512);
        float v[8]; float ss = 0.f;
#pragma unroll
        for (int e = 0; e < 4; ++e) { v[2 * e] = bf_lo(rawc[e]); v[2 * e + 1] = bf_hi(rawc[e]); ss += v[2 * e] * v[2 * e] + v[2 * e + 1] * v[2 * e + 1]; }
        const float rstd = rsqrtf(wave_sum(ss) * (1.f / 512.f) + EPSN);
        u4 o; o.x = pk2(v[0] * rstd, v[1] * rstd); o.y = pk2(v[2] * rstd, v[3] * rstd); o.z = pk2(v[4] * rstd, v[5] * rstd); o.w = pk2(v[6] * rstd, v[7] * rstd);
        *(u4*)(MIX + (size_t)(rowbase + wid * 8 + tt) * DM + 8 * lane) = o;
        rawc = rawn; }
    LDS_WAIT(); __syncthreads();
}

#define GAS __attribute__((address_space(1)))
#define XB_TMO      128
#define XB_XCNT(j)  (256  + 64 * (j))
#define XB_XSUB(j)  (1280 + 64 * (j))
#define XB_XGEN(j)  (2304 + 64 * (j))
#define XB_TOP      3328
#define XB_TOPGEN   3392
#define XCD_BAR_WORDS 3456
#define XB_SPIN_CAP (1u << 18)

__device__ __forceinline__ unsigned xb_ld(unsigned* p)              { return __hip_atomic_load(p, __ATOMIC_RELAXED, __HIP_MEMORY_SCOPE_AGENT); }
__device__ __forceinline__ unsigned xb_add(unsigned* p, unsigned v) { return __hip_atomic_fetch_add(p, v, __ATOMIC_RELAXED, __HIP_MEMORY_SCOPE_AGENT); }
__device__ __forceinline__ unsigned xb_xcc_id() { return (unsigned)__builtin_amdgcn_s_getreg((3 << 11) | 20) & 0xFu; }
#define XB_SPIN(cond, bar) do { unsigned _sp = 0; while (cond) { __builtin_amdgcn_s_sleep(1); \
    if ((++_sp & 255u) == 0u) { if (xb_ld(&(bar)[XB_TMO])) break; if (_sp > XB_SPIN_CAP) { atomicAdd(&(bar)[XB_TMO], 1u); break; } } } } while (0)

struct XcdBarrier {
    unsigned* bar; unsigned x;
    volatile LAS unsigned* st;
};

__device__ __forceinline__ XcdBarrier xcd_barrier_post(unsigned* bar, volatile LAS unsigned* st) {
    XcdBarrier b; b.bar = bar; b.x = xb_xcc_id(); b.st = st;
    if (threadIdx.x == 0) (void)xb_add(&bar[XB_XCNT(b.x)], 1u);
    return b;
}
__device__ __forceinline__ void xcd_barrier_complete(unsigned* bar, unsigned x, unsigned& nloc, unsigned& nx) {
    const unsigned G = gridDim.x * gridDim.y * gridDim.z;
    unsigned sum, cnt, mine, sp = 0u;
    for (;;) {
        sum = 0u; cnt = 0u; mine = 0u;
#pragma unroll
        for (unsigned j = 0; j < 16; ++j) { const unsigned c = xb_ld(&bar[XB_XCNT(j)]); sum += c; cnt += (c > 0u) ? 1u : 0u; mine = (j == x) ? c : mine; }
        if (sum == G) break;
        __builtin_amdgcn_s_sleep(1);
        if ((++sp & 255u) == 0u) { if (xb_ld(&bar[XB_TMO])) break; if (sp > XB_SPIN_CAP) { atomicAdd(&bar[XB_TMO], 1u); break; } }
    }
    nloc = mine > 0u ? mine : 1u; nx = cnt > 0u ? cnt : 1u;
}

__device__ __forceinline__ void xcd_barrier(const XcdBarrier& b) {
    asm volatile("s_waitcnt vmcnt(0)" ::: "memory");
    __syncthreads();
    if (threadIdx.x == 0) {
        unsigned* bar = b.bar;
        __builtin_amdgcn_s_waitcnt(0);
        unsigned nloc = b.st[0], nx = b.st[1];
        if (nloc == 0u) { xcd_barrier_complete(bar, b.x, nloc, nx); b.st[0] = nloc; b.st[1] = nx; }
        const unsigned old = xb_add(&bar[XB_XSUB(b.x)], 1u);
        const unsigned gen = old / nloc;
        if (old + 1u == (gen + 1u) * nloc) {
            __builtin_amdgcn_fence(__ATOMIC_RELEASE, "agent");
            asm volatile("s_waitcnt vmcnt(0)" ::: "memory");
            const unsigned og = xb_add(&bar[XB_TOP], 1u);
            const unsigned tg = og / nx;
            if (og + 1u == (tg + 1u) * nx) xb_add(&bar[XB_TOPGEN], 1u);
            else XB_SPIN(xb_ld(&bar[XB_TOPGEN]) == tg, bar);
            __builtin_amdgcn_fence(__ATOMIC_ACQUIRE, "agent");
            xb_add(&bar[XB_XGEN(b.x)], 1u);
            asm volatile("s_waitcnt vmcnt(0)" ::: "memory");
        } else {
            XB_SPIN(xb_ld(&bar[XB_XGEN(b.x)]) == gen, bar);
            __builtin_amdgcn_fence(__ATOMIC_ACQUIRE, "agent");
            asm volatile("s_waitcnt vmcnt(0)" ::: "memory");
        }
    }
    __syncthreads();
}

#ifndef REP_PH
#define REP_PH -1
#endif
#ifndef REP_SKIP_L1
#define REP_SKIP_L1 0
#endif
#ifndef USE_XBAR
#define USE_XBAR 1
#endif
__global__ void __launch_bounds__(512, 2) mega(Args a_) {
    extern __shared__ __attribute__((aligned(16))) unsigned char lds_raw[];
    LAS unsigned char* lds = (LAS unsigned char*)lds_raw;
    const int G = gridDim.x, bx = blockIdx.x;
    const int vcu = (G % 8 == 0) ? (bx % 8) * (G / 8) + bx / 8 : bx;
    KA a = (KA)__builtin_amdgcn_kernarg_segment_ptr();
    volatile LAS unsigned* bst = (volatile LAS unsigned*)(lds + LDS_BYTES - 64);
    if (threadIdx.x < 2) bst[threadIdx.x] = 0u;
    __syncthreads();
    (void)xcd_barrier_post((unsigned*)a->ws, bst);
    int nsync = 0;
#define GRID_SYNC() do { if (!USE_XBAR || a->ph_lo < 0) cg::this_grid().sync();     else { XcdBarrier xb_; xb_.bar = (unsigned*)a->ws; xb_.x = xb_xcc_id(); xb_.st = (volatile LAS unsigned*)(lds + LDS_BYTES - 64); xcd_barrier(xb_); } ++nsync; } while (0)
    const int ph_hi = a->ph_hi;
    for (int ph = a->ph_lo; ph < ph_hi; ++ph) {
        asm volatile("" : "+s"(a));
        for (int rep = 0; rep < (ph == REP_PH ? 2 : 1); ++rep) {
        if (rep) GRID_SYNC();
#define TL const int tid = mk_tid(), lane = tid & 63, wid = __builtin_amdgcn_readfirstlane(tid >> 6); (void)tid; (void)lane; (void)wid
        unsigned char* ws = a->ws;
        float* MOD = (float*)(ws + WS_MOD); float* ctxres = (float*)(ws + WS_CTXRES);
        bf16r* HN = (bf16r*)(ws + WS_HN);
        if (ph == 0) { if (PON(8)) { TL; p0_phase(a, lds, tid, wid, lane, G); } }
        else if (ph == NPHASE - 1) { if (PON(9)) { TL; finalnorm_phase(a, wid, lane, G); } }
        else {
            const int l = (ph - 1) >> 3, sub = (ph - 1) & 7;
            unsigned char* wl = ws + WS_W + (size_t)l * W_LAYER;
            const bool ctx_out = l == 0;
            if (sub == 0) { if (PON(0)) { TL; prenorm_phase(a, l, 0, MALL, l == 0 ? 0 : 11, l == 0 ? a->in[2] : ctxres, wid, lane, G); } }
            else if (sub == 1) { if (PON(1)) {
                pg8::Gemm g{HN, (const bf16r*)(wl + W_IN), MALL, DIN, DM, 256, DM}; pg8::StaticOrder S; S.init(MALL, DIN, G, bx);
                EpiWin E{ws, a->in[7] + l * 64, a->in[8] + l * 64};
                pg8::gemm_phase<EpiWin, pg8::StaticOrder, true, true>(lds, g, S, E); }
            } else if (sub == 2) { if (PON(2)) { TL;
                const int nctx = ctx_out ? 4 : 0, cnt = 64 + nctx + ((rep && REP_SKIP_L1) ? 0 : 68);
                attn_body::bf16* Qb = (attn_body::bf16*)(ws + WS_Q); attn_body::bf16* Ob = (attn_body::bf16*)(ws + WS_O); const attn_body::bf16* Kb = (const attn_body::bf16*)(ws + WS_K); const attn_body::bf16* Vb = (const attn_body::bf16*)(ws + WS_V);
                LAS unsigned char* l3 = lds; asm volatile("" : "+s"(l3)); char* shm = (char*)l3;
                volatile LAS int* qw = (volatile LAS int*)(lds + LDS_BYTES - 32);
                unsigned* qctr = (unsigned*)ws + 3584 + (l * 2 + rep) * 8 * 64;
                const int hx = (int)(xb_xcc_id() & 7u);
                lru_tables(a, l, (LAS float*)(lds + L1_TAB_OFF), tid); __syncthreads();
                for (int li = 0; li < 8; ++li) { const int x = (hx + li) & 7; const int b = x >> 1, kvh = x & 1;
                    for (;;) {
                        __syncthreads();
                        if (tid == 0) *qw = (int)__hip_atomic_fetch_add(qctr + x * 64, 1u, __ATOMIC_RELAXED, __HIP_MEMORY_SCOPE_AGENT);
                        __syncthreads();
                        const int i = __builtin_amdgcn_readfirstlane(*qw);
                        if (i >= cnt) break;
                        if (i < 64 + nctx) {
                            const bool lat = i < 64; const int h = kvh * 4 + (lat ? (i >> 4) : (i - 64));
                            const size_t qo = (size_t)(lat ? b * SEQL + (i & 15) * 256 : MLAT + b * CTXL) * 512 + h * 64;
                            attn_body::attn_unit<8>(Qb + qo, Kb + (size_t)b * KVR * 128 + kvh * 64, Vb + (size_t)b * KVR * 128 + kvh * 64, Ob + qo, lat ? NCH : 4, shm);
                        } else { const int it = i - 64 - nctx, t = x * 34 + (it >> 1); lru_l1_tile(a, l, t / NCH, t % NCH, it & 1, lds, tid, wid, lane); }
                    }
                } }
            } else if (sub == 3) { if (PON(3)) { TL;
                const int nt = ctx_out ? 4 * NCH : 4 * 64;
                for (int t = vcu; t < nt; t += G) { int b, cid; if (ctx_out) { b = t / NCH; cid = t % NCH; } else { b = t >> 6; cid = 4 + (t & 63); }
                    lru_l2_tile(a, l, b, cid, lds, tid, wid, lane); } }
            } else if (sub == 4) { if (PON(4)) {
                { pg8::Gemm g{(const bf16r*)(ws + WS_MIX), (const bf16r*)(wl + W_OUT), MLAT, DM, DM, 256, DM}; pg8::StaticOrder S; S.init(MLAT, DM, G, bx);
                  EpiRes E{l == 0 ? a->in[0] : a->out, l == 0 ? a->in[2] : ctxres, a->out, ctxres, MOD + l * 5 * 6144 + 2 * 1024};
                  pg8::gemm_phase<EpiRes, pg8::StaticOrder, true, true>(lds, g, S, E); }
                if (ctx_out) {
                    pg8::Gemm g{(const bf16r*)(ws + WS_MIX), (const bf16r*)(wl + W_OUT), MALL, DM, 256, 256, DM}; SplitOrder S{64, 4, 256, G, bx};
                    EpiPart E{(float*)(ws + WS_PART), MOD + l * 5 * 6144 + 2 * 1024, 256};
                    pg8::gemm_phase<EpiPart, SplitOrder, true, true>(lds, g, S, E); } }
            } else if (sub == 5) { if (PON(5)) { TL; prenorm_phase(a, l, 1, ctx_out ? MALL : MLAT, ctx_out ? 4 : 0, ctx_out ? a->in[2] : ctxres, wid, lane, G); } }
            else if (sub == 6) { if (PON(6)) {
                const int mrows = ctx_out ? MALL : MLAT, nM = (mrows + 253) / 254;
                pg8::Gemm g{HN - DM, (const bf16r*)(wl + W_UP), nM * 256, DFF2, DM, 254, DM}; pg8::StaticOrder S; S.init(nM * 256, DFF2, G, bx);
                EpiUpConv E{(bf16r*)(ws + WS_ACT), a->in[20] + (size_t)l * 3 * DFF2, a->in[21] + (size_t)l * DFF2, mrows};
                for (int i = 0;; ++i) { pg8::Unit u; if (!S.next(i, u)) break; OneUnit S1{u}; pg8::gemm_phase<EpiUpConv, OneUnit, false, true>(lds, g, S1, E); } }
            } else { if (PON(7)) {
                { pg8::Gemm g{(const bf16r*)(ws + WS_ACT), (const bf16r*)(wl + W_DOWN), MLAT, DM, DFF, 256, DFF}; pg8::StaticOrder S; S.init(MLAT, DM, G, bx);
                  EpiRes E{a->out, ctxres, a->out, ctxres, MOD + l * 5 * 6144 + 5 * 1024};
                  pg8::gemm_phase<EpiRes, pg8::StaticOrder, true, true>(lds, g, S, E); }
                if (ctx_out) {
                    pg8::Gemm g{(const bf16r*)(ws + WS_ACT), (const bf16r*)(wl + W_DOWN), MALL, DM, 256, 256, DFF}; SplitOrder S{176, 11, 256, G, bx};
                    EpiPart E{(float*)(ws + WS_PART), MOD + l * 5 * 6144 + 5 * 1024, 256};
                    pg8::gemm_phase<EpiPart, SplitOrder, true, true>(lds, g, S, E); } }
            }
        }
        }
        if (ph + 1 < ph_hi) GRID_SYNC();
    }
}

extern "C" void kernel_launch(void* const* d_in, const int* in_sizes, int n_in, void* d_out, int out_size, void* d_ws, size_t ws_size, hipStream_t stream) {
    static int grid = 0;
    if (grid == 0) {
        int dev = 0, cus = 0, per_cu = 0;
        if (n_in != 24 || ws_size < 255 * MiB) { fprintf(stderr, "kernel_launch: unexpected n_in %d / ws %zu\n", n_in, ws_size); grid = -1; return; }
        hipGetDevice(&dev); hipDeviceGetAttribute(&cus, hipDeviceAttributeMultiprocessorCount, dev);
        if (hipFuncSetAttribute((const void*)mega, hipFuncAttributeMaxDynamicSharedMemorySize, LDS_BYTES) != hipSuccess) { fprintf(stderr, "kernel_launch: hipFuncSetAttribute failed\n"); grid = -1; return; }
        if (hipOccupancyMaxActiveBlocksPerMultiprocessor(&per_cu, (const void*)mega, 512, LDS_BYTES) != hipSuccess || per_cu < 1) { fprintf(stderr, "kernel_launch: occupancy query says %d\n", per_cu); per_cu = 1; }
        (void)hipGetLastError();
        grid = cus;
    }
    if (grid < 0) return;
    if (hipMemsetAsync(d_ws, 0, 32768, stream) != hipSuccess) { fprintf(stderr, "kernel_launch: memset failed\n"); return; }
    Args a{};
    for (int i = 0; i < 24; ++i) a.in[i] = (const float*)d_in[i];
    a.out = (float*)d_out; a.ws = (unsigned char*)d_ws;
#if MK_MULTI
    for (int ph = 0; ph < NPHASE; ++ph) { a.ph_lo = ph; a.ph_hi = ph + 1; hipLaunchKernelGGL(mega, dim3(grid), dim3(512), LDS_BYTES, stream, a); }
#else
    a.ph_lo = 0; a.ph_hi = NPHASE;
    void* args[] = {&a};
    hipError_t e = hipLaunchCooperativeKernel((const void*)mega, dim3(grid), dim3(512), args, LDS_BYTES, stream);
    if (e != hipSuccess) fprintf(stderr, "cooperative launch failed: %s (grid %d)\n", hipGetErrorString(e), grid);
#endif
}
```

```cpp
#include <hip/hip_runtime.h>
#include <hip/hip_cooperative_groups.h>
#include <cstdio>
#include <cstdint>
namespace cg = cooperative_groups;
#ifndef MK_MULTI
#define MK_MULTI 0
#endif
__device__ __forceinline__ int mk_tid() { int t = threadIdx.x; asm volatile("" : "+v"(t)); return t; }
namespace pg8 {
#define PG8_LAS __attribute__((address_space(3)))
typedef unsigned short bf16_t;
typedef short bf16x8 __attribute__((ext_vector_type(8)));
typedef float f32x4 __attribute__((ext_vector_type(4)));
typedef unsigned u32x4 __attribute__((ext_vector_type(4)));
constexpr int BM = 256, BK = 64, HALF = 128, HTB = HALF * BK * 2  , STAGE_BYTES = 8 * HTB, NXCD = 8, WGM = 8;

__host__ __device__ __forceinline__ int lds_byte(int r, int c) { const int st = (r >> 4) * 2 + (c >> 5), rr = r & 15, cc = c & 31, ob = rr * 64 + cc * 2; return st * 1024 + (ob ^ (((ob >> 9) & 1) << 5)); }
__host__ __device__ __forceinline__ void stage_rc(int b, int& R, int& C) { const int st = b / 1024, sb = b % 1024, swz = sb ^ (((sb >> 9) & 1) << 5); R = (st >> 1) * 16 + swz / 64; C = (st & 1) * 32 + (swz % 64) / 2; }
__host__ __device__ __forceinline__ int perm32(int rho) { const int n = rho >> 4, i = rho & 15; return 8 * (i >> 2) + 4 * n + (i & 3); }

struct Unit { int pm, pn, koff; };
struct Gemm { const bf16_t* A; const bf16_t* Bt; int M, N, K; int a_rows; int ldk; };

struct StaticOrder {
    int nM, nN, nwg, G, c;
    __host__ __device__ void init(int M, int N, int G_, int c_) { nM = M / BM; nN = N / BM; nwg = nM * nN; G = G_; c = c_; }
    __host__ __device__ bool next(int i, Unit& u) const {
        const long L = (long)i * G + c; if (L >= nwg) return false;
        int wgid = (int)L; { const int q = nwg / NXCD, r = nwg % NXCD, xcd = wgid % NXCD, off = wgid / NXCD; wgid = (xcd < r ? xcd * (q + 1) : r * (q + 1) + (xcd - r) * q) + off; }
        const int nig = WGM * nN, gid = wgid / nig, fm = gid * WGM, gsz = (nM - fm) < WGM ? (nM - fm) : WGM;
        u.pm = fm + ((wgid % nig) % gsz); u.pn = (wgid % nig) / gsz; u.koff = 0; return true;
    }
    __device__ __forceinline__ void a_ready(const Unit&) const {}
    __device__ __forceinline__ void done(const Unit&) const {}
};

__device__ __forceinline__ unsigned cvt_pk_bf16(float lo, float hi) { unsigned r; asm volatile("v_cvt_pk_bf16_f32 %0, %1, %2" : "=v"(r) : "v"(lo), "v"(hi)); return r; }
typedef float f32x2 __attribute__((ext_vector_type(2)));
__device__ __forceinline__ f32x2 gelu_pk(f32x2 v) {
    const f32x2 av = __builtin_elementwise_abs(v), d = av * 0.2316418882f + 1.0f;
    f32x2 t; t.x = __builtin_amdgcn_rcpf(d.x); t.y = __builtin_amdgcn_rcpf(d.y);
    f32x2 q = t * 0.5307027145f + (-0.7265760135f); q = q * t + 0.7107068705f; q = q * t + (-0.142248368f); q = q * t + 0.127414796f; q = q * t;
    const f32x2 s = (v * v) * (-0.72134752044f);
    f32x2 e; e.x = __builtin_amdgcn_exp2f(s.x); e.y = __builtin_amdgcn_exp2f(s.y);
    const f32x2 m = v * (q * e), r = v - m;
    f32x2 o; o.x = v.x < 0.f ? m.x : r.x; o.y = v.y < 0.f ? m.y : r.y; return o;
}

template <int ACT  > struct EpiBf16 {
    static constexpr bool PERM = true, AFTER_DRAIN = false; static_assert(ACT == 0 || ACT == 1, "EpiBf16: ACT is 0 (none) or 1 (gelu_pk)");
    bf16_t* O; int ldc; const float* bias; int split_cols; size_t split_stride; float scale0;
    __device__ __forceinline__ void operator()(const f32x4 (&acc)[2][2][4][2], const Unit& u, int wr, int wc, int fr, int fq) const {
        const int row0 = u.pm * BM + wr * 64 + fr; int colt = u.pn * BM; bf16_t* base = O;
        float sc = 1.f; if (split_cols) { const int t = colt / split_cols; base += (size_t)t * split_stride; colt -= t * split_cols; if (t == 0) sc = scale0; }
        const int col0 = colt + wc * 32 + 8 * fq, bcol0 = u.pn * BM + wc * 32 + 8 * fq;
        f32x4 bv[2][2];
#pragma unroll
        for (int bj = 0; bj < 2; ++bj)
#pragma unroll
            for (int n = 0; n < 2; ++n) bv[bj][n] = bias ? *(const f32x4*)(bias + bcol0 + bj * HALF + 4 * n) : (f32x4){0.f, 0.f, 0.f, 0.f};
#pragma unroll
        for (int ai = 0; ai < 2; ++ai)
#pragma unroll
            for (int m = 0; m < 4; ++m) { bf16_t* rowp = base + (size_t)(row0 + ai * HALF + m * 16) * ldc + col0;
#pragma unroll
                for (int bj = 0; bj < 2; ++bj) { f32x4 v0 = acc[ai][bj][m][0] + bv[bj][0], v1 = acc[ai][bj][m][1] + bv[bj][1];
                    if (ACT == 1) { f32x2 a = gelu_pk((f32x2){v0[0], v0[1]}), b = gelu_pk((f32x2){v0[2], v0[3]}), c = gelu_pk((f32x2){v1[0], v1[1]}), d = gelu_pk((f32x2){v1[2], v1[3]});
                        v0 = (f32x4){a.x, a.y, b.x, b.y}; v1 = (f32x4){c.x, c.y, d.x, d.y}; }
                    v0 = v0 * sc; v1 = v1 * sc; u32x4 w; w.x = cvt_pk_bf16(v0[0], v0[1]); w.y = cvt_pk_bf16(v0[2], v0[3]); w.z = cvt_pk_bf16(v1[0], v1[1]); w.w = cvt_pk_bf16(v1[2], v1[3]);
                    *(u32x4*)(rowp + bj * HALF) = w; } }
    }
};

template <class Epi, class Sched, bool ALIGN_EPI = false, bool SP2 = false>
__device__ __forceinline__ void gemm_phase(PG8_LAS unsigned char* lds, const Gemm g, const Sched& S, const Epi& E) {
    const int tid = mk_tid(), wid = __builtin_amdgcn_readfirstlane(tid >> 6), lane = tid & 63, wr = wid >> 2, wc = wid & 3, fr = lane & 15, fq = lane >> 4;
    const int K = g.K, nt = K / BK;
    unsigned voffA[2], voffB[2];
#pragma unroll
    for (int i = 0; i < 2; ++i) { int R, C; stage_rc(tid * 16 + i * 8192, R, C); const int Rb = Epi::PERM ? ((R & ~31) + perm32(R & 31)) : R;
        voffA[i] = (unsigned)(R * g.ldk + C) * 2u; voffB[i] = (unsigned)(Rb * g.ldk + C) * 2u; }
    const size_t kstep = (size_t)(BK * 2);
    const size_t hstep = (size_t)HALF * g.ldk * 2;
    const size_t tstep = 2 * hstep;
    const unsigned ldsw = (unsigned)wid * 1024u;
    const int aoff = lds_byte(wr * 64 + fr, fq * 8), boff = lds_byte(wc * 32 + fr, fq * 8);
#define PG8_SA(b, h) (((b) * 2 + (h)) * HTB)
#define PG8_SB(b, h) ((4 + (b) * 2 + (h)) * HTB)
#define PG8_STAGE(bufoff, gbase, voff) do { _Pragma("unroll") for (int _i = 0; _i < 2; ++_i) \
        __builtin_amdgcn_global_load_lds((const unsigned*)((const char*)(gbase) + (voff)[_i]), (PG8_LAS unsigned*)(lds + (bufoff) + ldsw + _i * 8192), 16, 0, 0); } while (0)
#define PG8_LDA(dst, b, h) do { _Pragma("unroll") for (int m = 0; m < 4; ++m) _Pragma("unroll") for (int k = 0; k < 2; ++k) dst[m][k] = *(const PG8_LAS bf16x8*)(lds + PG8_SA(b, h) + aoff + m * 2048 + k * 1024); } while (0)
#define PG8_LDB(dst, b, h) do { _Pragma("unroll") for (int n = 0; n < 2; ++n) _Pragma("unroll") for (int k = 0; k < 2; ++k) dst[n][k] = *(const PG8_LAS bf16x8*)(lds + PG8_SB(b, h) + boff + n * 2048 + k * 1024); } while (0)
#define PG8_MMA(ai, bj, At, Bt) do { __builtin_amdgcn_s_setprio(1); _Pragma("unroll") for (int m = 0; m < 4; ++m) _Pragma("unroll") for (int n = 0; n < 2; ++n) _Pragma("unroll") for (int k = 0; k < 2; ++k) \
        acc[ai][bj][m][n] = __builtin_amdgcn_mfma_f32_16x16x32_bf16(Bt[n][k], At[m][k], acc[ai][bj][m][n], 0, 0, 0); __builtin_amdgcn_s_setprio(0); } while (0)
#define PG8_WAIT_V(n) asm volatile("s_waitcnt vmcnt(" #n ")" ::: "memory")
#define PG8_WAIT_L(n) asm volatile("s_waitcnt lgkmcnt(" #n ")" ::: "memory")
#define PG8_BAR __builtin_amdgcn_s_barrier()
#define PG8_SCHED __builtin_amdgcn_sched_barrier(0)
    Unit cur, nxt; int ui = 0;
    if (!S.next(0, cur)) return;
    f32x4 acc[2][2][4][2];
#pragma unroll
    for (int a = 0; a < 2; ++a)
#pragma unroll
        for (int b = 0; b < 2; ++b)
#pragma unroll
            for (int m = 0; m < 4; ++m)
#pragma unroll
                for (int n = 0; n < 2; ++n) acc[a][b][m][n] = (f32x4){0.f, 0.f, 0.f, 0.f};
    bf16x8 At[4][2], B0[2][2], B1[2][2];
    const size_t atstep = (size_t)g.a_rows * g.ldk * 2; const char* cA = (const char*)g.A + (size_t)cur.pm * atstep + (size_t)cur.koff * 2; const char* cB = (const char*)g.Bt + (size_t)cur.pn * tstep + (size_t)cur.koff * 2;
    S.a_ready(cur);
    if constexpr (SP2) {
        PG8_STAGE(PG8_SB(0, 0), cB, voffB); PG8_STAGE(PG8_SB(0, 1), cB + hstep, voffB); PG8_STAGE(PG8_SA(0, 0), cA, voffA); PG8_STAGE(PG8_SA(0, 1), cA + hstep, voffA);
        if (wr == 1) PG8_BAR;
        PG8_WAIT_V(2); PG8_BAR;
        PG8_STAGE(PG8_SB(1, 0), cB + kstep, voffB); PG8_STAGE(PG8_SA(1, 0), cA + kstep, voffA); PG8_STAGE(PG8_SB(1, 1), cB + hstep + kstep, voffB);
        PG8_WAIT_V(6); PG8_BAR;
    } else {
        PG8_STAGE(PG8_SB(0, 0), cB, voffB); PG8_STAGE(PG8_SA(0, 0), cA, voffA); PG8_STAGE(PG8_SB(0, 1), cB + hstep, voffB); PG8_STAGE(PG8_SA(0, 1), cA + hstep, voffA);
        if (wr == 1) PG8_BAR;
        PG8_WAIT_V(4); PG8_BAR;
        PG8_STAGE(PG8_SB(1, 0), cB + kstep, voffB); PG8_STAGE(PG8_SA(1, 0), cA + kstep, voffA); PG8_STAGE(PG8_SB(1, 1), cB + hstep + kstep, voffB);
        PG8_WAIT_V(6); PG8_BAR;
    }
    for (;;) {
        const bool has_next = S.next(ui + 1, nxt);
        const char* nA = has_next ? (const char*)g.A + (size_t)nxt.pm * atstep + (size_t)nxt.koff * 2 : cA; const char* nB = has_next ? (const char*)g.Bt + (size_t)nxt.pn * tstep + (size_t)nxt.koff * 2 : cB;
        for (int t = 0; t < nt; t += 2) {
            const bool last = (t == nt - 2);
            const char* a1 = cA + (size_t)(t + 1) * kstep;
            const char* a2 = last ? nA : cA + (size_t)(t + 2) * kstep; const char* b2 = last ? nB : cB + (size_t)(t + 2) * kstep;
            const char* a3 = a2 + kstep; const char* b3 = b2 + kstep;
            if (last && has_next) S.a_ready(nxt);
            if constexpr (SP2) {
            PG8_LDB(B0, 0, 0); PG8_LDB(B1, 0, 1); PG8_SCHED; PG8_LDA(At, 0, 0); PG8_STAGE(PG8_SA(1, 1), a1 + hstep, voffA);
            PG8_WAIT_V(8); PG8_WAIT_L(0); PG8_BAR; PG8_MMA(0, 0, At, B0); PG8_MMA(0, 1, At, B1); PG8_BAR; PG8_SCHED;
            PG8_LDA(At, 0, 1); PG8_STAGE(PG8_SB(0, 0), b2, voffB); PG8_STAGE(PG8_SB(0, 1), b2 + hstep, voffB); PG8_STAGE(PG8_SA(0, 0), a2, voffA);
            PG8_WAIT_V(8); PG8_WAIT_L(0); PG8_BAR; PG8_MMA(1, 0, At, B0); PG8_MMA(1, 1, At, B1); PG8_BAR; PG8_SCHED;
            PG8_LDB(B0, 1, 0); PG8_LDB(B1, 1, 1); PG8_SCHED; PG8_LDA(At, 1, 0); PG8_STAGE(PG8_SA(0, 1), a2 + hstep, voffA);
            PG8_WAIT_V(8); PG8_WAIT_L(0); PG8_BAR; PG8_MMA(0, 0, At, B0); PG8_MMA(0, 1, At, B1); PG8_BAR; PG8_SCHED;
            PG8_LDA(At, 1, 1); PG8_STAGE(PG8_SB(1, 0), b3, voffB); PG8_STAGE(PG8_SB(1, 1), b3 + hstep, voffB); PG8_STAGE(PG8_SA(1, 0), a3, voffA);
            PG8_WAIT_V(8); PG8_WAIT_L(0); PG8_BAR; PG8_MMA(1, 0, At, B0); PG8_MMA(1, 1, At, B1); PG8_BAR; PG8_SCHED;
            } else {
            PG8_LDB(B0, 0, 0); PG8_SCHED; PG8_LDA(At, 0, 0); PG8_STAGE(PG8_SA(1, 1), a1 + hstep, voffA);
            PG8_WAIT_L(8); PG8_BAR; PG8_WAIT_L(0); PG8_MMA(0, 0, At, B0); PG8_BAR; PG8_SCHED;
            PG8_LDB(B1, 0, 1); PG8_STAGE(PG8_SB(0, 0), b2, voffB);
            PG8_BAR; PG8_WAIT_L(0); PG8_MMA(0, 1, At, B1); PG8_BAR;
            PG8_LDA(At, 0, 1); PG8_STAGE(PG8_SA(0, 0), a2, voffA);
            PG8_BAR; PG8_WAIT_L(0); PG8_MMA(1, 0, At, B0); PG8_BAR; PG8_SCHED;
            PG8_STAGE(PG8_SB(0, 1), b2 + hstep, voffB);
            PG8_WAIT_V(6); PG8_BAR; PG8_MMA(1, 1, At, B1); PG8_BAR;
            PG8_LDB(B0, 1, 0); PG8_SCHED; PG8_LDA(At, 1, 0); PG8_STAGE(PG8_SA(0, 1), a2 + hstep, voffA);
            PG8_WAIT_L(8); PG8_BAR; PG8_WAIT_L(0); PG8_MMA(0, 0, At, B0); PG8_BAR; PG8_SCHED;
            PG8_LDB(B1, 1, 1); PG8_STAGE(PG8_SB(1, 0), b3, voffB);
            PG8_BAR; PG8_WAIT_L(0); PG8_MMA(0, 1, At, B1); PG8_BAR;
            PG8_LDA(At, 1, 1); PG8_STAGE(PG8_SA(1, 0), a3, voffA);
            PG8_BAR; PG8_WAIT_L(0); PG8_MMA(1, 0, At, B0); PG8_BAR; PG8_SCHED;
            PG8_STAGE(PG8_SB(1, 1), b3 + hstep, voffB);
            PG8_WAIT_V(6); PG8_BAR; PG8_MMA(1, 1, At, B1); PG8_BAR;
            }
        }
        if constexpr (ALIGN_EPI) { if (wr == 0) PG8_BAR; }
        if constexpr (!Epi::AFTER_DRAIN) { const int l2_ = mk_tid() & 63; E(acc, cur, wr, wc, l2_ & 15, l2_ >> 4); S.done(cur); }
        if (!has_next) break;
#pragma unroll
        for (int a = 0; a < 2; ++a)
#pragma unroll
            for (int b = 0; b < 2; ++b)
#pragma unroll
                for (int m = 0; m < 4; ++m)
#pragma unroll
                    for (int n = 0; n < 2; ++n) acc[a][b][m][n] = (f32x4){0.f, 0.f, 0.f, 0.f};
        cur = nxt; cA = nA; cB = nB; ++ui;
        if constexpr (ALIGN_EPI) { if (wr == 1) PG8_BAR; }
    }
    PG8_WAIT_V(0);
    if constexpr (!ALIGN_EPI) { if (wr == 0) PG8_BAR; }
    PG8_BAR;
    if constexpr (Epi::AFTER_DRAIN) { const int l2_ = mk_tid() & 63; E.fused(acc, cur, wr, wc, l2_ & 15, l2_ >> 4, lds, wid, l2_); S.done(cur); }
#undef PG8_SA
#undef PG8_SB
#undef PG8_STAGE
#undef PG8_LDA
#undef PG8_LDB
#undef PG8_MMA
#undef PG8_WAIT_V
#undef PG8_WAIT_L
#undef PG8_BAR
#undef PG8_SCHED
}
}

#include <hip/hip_bf16.h>
#include <cmath>
namespace attn_body {
using bf16=__hip_bfloat16;
using bf16x8=__attribute__((ext_vector_type(8)))short;
using s16x4=__attribute__((ext_vector_type(4)))short;
using f32x16=__attribute__((ext_vector_type(16)))float;
using u32x4=__attribute__((ext_vector_type(4)))unsigned;
constexpr int D=64,QP=512,KVP=128;
constexpr int NW=8,QBLK=32,QB=QBLK*NW,KVBLK=64;
constexpr int ATTN_UNIT_ROWS=QB;
__device__ __forceinline__ int crow(int r,int hi){return (r&3)+8*(r>>2)+4*hi;}
#define SBAR() __builtin_amdgcn_sched_barrier(0)
__device__ __forceinline__ void cmask(f32x16&p0,f32x16&p1,int jb,int qrel,int hi){
  const float NEG=-INFINITY; int kb=64*jb+4*hi;
  #pragma unroll
  for(int r=0;r<16;++r){int kv=kb+(r&3)+8*(r>>2); if(kv>qrel)p0[r]=NEG; if(kv+32>qrel)p1[r]=NEG;}
}

constexpr int NSLOT=3, SLOTB=8192;
constexpr int LDS_K=0, LDS_V=NSLOT*SLOTB, LDS_WS=2*NSLOT*SLOTB, LDS_OST=LDS_WS+NW*64*4, LDS_BYTES=LDS_OST+NW*4096;
constexpr float C2=0.125f*1.4426950408889634f;
__device__ __forceinline__ void glds16(const void*gsrc,unsigned lds_dst){unsigned keep;
  asm volatile("s_mov_b32 %0, m0\n\ts_mov_b32 m0, %2\n\ts_nop 0\n\tglobal_load_lds_dwordx4 %1, off\n\ts_mov_b32 m0, %0":"=&s"(keep):"v"(gsrc),"s"(lds_dst):"memory");}
__device__ __forceinline__ float max3f(float a,float b,float c){float r;asm("v_max3_f32 %0, %1, %2, %3":"=v"(r):"v"(a),"v"(b),"v"(c));return r;}
__device__ __forceinline__ float max2f(float a,float b){float r;asm("v_max_f32_e32 %0, %1, %2":"=v"(r):"v"(a),"v"(b));return r;}
__device__ __forceinline__ float fadd_s(float a,float b){float r;asm("v_add_f32_e32 %0, %1, %2":"=v"(r):"v"(a),"v"(b));return r;}
__device__ __forceinline__ float fsub_s(float a,float b){float r;asm("v_sub_f32_e32 %0, %1, %2":"=v"(r):"v"(a),"v"(b));return r;}
typedef float f32x2_t __attribute__((ext_vector_type(2))); typedef __bf16 bf16x2_t __attribute__((ext_vector_type(2)));
__device__ __forceinline__ unsigned cvtpk_s(float lo,float hi){f32x2_t v={lo,hi};bf16x2_t b=__builtin_convertvector(v,bf16x2_t);return __builtin_bit_cast(unsigned,b);}
#define WAIT_BAR(N) asm volatile("s_waitcnt vmcnt(" #N ") lgkmcnt(0)\n\ts_barrier":::"memory")

__device__ __forceinline__ void qkt(f32x16&p0,f32x16&p1,const char*Kslot,const bf16x8*qr,const f32x16&negm,int r32,int hi){
  const char*kb=Kslot+hi*1024+r32*16;
  #pragma unroll
  for(int d0=0;d0<4;++d0){
    const bf16x8 b0=*reinterpret_cast<const bf16x8*>(kb+d0*2048);
    const bf16x8 b1=*reinterpret_cast<const bf16x8*>(kb+d0*2048+512);
    if(d0==0){p0=__builtin_amdgcn_mfma_f32_32x32x16_bf16(b0,qr[0],negm,0,0,0);p1=__builtin_amdgcn_mfma_f32_32x32x16_bf16(b1,qr[0],negm,0,0,0);}
    else{p0=__builtin_amdgcn_mfma_f32_32x32x16_bf16(b0,qr[d0],p0,0,0,0);p1=__builtin_amdgcn_mfma_f32_32x32x16_bf16(b1,qr[d0],p1,0,0,0);}}
}
typedef __attribute__((address_space(3))) const char* lds_cptr;
typedef short v4i16_t __attribute__((ext_vector_type(4)));
__device__ __forceinline__ void kload8(bf16x8*kf,lds_cptr kp){
  kf[0]=*(const __attribute__((address_space(3))) bf16x8*)(kp);      kf[1]=*(const __attribute__((address_space(3))) bf16x8*)(kp+512);
  kf[2]=*(const __attribute__((address_space(3))) bf16x8*)(kp+2048); kf[3]=*(const __attribute__((address_space(3))) bf16x8*)(kp+2560);
  kf[4]=*(const __attribute__((address_space(3))) bf16x8*)(kp+4096); kf[5]=*(const __attribute__((address_space(3))) bf16x8*)(kp+4608);
  kf[6]=*(const __attribute__((address_space(3))) bf16x8*)(kp+6144); kf[7]=*(const __attribute__((address_space(3))) bf16x8*)(kp+6656);
}
__device__ __forceinline__ void kload2(bf16x8*kf,lds_cptr kp,int j){ kf[2*j]=*(const __attribute__((address_space(3))) bf16x8*)(kp+j*2048); kf[2*j+1]=*(const __attribute__((address_space(3))) bf16x8*)(kp+j*2048+512); }
__device__ __forceinline__ s16x4 vtr(lds_cptr p){ return __builtin_bit_cast(s16x4,__builtin_amdgcn_ds_read_tr16_b64_v4i16((__attribute__((address_space(3))) v4i16_t*)p)); }
__device__ __forceinline__ float rowmax(const f32x16&p0,const f32x16&p1){
  float a=max3f(p0[0],p0[1],p1[0]),b=max3f(p0[2],p0[3],p1[1]);a=max3f(a,p1[2],p1[3]);
  #pragma unroll
  for(int r=4;r<16;r+=4){a=max3f(a,p0[r],p0[r+1]);b=max3f(b,p0[r+2],p0[r+3]);a=max3f(a,p1[r],p1[r+1]);b=max3f(b,p1[r+2],p1[r+3]);}
  const float m=max2f(a,b);
  auto rr=__builtin_amdgcn_permlane32_swap(__float_as_uint(m),__float_as_uint(m),false,false);
  return max2f(__uint_as_float(rr[0]),__uint_as_float(rr[1]));
}
__device__ __forceinline__ void pv(f32x16*o,int vb,bf16x8 pa0,bf16x8 pa1,bf16x8 pa2,bf16x8 pa3){
  #pragma unroll
  for(int d0=0;d0<2;++d0){s16x4 lo[4],hi[4];
    #pragma unroll
    for(int ks=0;ks<4;++ks){
      asm volatile("ds_read_b64_tr_b16 %0,%1 offset:%c2":"=&v"(lo[ks]):"v"(vb),"i"(d0*4096+ks*1024):"memory");
      asm volatile("ds_read_b64_tr_b16 %0,%1 offset:%c2":"=&v"(hi[ks]):"v"(vb),"i"(d0*4096+ks*1024+512):"memory");}
    asm volatile("s_waitcnt lgkmcnt(0)":::"memory");SBAR();
    #define PK(k) (bf16x8){lo[k][0],lo[k][1],lo[k][2],lo[k][3],hi[k][0],hi[k][1],hi[k][2],hi[k][3]}
    o[d0]=__builtin_amdgcn_mfma_f32_32x32x16_bf16(pa0,PK(0),o[d0],0,0,0);
    o[d0]=__builtin_amdgcn_mfma_f32_32x32x16_bf16(pa1,PK(1),o[d0],0,0,0);
    o[d0]=__builtin_amdgcn_mfma_f32_32x32x16_bf16(pa2,PK(2),o[d0],0,0,0);
    o[d0]=__builtin_amdgcn_mfma_f32_32x32x16_bf16(pa3,PK(3),o[d0],0,0,0);
    #undef PK
  }
}

#ifndef ATTN_STORE16
#define ATTN_STORE16(p,v) (*(u32x4*)(p)=(v))
#endif
template<int THRL> __device__ __forceinline__ void attn_unit(const bf16*Qu,const bf16*__restrict__ Kh,const bf16*__restrict__ Vh,bf16*Ou,const int NT,char*shm){
  const int tid=mk_tid(),lane=tid&63,r32=lane&31,hi=lane>>5; const int wid=__builtin_amdgcn_readfirstlane(tid>>6);
  const bf16*Qw=Qu+(long)(wid*QBLK)*QP;
  const unsigned lds0=(unsigned)(uintptr_t)shm;
  float*wsf=(float*)(shm+LDS_WS)+wid*64;
  const bf16*ksrc=Kh+(long)lane*KVP+wid*8;
  const bf16*vsrc=Vh+(long)(16*(wid&3)+(lane>>2))*KVP+(wid>>2)*32+(lane&3)*8;
  const unsigned kdst=lds0+LDS_K+wid*1024, vdst=lds0+LDS_V+wid*1024;
  #define DMA_K(t,slot) glds16(ksrc+(long)(t)*KVBLK*KVP,(unsigned)__builtin_amdgcn_readfirstlane(kdst+(slot)))
  #define DMA_V(t,slot) glds16(vsrc+(long)(t)*KVBLK*KVP,(unsigned)__builtin_amdgcn_readfirstlane(vdst+(slot)))
  const int vb0=(int)(lds0+LDS_V)+((lane>>4)&1)*32+(lane&3)*8+(4*hi+((lane&15)>>2))*64;
  const char*Kbase=shm+LDS_K; bf16x8 kf[8];
  const lds_cptr shm3=(lds_cptr)shm; const lds_cptr kp0=shm3+LDS_K+hi*1024+r32*16; const lds_cptr vp0=shm3+LDS_V+((lane>>4)&1)*32+(lane&3)*8+(4*hi+((lane&15)>>2))*64;
  DMA_K(0,0);DMA_V(0,0);DMA_K(1,SLOTB);
  bf16x8 qr[4];
  #pragma unroll
  for(int d0=0;d0<4;++d0)qr[d0]=*reinterpret_cast<const bf16x8*>(&Qw[(long)r32*QP+d0*16+hi*8]);
  float mhat=0.f,l_reg=0.f;f32x16 o[2];o[0]=f32x16{};o[1]=f32x16{};f32x16 negm=f32x16{};asm volatile("":"+v"(negm));
  #define CMASK(P0,P1,t) do{}while(0)
  bool resc=false;
  #define START(P0,P1) do{ const float rm=rowmax(P0,P1); resc=false; \
    { const float dl=rm; mhat=fadd_s(mhat,dl); \
      _Pragma("unroll") for(int r=0;r<16;++r){P0[r]=fsub_s(P0[r],dl);P1[r]=fsub_s(P1[r],dl);} \
      _Pragma("unroll") for(int r=0;r<16;++r)negm[r]=-mhat; asm volatile("":"+v"(negm)); } \
    _Pragma("unroll") for(int r=0;r<16;++r)P0[r]=__builtin_amdgcn_exp2f(P0[r]); }while(0)
  #define RESC() do{ if(resc){ asm volatile("s_waitcnt lgkmcnt(0)":::"memory"); \
      _Pragma("unroll") for(int d_=0;d_<2;++d_) _Pragma("unroll") for(int r=0;r<16;++r)o[d_][r]*=wsf[crow(r,hi)]; } }while(0)
  f32x16 pA0,pA1,pB0,pB1;
  int sl_prev=0,sl_cur=0,sl_next=SLOTB;
  #define ROT() do{sl_prev=sl_cur;sl_cur=sl_next;sl_next=(sl_next==(NSLOT-1)*SLOTB)?0:sl_next+SLOTB;}while(0)
  DMA_K(2,2*SLOTB);
  WAIT_BAR(3);
  qkt(pA0,pA1,Kbase,qr,negm,r32,hi);asm volatile("s_nop 15\n\ts_nop 7":"+v"(pA0),"+v"(pA1));CMASK(pA0,pA1,0);
  START(pA0,pA1);
  _Pragma("unroll") for(int r=0;r<16;++r)pA1[r]=__builtin_amdgcn_exp2f(pA1[r]);
  WAIT_BAR(0);
  DMA_K(3,0);DMA_V(1,SLOTB);
  ROT();
  kload8(kf,kp0+sl_cur);
  WAIT_BAR(2);
  s16x4 vlo[8],vhi[8]; u32x4 pw0,pw1,pw2,pw3;
  #define PKW(P,B) cvtpk_s(P[B],P[B+1])
  #define PAF(k) __builtin_bit_cast(bf16x8,pw##k)
  #define VFR(i) (bf16x8){vlo[i][0],vlo[i][1],vlo[i][2],vlo[i][3],vhi[i][0],vhi[i][1],vhi[i][2],vhi[i][3]}
  #define PIN(x) asm volatile("":"+v"(x))
  #define MX3(a,b,c) __builtin_fmaxf(__builtin_fmaxf((a),(b)),(c))
  #define GAPA(MF,A0,A1,A2,A3,W0,W1,PW) do{ MF; sacc+=A0; sacc+=A1; sacc+=A2; sacc+=A3; PIN(sacc); W0; W1; PIN(PW); SBAR(); }while(0)
  #define EX(v) __builtin_amdgcn_exp2f(v)
  #define GAPB(MF,X,B) do{ MF; X[B]=EX(X[B]); X[B+1]=EX(X[B+1]); X[B+2]=EX(X[B+2]); X[B+3]=EX(X[B+3]); PIN(X); SBAR(); }while(0)
  #define VRD(i) do{ vlo[i]=vtr(vp_+(((i)>>2)*4096+((i)&3)*1024)); vhi[i]=vtr(vp_+(((i)>>2)*4096+((i)&3)*1024+512)); }while(0)
  #define KRD(G,j) do{ if(G){ kload2(kf,kp0+sl_next,j); SBAR(); } }while(0)
  #define STEP(C0,C1,P0,P1,t,GK,GV,GL) do{ SBAR(); \
    const lds_cptr vp_=vp0+sl_prev; \
    VRD(0); SBAR(); float sacc=(P0[0]+P0[1]); \
    GAPA(C0=__builtin_amdgcn_mfma_f32_32x32x16_bf16(kf[0],qr[0],negm,0,0,0), P0[2],P0[3],P0[4],P0[5],     pw0[0]=PKW(P0,0), pw0[1]=PKW(P0,2), pw0); \
    VRD(4); SBAR(); GAPA(C1=__builtin_amdgcn_mfma_f32_32x32x16_bf16(kf[1],qr[0],negm,0,0,0), P0[6],P0[7],P0[8],P0[9],     pw0[2]=PKW(P0,4), pw0[3]=PKW(P0,6), pw0); \
    VRD(1); SBAR(); GAPA(C0=__builtin_amdgcn_mfma_f32_32x32x16_bf16(kf[2],qr[1],C0,0,0,0),   P0[10],P0[11],P0[12],P0[13], pw1[0]=PKW(P0,8), pw1[1]=PKW(P0,10), pw1); \
    VRD(5); SBAR(); GAPA(C1=__builtin_amdgcn_mfma_f32_32x32x16_bf16(kf[3],qr[1],C1,0,0,0),   P0[14],P0[15],P1[0],P1[1],   pw1[2]=PKW(P0,12),pw1[3]=PKW(P0,14), pw1); \
    VRD(2); SBAR(); GAPA(C0=__builtin_amdgcn_mfma_f32_32x32x16_bf16(kf[4],qr[2],C0,0,0,0),   P1[2],P1[3],P1[4],P1[5],     pw2[0]=PKW(P1,0), pw2[1]=PKW(P1,2), pw2); \
    VRD(6); SBAR(); GAPA(C1=__builtin_amdgcn_mfma_f32_32x32x16_bf16(kf[5],qr[2],C1,0,0,0),   P1[6],P1[7],P1[8],P1[9],     pw2[2]=PKW(P1,4), pw2[3]=PKW(P1,6), pw2); \
    VRD(3); SBAR(); GAPA(C0=__builtin_amdgcn_mfma_f32_32x32x16_bf16(kf[6],qr[3],C0,0,0,0),   P1[10],P1[11],P1[12],P1[13], pw3[0]=PKW(P1,8), pw3[1]=PKW(P1,10), pw3); \
    VRD(7); SBAR(); GAPA(C1=__builtin_amdgcn_mfma_f32_32x32x16_bf16(kf[7],qr[3],C1,0,0,0),   P1[14],P1[15],0.f,0.f,       pw3[2]=PKW(P1,12),pw3[3]=PKW(P1,14), pw3); \
    l_reg+=sacc; \
    if(GK){DMA_K((t)+3,sl_cur);} if(GV){DMA_V((t)+1,sl_next);} \
    CMASK(C0,C1,t); \
    { float a=MX3(C0[0],C0[1],C1[0]),b=MX3(C0[2],C0[3],C1[1]); a=MX3(a,C1[2],C1[3]); \
      _Pragma("unroll") for(int r=4;r<16;r+=4){a=MX3(a,C0[r],C0[r+1]);b=MX3(b,C0[r+2],C0[r+3]);a=MX3(a,C1[r],C1[r+1]);b=MX3(b,C1[r+2],C1[r+3]);} \
      float rm=__builtin_fmaxf(a,b); { auto rr=__builtin_amdgcn_permlane32_swap(__float_as_uint(rm),__float_as_uint(rm),false,false); rm=__builtin_fmaxf(__uint_as_float(rr[0]),__uint_as_float(rr[1])); } \
      resc=false; \
      if(__builtin_expect(__any(rm>(float)THRL),0)){ const float dl=__builtin_fmaxf(rm,0.f); mhat+=dl; \
        _Pragma("unroll") for(int r=0;r<16;++r){C0[r]-=dl;C1[r]-=dl;} \
        _Pragma("unroll") for(int r=0;r<16;++r)negm[r]=-mhat; asm volatile("":"+v"(negm)); \
        const float f=__builtin_amdgcn_exp2f(-dl); l_reg*=f; if(hi==0)wsf[r32]=f; resc=true; } } \
    SBAR(); \
    GAPB(o[0]=__builtin_amdgcn_mfma_f32_32x32x16_bf16(PAF(0),VFR(0),o[0],0,0,0), C0,0); \
    GAPB(o[1]=__builtin_amdgcn_mfma_f32_32x32x16_bf16(PAF(0),VFR(4),o[1],0,0,0), C0,4); \
    KRD(GL,0); GAPB(o[0]=__builtin_amdgcn_mfma_f32_32x32x16_bf16(PAF(1),VFR(1),o[0],0,0,0), C0,8); \
    KRD(GL,1); GAPB(o[1]=__builtin_amdgcn_mfma_f32_32x32x16_bf16(PAF(1),VFR(5),o[1],0,0,0), C0,12); \
    KRD(GL,2); GAPB(o[0]=__builtin_amdgcn_mfma_f32_32x32x16_bf16(PAF(2),VFR(2),o[0],0,0,0), C1,0); \
    KRD(GL,3); GAPB(o[1]=__builtin_amdgcn_mfma_f32_32x32x16_bf16(PAF(2),VFR(6),o[1],0,0,0), C1,4); \
    GAPB(o[0]=__builtin_amdgcn_mfma_f32_32x32x16_bf16(PAF(3),VFR(3),o[0],0,0,0), C1,8); \
    GAPB(o[1]=__builtin_amdgcn_mfma_f32_32x32x16_bf16(PAF(3),VFR(7),o[1],0,0,0), C1,12); \
    }while(0)
  int t=1;
  #undef CMASK
  #define CMASK(P0,P1,t) do{}while(0)
  for(;t+5<NT;t+=2){
    STEP(pB0,pB1,pA0,pA1,t,true,true,true);     WAIT_BAR(2); RESC(); ROT();
    STEP(pA0,pA1,pB0,pB1,t+1,true,true,true);   WAIT_BAR(2); RESC(); ROT();
  }
  #undef CMASK
  #define CMASK(P0,P1,t) do{}while(0)
  #define ENDW(tt) do{ if((tt)+3<NT){WAIT_BAR(2);} else if((tt)+2<NT){WAIT_BAR(1);} else {WAIT_BAR(0);} }while(0)
  for(;t+1<NT;t+=2){
    STEP(pB0,pB1,pA0,pA1,t,(t+3<NT),(t+1<NT),(t+1<NT));       ENDW(t);   RESC(); ROT();
    STEP(pA0,pA1,pB0,pB1,t+1,(t+4<NT),(t+2<NT),(t+2<NT));     ENDW(t+1); RESC(); ROT();
  }
  STEP(pB0,pB1,pA0,pA1,NT-1,false,false,false); RESC();
  { float sacc=pB0[0]+pB0[1]; _Pragma("unroll") for(int r=2;r<16;++r)sacc+=pB0[r]; _Pragma("unroll") for(int r=0;r<16;++r)sacc+=pB1[r]; l_reg+=sacc;
    pw0=(u32x4){PKW(pB0,0),PKW(pB0,2),PKW(pB0,4),PKW(pB0,6)};pw1=(u32x4){PKW(pB0,8),PKW(pB0,10),PKW(pB0,12),PKW(pB0,14)};pw2=(u32x4){PKW(pB1,0),PKW(pB1,2),PKW(pB1,4),PKW(pB1,6)};pw3=(u32x4){PKW(pB1,8),PKW(pB1,10),PKW(pB1,12),PKW(pB1,14)};
    SBAR(); pv(o,vb0+sl_cur,PAF(0),PAF(1),PAF(2),PAF(3)); }
  #undef PKW
  #undef PAF
  #undef VFR
  #undef PIN
  #undef MX3
  #undef GAPA
  #undef GAPB
  #undef EX
  #undef VRD
  #undef KRD
  #undef STEP
  #undef ENDW
  {auto rr=__builtin_amdgcn_permlane32_swap(__float_as_uint(l_reg),__float_as_uint(l_reg),false,false);l_reg=__uint_as_float(rr[0])+__uint_as_float(rr[1]);}
  if(hi==0)wsf[32+r32]=l_reg;asm volatile("s_waitcnt lgkmcnt(0)":::"memory");
  float rli[16];
  #pragma unroll
  for(int r=0;r<16;++r)rli[r]=__builtin_amdgcn_rcpf(wsf[32+crow(r,hi)]);
  bf16*Ow=Ou+(long)(wid*QBLK)*QP;
  { bf16*stg=(bf16*)(shm+LDS_OST)+wid*2048;
    #pragma unroll
    for(int r=0;r<16;++r){const int orow=crow(r,hi);
      #pragma unroll
      for(int d0=0;d0<2;++d0)stg[orow*64+d0*32+r32]=__float2bfloat16(o[d0][r]*rli[r]);}
    asm volatile("s_waitcnt lgkmcnt(0)":::"memory");
    #pragma unroll
    for(int i=0;i<4;++i){const int row=i*8+(lane>>3),ch=lane&7; const u32x4 v=*(const u32x4*)(stg+row*64+ch*8); ATTN_STORE16(Ow+(long)row*QP+ch*8,v);} }
  asm volatile("s_waitcnt lgkmcnt(0)\n\ts_barrier":::"memory");
  #undef DMA_K
  #undef DMA_V
  #undef CMASK
  #undef START
  #undef RESC
  #undef ROT
}
constexpr int ATTN_LDS_BYTES=LDS_BYTES;
#undef SBAR
#undef WAIT_BAR
}

#define LAS __attribute__((address_space(3)))
typedef unsigned short bf16r;
typedef float f4 __attribute__((ext_vector_type(4)));
typedef unsigned u4 __attribute__((ext_vector_type(4)));
typedef unsigned u2 __attribute__((ext_vector_type(2)));
typedef short s8v __attribute__((ext_vector_type(8)));

constexpr int DM = 1024, SEQL = 4096, CTXL = 256, MLAT = 16384, MCTX = 1024, MALL = 17408;
constexpr int DIN = 1792, DFF = 2816, DFF2 = 5632, KVR = 4352, NCH = 68;
constexpr float EPSN = 1e-6f;
constexpr size_t MiB = 1u << 20;
constexpr size_t WS_MOD = 1 * MiB, WS_COS = 2 * MiB, WS_SIN = 2 * MiB + 512 * 1024, WS_GW = 3 * MiB, WS_AGGA = 4 * MiB, WS_AGGB = 6 * MiB, WS_CTXRES = 8 * MiB;
constexpr size_t WS_W = 12 * MiB, W_LAYER = 22 * MiB, W_IN = 0, W_OUT = 3 * MiB + 512 * 1024, W_UP = 5 * MiB + 512 * 1024, W_DOWN = 16 * MiB + 512 * 1024;
constexpr size_t WS_HN = 56 * MiB + 4096;
constexpr size_t WS_Q = 92 * MiB, WS_K = 109 * MiB, WS_V = 114 * MiB, WS_XL = 119 * MiB, WS_GG = 136 * MiB, WS_MIX = 153 * MiB;
constexpr size_t WS_LAB = 187 * MiB;
constexpr size_t WS_O = WS_HN;
constexpr size_t WS_PART = 187 * MiB;
constexpr size_t WS_ACT = 92 * MiB;
constexpr int LDS_BYTES = 147456;
constexpr int NPHASE = 18;
constexpr int L1_TAB_OFF = 84992;
#ifndef PHM
#define PHM 0x3ff
#endif
#define PON(k) ((PHM >> (k)) & 1)

struct Args { const float* in[24]; float* out; unsigned char* ws; int ph_lo, ph_hi; };
typedef const __attribute__((address_space(4))) Args* KA;

#define LDS_WAIT() asm volatile("s_waitcnt lgkmcnt(0)" ::: "memory")
__device__ __forceinline__ unsigned pk2(float lo, float hi) { return attn_body::cvtpk_s(lo, hi); }
__device__ __forceinline__ float bf_lo(unsigned w) { return __builtin_bit_cast(float, w << 16); }
__device__ __forceinline__ float bf_hi(unsigned w) { return __builtin_bit_cast(float, w & 0xffff0000u); }
__device__ __forceinline__ float wave_sum(float v) {
#pragma unroll
    for (int o = 1; o < 64; o <<= 1) v += __shfl_xor(v, o);
    return v;
}
__device__ __forceinline__ float fexp(float x) { return __builtin_amdgcn_exp2f(x * 1.4426950408889634f); }
__device__ __forceinline__ float sigmoidf_(float x) { return __builtin_amdgcn_rcpf(1.f + fexp(-x)); }
__device__ __forceinline__ float gelu_tanh(float x) { const float z = 0.7978845608028654f * (x + 0.044715f * x * x * x); return x * sigmoidf_(2.f * z); }
__device__ __forceinline__ int kvrow(int row) { return row < MLAT ? (row >> 12) * KVR + CTXL + (row & 4095) : ((row - MLAT) >> 8) * KVR + ((row - MLAT) & 255); }

__device__ __forceinline__ int win_dst(int s) {
    if (s < 512) { const int h = s >> 6, d = s & 63; return (h >> 2) * 256 + (d >> 5) * 128 + (h & 3) * 32 + (d & 31); }
    if (s < 768) { const int t = s - 512, hh = t >> 6, d = t & 63; return 512 + (d >> 5) * 128 + hh * 32 + (d & 31); }
    return s;
}
__device__ __forceinline__ int wup_dst(int s) { return s < DFF ? (s >> 7) * 256 + (s & 127) : ((s - DFF) >> 7) * 256 + 128 + ((s - DFF) & 127); }

template <int MODE> __device__ __forceinline__ void p0_transpose_item(const float* W, int K, int N, bf16r* WT, const float* ksA, const float* ksB, LAS float* scr, int item, int lane) {
    const int nblk = N / 32, kb = item / nblk, nb = item % nblk, k0 = 64 * kb, n0 = 32 * nb;
    float tv[32];
#pragma unroll
    for (int i = 0; i < 32; ++i) { const int kk = 2 * i + (lane >> 5); tv[i] = __builtin_nontemporal_load(W + (size_t)(k0 + kk) * N + n0 + (lane & 31)); }
#pragma unroll
    for (int i = 0; i < 32; ++i) { const int kk = 2 * i + (lane >> 5); float v = tv[i];
        if (MODE == 3) { const int k = k0 + kk; v *= (k < 512 ? ksA[k] : ksB[k - 512]); }
        scr[kk * 33 + (lane & 31)] = v; }
    LDS_WAIT();
    const int c = lane & 7;
#pragma unroll
    for (int j = 0; j < 4; ++j) { const int n = (lane >> 3) + 8 * j; const LAS float* s = scr + (8 * c) * 33 + n;
        u4 o; o.x = pk2(s[0 * 33], s[1 * 33]); o.y = pk2(s[2 * 33], s[3 * 33]); o.z = pk2(s[4 * 33], s[5 * 33]); o.w = pk2(s[6 * 33], s[7 * 33]);
        const int sc = n0 + n; const int dst = MODE == 1 ? win_dst(sc) : MODE == 2 ? wup_dst(sc) : sc;
        *(u4*)(WT + (size_t)dst * K + k0 + 8 * c) = o; }
    LDS_WAIT();
}

__device__ __forceinline__ void p0_phase(KA a, LAS unsigned char* lds, int tid, int wid, int lane, int G) {
    unsigned char* ws = a->ws;
    float* MOD = (float*)(ws + WS_MOD);
    {
        LAS float* sc = (LAS float*)lds; LAS float* red = sc + 5 * 1024;
        bool have = false;
        for (int it = blockIdx.x; it < 192; it += G) {
            if (!have) { for (int e = tid; e < 5 * 1024; e += 512) { const int r = e >> 10, k = e & 1023; const float v = r < 4 ? a->in[1][r * 1024 + k] : a->in[3][k]; sc[e] = v * sigmoidf_(v); } have = true; }
            __syncthreads();
            const int l = it / 96, nb = it % 96;
            const float* wp = a->in[4] + (size_t)l * 1024 * 6144 + (size_t)(wid * 128) * 6144 + nb * 64 + lane;
            float acc[5] = {0.f, 0.f, 0.f, 0.f, 0.f};
#pragma unroll 32
            for (int k = 0; k < 128; ++k) { const float wv = __builtin_nontemporal_load(wp + (size_t)k * 6144);
#pragma unroll
                for (int r = 0; r < 5; ++r) acc[r] += sc[r * 1024 + wid * 128 + k] * wv; }
#pragma unroll
            for (int r = 0; r < 5; ++r) red[(wid * 5 + r) * 64 + lane] = acc[r];
            __syncthreads();
            if (tid < 320) { const int r = tid >> 6, col = tid & 63; float s = a->in[5][l * 6144 + nb * 64 + col];
#pragma unroll
                for (int w = 0; w < 8; ++w) s += red[(w * 5 + r) * 64 + col];
                MOD[(l * 5 + r) * 6144 + nb * 64 + col] = s; }
        }
        __syncthreads();
    }
    {
        float* cosT = (float*)(ws + WS_COS); float* sinT = (float*)(ws + WS_SIN); bf16r* GW = (bf16r*)(ws + WS_GW);
        const int gt = blockIdx.x * 512 + tid, NT_ = G * 512;
        for (int e = gt; e < 4096 * 32; e += NT_) { const int t = e >> 5, j = e & 31; const float pos = (float)(j < 16 ? (t >> 6) : (t & 63));
            const float inv = powf(10000.0f, -(float)(j & 15) * (1.0f / 16.0f)); const float ang = pos * inv; cosT[e] = cosf(ang); sinT[e] = sinf(ang); }
        for (int e = gt; e < 2 * 2 * 2 * 8 * 64 * 64; e += NT_) {
            const int c = e & 63, d = (e >> 6) & 63, n = (e >> 12) & 7, mat = (e >> 15) & 1, dir = (e >> 16) & 1, l = e >> 17;
            const float* src = mat ? a->in[13] : a->in[11];
            GW[e] = (bf16r)(pk2(src[((((size_t)l * 2 + dir) * 8 + n) * 64 + c) * 64 + d], 0.f) & 0xffffu); }
    }
    {
        LAS float* scr = (LAS float*)lds + wid * (64 * 33 + 16);
        const int gw = blockIdx.x * 8 + wid, NGW = G * 8;
        constexpr int I_IN = 16 * 56, I_OUT = 16 * 32, I_UP = 16 * 176, I_DN = 44 * 32, I_L = I_IN + I_OUT + I_UP + I_DN;
        for (int it = gw; it < 2 * I_L; it += NGW) {
            const int l = it / I_L; int r = it % I_L;
            unsigned char* wl = ws + WS_W + (size_t)l * W_LAYER;
            if (r < I_IN) { p0_transpose_item<1>(a->in[6] + (size_t)l * DM * DIN, DM, DIN, (bf16r*)(wl + W_IN), nullptr, nullptr, scr, r, lane); continue; } r -= I_IN;
            if (r < I_OUT) { p0_transpose_item<3>(a->in[18] + (size_t)l * DM * DM, DM, DM, (bf16r*)(wl + W_OUT), a->in[16] + l * 512, a->in[17] + l * 512, scr, r, lane); continue; } r -= I_OUT;
            if (r < I_UP) { p0_transpose_item<2>(a->in[19] + (size_t)l * DM * DFF2, DM, DFF2, (bf16r*)(wl + W_UP), nullptr, nullptr, scr, r, lane); continue; } r -= I_UP;
            p0_transpose_item<0>(a->in[22] + (size_t)l * DFF * DM, DFF, DM, (bf16r*)(wl + W_DOWN), nullptr, nullptr, scr, r, lane);
        }
    }
}

__device__ __forceinline__ void prenorm_phase(KA a, int l, int which, int nrows, int nsplit, const float* ctx_src, int wid, int lane, int G) {
    const float* MOD = (const float*)(a->ws + WS_MOD); bf16r* HN = (bf16r*)(a->ws + WS_HN);
    float* ctxres = (float*)(a->ws + WS_CTXRES); const float* PART = (const float*)(a->ws + WS_PART);
    const int gw = blockIdx.x * 8 + wid, NGW = G * 8;
    const bool from_in = (l == 0 && which == 0);
    for (int row = gw; row < nrows; row += 2 * NGW) {
        const int row2 = row + NGW; const bool has2 = row2 < nrows; const int r2 = has2 ? row2 : row;
        const float* lat = from_in ? a->in[0] : a->out;
        const float* s0 = row < MLAT ? lat + (size_t)row * DM : ctx_src + (size_t)(row - MLAT) * DM;
        const float* s1 = r2 < MLAT ? lat + (size_t)r2 * DM : ctx_src + (size_t)(r2 - MLAT) * DM;
        const float* md0 = MOD + (l * 5 + (row < MLAT ? (row >> 12) : 4)) * 6144 + (which ? 3 * 1024 : 0);
        const float* md1 = MOD + (l * 5 + (r2 < MLAT ? (r2 >> 12) : 4)) * 6144 + (which ? 3 * 1024 : 0);
        f4 v0[4], v1[4];
#pragma unroll
        for (int j = 0; j < 4; ++j) { v0[j] = __builtin_nontemporal_load((const f4*)(s0 + 4 * (lane + 64 * j))); v1[j] = __builtin_nontemporal_load((const f4*)(s1 + 4 * (lane + 64 * j))); }
        if (nsplit > 0) {
            if (row >= MLAT) { const float* pp = PART + (size_t)(row - MLAT) * DM + 4 * lane;
                for (int ks = 0; ks < nsplit; ks += 4) {
                    f4 t_[4][4]; float wk_[4];
#pragma unroll
                    for (int kk = 0; kk < 4; ++kk) { const int k2 = ks + kk < nsplit ? ks + kk : nsplit - 1; wk_[kk] = ks + kk < nsplit ? 1.f : 0.f;
#pragma unroll
                        for (int j = 0; j < 4; ++j) t_[kk][j] = *(const f4*)(pp + (size_t)k2 * MCTX * DM + 256 * j); }
                    __builtin_amdgcn_sched_barrier(0);
#pragma unroll
                    for (int kk = 0; kk < 4; ++kk)
#pragma unroll
                        for (int j = 0; j < 4; ++j) v0[j] += t_[kk][j] * wk_[kk];
                }
#pragma unroll
                for (int j = 0; j < 4; ++j) *(f4*)(ctxres + (size_t)(row - MLAT) * DM + 4 * (lane + 64 * j)) = v0[j]; }
            if (has2 && row2 >= MLAT) { const float* pp = PART + (size_t)(row2 - MLAT) * DM + 4 * lane;
                for (int ks = 0; ks < nsplit; ks += 4) {
                    f4 t_[4][4]; float wk_[4];
#pragma unroll
                    for (int kk = 0; kk < 4; ++kk) { const int k2 = ks + kk < nsplit ? ks + kk : nsplit - 1; wk_[kk] = ks + kk < nsplit ? 1.f : 0.f;
#pragma unroll
                        for (int j = 0; j < 4; ++j) t_[kk][j] = *(const f4*)(pp + (size_t)k2 * MCTX * DM + 256 * j); }
                    __builtin_amdgcn_sched_barrier(0);
#pragma unroll
                    for (int kk = 0; kk < 4; ++kk)
#pragma unroll
                        for (int j = 0; j < 4; ++j) v1[j] += t_[kk][j] * wk_[kk];
                }
#pragma unroll
                for (int j = 0; j < 4; ++j) *(f4*)(ctxres + (size_t)(row2 - MLAT) * DM + 4 * (lane + 64 * j)) = v1[j]; }
        }
        float ss0 = 0.f, ss1 = 0.f;
#pragma unroll
        for (int j = 0; j < 4; ++j) { ss0 += (v0[j].x * v0[j].x + v0[j].y * v0[j].y) + (v0[j].z * v0[j].z + v0[j].w * v0[j].w); ss1 += (v1[j].x * v1[j].x + v1[j].y * v1[j].y) + (v1[j].z * v1[j].z + v1[j].w * v1[j].w); }
#pragma unroll
        for (int o = 1; o < 64; o <<= 1) { ss0 += __shfl_xor(ss0, o); ss1 += __shfl_xor(ss1, o); }
        const float rs0 = rsqrtf(ss0 * (1.f / DM) + EPSN), rs1 = rsqrtf(ss1 * (1.f / DM) + EPSN);
#pragma unroll
        for (int j = 0; j < 4; ++j) { const int col = 4 * (lane + 64 * j);
            { const f4 sh = *(const f4*)(md0 + col), sc = *(const f4*)(md0 + 1024 + col); const f4 h = v0[j] * rs0 * (sc + 1.f) + sh; u2 w; w.x = pk2(h.x, h.y); w.y = pk2(h.z, h.w); *(u2*)(HN + (size_t)row * DM + col) = w; }
            if (has2) { const f4 sh = *(const f4*)(md1 + col), sc = *(const f4*)(md1 + 1024 + col); const f4 h = v1[j] * rs1 * (sc + 1.f) + sh; u2 w; w.x = pk2(h.x, h.y); w.y = pk2(h.z, h.w); *(u2*)(HN + (size_t)row2 * DM + col) = w; } }
    }
}
__device__ __forceinline__ void finalnorm_phase(KA a, int wid, int lane, int G) {
    const float* fw = a->in[23];
    const int gw = blockIdx.x * 8 + wid, NGW = G * 8;
    f4 wv[4];
#pragma unroll
    for (int j = 0; j < 4; ++j) wv[j] = *(const f4*)(fw + 4 * (lane + 64 * j));
    for (int row = gw; row < MLAT; row += 2 * NGW) {
        const int row2 = row + NGW; const bool has2 = row2 < MLAT;
        float* p0 = a->out + (size_t)row * DM; float* p1 = a->out + (size_t)(has2 ? row2 : row) * DM;
        f4 v0[4], v1[4]; float ss0 = 0.f, ss1 = 0.f;
#pragma unroll
        for (int j = 0; j < 4; ++j) { v0[j] = *(const f4*)(p0 + 4 * (lane + 64 * j)); v1[j] = *(const f4*)(p1 + 4 * (lane + 64 * j)); }
#pragma unroll
        for (int j = 0; j < 4; ++j) { ss0 += (v0[j].x * v0[j].x + v0[j].y * v0[j].y) + (v0[j].z * v0[j].z + v0[j].w * v0[j].w); ss1 += (v1[j].x * v1[j].x + v1[j].y * v1[j].y) + (v1[j].z * v1[j].z + v1[j].w * v1[j].w); }
#pragma unroll
        for (int o = 1; o < 64; o <<= 1) { ss0 += __shfl_xor(ss0, o); ss1 += __shfl_xor(ss1, o); }
        const float rs0 = rsqrtf(ss0 * (1.f / DM) + EPSN), rs1 = rsqrtf(ss1 * (1.f / DM) + EPSN);
#pragma unroll
        for (int j = 0; j < 4; ++j) { __builtin_nontemporal_store(v0[j] * rs0 * wv[j], (f4*)(p0 + 4 * (lane + 64 * j))); if (has2) __builtin_nontemporal_store(v1[j] * rs1 * wv[j], (f4*)(p1 + 4 * (lane + 64 * j))); }
    }
}

struct EpiWin {
    static constexpr bool PERM = true, AFTER_DRAIN = false;
    unsigned char* ws_; const float *qw, *kw;
    __device__ __forceinline__ void operator()(const pg8::f32x4 (&acc)[2][2][4][2], const pg8::Unit& u, int wr, int wc, int fr, int fq) const {
        bf16r* const Q = (bf16r*)(ws_ + WS_Q); bf16r* const Kb = (bf16r*)(ws_ + WS_K); bf16r* const Vb = (bf16r*)(ws_ + WS_V); bf16r* const XL = (bf16r*)(ws_ + WS_XL); bf16r* const GG = (bf16r*)(ws_ + WS_GG);
        const float* const cosT = (const float*)(ws_ + WS_COS); const float* const sinT = (const float*)(ws_ + WS_SIN);
        const int pn = u.pn, row0 = u.pm * 256 + wr * 64 + fr;
        if (pn >= 3) {
            const bool isg = pn >= 5; bf16r* dst = isg ? GG : XL; const int cb = (pn - (isg ? 5 : 3)) * 256 + wc * 32 + 8 * fq;
#pragma unroll
            for (int ai = 0; ai < 2; ++ai)
#pragma unroll
                for (int m = 0; m < 4; ++m) { const int row = row0 + ai * 128 + m * 16;
#pragma unroll
                    for (int bj = 0; bj < 2; ++bj)
#pragma unroll
                        for (int n = 0; n < 2; ++n) { pg8::f32x4 v = acc[ai][bj][m][n];
                            if (isg) { v[0] = gelu_tanh(v[0]); v[1] = gelu_tanh(v[1]); v[2] = gelu_tanh(v[2]); v[3] = gelu_tanh(v[3]); }
                            u2 w; w.x = pk2(v[0], v[1]); w.y = pk2(v[2], v[3]);
                            const int col = cb + bj * 128 + n * 4;
                            if (isg) *(u2*)(dst + (size_t)(row >> 4) * 8192 + (col >> 6) * 1024 + ((col >> 4) & 3) * 256 + (row & 15) * 16 + (col & 15)) = w;
                            else *(u2*)(dst + (size_t)row * 512 + col) = w; } }
            return;
        }
        if (pn == 2 && wc >= 2) {
#pragma unroll
            for (int ai = 0; ai < 2; ++ai)
#pragma unroll
                for (int m = 0; m < 4; ++m) { const int row = row0 + ai * 128 + m * 16; bf16r* base = Vb + (size_t)kvrow(row) * 128 + (wc - 2) * 64 + 8 * fq;
#pragma unroll
                    for (int bj = 0; bj < 2; ++bj)
#pragma unroll
                        for (int n = 0; n < 2; ++n) { const pg8::f32x4 v = acc[ai][bj][m][n]; u2 w; w.x = pk2(v[0], v[1]); w.y = pk2(v[2], v[3]);
                            *(u2*)(base + 32 * bj + 4 * n) = w; } }
            return;
        }
        const bool isk = pn == 2; const float* nw = isk ? kw : qw;
        pg8::f32x4 wv[2][2];
#pragma unroll
        for (int bj = 0; bj < 2; ++bj)
#pragma unroll
            for (int n = 0; n < 2; ++n) wv[bj][n] = *(const pg8::f32x4*)(nw + 32 * bj + 8 * fq + 4 * n);
        const float osc = isk ? 1.f : attn_body::C2;
#pragma unroll
        for (int am = 0; am < 4; ++am) { const int ai = am >> 1, m0 = (am & 1) * 2;
            pg8::f32x4 csv[2][2], snv[2][2];
            const bool lat_ = (row0 + ai * 128) < MLAT;
#pragma unroll
            for (int mm = 0; mm < 2; ++mm) { const int t = (row0 + ai * 128 + (m0 + mm) * 16) & 4095;
#pragma unroll
                for (int n = 0; n < 2; ++n) { csv[mm][n] = *(const pg8::f32x4*)(cosT + t * 32 + 8 * fq + 4 * n); snv[mm][n] = *(const pg8::f32x4*)(sinT + t * 32 + 8 * fq + 4 * n); } }
            __builtin_amdgcn_sched_barrier(0);
#pragma unroll
            for (int mm = 0; mm < 2; ++mm) { const int m = m0 + mm; const int row = row0 + ai * 128 + m * 16;
                float ss = 0.f;
#pragma unroll
                for (int bj = 0; bj < 2; ++bj)
#pragma unroll
                    for (int n = 0; n < 2; ++n) { const pg8::f32x4 v = acc[ai][bj][m][n]; ss += (v[0] * v[0] + v[1] * v[1]) + (v[2] * v[2] + v[3] * v[3]); }
                ss += __shfl_xor(ss, 16); ss += __shfl_xor(ss, 32);
                const float rstd = rsqrtf(ss * (1.f / 64.f) + EPSN) * osc;
                pg8::f32x4 y[2][2];
#pragma unroll
                for (int bj = 0; bj < 2; ++bj)
#pragma unroll
                    for (int n = 0; n < 2; ++n) y[bj][n] = acc[ai][bj][m][n] * rstd * wv[bj][n];
                if (lat_) {
#pragma unroll
                    for (int n = 0; n < 2; ++n) { const pg8::f32x4 cs = csv[mm][n], sn = snv[mm][n];
                        const pg8::f32x4 o0 = y[0][n] * cs - y[1][n] * sn, o1 = y[1][n] * cs + y[0][n] * sn; y[0][n] = o0; y[1][n] = o1; } }
                bf16r* base = isk ? Kb + (size_t)kvrow(row) * 128 + wc * 64 + 8 * fq : Q + (size_t)row * 512 + (4 * pn + wc) * 64 + 8 * fq;
#pragma unroll
                for (int bj = 0; bj < 2; ++bj)
#pragma unroll
                    for (int n = 0; n < 2; ++n) { u2 w; w.x = pk2(y[bj][n][0], y[bj][n][1]); w.y = pk2(y[bj][n][2], y[bj][n][3]); *(u2*)(base + 32 * bj + 4 * n) = w; }
            }
            __builtin_amdgcn_sched_barrier(0);
        }
    }
};
struct EpiRes {
    static constexpr bool PERM = false, AFTER_DRAIN = false;
    const float *base_lat, *base_ctx; float *out_lat, *out_ctx; const float* gate;
    __device__ __forceinline__ void operator()(const pg8::f32x4 (&acc)[2][2][4][2], const pg8::Unit& u, int wr, int wc, int fr, int fq) const {
        const int pm = u.pm; const bool isctx = pm >= 64;
        const float* base = isctx ? base_ctx + (size_t)(pm - 64) * 256 * DM : base_lat + (size_t)pm * 256 * DM;
        float* out = isctx ? out_ctx + (size_t)(pm - 64) * 256 * DM : out_lat + (size_t)pm * 256 * DM;
        const float* gt = gate + (isctx ? 4 : (pm >> 4)) * 6144;
        const int col0 = u.pn * 256 + wc * 32 + 4 * fq;
        pg8::f32x4 gv[2][2];
#pragma unroll
        for (int bj = 0; bj < 2; ++bj)
#pragma unroll
            for (int n = 0; n < 2; ++n) gv[bj][n] = *(const pg8::f32x4*)(gt + col0 + bj * 128 + n * 16);
#pragma unroll
        for (int am = 0; am < 4; ++am) {
            const int ai = am >> 1, m0 = (am & 1) * 2;
            pg8::f32x4 bs[2][2][2];
#pragma unroll
            for (int mm = 0; mm < 2; ++mm) { const size_t ro = (size_t)(ai * 128 + wr * 64 + (m0 + mm) * 16 + fr) * DM + col0;
#pragma unroll
                for (int bj = 0; bj < 2; ++bj)
#pragma unroll
                    for (int n = 0; n < 2; ++n) bs[mm][bj][n] = *(const pg8::f32x4*)(base + ro + bj * 128 + n * 16); }
            __builtin_amdgcn_sched_barrier(0);
#pragma unroll
            for (int mm = 0; mm < 2; ++mm) { const size_t ro = (size_t)(ai * 128 + wr * 64 + (m0 + mm) * 16 + fr) * DM + col0;
#pragma unroll
                for (int bj = 0; bj < 2; ++bj)
#pragma unroll
                    for (int n = 0; n < 2; ++n) *(pg8::f32x4*)(out + ro + bj * 128 + n * 16) = bs[mm][bj][n] + gv[bj][n] * acc[ai][bj][m0 + mm][n]; }
            __builtin_amdgcn_sched_barrier(0);
        }
    }
};
struct EpiUpConv {
    static constexpr bool PERM = true, AFTER_DRAIN = true;
    bf16r* ACT; const float* cw; const float* cb; int mrows;
    __device__ __forceinline__ void fused(pg8::f32x4 (&acc)[2][2][4][2], const pg8::Unit& u, int wr, int wc, int fr, int fq, PG8_LAS unsigned char* lds, int wid, int lane) const {
        constexpr int PITCH = 544;
#pragma unroll
        for (int ai = 0; ai < 2; ++ai)
#pragma unroll
            for (int m = 0; m < 4; ++m) { const int lr = ai * 128 + wr * 64 + m * 16 + fr;
#pragma unroll
                for (int bj = 0; bj < 2; ++bj)
#pragma unroll
                    for (int n = 0; n < 2; ++n) { const pg8::f32x4 v = acc[ai][bj][m][n]; u2 w; w.x = pk2(v[0], v[1]); w.y = pk2(v[2], v[3]);
                        *(PG8_LAS u2*)(lds + lr * PITCH + (bj * 128 + wc * 32 + 8 * fq + 4 * n) * 2) = w; } }
        LDS_WAIT(); __syncthreads();
        const int tid = wid * 64 + lane, cgp = tid & 15, rr = tid >> 4;
        const int ch = u.pn * 128 + 8 * cgp;
        float wg[3][8], wvv[3][8], bg[8], bv[8];
#pragma unroll
        for (int k = 0; k < 3; ++k)
#pragma unroll
            for (int h = 0; h < 2; ++h) { const f4 t0 = *(const f4*)(cw + k * DFF2 + ch + 4 * h), t1 = *(const f4*)(cw + k * DFF2 + DFF + ch + 4 * h);
                wg[k][4 * h] = t0.x; wg[k][4 * h + 1] = t0.y; wg[k][4 * h + 2] = t0.z; wg[k][4 * h + 3] = t0.w; wvv[k][4 * h] = t1.x; wvv[k][4 * h + 1] = t1.y; wvv[k][4 * h + 2] = t1.z; wvv[k][4 * h + 3] = t1.w; }
#pragma unroll
        for (int h = 0; h < 2; ++h) { const f4 t0 = *(const f4*)(cb + ch + 4 * h), t1 = *(const f4*)(cb + DFF + ch + 4 * h);
            bg[4 * h] = t0.x; bg[4 * h + 1] = t0.y; bg[4 * h + 2] = t0.z; bg[4 * h + 3] = t0.w; bv[4 * h] = t1.x; bv[4 * h + 1] = t1.y; bv[4 * h + 2] = t1.z; bv[4 * h + 3] = t1.w; }
        const int row_first = u.pm * 254 - 1, lr0 = 1 + 8 * rr;
        PG8_LAS const unsigned char* up = lds + 16 * cgp;
        u4 pg_ = *(PG8_LAS const u4*)(up + (lr0 - 1) * PITCH), pv_ = *(PG8_LAS const u4*)(up + (lr0 - 1) * PITCH + 256);
        u4 cg_ = *(PG8_LAS const u4*)(up + lr0 * PITCH), cv_ = *(PG8_LAS const u4*)(up + lr0 * PITCH + 256);
#pragma unroll
        for (int i = 0; i < 8; ++i) { const int lr = lr0 + i;
            if (lr <= 254) {
                const u4 ng_ = *(PG8_LAS const u4*)(up + (lr + 1) * PITCH), nv_ = *(PG8_LAS const u4*)(up + (lr + 1) * PITCH + 256);
                const int r = row_first + lr;
                if (r < mrows) {
                    const int p = r < MLAT ? (r & 4095) : ((r - MLAT) & 255), T = r < MLAT ? SEQL : CTXL;
                    const bool hp = p > 0, hn = p < T - 1;
                    const u4 z4 = (u4){0u, 0u, 0u, 0u};
                    const u4 pgm = hp ? pg_ : z4, pvm = hp ? pv_ : z4, ngm = hn ? ng_ : z4, nvm = hn ? nv_ : z4;
                    unsigned ow[4];
#pragma unroll
                    for (int e2 = 0; e2 < 4; ++e2) {
                        float o2[2];
#pragma unroll
                        for (int hh = 0; hh < 2; ++hh) { const int e = 2 * e2 + hh;
                            const float gp = hh ? bf_hi(pgm[e2]) : bf_lo(pgm[e2]), gc = hh ? bf_hi(cg_[e2]) : bf_lo(cg_[e2]), gn = hh ? bf_hi(ngm[e2]) : bf_lo(ngm[e2]);
                            const float vp = hh ? bf_hi(pvm[e2]) : bf_lo(pvm[e2]), vc = hh ? bf_hi(cv_[e2]) : bf_lo(cv_[e2]), vn = hh ? bf_hi(nvm[e2]) : bf_lo(nvm[e2]);
                            const float g = bg[e] + wg[1][e] * gc + wg[0][e] * gp + wg[2][e] * gn;
                            const float v = bv[e] + wvv[1][e] * vc + wvv[0][e] * vp + wvv[2][e] * vn;
                            o2[hh] = g * sigmoidf_(g) * v; }
                        ow[e2] = pk2(o2[0], o2[1]); }
                    u4 o; o.x = ow[0]; o.y = ow[1]; o.z = ow[2]; o.w = ow[3];
                    __builtin_nontemporal_store(o, (u4*)(ACT + (size_t)r * DFF + ch));
                }
                pg_ = cg_; pv_ = cv_; cg_ = ng_; cv_ = nv_;
            } }
        LDS_WAIT(); __syncthreads();
    }
};
struct SplitOrder { int nsub, S, kslice, G, c;
    __device__ __forceinline__ bool next(int i, pg8::Unit& u) const { const int x = c + i * G; if (x >= nsub) return false; const int ks = x % S, t = x / S; u.pm = 64 + (t >> 2); u.pn = t & 3; u.koff = ks * kslice; return true; }
    __device__ __forceinline__ void a_ready(const pg8::Unit&) const {}
    __device__ __forceinline__ void done(const pg8::Unit&) const {} };
struct EpiPart {
    static constexpr bool PERM = false, AFTER_DRAIN = false;
    float* part; const float* gate; int kslice;
    __device__ __forceinline__ void operator()(const pg8::f32x4 (&acc)[2][2][4][2], const pg8::Unit& u, int wr, int wc, int fr, int fq) const {
        asm volatile("" : "+v"(fr), "+v"(fq));
        float* out = part + ((size_t)(u.koff / kslice) * MCTX + (size_t)(u.pm - 64) * 256) * DM;
        const float* gt = gate + 4 * 6144;
        const int col0 = u.pn * 256 + wc * 32 + 4 * fq;
        pg8::f32x4 gv[2][2];
#pragma unroll
        for (int bj = 0; bj < 2; ++bj)
#pragma unroll
            for (int n = 0; n < 2; ++n) gv[bj][n] = *(const pg8::f32x4*)(gt + col0 + bj * 128 + n * 16);
#pragma unroll
        for (int ai = 0; ai < 2; ++ai)
#pragma unroll
            for (int m = 0; m < 4; ++m) { const size_t ro = (size_t)(ai * 128 + wr * 64 + m * 16 + fr) * DM + col0;
#pragma unroll
                for (int bj = 0; bj < 2; ++bj)
#pragma unroll
                    for (int n = 0; n < 2; ++n) *(pg8::f32x4*)(out + ro + bj * 128 + n * 16) = gv[bj][n] * acc[ai][bj][m][n]; }
    }
};
struct OneUnit { pg8::Unit u;
    __device__ __forceinline__ bool next(int i, pg8::Unit& o) const { if (i) return false; o = u; return true; }
    __device__ __forceinline__ void a_ready(const pg8::Unit&) const {}
    __device__ __forceinline__ void done(const pg8::Unit&) const {} };

#define DPPF(old, src, ctrl) __builtin_bit_cast(float, __builtin_amdgcn_update_dpp(__builtin_bit_cast(int, (float)(old)), __builtin_bit_cast(int, (float)(src)), ctrl, 0xf, 0xf, false))
struct LruCtx { const bf16r* XLp; const bf16r* GWn; LAS const float* tab; LAS float* scr; int p0, T, n, tok, q; };
typedef _Float16 h2v __attribute__((ext_vector_type(2)));
__device__ __forceinline__ unsigned pkh2(float lo, float hi) { return __builtin_bit_cast(unsigned, __builtin_amdgcn_cvt_pkrtz(lo, hi)); }
__device__ __forceinline__ float h2lo(unsigned w) { return (float)__builtin_bit_cast(h2v, w).x; }
__device__ __forceinline__ float h2hi(unsigned w) { return (float)__builtin_bit_cast(h2v, w).y; }
__device__ __forceinline__ void lru_conv_load(const LruCtx& c, int s, u4 (&raw)[8]) {
    const int i = 16 * s + c.tok, p = c.p0 + i;
#pragma unroll
    for (int ks = 0; ks < 2; ++ks)
#pragma unroll
        for (int k = 0; k < 4; ++k) { const int pp = p + k - 2; const bool ok = pp >= 0 && pp < c.T;
            raw[4 * ks + k] = *(const u4*)(c.XLp + (ptrdiff_t)(ok ? i + k - 2 : i) * 512 + 32 * ks + 8 * c.q); }
}
__device__ __forceinline__ void lru_conv(const LruCtx& c, int s, const u4 (&raw)[8], s8v (&frag)[2], f4 (&xc)[4]) {
    const int i = 16 * s + c.tok, p = c.p0 + i;
    float xb[2][8];
#pragma unroll
    for (int ks = 0; ks < 2; ++ks) { const int c0 = 32 * ks + 8 * c.q, chn = 64 * c.n + c0;
#pragma unroll
        for (int h = 0; h < 2; ++h) { const f4 t = *(LAS const f4*)(c.tab + 2048 + chn + 4 * h); xb[ks][4 * h] = t.x; xb[ks][4 * h + 1] = t.y; xb[ks][4 * h + 2] = t.z; xb[ks][4 * h + 3] = t.w; }
#pragma unroll
        for (int k = 0; k < 4; ++k) { const int pp = p + k - 2; const bool ok = pp >= 0 && pp < c.T;
            const u4 rw = raw[4 * ks + k];
#pragma unroll
            for (int h = 0; h < 2; ++h) { f4 w = *(LAS const f4*)(c.tab + k * 512 + chn + 4 * h); if (!ok) w = (f4){0.f, 0.f, 0.f, 0.f};
                xb[ks][4 * h] += w.x * bf_lo(rw[2 * h]); xb[ks][4 * h + 1] += w.y * bf_hi(rw[2 * h]); xb[ks][4 * h + 2] += w.z * bf_lo(rw[2 * h + 1]); xb[ks][4 * h + 3] += w.w * bf_hi(rw[2 * h + 1]); } } }
#pragma unroll
    for (int ks = 0; ks < 2; ++ks) { LAS float* sp = c.scr + c.tok * 68 + 32 * ks + 8 * c.q;
        *(LAS f4*)sp = (f4){xb[ks][0], xb[ks][1], xb[ks][2], xb[ks][3]}; *(LAS f4*)(sp + 4) = (f4){xb[ks][4], xb[ks][5], xb[ks][6], xb[ks][7]};
        u4 w; w.x = pk2(xb[ks][0], xb[ks][1]); w.y = pk2(xb[ks][2], xb[ks][3]); w.z = pk2(xb[ks][4], xb[ks][5]); w.w = pk2(xb[ks][6], xb[ks][7]); frag[ks] = __builtin_bit_cast(s8v, w); }
    LDS_WAIT();
#pragma unroll
    for (int rb = 0; rb < 4; ++rb) xc[rb] = *(LAS const f4*)(c.scr + c.tok * 68 + 16 * rb + 4 * c.q);
    LDS_WAIT();
}
__device__ __forceinline__ void lru_wload(const LruCtx& c, int dir, s8v (&W)[16]) {
    const bf16r* gwa = c.GWn + (size_t)(dir * 2) * 8 * 4096, *gwx = gwa + 8 * 4096;
#pragma unroll
    for (int rb = 0; rb < 4; ++rb)
#pragma unroll
        for (int ks = 0; ks < 2; ++ks) { const int off = (16 * rb + c.tok) * 64 + 32 * ks + 8 * c.q; W[4 * rb + 2 * ks] = *(const s8v*)(gwa + off); W[4 * rb + 2 * ks + 1] = *(const s8v*)(gwx + off); }
}
__device__ __forceinline__ void lru_gates(const LruCtx& c, int dir, const s8v (&W)[16], const s8v (&frag)[2], const f4 (&xc)[4], float (&LA)[16], float (&AV)[16], float (&B)[16]) {
    f4 ga[4], gx[4];
#pragma unroll
    for (int rb = 0; rb < 4; ++rb) { ga[rb] = (f4){0.f, 0.f, 0.f, 0.f}; gx[rb] = (f4){0.f, 0.f, 0.f, 0.f};
#pragma unroll
        for (int ks = 0; ks < 2; ++ks) {
            ga[rb] = __builtin_amdgcn_mfma_f32_16x16x32_bf16(W[4 * rb + 2 * ks], frag[ks], ga[rb], 0, 0, 0);
            gx[rb] = __builtin_amdgcn_mfma_f32_16x16x32_bf16(W[4 * rb + 2 * ks + 1], frag[ks], gx[rb], 0, 0, 0); } }
#pragma unroll
    for (int rb = 0; rb < 4; ++rb) { const int chn = dir * 512 + 64 * c.n + 16 * rb + 4 * c.q;
        const f4 ba = *(LAS const f4*)(c.tab + 2560 + chn), bx = *(LAS const f4*)(c.tab + 3584 + chn), cl = *(LAS const f4*)(c.tab + 4608 + chn);
#pragma unroll
        for (int j = 0; j < 4; ++j) { const float r = sigmoidf_(ga[rb][j] + ba[j]), ii = sigmoidf_(gx[rb][j] + bx[j]);
            const float la = cl[j] * r, z = 1.3862943611198906f * la, av = __builtin_amdgcn_exp2f(la);
            const float om = (z > -0.0078125f) ? -z * (1.f + 0.5f * z) : __builtin_fmaf(-av, av, 1.f);
            LA[4 * rb + j] = la; AV[4 * rb + j] = av; B[4 * rb + j] = __builtin_amdgcn_sqrtf(om) * ii * xc[rb][j]; } }
}
__device__ __forceinline__ void scan_fwd(float (&A)[16], float (&B)[16]) {
#pragma unroll
    for (int k = 0; k < 16; ++k) { float a_ = A[k], b_ = B[k], ap, bp;
        ap = DPPF(1.f, a_, 0x111); bp = DPPF(0.f, b_, 0x111); b_ = a_ * bp + b_; a_ = a_ * ap;
        ap = DPPF(1.f, a_, 0x112); bp = DPPF(0.f, b_, 0x112); b_ = a_ * bp + b_; a_ = a_ * ap;
        ap = DPPF(1.f, a_, 0x114); bp = DPPF(0.f, b_, 0x114); b_ = a_ * bp + b_; a_ = a_ * ap;
        ap = DPPF(1.f, a_, 0x118); bp = DPPF(0.f, b_, 0x118); b_ = a_ * bp + b_; a_ = a_ * ap;
        A[k] = a_; B[k] = b_; }
}
__device__ __forceinline__ void scan_bwd(float (&A)[16], float (&B)[16]) {
#pragma unroll
    for (int k = 0; k < 16; ++k) { float a_ = A[k], b_ = B[k], ap, bp;
        ap = DPPF(1.f, a_, 0x101); bp = DPPF(0.f, b_, 0x101); b_ = a_ * bp + b_; a_ = a_ * ap;
        ap = DPPF(1.f, a_, 0x102); bp = DPPF(0.f, b_, 0x102); b_ = a_ * bp + b_; a_ = a_ * ap;
        ap = DPPF(1.f, a_, 0x104); bp = DPPF(0.f, b_, 0x104); b_ = a_ * bp + b_; a_ = a_ * ap;
        ap = DPPF(1.f, a_, 0x108); bp = DPPF(0.f, b_, 0x108); b_ = a_ * bp + b_; a_ = a_ * ap;
        A[k] = a_; B[k] = b_; }
}
#define DPPZ(src, ctrl) __builtin_bit_cast(float, __builtin_amdgcn_update_dpp(0, __builtin_bit_cast(int, (float)(src)), ctrl, 0xf, 0xf, true))
__device__ __forceinline__ float rowsum_fwd(float x) { x += DPPZ(x, 0x111); x += DPPZ(x, 0x112); x += DPPZ(x, 0x114); x += DPPZ(x, 0x118); return x; }
__device__ __forceinline__ float rowsum_bwd(float x) { x += DPPZ(x, 0x101); x += DPPZ(x, 0x102); x += DPPZ(x, 0x104); x += DPPZ(x, 0x108); return x; }
__device__ __forceinline__ void lru_tables(KA a, int l, LAS float* tab, int tid) {
    for (int e = tid; e < 5632; e += 512) { float v;
        if (e < 2048) v = a->in[9][l * 2048 + e];
        else if (e < 2560) v = a->in[10][l * 512 + (e - 2048)];
        else if (e < 3584) v = a->in[12][l * 1024 + (e - 2560)];
        else if (e < 4608) v = a->in[14][l * 1024 + (e - 3584)];
        else { const float lam = a->in[15][l * 1024 + (e - 4608)]; const float x = fexp(-lam); const float sp = x < 0.03f ? x * (1.f - x * (0.5f - x * (0.33333334f - x * 0.25f))) : (lam < -20.f ? -lam : __builtin_amdgcn_logf(1.f + x) * 0.6931471805599453f); v = -8.f * sp * 1.4426950408889634f; }
        tab[e] = v; }
}
__device__ __forceinline__ void lru_l1_tile(KA a, int l, int b, int cid, int dir, LAS unsigned char* lds, int tid, int wid, int lane) {
    asm volatile("" : "+v"(lane), "+v"(tid));
    unsigned char* ws = a->ws;
    LAS float* tab = (LAS float*)(lds + L1_TAB_OFF); LAS float* scr = (LAS float*)(lds + L1_TAB_OFF + 22528) + wid * (16 * 68);
    LruCtx c; c.n = wid; c.tok = lane & 15; c.q = lane >> 4; c.tab = tab; c.scr = scr;
    const bool isctx = cid < 4; c.p0 = (isctx ? cid : cid - 4) * 64; c.T = isctx ? CTXL : SEQL;
    const int rowbase = isctx ? MLAT + b * CTXL + c.p0 : b * SEQL + c.p0;
    c.XLp = (const bf16r*)(ws + WS_XL) + (size_t)rowbase * 512 + c.n * 64;
    c.GWn = (const bf16r*)(ws + WS_GW) + (size_t)(l * 4) * 8 * 4096 + c.n * 4096;
    float* AGGA = (float*)(ws + WS_AGGA); float* AGGB = (float*)(ws + WS_AGGB);
    unsigned* LAB = (unsigned*)(ws + WS_LAB) + (size_t)(rowbase >> 4) * 8192 + 1024 * c.n + 16 * c.tok + 4 * c.q;
    const int bl = (lane & 48) | 15, bf_ = (lane & 48);
    {
        LAS float* rab = (LAS float*)(lds + L1_TAB_OFF + 22528 + 34816) + wid * 128 + c.q * 32;
#pragma unroll
        for (int k = 0; k < 16; ++k) { rab[2 * k] = 1.f; rab[2 * k + 1] = 0.f; }
        s8v W[16];
        lru_wload(c, dir, W);
        u4 rawc[8];
        lru_conv_load(c, 0, rawc);
#pragma unroll 1
        for (int s = 0; s < 4; ++s) {
            s8v frag[2]; f4 xc[4];
            lru_conv(c, s, rawc, frag, xc);
            __builtin_amdgcn_sched_barrier(0);
            lru_conv_load(c, s < 3 ? s + 1 : 3, rawc);
            __builtin_amdgcn_sched_barrier(0);
            float LAv[16], A[16], B[16];
            lru_gates(c, dir, W, frag, xc, LAv, A, B);
            unsigned* lp = LAB + (size_t)dir * MALL * 512 + (size_t)s * 8192;
#pragma unroll
            for (int rb = 0; rb < 4; ++rb) { u4 w; w.x = pkh2(LAv[4 * rb], B[4 * rb]); w.y = pkh2(LAv[4 * rb + 1], B[4 * rb + 1]); w.z = pkh2(LAv[4 * rb + 2], B[4 * rb + 2]); w.w = pkh2(LAv[4 * rb + 3], B[4 * rb + 3]); *(u4*)(lp + 256 * rb) = w; }
            if (dir == 0) scan_fwd(A, B); else scan_bwd(A, B);
#pragma unroll
            for (int k = 0; k < 16; ++k) {
                const float a_ = __shfl(A[k], dir ? bf_ : bl), b_ = __shfl(B[k], dir ? bf_ : bl);
                const float ra = rab[2 * k], rb_ = rab[2 * k + 1];
                if (dir == 0) { rab[2 * k + 1] = a_ * rb_ + b_; rab[2 * k] = a_ * ra; }
                else { rab[2 * k + 1] = ra * b_ + rb_; rab[2 * k] = ra * a_; } }
            LDS_WAIT();
        }
        if (c.tok == 0) { const size_t o = ((size_t)(b * 2 + dir) * NCH + cid) * 512 + 64 * c.n + 4 * c.q;
#pragma unroll
            for (int rb = 0; rb < 4; ++rb) { *(f4*)(AGGA + o + 16 * rb) = (f4){rab[8 * rb], rab[8 * rb + 2], rab[8 * rb + 4], rab[8 * rb + 6]}; *(f4*)(AGGB + o + 16 * rb) = (f4){rab[8 * rb + 1], rab[8 * rb + 3], rab[8 * rb + 5], rab[8 * rb + 7]}; } }
    }
    LDS_WAIT(); __syncthreads();
}
__device__ __forceinline__ void lru_l2_tile(KA a, int l, int b, int cid, LAS unsigned char* lds, int tid, int wid, int lane) {
    asm volatile("" : "+v"(lane));
    unsigned char* ws = a->ws;
    LAS float* part = (LAS float*)lds;
    LAS float* hfl = (LAS float*)(lds + 4096) + wid * 4096 + lane;
    const int n = wid, tok = lane & 15, q = lane >> 4;
    const bool isctx = cid < 4; const int p0 = (isctx ? cid : cid - 4) * 64;
    const int rowbase = isctx ? MLAT + b * CTXL + p0 : b * SEQL + p0;
    const float* AGGA = (const float*)(ws + WS_AGGA); const float* AGGB = (const float*)(ws + WS_AGGB);
    const unsigned* LAB = (const unsigned*)(ws + WS_LAB) + (size_t)(rowbase >> 4) * 8192 + 1024 * n + 16 * tok + 4 * q;
    const bf16r* GGp = (const bf16r*)(ws + WS_GG) + (size_t)(rowbase >> 4) * 8192 + 1024 * n + 16 * tok + 4 * q;
    const int bl = (lane & 48) | 15, bf_ = (lane & 48);
    float hin[16], hinb[16], A[16], B[16];
#pragma unroll 1
    for (int dir = 0; dir < 2; ++dir) {
        const float* ap_ = AGGA + ((size_t)(b * 2 + dir) * NCH) * 512 + 64 * n + 4 * q; const float* bp_ = AGGB + ((size_t)(b * 2 + dir) * NCH) * 512 + 64 * n + 4 * q;
#pragma unroll
        for (int k = 0; k < 16; ++k) { A[k] = 1.f; B[k] = 0.f; }
#pragma unroll
        for (int eb = 0; eb < 5; eb += 3) {
            f4 avv[3][4], bvv[3][4]; bool okv[3];
#pragma unroll
            for (int e2 = 0; e2 < 3; ++e2) { if (eb + e2 < 5) { const int o = 5 * tok + eb + e2; int ch; bool ok;
                if (dir == 0) { ch = o; ok = o < cid; } else { ch = o < 4 ? 3 - o : 71 - o; ok = isctx ? (o < 4 && ch > cid) : (o < 4 || (o < 68 && ch > cid)); }
                ch = ch < 0 ? 0 : (ch > NCH - 1 ? NCH - 1 : ch); okv[e2] = ok;
#pragma unroll
                for (int rb = 0; rb < 4; ++rb) { avv[e2][rb] = *(const f4*)(ap_ + (size_t)ch * 512 + 16 * rb); bvv[e2][rb] = *(const f4*)(bp_ + (size_t)ch * 512 + 16 * rb); } } }
            __builtin_amdgcn_sched_barrier(0);
#pragma unroll
            for (int e2 = 0; e2 < 3; ++e2) { if (eb + e2 < 5) {
#pragma unroll
                for (int rb = 0; rb < 4; ++rb) { f4 av = avv[e2][rb], bv = bvv[e2][rb];
                    if (!okv[e2]) { av = (f4){1.f, 1.f, 1.f, 1.f}; bv = (f4){0.f, 0.f, 0.f, 0.f}; }
#pragma unroll
                    for (int jj = 0; jj < 4; ++jj) { B[4 * rb + jj] = av[jj] * B[4 * rb + jj] + bv[jj]; A[4 * rb + jj] = av[jj] * A[4 * rb + jj]; } } } }
            __builtin_amdgcn_sched_barrier(0);
        }
        scan_fwd(A, B);
        if (dir == 0) {
#pragma unroll
            for (int k = 0; k < 16; ++k) hin[k] = __shfl(B[k], bl);
        } else {
#pragma unroll
            for (int k = 0; k < 16; ++k) hinb[k] = __shfl(B[k], bl);
        }
    }
    u4 wc_[4], wn_[4]; u2 gc_[4], gn_[4];
#pragma unroll
    for (int rb = 0; rb < 4; ++rb) { wc_[rb] = *(const u4*)(LAB + 256 * rb); gc_[rb] = (u2){0u, 0u}; gn_[rb] = (u2){0u, 0u}; }
#pragma unroll 1
    for (int st = 0; st < 8; ++st) {
        const int s = st < 4 ? st : 7 - st;
        { const int sn = st + 1 < 8 ? st + 1 : 7; const int s2 = sn < 4 ? sn : 7 - sn; const bool bw = sn >= 4;
          const unsigned* lp_ = LAB + (size_t)(bw ? MALL : 0) * 512 + (size_t)s2 * 8192; const bf16r* gp_ = GGp + (size_t)s2 * 8192;
#pragma unroll
          for (int rb = 0; rb < 4; ++rb) { wn_[rb] = *(const u4*)(lp_ + 256 * rb); gn_[rb] = *(const u2*)(gp_ + 256 * rb); } }
        __builtin_amdgcn_sched_barrier(0);
#pragma unroll
        for (int rb = 0; rb < 4; ++rb)
#pragma unroll
            for (int j = 0; j < 4; ++j) { A[4 * rb + j] = h2lo(wc_[rb][j]); B[4 * rb + j] = h2hi(wc_[rb][j]); }
        LAS float* hs = hfl + s * 1024;
        if (st < 4) {
#pragma unroll
            for (int k = 0; k < 16; ++k) { const float L = rowsum_fwd(A[k]); const float P = __builtin_amdgcn_exp2f(L); const float C = rowsum_fwd(B[k] * __builtin_amdgcn_exp2f(-L)); A[k] = P; B[k] = P * C; }
#pragma unroll
            for (int k = 0; k < 16; ++k) { const float h = A[k] * hin[k] + B[k]; hs[k * 64] = h; hin[k] = __shfl(h, bl); }
        } else {
            if (st == 4) {
#pragma unroll
                for (int k = 0; k < 16; ++k) hin[k] = hinb[k]; }
#pragma unroll
            for (int k = 0; k < 16; ++k) { const float L = rowsum_bwd(A[k]); const float P = __builtin_amdgcn_exp2f(L); const float C = rowsum_bwd(B[k] * __builtin_amdgcn_exp2f(-L)); A[k] = P; B[k] = P * C; }
            float sq = 0.f;
#pragma unroll
            for (int rb = 0; rb < 4; ++rb)
#pragma unroll
                for (int j = 0; j < 4; ++j) { const int k = 4 * rb + j; const float h = A[k] * hin[k] + B[k]; hin[k] = __shfl(h, bf_);
                    const float gg = (j & 1) ? bf_hi(gc_[rb][j >> 1]) : bf_lo(gc_[rb][j >> 1]);
                    const float r = (hs[k * 64] + h) * gg; hs[k * 64] = r; sq += r * r; }
            sq += __shfl_xor(sq, 16); sq += __shfl_xor(sq, 32); if (q == 0) part[wid * 64 + 16 * s + tok] = sq;
        }
#pragma unroll
        for (int rb = 0; rb < 4; ++rb) { wc_[rb] = wn_[rb]; gc_[rb] = gn_[rb]; }
    }
    LDS_WAIT(); __syncthreads();
    bf16r* MIX = (bf16r*)(ws + WS_MIX);
#pragma unroll 1
    for (int s = 0; s < 4; ++s) { float t = 0.f;
#pragma unroll
        for (int w = 0; w < 8; ++w) t += part[w * 64 + 16 * s + tok];
        const float rstd = rsqrtf(t * (1.f / 512.f) + EPSN);
        bf16r* mp = MIX + (size_t)(rowbase + 16 * s + tok) * DM + 512 + 64 * n + 4 * q;
        const LAS float* hs = hfl + s * 1024;
#pragma unroll
        for (int rb = 0; rb < 4; ++rb) { u2 w; w.x = pk2(hs[(4 * rb) * 64] * rstd, hs[(4 * rb + 1) * 64] * rstd); w.y = pk2(hs[(4 * rb + 2) * 64] * rstd, hs[(4 * rb + 3) * 64] * rstd); *(u2*)(mp + 16 * rb) = w; } }
    const bf16r* O = (const bf16r*)(ws + WS_O) + (size_t)(rowbase + wid * 8) * 512 + 8 * lane;
    u4 rawc = *(const u4*)O;
#pragma unroll 1
    for (int tt = 0; tt < 8; ++tt) {
        const u4 rawn = *(const u4*)(O + (size_t)(tt < 7 ? tt + 1 : 7) * 512);
        float v[8]; float ss = 0.f;
#pragma unroll
        for (int e = 0; e < 4; ++e) { v[2 * e] = bf_lo(rawc[e]); v[2 * e + 1] = bf_hi(rawc[e]); ss += v[2 * e] * v[2 * e] + v[2 * e + 1] * v[2 * e + 1]; }
        const float rstd = rsqrtf(wave_sum(ss) * (1.f / 512.f) + EPSN);
        u4 o; o.x = pk2(v[0] * rstd, v[1] * rstd); o.y = pk2(v[2] * rstd, v[3] * rstd); o.z = pk2(v[4] * rstd, v[5] * rstd); o.w = pk2(v[6] * rstd, v[7] * rstd);
        *(u4*)(MIX + (size_t)(rowbase + wid * 8 + tt) * DM + 8 * lane) = o;
        rawc = rawn; }
    LDS_WAIT(); __syncthreads();
}

#define GAS __attribute__((address_space(1)))
#define XB_TMO      128
#define XB_XCNT(j)  (256  + 64 * (j))
#define XB_XSUB(j)  (1280 + 64 * (j))
#define XB_XGEN(j)  (2304 + 64 * (j))
#define XB_TOP      3328
#define XB_TOPGEN   3392
#define XCD_BAR_WORDS 3456
#define XB_SPIN_CAP (1u << 18)

__device__ __forceinline__ unsigned xb_ld(unsigned* p)              { return __hip_atomic_load(p, __ATOMIC_RELAXED, __HIP_MEMORY_SCOPE_AGENT); }
__device__ __forceinline__ unsigned xb_add(unsigned* p, unsigned v) { return __hip_atomic_fetch_add(p, v, __ATOMIC_RELAXED, __HIP_MEMORY_SCOPE_AGENT); }
__device__ __forceinline__ unsigned xb_xcc_id() { return (unsigned)__builtin_amdgcn_s_getreg((3 << 11) | 20) & 0xFu; }
#define XB_SPIN(cond, bar) do { unsigned _sp = 0; while (cond) { __builtin_amdgcn_s_sleep(1); \
    if ((++_sp & 255u) == 0u) { if (xb_ld(&(bar)[XB_TMO])) break; if (_sp > XB_SPIN_CAP) { atomicAdd(&(bar)[XB_TMO], 1u); break; } } } } while (0)

struct XcdBarrier {
    unsigned* bar; unsigned x;
    volatile LAS unsigned* st;
};

__device__ __forceinline__ XcdBarrier xcd_barrier_post(unsigned* bar, volatile LAS unsigned* st) {
    XcdBarrier b; b.bar = bar; b.x = xb_xcc_id(); b.st = st;
    if (threadIdx.x == 0) (void)xb_add(&bar[XB_XCNT(b.x)], 1u);
    return b;
}
__device__ __forceinline__ void xcd_barrier_complete(unsigned* bar, unsigned x, unsigned& nloc, unsigned& nx) {
    const unsigned G = gridDim.x * gridDim.y * gridDim.z;
    unsigned sum, cnt, mine, sp = 0u;
    for (;;) {
        sum = 0u; cnt = 0u; mine = 0u;
#pragma unroll
        for (unsigned j = 0; j < 16; ++j) { const unsigned c = xb_ld(&bar[XB_XCNT(j)]); sum += c; cnt += (c > 0u) ? 1u : 0u; mine = (j == x) ? c : mine; }
        if (sum == G) break;
        __builtin_amdgcn_s_sleep(1);
        if ((++sp & 255u) == 0u) { if (xb_ld(&bar[XB_TMO])) break; if (sp > XB_SPIN_CAP) { atomicAdd(&bar[XB_TMO], 1u); break; } }
    }
    nloc = mine > 0u ? mine : 1u; nx = cnt > 0u ? cnt : 1u;
}

__device__ __forceinline__ void xcd_barrier(const XcdBarrier& b) {
    asm volatile("s_waitcnt vmcnt(0)" ::: "memory");
    __syncthreads();
    if (threadIdx.x == 0) {
        unsigned* bar = b.bar;
        __builtin_amdgcn_s_waitcnt(0);
        unsigned nloc = b.st[0], nx = b.st[1];
        if (nloc == 0u) { xcd_barrier_complete(bar, b.x, nloc, nx); b.st[0] = nloc; b.st[1] = nx; }
        const unsigned old = xb_add(&bar[XB_XSUB(b.x)], 1u);
        const unsigned gen = old / nloc;
        if (old + 1u == (gen + 1u) * nloc) {
            __builtin_amdgcn_fence(__ATOMIC_RELEASE, "agent");
            asm volatile("s_waitcnt vmcnt(0)" ::: "memory");
            const unsigned og = xb_add(&bar[XB_TOP], 1u);
            const unsigned tg = og / nx;
            if (og + 1u == (tg + 1u) * nx) xb_add(&bar[XB_TOPGEN], 1u);
            else XB_SPIN(xb_ld(&bar[XB_TOPGEN]) == tg, bar);
            __builtin_amdgcn_fence(__ATOMIC_ACQUIRE, "agent");
            xb_add(&bar[XB_XGEN(b.x)], 1u);
            asm volatile("s_waitcnt vmcnt(0)" ::: "memory");
        } else {
            XB_SPIN(xb_ld(&bar[XB_XGEN(b.x)]) == gen, bar);
            __builtin_amdgcn_fence(__ATOMIC_ACQUIRE, "agent");
            asm volatile("s_waitcnt vmcnt(0)" ::: "memory");
        }
    }
    __syncthreads();
}

#ifndef REP_PH
#define REP_PH -1
#endif
#ifndef REP_SKIP_L1
#define REP_SKIP_L1 0
#endif
#ifndef USE_XBAR
#define USE_XBAR 1
#endif
__global__ void __launch_bounds__(512, 2) mega(Args a_) {
    extern __shared__ __attribute__((aligned(16))) unsigned char lds_raw[];
    LAS unsigned char* lds = (LAS unsigned char*)lds_raw;
    const int G = gridDim.x, bx = blockIdx.x;
    const int vcu = (G % 8 == 0) ? (bx % 8) * (G / 8) + bx / 8 : bx;
    KA a = (KA)__builtin_amdgcn_kernarg_segment_ptr();
    volatile LAS unsigned* bst = (volatile LAS unsigned*)(lds + LDS_BYTES - 64);
    if (threadIdx.x < 2) bst[threadIdx.x] = 0u;
    __syncthreads();
    (void)xcd_barrier_post((unsigned*)a->ws, bst);
    int nsync = 0;
#define GRID_SYNC() do { if (!USE_XBAR || a->ph_lo < 0) cg::this_grid().sync();     else { XcdBarrier xb_; xb_.bar = (unsigned*)a->ws; xb_.x = xb_xcc_id(); xb_.st = (volatile LAS unsigned*)(lds + LDS_BYTES - 64); xcd_barrier(xb_); } ++nsync; } while (0)
    const int ph_hi = a->ph_hi;
    for (int ph = a->ph_lo; ph < ph_hi; ++ph) {
        asm volatile("" : "+s"(a));
        for (int rep = 0; rep < (ph == REP_PH ? 2 : 1); ++rep) {
        if (rep) GRID_SYNC();
#define TL const int tid = mk_tid(), lane = tid & 63, wid = __builtin_amdgcn_readfirstlane(tid >> 6); (void)tid; (void)lane; (void)wid
        unsigned char* ws = a->ws;
        float* MOD = (float*)(ws + WS_MOD); float* ctxres = (float*)(ws + WS_CTXRES);
        bf16r* HN = (bf16r*)(ws + WS_HN);
        if (ph == 0) { if (PON(8)) { TL; p0_phase(a, lds, tid, wid, lane, G); } }
        else if (ph == NPHASE - 1) { if (PON(9)) { TL; finalnorm_phase(a, wid, lane, G); } }
        else {
            const int l = (ph - 1) >> 3, sub = (ph - 1) & 7;
            unsigned char* wl = ws + WS_W + (size_t)l * W_LAYER;
            const bool ctx_out = l == 0;
            if (sub == 0) { if (PON(0)) { TL; prenorm_phase(a, l, 0, MALL, l == 0 ? 0 : 11, l == 0 ? a->in[2] : ctxres, wid, lane, G); } }
            else if (sub == 1) { if (PON(1)) {
                pg8::Gemm g{HN, (const bf16r*)(wl + W_IN), MALL, DIN, DM, 256, DM}; pg8::StaticOrder S; S.init(MALL, DIN, G, bx);
                EpiWin E{ws, a->in[7] + l * 64, a->in[8] + l * 64};
                pg8::gemm_phase<EpiWin, pg8::StaticOrder, true, true>(lds, g, S, E); }
            } else if (sub == 2) { if (PON(2)) { TL;
                const int nctx = ctx_out ? 4 : 0, cnt = 64 + nctx + ((rep && REP_SKIP_L1) ? 0 : 68);
                attn_body::bf16* Qb = (attn_body::bf16*)(ws + WS_Q); attn_body::bf16* Ob = (attn_body::bf16*)(ws + WS_O); const attn_body::bf16* Kb = (const attn_body::bf16*)(ws + WS_K); const attn_body::bf16* Vb = (const attn_body::bf16*)(ws + WS_V);
                LAS unsigned char* l3 = lds; asm volatile("" : "+s"(l3)); char* shm = (char*)l3;
                volatile LAS int* qw = (volatile LAS int*)(lds + LDS_BYTES - 32);
                unsigned* qctr = (unsigned*)ws + 3584 + (l * 2 + rep) * 8 * 64;
                const int hx = (int)(xb_xcc_id() & 7u);
                lru_tables(a, l, (LAS float*)(lds + L1_TAB_OFF), tid); __syncthreads();
                for (int li = 0; li < 8; ++li) { const int x = (hx + li) & 7; const int b = x >> 1, kvh = x & 1;
                    for (;;) {
                        __syncthreads();
                        if (tid == 0) *qw = (int)__hip_atomic_fetch_add(qctr + x * 64, 1u, __ATOMIC_RELAXED, __HIP_MEMORY_SCOPE_AGENT);
                        __syncthreads();
                        const int i = __builtin_amdgcn_readfirstlane(*qw);
                        if (i >= cnt) break;
                        if (i < 64 + nctx) {
                            const bool lat = i < 64; const int h = kvh * 4 + (lat ? (i >> 4) : (i - 64));
                            const size_t qo = (size_t)(lat ? b * SEQL + (i & 15) * 256 : MLAT + b * CTXL) * 512 + h * 64;
                            attn_body::attn_unit<8>(Qb + qo, Kb + (size_t)b * KVR * 128 + kvh * 64, Vb + (size_t)b * KVR * 128 + kvh * 64, Ob + qo, lat ? NCH : 4, shm);
                        } else { const int it = i - 64 - nctx, t = x * 34 + (it >> 1); lru_l1_tile(a, l, t / NCH, t % NCH, it & 1, lds, tid, wid, lane); }
                    }
                } }
            } else if (sub == 3) { if (PON(3)) { TL;
                const int nt = ctx_out ? 4 * NCH : 4 * 64;
                for (int t = vcu; t < nt; t += G) { int b, cid; if (ctx_out) { b = t / NCH; cid = t % NCH; } else { b = t >> 6; cid = 4 + (t & 63); }
                    lru_l2_tile(a, l, b, cid, lds, tid, wid, lane); } }
            } else if (sub == 4) { if (PON(4)) {
                { pg8::Gemm g{(const bf16r*)(ws + WS_MIX), (const bf16r*)(wl + W_OUT), MLAT, DM, DM, 256, DM}; pg8::StaticOrder S; S.init(MLAT, DM, G, bx);
                  EpiRes E{l == 0 ? a->in[0] : a->out, l == 0 ? a->in[2] : ctxres, a->out, ctxres, MOD + l * 5 * 6144 + 2 * 1024};
                  pg8::gemm_phase<EpiRes, pg8::StaticOrder, true, true>(lds, g, S, E); }
                if (ctx_out) {
                    pg8::Gemm g{(const bf16r*)(ws + WS_MIX), (const bf16r*)(wl + W_OUT), MALL, DM, 256, 256, DM}; SplitOrder S{64, 4, 256, G, bx};
                    EpiPart E{(float*)(ws + WS_PART), MOD + l * 5 * 6144 + 2 * 1024, 256};
                    pg8::gemm_phase<EpiPart, SplitOrder, true, true>(lds, g, S, E); } }
            } else if (sub == 5) { if (PON(5)) { TL; prenorm_phase(a, l, 1, ctx_out ? MALL : MLAT, ctx_out ? 4 : 0, ctx_out ? a->in[2] : ctxres, wid, lane, G); } }
            else if (sub == 6) { if (PON(6)) {
                const int mrows = ctx_out ? MALL : MLAT, nM = (mrows + 253) / 254;
                pg8::Gemm g{HN - DM, (const bf16r*)(wl + W_UP), nM * 256, DFF2, DM, 254, DM}; pg8::StaticOrder S; S.init(nM * 256, DFF2, G, bx);
                EpiUpConv E{(bf16r*)(ws + WS_ACT), a->in[20] + (size_t)l * 3 * DFF2, a->in[21] + (size_t)l * DFF2, mrows};
                for (int i = 0;; ++i) { pg8::Unit u; if (!S.next(i, u)) break; OneUnit S1{u}; pg8::gemm_phase<EpiUpConv, OneUnit, false, true>(lds, g, S1, E); } }
            } else { if (PON(7)) {
                { pg8::Gemm g{(const bf16r*)(ws + WS_ACT), (const bf16r*)(wl + W_DOWN), MLAT, DM, DFF, 256, DFF}; pg8::StaticOrder S; S.init(MLAT, DM, G, bx);
                  EpiRes E{a->out, ctxres, a->out, ctxres, MOD + l * 5 * 6144 + 5 * 1024};
                  pg8::gemm_phase<EpiRes, pg8::StaticOrder, true, true>(lds, g, S, E); }
                if (ctx_out) {
                    pg8::Gemm g{(const bf16r*)(ws + WS_ACT), (const bf16r*)(wl + W_DOWN), MALL, DM, 256, 256, DFF}; SplitOrder S{176, 11, 256, G, bx};
                    EpiPart E{(float*)(ws + WS_PART), MOD + l * 5 * 6144 + 5 * 1024, 256};
                    pg8::gemm_phase<EpiPart, SplitOrder, true, true>(lds, g, S, E); } }
            }
        }
        }
        if (ph + 1 < ph_hi) GRID_SYNC();
    }
}

extern "C" void kernel_launch(void* const* d_in, const int* in_sizes, int n_in, void* d_out, int out_size, void* d_ws, size_t ws_size, hipStream_t stream) {
    static int grid = 0;
    if (grid == 0) {
        int dev = 0, cus = 0, per_cu = 0;
        if (n_in != 24 || ws_size < 255 * MiB) { fprintf(stderr, "kernel_launch: unexpected n_in %d / ws %zu\n", n_in, ws_size); grid = -1; return; }
        hipGetDevice(&dev); hipDeviceGetAttribute(&cus, hipDeviceAttributeMultiprocessorCount, dev);
        if (hipFuncSetAttribute((const void*)mega, hipFuncAttributeMaxDynamicSharedMemorySize, LDS_BYTES) != hipSuccess) { fprintf(stderr, "kernel_launch: hipFuncSetAttribute failed\n"); grid = -1; return; }
        if (hipOccupancyMaxActiveBlocksPerMultiprocessor(&per_cu, (const void*)mega, 512, LDS_BYTES) != hipSuccess || per_cu < 1) { fprintf(stderr, "kernel_launch: occupancy query says %d\n", per_cu); per_cu = 1; }
        (void)hipGetLastError();
        grid = cus;
    }
    if (grid < 0) return;
    if (hipMemsetAsync(d_ws, 0, 32768, stream) != hipSuccess) { fprintf(stderr, "kernel_launch: memset failed\n"); return; }
    Args a{};
    for (int i = 0; i < 24; ++i) a.in[i] = (const float*)d_in[i];
    a.out = (float*)d_out; a.ws = (unsigned char*)d_ws;
#if MK_MULTI
    for (int ph = 0; ph < NPHASE; ++ph) { a.ph_lo = ph; a.ph_hi = ph + 1; hipLaunchKernelGGL(mega, dim3(grid), dim3(512), LDS_BYTES, stream, a); }
#else
    a.ph_lo = 0; a.ph_hi = NPHASE;
    void* args[] = {&a};
    hipError_t e = hipLaunchCooperativeKernel((const void*)mega, dim3(grid), dim3(512), args, LDS_BYTES, stream);
    if (e != hipSuccess) fprintf(stderr, "cooperative launch failed: %s (grid %d)\n", hipGetErrorString(e), grid);
#endif
}
```

```cpp
#include <hip/hip_runtime.h>
#include <hip/hip_cooperative_groups.h>
#include <cstdio>
#include <cstdint>
namespace cg = cooperative_groups;
#ifndef MK_MULTI
#define MK_MULTI 0
#endif
__device__ __forceinline__ int mk_tid() { int t = threadIdx.x; asm volatile("" : "+v"(t)); return t; }
namespace pg8 {
#define PG8_LAS __attribute__((address_space(3)))
typedef unsigned short bf16_t;
typedef short bf16x8 __attribute__((ext_vector_type(8)));
typedef float f32x4 __attribute__((ext_vector_type(4)));
typedef unsigned u32x4 __attribute__((ext_vector_type(4)));
constexpr int BM = 256, BK = 64, HALF = 128, HTB = HALF * BK * 2  , STAGE_BYTES = 8 * HTB, NXCD = 8, WGM = 8;

__host__ __device__ __forceinline__ int lds_byte(int r, int c) { const int st = (r >> 4) * 2 + (c >> 5), rr = r & 15, cc = c & 31, ob = rr * 64 + cc * 2; return st * 1024 + (ob ^ (((ob >> 9) & 1) << 5)); }
__host__ __device__ __forceinline__ void stage_rc(int b, int& R, int& C) { const int st = b / 1024, sb = b % 1024, swz = sb ^ (((sb >> 9) & 1) << 5); R = (st >> 1) * 16 + swz / 64; C = (st & 1) * 32 + (swz % 64) / 2; }
__host__ __device__ __forceinline__ int perm32(int rho) { const int n = rho >> 4, i = rho & 15; return 8 * (i >> 2) + 4 * n + (i & 3); }

struct Unit { int pm, pn, koff; };
struct Gemm { const bf16_t* A; const bf16_t* Bt; int M, N, K; int a_rows; int ldk; };

struct StaticOrder {
    int nM, nN, nwg, G, c;
    __host__ __device__ void init(int M, int N, int G_, int c_) { nM = M / BM; nN = N / BM; nwg = nM * nN; G = G_; c = c_; }
    __host__ __device__ bool next(int i, Unit& u) const {
        const long L = (long)i * G + c; if (L >= nwg) return false;
        int wgid = (int)L; { const int q = nwg / NXCD, r = nwg % NXCD, xcd = wgid % NXCD, off = wgid / NXCD; wgid = (xcd < r ? xcd * (q + 1) : r * (q + 1) + (xcd - r) * q) + off; }
        const int nig = WGM * nN, gid = wgid / nig, fm = gid * WGM, gsz = (nM - fm) < WGM ? (nM - fm) : WGM;
        u.pm = fm + ((wgid % nig) % gsz); u.pn = (wgid % nig) / gsz; u.koff = 0; return true;
    }
    __device__ __forceinline__ void a_ready(const Unit&) const {}
    __device__ __forceinline__ void done(const Unit&) const {}
};

__device__ __forceinline__ unsigned cvt_pk_bf16(float lo, float hi) { unsigned r; asm volatile("v_cvt_pk_bf16_f32 %0, %1, %2" : "=v"(r) : "v"(lo), "v"(hi)); return r; }
typedef float f32x2 __attribute__((ext_vector_type(2)));
__device__ __forceinline__ f32x2 gelu_pk(f32x2 v) {
    const f32x2 av = __builtin_elementwise_abs(v), d = av * 0.2316418882f + 1.0f;
    f32x2 t; t.x = __builtin_amdgcn_rcpf(d.x); t.y = __builtin_amdgcn_rcpf(d.y);
    f32x2 q = t * 0.5307027145f + (-0.7265760135f); q = q * t + 0.7107068705f; q = q * t + (-0.142248368f); q = q * t + 0.127414796f; q = q * t;
    const f32x2 s = (v * v) * (-0.72134752044f);
    f32x2 e; e.x = __builtin_amdgcn_exp2f(s.x); e.y = __builtin_amdgcn_exp2f(s.y);
    const f32x2 m = v * (q * e), r = v - m;
    f32x2 o; o.x = v.x < 0.f ? m.x : r.x; o.y = v.y < 0.f ? m.y : r.y; return o;
}

template <int ACT  > struct EpiBf16 {
    static constexpr bool PERM = true, AFTER_DRAIN = false; static_assert(ACT == 0 || ACT == 1, "EpiBf16: ACT is 0 (none) or 1 (gelu_pk)");
    bf16_t* O; int ldc; const float* bias; int split_cols; size_t split_stride; float scale0;
    __device__ __forceinline__ void operator()(const f32x4 (&acc)[2][2][4][2], const Unit& u, int wr, int wc, int fr, int fq) const {
        const int row0 = u.pm * BM + wr * 64 + fr; int colt = u.pn * BM; bf16_t* base = O;
        float sc = 1.f; if (split_cols) { const int t = colt / split_cols; base += (size_t)t * split_stride; colt -= t * split_cols; if (t == 0) sc = scale0; }
        const int col0 = colt + wc * 32 + 8 * fq, bcol0 = u.pn * BM + wc * 32 + 8 * fq;
        f32x4 bv[2][2];
#pragma unroll
        for (int bj = 0; bj < 2; ++bj)
#pragma unroll
            for (int n = 0; n < 2; ++n) bv[bj][n] = bias ? *(const f32x4*)(bias + bcol0 + bj * HALF + 4 * n) : (f32x4){0.f, 0.f, 0.f, 0.f};
#pragma unroll
        for (int ai = 0; ai < 2; ++ai)
#pragma unroll
            for (int m = 0; m < 4; ++m) { bf16_t* rowp = base + (size_t)(row0 + ai * HALF + m * 16) * ldc + col0;
#pragma unroll
                for (int bj = 0; bj < 2; ++bj) { f32x4 v0 = acc[ai][bj][m][0] + bv[bj][0], v1 = acc[ai][bj][m][1] + bv[bj][1];
                    if (ACT == 1) { f32x2 a = gelu_pk((f32x2){v0[0], v0[1]}), b = gelu_pk((f32x2){v0[2], v0[3]}), c = gelu_pk((f32x2){v1[0], v1[1]}), d = gelu_pk((f32x2){v1[2], v1[3]});
                        v0 = (f32x4){a.x, a.y, b.x, b.y}; v1 = (f32x4){c.x, c.y, d.x, d.y}; }
                    v0 = v0 * sc; v1 = v1 * sc; u32x4 w; w.x = cvt_pk_bf16(v0[0], v0[1]); w.y = cvt_pk_bf16(v0[2], v0[3]); w.z = cvt_pk_bf16(v1[0], v1[1]); w.w = cvt_pk_bf16(v1[2], v1[3]);
                    *(u32x4*)(rowp + bj * HALF) = w; } }
    }
};

template <class Epi, class Sched, bool ALIGN_EPI = false, bool SP2 = false>
__device__ __forceinline__ void gemm_phase(PG8_LAS unsigned char* lds, const Gemm g, const Sched& S, const Epi& E) {
    const int tid = mk_tid(), wid = __builtin_amdgcn_readfirstlane(tid >> 6), lane = tid & 63, wr = wid >> 2, wc = wid & 3, fr = lane & 15, fq = lane >> 4;
    const int K = g.K, nt = K / BK;
    unsigned voffA[2], voffB[2];
#pragma unroll
    for (int i = 0; i < 2; ++i) { int R, C; stage_rc(tid * 16 + i * 8192, R, C); const int Rb = Epi::PERM ? ((R & ~31) + perm32(R & 31)) : R;
        voffA[i] = (unsigned)(R * g.ldk + C) * 2u; voffB[i] = (unsigned)(Rb * g.ldk + C) * 2u; }
    const size_t kstep = (size_t)(BK * 2);
    const size_t hstep = (size_t)HALF * g.ldk * 2;
    const size_t tstep = 2 * hstep;
    const unsigned ldsw = (unsigned)wid * 1024u;
    const int aoff = lds_byte(wr * 64 + fr, fq * 8), boff = lds_byte(wc * 32 + fr, fq * 8);
#define PG8_SA(b, h) (((b) * 2 + (h)) * HTB)
#define PG8_SB(b, h) ((4 + (b) * 2 + (h)) * HTB)
#define PG8_STAGE(bufoff, gbase, voff) do { _Pragma("unroll") for (int _i = 0; _i < 2; ++_i) \
        __builtin_amdgcn_global_load_lds((const unsigned*)((const char*)(gbase) + (voff)[_i]), (PG8_LAS unsigned*)(lds + (bufoff) + ldsw + _i * 8192), 16, 0, 0); } while (0)
#define PG8_LDA(dst, b, h) do { _Pragma("unroll") for (int m = 0; m < 4; ++m) _Pragma("unroll") for (int k = 0; k < 2; ++k) dst[m][k] = *(const PG8_LAS bf16x8*)(lds + PG8_SA(b, h) + aoff + m * 2048 + k * 1024); } while (0)
#define PG8_LDB(dst, b, h) do { _Pragma("unroll") for (int n = 0; n < 2; ++n) _Pragma("unroll") for (int k = 0; k < 2; ++k) dst[n][k] = *(const PG8_LAS bf16x8*)(lds + PG8_SB(b, h) + boff + n * 2048 + k * 1024); } while (0)
#define PG8_MMA(ai, bj, At, Bt) do { __builtin_amdgcn_s_setprio(1); _Pragma("unroll") for (int m = 0; m < 4; ++m) _Pragma("unroll") for (int n = 0; n < 2; ++n) _Pragma("unroll") for (int k = 0; k < 2; ++k) \
        acc[ai][bj][m][n] = __builtin_amdgcn_mfma_f32_16x16x32_bf16(Bt[n][k], At[m][k], acc[ai][bj][m][n], 0, 0, 0); __builtin_amdgcn_s_setprio(0); } while (0)
#define PG8_WAIT_V(n) asm volatile("s_waitcnt vmcnt(" #n ")" ::: "memory")
#define PG8_WAIT_L(n) asm volatile("s_waitcnt lgkmcnt(" #n ")" ::: "memory")
#define PG8_BAR __builtin_amdgcn_s_barrier()
#define PG8_SCHED __builtin_amdgcn_sched_barrier(0)
    Unit cur, nxt; int ui = 0;
    if (!S.next(0, cur)) return;
    f32x4 acc[2][2][4][2];
#pragma unroll
    for (int a = 0; a < 2; ++a)
#pragma unroll
        for (int b = 0; b < 2; ++b)
#pragma unroll
            for (int m = 0; m < 4; ++m)
#pragma unroll
                for (int n = 0; n < 2; ++n) acc[a][b][m][n] = (f32x4){0.f, 0.f, 0.f, 0.f};
    bf16x8 At[4][2], B0[2][2], B1[2][2];
    const size_t atstep = (size_t)g.a_rows * g.ldk * 2; const char* cA = (const char*)g.A + (size_t)cur.pm * atstep + (size_t)cur.koff * 2; const char* cB = (const char*)g.Bt + (size_t)cur.pn * tstep + (size_t)cur.koff * 2;
    S.a_ready(cur);
    if constexpr (SP2) {
        PG8_STAGE(PG8_SB(0, 0), cB, voffB); PG8_STAGE(PG8_SB(0, 1), cB + hstep, voffB); PG8_STAGE(PG8_SA(0, 0), cA, voffA); PG8_STAGE(PG8_SA(0, 1), cA + hstep, voffA);
        if (wr == 1) PG8_BAR;
        PG8_WAIT_V(2); PG8_BAR;
        PG8_STAGE(PG8_SB(1, 0), cB + kstep, voffB); PG8_STAGE(PG8_SA(1, 0), cA + kstep, voffA); PG8_STAGE(PG8_SB(1, 1), cB + hstep + kstep, voffB);
        PG8_WAIT_V(6); PG8_BAR;
    } else {
        PG8_STAGE(PG8_SB(0, 0), cB, voffB); PG8_STAGE(PG8_SA(0, 0), cA, voffA); PG8_STAGE(PG8_SB(0, 1), cB + hstep, voffB); PG8_STAGE(PG8_SA(0, 1), cA + hstep, voffA);
        if (wr == 1) PG8_BAR;
        PG8_WAIT_V(4); PG8_BAR;
        PG8_STAGE(PG8_SB(1, 0), cB + kstep, voffB); PG8_STAGE(PG8_SA(1, 0), cA + kstep, voffA); PG8_STAGE(PG8_SB(1, 1), cB + hstep + kstep, voffB);
        PG8_WAIT_V(6); PG8_BAR;
    }
    for (;;) {
        const bool has_next = S.next(ui + 1, nxt);
        const char* nA = has_next ? (const char*)g.A + (size_t)nxt.pm * atstep + (size_t)nxt.koff * 2 : cA; const char* nB = has_next ? (const char*)g.Bt + (size_t)nxt.pn * tstep + (size_t)nxt.koff * 2 : cB;
        for (int t = 0; t < nt; t += 2) {
            const bool last = (t == nt - 2);
            const char* a1 = cA + (size_t)(t + 1) * kstep;
            const char* a2 = last ? nA : cA + (size_t)(t + 2) * kstep; const char* b2 = last ? nB : cB + (size_t)(t + 2) * kstep;
            const char* a3 = a2 + kstep; const char* b3 = b2 + kstep;
            if (last && has_next) S.a_ready(nxt);
            if constexpr (SP2) {
            PG8_LDB(B0, 0, 0); PG8_LDB(B1, 0, 1); PG8_SCHED; PG8_LDA(At, 0, 0); PG8_STAGE(PG8_SA(1, 1), a1 + hstep, voffA);
            PG8_WAIT_V(8); PG8_WAIT_L(0); PG8_BAR; PG8_MMA(0, 0, At, B0); PG8_MMA(0, 1, At, B1); PG8_BAR; PG8_SCHED;
            PG8_LDA(At, 0, 1); PG8_STAGE(PG8_SB(0, 0), b2, voffB); PG8_STAGE(PG8_SB(0, 1), b2 + hstep, voffB); PG8_STAGE(PG8_SA(0, 0), a2, voffA);
            PG8_WAIT_V(8); PG8_WAIT_L(0); PG8_BAR; PG8_MMA(1, 0, At, B0); PG8_MMA(1, 1, At, B1); PG8_BAR; PG8_SCHED;
            PG8_LDB(B0, 1, 0); PG8_LDB(B1, 1, 1); PG8_SCHED; PG8_LDA(At, 1, 0); PG8_STAGE(PG8_SA(0, 1), a2 + hstep, voffA);
            PG8_WAIT_V(8); PG8_WAIT_L(0); PG8_BAR; PG8_MMA(0, 0, At, B0); PG8_MMA(0, 1, At, B1); PG8_BAR; PG8_SCHED;
            PG8_LDA(At, 1, 1); PG8_STAGE(PG8_SB(1, 0), b3, voffB); PG8_STAGE(PG8_SB(1, 1), b3 + hstep, voffB); PG8_STAGE(PG8_SA(1, 0), a3, voffA);
            PG8_WAIT_V(8); PG8_WAIT_L(0); PG8_BAR; PG8_MMA(1, 0, At, B0); PG8_MMA(1, 1, At, B1); PG8_BAR; PG8_SCHED;
            } else {
            PG8_LDB(B0, 0, 0); PG8_SCHED; PG8_LDA(At, 0, 0); PG8_STAGE(PG8_SA(1, 1), a1 + hstep, voffA);
            PG8_WAIT_L(8); PG8_BAR; PG8_WAIT_L(0); PG8_MMA(0, 0, At, B0); PG8_BAR; PG8_SCHED;
            PG8_LDB(B1, 0, 1); PG8_STAGE(PG8_SB(0, 0), b2, voffB);
            PG8_BAR; PG8_WAIT_L(0); PG8_MMA(0, 1, At, B1); PG8_BAR;
            PG8_LDA(At, 0, 1); PG8_STAGE(PG8_SA(0, 0), a2, voffA);
            PG8_BAR; PG8_WAIT_L(0); PG8_MMA(1, 0, At, B0); PG8_BAR; PG8_SCHED;
            PG8_STAGE(PG8_SB(0, 1), b2 + hstep, voffB);
            PG8_WAIT_V(6); PG8_BAR; PG8_MMA(1, 1, At, B1); PG8_BAR;
            PG8_LDB(B0, 1, 0); PG8_SCHED; PG8_LDA(At, 1, 0); PG8_STAGE(PG8_SA(0, 1), a2 + hstep, voffA);
            PG8_WAIT_L(8); PG8_BAR; PG8_WAIT_L(0); PG8_MMA(0, 0, At, B0); PG8_BAR; PG8_SCHED;
            PG8_LDB(B1, 1, 1); PG8_STAGE(PG8_SB(1, 0), b3, voffB);
            PG8_BAR; PG8_WAIT_L(0); PG8_MMA(0, 1, At, B1); PG8_BAR;
            PG8_LDA(At, 1, 1); PG8_STAGE(PG8_SA(1, 0), a3, voffA);
            PG8_BAR; PG8_WAIT_L(0); PG8_MMA(1, 0, At, B0); PG8_BAR; PG8_SCHED;
            PG8_STAGE(PG8_SB(1, 1), b3 + hstep, voffB);
            PG8_WAIT_V(6); PG8_BAR; PG8_MMA(1, 1, At, B1); PG8_BAR;
            }
        }
        if constexpr (ALIGN_EPI) { if (wr == 0) PG8_BAR; }
        if constexpr (!Epi::AFTER_DRAIN) { const int l2_ = mk_tid() & 63; E(acc, cur, wr, wc, l2_ & 15, l2_ >> 4); S.done(cur); }
        if (!has_next) break;
#pragma unroll
        for (int a = 0; a < 2; ++a)
#pragma unroll
            for (int b = 0; b < 2; ++b)
#pragma unroll
                for (int m = 0; m < 4; ++m)
#pragma unroll
                    for (int n = 0; n < 2; ++n) acc[a][b][m][n] = (f32x4){0.f, 0.f, 0.f, 0.f};
        cur = nxt; cA = nA; cB = nB; ++ui;
        if constexpr (ALIGN_EPI) { if (wr == 1) PG8_BAR; }
    }
    PG8_WAIT_V(0);
    if constexpr (!ALIGN_EPI) { if (wr == 0) PG8_BAR; }
    PG8_BAR;
    if constexpr (Epi::AFTER_DRAIN) { const int l2_ = mk_tid() & 63; E.fused(acc, cur, wr, wc, l2_ & 15, l2_ >> 4, lds, wid, l2_); S.done(cur); }
#undef PG8_SA
#undef PG8_SB
#undef PG8_STAGE
#undef PG8_LDA
#undef PG8_LDB
#undef PG8_MMA
#undef PG8_WAIT_V
#undef PG8_WAIT_L
#undef PG8_BAR
#undef PG8_SCHED
}
}

#include <hip/hip_bf16.h>
#include <cmath>
namespace attn_body {
using bf16=__hip_bfloat16;
using bf16x8=__attribute__((ext_vector_type(8)))short;
using s16x4=__attribute__((ext_vector_type(4)))short;
using f32x16=__attribute__((ext_vector_type(16)))float;
using u32x4=__attribute__((ext_vector_type(4)))unsigned;
constexpr int D=64,QP=512,KVP=128;
constexpr int NW=8,QBLK=32,QB=QBLK*NW,KVBLK=64;
constexpr int ATTN_UNIT_ROWS=QB;
__device__ __forceinline__ int crow(int r,int hi){return (r&3)+8*(r>>2)+4*hi;}
#define SBAR() __builtin_amdgcn_sched_barrier(0)
__device__ __forceinline__ void cmask(f32x16&p0,f32x16&p1,int jb,int qrel,int hi){
  const float NEG=-INFINITY; int kb=64*jb+4*hi;
  #pragma unroll
  for(int r=0;r<16;++r){int kv=kb+(r&3)+8*(r>>2); if(kv>qrel)p0[r]=NEG; if(kv+32>qrel)p1[r]=NEG;}
}

constexpr int NSLOT=3, SLOTB=8192;
constexpr int LDS_K=0, LDS_V=NSLOT*SLOTB, LDS_WS=2*NSLOT*SLOTB, LDS_OST=LDS_WS+NW*64*4, LDS_BYTES=LDS_OST+NW*4096;
constexpr float C2=0.125f*1.4426950408889634f;
__device__ __forceinline__ void glds16(const void*gsrc,unsigned lds_dst){unsigned keep;
  asm volatile("s_mov_b32 %0, m0\n\ts_mov_b32 m0, %2\n\ts_nop 0\n\tglobal_load_lds_dwordx4 %1, off\n\ts_mov_b32 m0, %0":"=&s"(keep):"v"(gsrc),"s"(lds_dst):"memory");}
__device__ __forceinline__ float max3f(float a,float b,float c){float r;asm("v_max3_f32 %0, %1, %2, %3":"=v"(r):"v"(a),"v"(b),"v"(c));return r;}
__device__ __forceinline__ float max2f(float a,float b){float r;asm("v_max_f32_e32 %0, %1, %2":"=v"(r):"v"(a),"v"(b));return r;}
__device__ __forceinline__ float fadd_s(float a,float b){float r;asm("v_add_f32_e32 %0, %1, %2":"=v"(r):"v"(a),"v"(b));return r;}
__device__ __forceinline__ float fsub_s(float a,float b){float r;asm("v_sub_f32_e32 %0, %1, %2":"=v"(r):"v"(a),"v"(b));return r;}
typedef float f32x2_t __attribute__((ext_vector_type(2))); typedef __bf16 bf16x2_t __attribute__((ext_vector_type(2)));
__device__ __forceinline__ unsigned cvtpk_s(float lo,float hi){f32x2_t v={lo,hi};bf16x2_t b=__builtin_convertvector(v,bf16x2_t);return __builtin_bit_cast(unsigned,b);}
#define WAIT_BAR(N) asm volatile("s_waitcnt vmcnt(" #N ") lgkmcnt(0)\n\ts_barrier":::"memory")

__device__ __forceinline__ void qkt(f32x16&p0,f32x16&p1,const char*Kslot,const bf16x8*qr,const f32x16&negm,int r32,int hi){
  const char*kb=Kslot+hi*1024+r32*16;
  #pragma unroll
  for(int d0=0;d0<4;++d0){
    const bf16x8 b0=*reinterpret_cast<const bf16x8*>(kb+d0*2048);
    const bf16x8 b1=*reinterpret_cast<const bf16x8*>(kb+d0*2048+512);
    if(d0==0){p0=__builtin_amdgcn_mfma_f32_32x32x16_bf16(b0,qr[0],negm,0,0,0);p1=__builtin_amdgcn_mfma_f32_32x32x16_bf16(b1,qr[0],negm,0,0,0);}
    else{p0=__builtin_amdgcn_mfma_f32_32x32x16_bf16(b0,qr[d0],p0,0,0,0);p1=__builtin_amdgcn_mfma_f32_32x32x16_bf16(b1,qr[d0],p1,0,0,0);}}
}
typedef __attribute__((address_space(3))) const char* lds_cptr;
typedef short v4i16_t __attribute__((ext_vector_type(4)));
__device__ __forceinline__ void kload8(bf16x8*kf,lds_cptr kp){
  kf[0]=*(const __attribute__((address_space(3))) bf16x8*)(kp);      kf[1]=*(const __attribute__((address_space(3))) bf16x8*)(kp+512);
  kf[2]=*(const __attribute__((address_space(3))) bf16x8*)(kp+2048); kf[3]=*(const __attribute__((address_space(3))) bf16x8*)(kp+2560);
  kf[4]=*(const __attribute__((address_space(3))) bf16x8*)(kp+4096); kf[5]=*(const __attribute__((address_space(3))) bf16x8*)(kp+4608);
  kf[6]=*(const __attribute__((address_space(3))) bf16x8*)(kp+6144); kf[7]=*(const __attribute__((address_space(3))) bf16x8*)(kp+6656);
}
__device__ __forceinline__ void kload2(bf16x8*kf,lds_cptr kp,int j){ kf[2*j]=*(const __attribute__((address_space(3))) bf16x8*)(kp+j*2048); kf[2*j+1]=*(const __attribute__((address_space(3))) bf16x8*)(kp+j*2048+512); }
__device__ __forceinline__ s16x4 vtr(lds_cptr p){ return __builtin_bit_cast(s16x4,__builtin_amdgcn_ds_read_tr16_b64_v4i16((__attribute__((address_space(3))) v4i16_t*)p)); }
__device__ __forceinline__ float rowmax(const f32x16&p0,const f32x16&p1){
  float a=max3f(p0[0],p0[1],p1[0]),b=max3f(p0[2],p0[3],p1[1]);a=max3f(a,p1[2],p1[3]);
  #pragma unroll
  for(int r=4;r<16;r+=4){a=max3f(a,p0[r],p0[r+1]);b=max3f(b,p0[r+2],p0[r+3]);a=max3f(a,p1[r],p1[r+1]);b=max3f(b,p1[r+2],p1[r+3]);}
  const float m=max2f(a,b);
  auto rr=__builtin_amdgcn_permlane32_swap(__float_as_uint(m),__float_as_uint(m),false,false);
  return max2f(__uint_as_float(rr[0]),__uint_as_float(rr[1]));
}
__device__ __forceinline__ void pv(f32x16*o,int vb,bf16x8 pa0,bf16x8 pa1,bf16x8 pa2,bf16x8 pa3){
  #pragma unroll
  for(int d0=0;d0<2;++d0){s16x4 lo[4],hi[4];
    #pragma unroll
    for(int ks=0;ks<4;++ks){
      asm volatile("ds_read_b64_tr_b16 %0,%1 offset:%c2":"=&v"(lo[ks]):"v"(vb),"i"(d0*4096+ks*1024):"memory");
      asm volatile("ds_read_b64_tr_b16 %0,%1 offset:%c2":"=&v"(hi[ks]):"v"(vb),"i"(d0*4096+ks*1024+512):"memory");}
    asm volatile("s_waitcnt lgkmcnt(0)":::"memory");SBAR();
    #define PK(k) (bf16x8){lo[k][0],lo[k][1],lo[k][2],lo[k][3],hi[k][0],hi[k][1],hi[k][2],hi[k][3]}
    o[d0]=__builtin_amdgcn_mfma_f32_32x32x16_bf16(pa0,PK(0),o[d0],0,0,0);
    o[d0]=__builtin_amdgcn_mfma_f32_32x32x16_bf16(pa1,PK(1),o[d0],0,0,0);
    o[d0]=__builtin_amdgcn_mfma_f32_32x32x16_bf16(pa2,PK(2),o[d0],0,0,0);
    o[d0]=__builtin_amdgcn_mfma_f32_32x32x16_bf16(pa3,PK(3),o[d0],0,0,0);
    #undef PK
  }
}

#ifndef ATTN_STORE16
#define ATTN_STORE16(p,v) (*(u32x4*)(p)=(v))
#endif
template<int THRL> __device__ __forceinline__ void attn_unit(const bf16*Qu,const bf16*__restrict__ Kh,const bf16*__restrict__ Vh,bf16*Ou,const int NT,char*shm){
  const int tid=mk_tid(),lane=tid&63,r32=lane&31,hi=lane>>5; const int wid=__builtin_amdgcn_readfirstlane(tid>>6);
  const bf16*Qw=Qu+(long)(wid*QBLK)*QP;
  const unsigned lds0=(unsigned)(uintptr_t)shm;
  float*wsf=(float*)(shm+LDS_WS)+wid*64;
  const bf16*ksrc=Kh+(long)lane*KVP+wid*8;
  const bf16*vsrc=Vh+(long)(16*(wid&3)+(lane>>2))*KVP+(wid>>2)*32+(lane&3)*8;
  const unsigned kdst=lds0+LDS_K+wid*1024, vdst=lds0+LDS_V+wid*1024;
  #define DMA_K(t,slot) glds16(ksrc+(long)(t)*KVBLK*KVP,(unsigned)__builtin_amdgcn_readfirstlane(kdst+(slot)))
  #define DMA_V(t,slot) glds16(vsrc+(long)(t)*KVBLK*KVP,(unsigned)__builtin_amdgcn_readfirstlane(vdst+(slot)))
  const int vb0=(int)(lds0+LDS_V)+((lane>>4)&1)*32+(lane&3)*8+(4*hi+((lane&15)>>2))*64;
  const char*Kbase=shm+LDS_K; bf16x8 kf[8];
  const lds_cptr shm3=(lds_cptr)shm; const lds_cptr kp0=shm3+LDS_K+hi*1024+r32*16; const lds_cptr vp0=shm3+LDS_V+((lane>>4)&1)*32+(lane&3)*8+(4*hi+((lane&15)>>2))*64;
  DMA_K(0,0);DMA_V(0,0);DMA_K(1,SLOTB);
  bf16x8 qr[4];
  #pragma unroll
  for(int d0=0;d0<4;++d0)qr[d0]=*reinterpret_cast<const bf16x8*>(&Qw[(long)r32*QP+d0*16+hi*8]);
  float mhat=0.f,l_reg=0.f;f32x16 o[2];o[0]=f32x16{};o[1]=f32x16{};f32x16 negm=f32x16{};asm volatile("":"+v"(negm));
  #define CMASK(P0,P1,t) do{}while(0)
  bool resc=false;
  #define START(P0,P1) do{ const float rm=rowmax(P0,P1); resc=false; \
    { const float dl=rm; mhat=fadd_s(mhat,dl); \
      _Pragma("unroll") for(int r=0;r<16;++r){P0[r]=fsub_s(P0[r],dl);P1[r]=fsub_s(P1[r],dl);} \
      _Pragma("unroll") for(int r=0;r<16;++r)negm[r]=-mhat; asm volatile("":"+v"(negm)); } \
    _Pragma("unroll") for(int r=0;r<16;++r)P0[r]=__builtin_amdgcn_exp2f(P0[r]); }while(0)
  #define RESC() do{ if(resc){ asm volatile("s_waitcnt lgkmcnt(0)":::"memory"); \
      _Pragma("unroll") for(int d_=0;d_<2;++d_) _Pragma("unroll") for(int r=0;r<16;++r)o[d_][r]*=wsf[crow(r,hi)]; } }while(0)
  f32x16 pA0,pA1,pB0,pB1;
  int sl_prev=0,sl_cur=0,sl_next=SLOTB;
  #define ROT() do{sl_prev=sl_cur;sl_cur=sl_next;sl_next=(sl_next==(NSLOT-1)*SLOTB)?0:sl_next+SLOTB;}while(0)
  DMA_K(2,2*SLOTB);
  WAIT_BAR(3);
  qkt(pA0,pA1,Kbase,qr,negm,r32,hi);asm volatile("s_nop 15\n\ts_nop 7":"+v"(pA0),"+v"(pA1));CMASK(pA0,pA1,0);
  START(pA0,pA1);
  _Pragma("unroll") for(int r=0;r<16;++r)pA1[r]=__builtin_amdgcn_exp2f(pA1[r]);
  WAIT_BAR(0);
  DMA_K(3,0);DMA_V(1,SLOTB);
  ROT();
  kload8(kf,kp0+sl_cur);
  WAIT_BAR(2);
  s16x4 vlo[8],vhi[8]; u32x4 pw0,pw1,pw2,pw3;
  #define PKW(P,B) cvtpk_s(P[B],P[B+1])
  #define PAF(k) __builtin_bit_cast(bf16x8,pw##k)
  #define VFR(i) (bf16x8){vlo[i][0],vlo[i][1],vlo[i][2],vlo[i][3],vhi[i][0],vhi[i][1],vhi[i][2],vhi[i][3]}
  #define PIN(x) asm volatile("":"+v"(x))
  #define MX3(a,b,c) __builtin_fmaxf(__builtin_fmaxf((a),(b)),(c))
  #define GAPA(MF,A0,A1,A2,A3,W0,W1,PW) do{ MF; sacc+=A0; sacc+=A1; sacc+=A2; sacc+=A3; PIN(sacc); W0; W1; PIN(PW); SBAR(); }while(0)
  #define EX(v) __builtin_amdgcn_exp2f(v)
  #define GAPB(MF,X,B) do{ MF; X[B]=EX(X[B]); X[B+1]=EX(X[B+1]); X[B+2]=EX(X[B+2]); X[B+3]=EX(X[B+3]); PIN(X); SBAR(); }while(0)
  #define VRD(i) do{ vlo[i]=vtr(vp_+(((i)>>2)*4096+((i)&3)*1024)); vhi[i]=vtr(vp_+(((i)>>2)*4096+((i)&3)*1024+512)); }while(0)
  #define KRD(G,j) do{ if(G){ kload2(kf,kp0+sl_next,j); SBAR(); } }while(0)
  #define STEP(C0,C1,P0,P1,t,GK,GV,GL) do{ SBAR(); \
    const lds_cptr vp_=vp0+sl_prev; \
    VRD(0); SBAR(); float sacc=(P0[0]+P0[1]); \
    GAPA(C0=__builtin_amdgcn_mfma_f32_32x32x16_bf16(kf[0],qr[0],negm,0,0,0), P0[2],P0[3],P0[4],P0[5],     pw0[0]=PKW(P0,0), pw0[1]=PKW(P0,2), pw0); \
    VRD(4); SBAR(); GAPA(C1=__builtin_amdgcn_mfma_f32_32x32x16_bf16(kf[1],qr[0],negm,0,0,0), P0[6],P0[7],P0[8],P0[9],     pw0[2]=PKW(P0,4), pw0[3]=PKW(P0,6), pw0); \
    VRD(1); SBAR(); GAPA(C0=__builtin_amdgcn_mfma_f32_32x32x16_bf16(kf[2],qr[1],C0,0,0,0),   P0[10],P0[11],P0[12],P0[13], pw1[0]=PKW(P0,8), pw1[1]=PKW(P0,10), pw1); \
    VRD(5); SBAR(); GAPA(C1=__builtin_amdgcn_mfma_f32_32x32x16_bf16(kf[3],qr[1],C1,0,0,0),   P0[14],P0[15],P1[0],P1[1],   pw1[2]=PKW(P0,12),pw1[3]=PKW(P0,14), pw1); \
    VRD(2); SBAR(); GAPA(C0=__builtin_amdgcn_mfma_f32_32x32x16_bf16(kf[4],qr[2],C0,0,0,0),   P1[2],P1[3],P1[4],P1[5],     pw2[0]=PKW(P1,0), pw2[1]=PKW(P1,2), pw2); \
    VRD(6); SBAR(); GAPA(C1=__builtin_amdgcn_mfma_f32_32x32x16_bf16(kf[5],qr[2],C1,0,0,0),   P1[6],P1[7],P1[8],P1[9],     pw2[2]=PKW(P1,4), pw2[3]=PKW(P1,6), pw2); \
    VRD(3); SBAR(); GAPA(C0=__builtin_amdgcn_mfma_f32_32x32x16_bf16(kf[6],qr[3],C0,0,0,0),   P1[10],P1[11],P1[12],P1[13], pw3[0]=PKW(P1,8), pw3[1]=PKW(P1,10), pw3); \
    VRD(7); SBAR(); GAPA(C1=__builtin_amdgcn_mfma_f32_32x32x16_bf16(kf[7],qr[3],C1,0,0,0),   P1[14],P1[15],0.f,0.f,       pw3[2]=PKW(P1,12),pw3[3]=PKW(P1,14), pw3); \
    l_reg+=sacc; \
    if(GK){DMA_K((t)+3,sl_cur);} if(GV){DMA_V((t)+1,sl_next);} \
    CMASK(C0,C1,t); \
    { float a=MX3(C0[0],C0[1],C1[0]),b=MX3(C0[2],C0[3],C1[1]); a=MX3(a,C1[2],C1[3]); \
      _Pragma("unroll") for(int r=4;r<16;r+=4){a=MX3(a,C0[r],C0[r+1]);b=MX3(b,C0[r+2],C0[r+3]);a=MX3(a,C1[r],C1[r+1]);b=MX3(b,C1[r+2],C1[r+3]);} \
      float rm=__builtin_fmaxf(a,b); { auto rr=__builtin_amdgcn_permlane32_swap(__float_as_uint(rm),__float_as_uint(rm),false,false); rm=__builtin_fmaxf(__uint_as_float(rr[0]),__uint_as_float(rr[1])); } \
      resc=false; \
      if(__builtin_expect(__any(rm>(float)THRL),0)){ const float dl=__builtin_fmaxf(rm,0.f); mhat+=dl; \
        _Pragma("unroll") for(int r=0;r<16;++r){C0[r]-=dl;C1[r]-=dl;} \
        _Pragma("unroll") for(int r=0;r<16;++r)negm[r]=-mhat; asm volatile("":"+v"(negm)); \
        const float f=__builtin_amdgcn_exp2f(-dl); l_reg*=f; if(hi==0)wsf[r32]=f; resc=true; } } \
    SBAR(); \
    GAPB(o[0]=__builtin_amdgcn_mfma_f32_32x32x16_bf16(PAF(0),VFR(0),o[0],0,0,0), C0,0); \
    GAPB(o[1]=__builtin_amdgcn_mfma_f32_32x32x16_bf16(PAF(0),VFR(4),o[1],0,0,0), C0,4); \
    KRD(GL,0); GAPB(o[0]=__builtin_amdgcn_mfma_f32_32x32x16_bf16(PAF(1),VFR(1),o[0],0,0,0), C0,8); \
    KRD(GL,1); GAPB(o[1]=__builtin_amdgcn_mfma_f32_32x32x16_bf16(PAF(1),VFR(5),o[1],0,0,0), C0,12); \
    KRD(GL,2); GAPB(o[0]=__builtin_amdgcn_mfma_f32_32x32x16_bf16(PAF(2),VFR(2),o[0],0,0,0), C1,0); \
    KRD(GL,3); GAPB(o[1]=__builtin_amdgcn_mfma_f32_32x32x16_bf16(PAF(2),VFR(6),o[1],0,0,0), C1,4); \
    GAPB(o[0]=__builtin_amdgcn_mfma_f32_32x32x16_bf16(PAF(3),VFR(3),o[0],0,0,0), C1,8); \
    GAPB(o[1]=__builtin_amdgcn_mfma_f32_32x32x16_bf16(PAF(3),VFR(7),o[1],0,0,0), C1,12); \
    }while(0)
  int t=1;
  #undef CMASK
  #define CMASK(P0,P1,t) do{}while(0)
  for(;t+5<NT;t+=2){
    STEP(pB0,pB1,pA0,pA1,t,true,true,true);     WAIT_BAR(2); RESC(); ROT();
    STEP(pA0,pA1,pB0,pB1,t+1,true,true,true);   WAIT_BAR(2); RESC(); ROT();
  }
  #undef CMASK
  #define CMASK(P0,P1,t) do{}while(0)
  #define ENDW(tt) do{ if((tt)+3<NT){WAIT_BAR(2);} else if((tt)+2<NT){WAIT_BAR(1);} else {WAIT_BAR(0);} }while(0)
  for(;t+1<NT;t+=2){
    STEP(pB0,pB1,pA0,pA1,t,(t+3<NT),(t+1<NT),(t+1<NT));       ENDW(t);   RESC(); ROT();
    STEP(pA0,pA1,pB0,pB1,t+1,(t+4<NT),(t+2<NT),(t+2<NT));     ENDW(t+1); RESC(); ROT();
  }
  STEP(pB0,pB1,pA0,pA1,NT-1,false,false,false); RESC();
  { float sacc=pB0[0]+pB0[1]; _Pragma("unroll") for(int r=2;r<16;++r)sacc+=pB0[r]; _Pragma("unroll") for(int r=0;r<16;++r)sacc+=pB1[r]; l_reg+=sacc;
    pw0=(u32x4){PKW(pB0,0),PKW(pB0,2),PKW(pB0,4),PKW(pB0,6)};pw1=(u32x4){PKW(pB0,8),PKW(pB0,10),PKW(pB0,12),PKW(pB0,14)};pw2=(u32x4){PKW(pB1,0),PKW(pB1,2),PKW(pB1,4),PKW(pB1,6)};pw3=(u32x4){PKW(pB1,8),PKW(pB1,10),PKW(pB1,12),PKW(pB1,14)};
    SBAR(); pv(o,vb0+sl_cur,PAF(0),PAF(1),PAF(2),PAF(3)); }
  #undef PKW
  #undef PAF
  #undef VFR
  #undef PIN
  #undef MX3
  #undef GAPA
  #undef GAPB
  #undef EX
  #undef VRD
  #undef KRD
  #undef STEP
  #undef ENDW
  {auto rr=__builtin_amdgcn_permlane32_swap(__float_as_uint(l_reg),__float_as_uint(l_reg),false,false);l_reg=__uint_as_float(rr[0])+__uint_as_float(rr[1]);}
  if(hi==0)wsf[32+r32]=l_reg;asm volatile("s_waitcnt lgkmcnt(0)":::"memory");
  float rli[16];
  #pragma unroll
  for(int r=0;r<16;++r)rli[r]=__builtin_amdgcn_rcpf(wsf[32+crow(r,hi)]);
  bf16*Ow=Ou+(long)(wid*QBLK)*QP;
  { bf16*stg=(bf16*)(shm+LDS_OST)+wid*2048;
    #pragma unroll
    for(int r=0;r<16;++r){const int orow=crow(r,hi);
      #pragma unroll
      for(int d0=0;d0<2;++d0)stg[orow*64+d0*32+r32]=__float2bfloat16(o[d0][r]*rli[r]);}
    asm volatile("s_waitcnt lgkmcnt(0)":::"memory");
    #pragma unroll
    for(int i=0;i<4;++i){const int row=i*8+(lane>>3),ch=lane&7; const u32x4 v=*(const u32x4*)(stg+row*64+ch*8); ATTN_STORE16(Ow+(long)row*QP+ch*8,v);} }
  asm volatile("s_waitcnt lgkmcnt(0)\n\ts_barrier":::"memory");
  #undef DMA_K
  #undef DMA_V
  #undef CMASK
  #undef START
  #undef RESC
  #undef ROT
}
constexpr int ATTN_LDS_BYTES=LDS_BYTES;
#undef SBAR
#undef WAIT_BAR
}

#define LAS __attribute__((address_space(3)))
typedef unsigned short bf16r;
typedef float f4 __attribute__((ext_vector_type(4)));
typedef unsigned u4 __attribute__((ext_vector_type(4)));
typedef unsigned u2 __attribute__((ext_vector_type(2)));
typedef short s8v __attribute__((ext_vector_type(8)));

constexpr int DM = 1024, SEQL = 4096, CTXL = 256, MLAT = 16384, MCTX = 1024, MALL = 17408;
constexpr int DIN = 1792, DFF = 2816, DFF2 = 5632, KVR = 4352, NCH = 68;
constexpr float EPSN = 1e-6f;
constexpr size_t MiB = 1u << 20;
constexpr size_t WS_MOD = 1 * MiB, WS_COS = 2 * MiB, WS_SIN = 2 * MiB + 512 * 1024, WS_GW = 3 * MiB, WS_AGGA = 4 * MiB, WS_AGGB = 6 * MiB, WS_CTXRES = 8 * MiB;
constexpr size_t WS_W = 12 * MiB, W_LAYER = 22 * MiB, W_IN = 0, W_OUT = 3 * MiB + 512 * 1024, W_UP = 5 * MiB + 512 * 1024, W_DOWN = 16 * MiB + 512 * 1024;
constexpr size_t WS_HN = 56 * MiB + 4096;
constexpr size_t WS_Q = 92 * MiB, WS_K = 109 * MiB, WS_V = 114 * MiB, WS_XL = 119 * MiB, WS_GG = 136 * MiB, WS_MIX = 153 * MiB;
constexpr size_t WS_LAB = 187 * MiB;
constexpr size_t WS_O = WS_HN;
constexpr size_t WS_PART = 187 * MiB;
constexpr size_t WS_ACT = 92 * MiB;
constexpr int LDS_BYTES = 147456;
constexpr int NPHASE = 18;
constexpr int L1_TAB_OFF = 84992;
#ifndef PHM
#define PHM 0x3ff
#endif
#define PON(k) ((PHM >> (k)) & 1)

struct Args { const float* in[24]; float* out; unsigned char* ws; int ph_lo, ph_hi; };
typedef const __attribute__((address_space(4))) Args* KA;

#define LDS_WAIT() asm volatile("s_waitcnt lgkmcnt(0)" ::: "memory")
__device__ __forceinline__ unsigned pk2(float lo, float hi) { return attn_body::cvtpk_s(lo, hi); }
__device__ __forceinline__ float bf_lo(unsigned w) { return __builtin_bit_cast(float, w << 16); }
__device__ __forceinline__ float bf_hi(unsigned w) { return __builtin_bit_cast(float, w & 0xffff0000u); }
__device__ __forceinline__ float wave_sum(float v) {
#pragma unroll
    for (int o = 1; o < 64; o <<= 1) v += __shfl_xor(v, o);
    return v;
}
__device__ __forceinline__ float fexp(float x) { return __builtin_amdgcn_exp2f(x * 1.4426950408889634f); }
__device__ __forceinline__ float sigmoidf_(float x) { return __builtin_amdgcn_rcpf(1.f + fexp(-x)); }
__device__ __forceinline__ float gelu_tanh(float x) { const float z = 0.7978845608028654f * (x + 0.044715f * x * x * x); return x * sigmoidf_(2.f * z); }
__device__ __forceinline__ int kvrow(int row) { return row < MLAT ? (row >> 12) * KVR + CTXL + (row & 4095) : ((row - MLAT) >> 8) * KVR + ((row - MLAT) & 255); }

__device__ __forceinline__ int win_dst(int s) {
    if (s < 512) { const int h = s >> 6, d = s & 63; return (h >> 2) * 256 + (d >> 5) * 128 + (h & 3) * 32 + (d & 31); }
    if (s < 768) { const int t = s - 512, hh = t >> 6, d = t & 63; return 512 + (d >> 5) * 128 + hh * 32 + (d & 31); }
    return s;
}
__device__ __forceinline__ int wup_dst(int s) { return s < DFF ? (s >> 7) * 256 + (s & 127) : ((s - DFF) >> 7) * 256 + 128 + ((s - DFF) & 127); }

template <int MODE> __device__ __forceinline__ void p0_transpose_item(const float* W, int K, int N, bf16r* WT, const float* ksA, const float* ksB, LAS float* scr, int item, int lane) {
    const int nblk = N / 32, kb = item / nblk, nb = item % nblk, k0 = 64 * kb, n0 = 32 * nb;
    float tv[32];
#pragma unroll
    for (int i = 0; i < 32; ++i) { const int kk = 2 * i + (lane >> 5); tv[i] = __builtin_nontemporal_load(W + (size_t)(k0 + kk) * N + n0 + (lane & 31)); }
#pragma unroll
    for (int i = 0; i < 32; ++i) { const int kk = 2 * i + (lane >> 5); float v = tv[i];
        if (MODE == 3) { const int k = k0 + kk; v *= (k < 512 ? ksA[k] : ksB[k - 512]); }
        scr[kk * 33 + (lane & 31)] = v; }
    LDS_WAIT();
    const int c = lane & 7;
#pragma unroll
    for (int j = 0; j < 4; ++j) { const int n = (lane >> 3) + 8 * j; const LAS float* s = scr + (8 * c) * 33 + n;
        u4 o; o.x = pk2(s[0 * 33], s[1 * 33]); o.y = pk2(s[2 * 33], s[3 * 33]); o.z = pk2(s[4 * 33], s[5 * 33]); o.w = pk2(s[6 * 33], s[7 * 33]);
        const int sc = n0 + n; const int dst = MODE == 1 ? win_dst(sc) : MODE == 2 ? wup_dst(sc) : sc;
        *(u4*)(WT + (size_t)dst * K + k0 + 8 * c) = o; }
    LDS_WAIT();
}

__device__ __forceinline__ void p0_phase(KA a, LAS unsigned char* lds, int tid, int wid, int lane, int G) {
    unsigned char* ws = a->ws;
    float* MOD = (float*)(ws + WS_MOD);
    {
        LAS float* sc = (LAS float*)lds; LAS float* red = sc + 5 * 1024;
        bool have = false;
        for (int it = blockIdx.x; it < 192; it += G) {
            if (!have) { for (int e = tid; e < 5 * 1024; e += 512) { const int r = e >> 10, k = e & 1023; const float v = r < 4 ? a->in[1][r * 1024 + k] : a->in[3][k]; sc[e] = v * sigmoidf_(v); } have = true; }
            __syncthreads();
            const int l = it / 96, nb = it % 96;
            const float* wp = a->in[4] + (size_t)l * 1024 * 6144 + (size_t)(wid * 128) * 6144 + nb * 64 + lane;
            float acc[5] = {0.f, 0.f, 0.f, 0.f, 0.f};
#pragma unroll 32
            for (int k = 0; k < 128; ++k) { const float wv = __builtin_nontemporal_load(wp + (size_t)k * 6144);
#pragma unroll
                for (int r = 0; r < 5; ++r) acc[r] += sc[r * 1024 + wid * 128 + k] * wv; }
#pragma unroll
            for (int r = 0; r < 5; ++r) red[(wid * 5 + r) * 64 + lane] = acc[r];
            __syncthreads();
            if (tid < 320) { const int r = tid >> 6, col = tid & 63; float s = a->in[5][l * 6144 + nb * 64 + col];
#pragma unroll
                for (int w = 0; w < 8; ++w) s += red[(w * 5 + r) * 64 + col];
                MOD[(l * 5 + r) * 6144 + nb * 64 + col] = s; }
        }
        __syncthreads();
    }
    {
        float* cosT = (float*)(ws + WS_COS); float* sinT = (float*)(ws + WS_SIN); bf16r* GW = (bf16r*)(ws + WS_GW);
        const int gt = blockIdx.x * 512 + tid, NT_ = G * 512;
        for (int e = gt; e < 4096 * 32; e += NT_) { const int t = e >> 5, j = e & 31; const float pos = (float)(j < 16 ? (t >> 6) : (t & 63));
            const float inv = powf(10000.0f, -(float)(j & 15) * (1.0f / 16.0f)); const float ang = pos * inv; cosT[e] = cosf(ang); sinT[e] = sinf(ang); }
        for (int e = gt; e < 2 * 2 * 2 * 8 * 64 * 64; e += NT_) {
            const int c = e & 63, d = (e >> 6) & 63, n = (e >> 12) & 7, mat = (e >> 15) & 1, dir = (e >> 16) & 1, l = e >> 17;
            const float* src = mat ? a->in[13] : a->in[11];
            GW[e] = (bf16r)(pk2(src[((((size_t)l * 2 + dir) * 8 + n) * 64 + c) * 64 + d], 0.f) & 0xffffu); }
    }
    {
        LAS float* scr = (LAS float*)lds + wid * (64 * 33 + 16);
        const int gw = blockIdx.x * 8 + wid, NGW = G * 8;
        constexpr int I_IN = 16 * 56, I_OUT = 16 * 32, I_UP = 16 * 176, I_DN = 44 * 32, I_L = I_IN + I_OUT + I_UP + I_DN;
        for (int it = gw; it < 2 * I_L; it += NGW) {
            const int l = it / I_L; int r = it % I_L;
            unsigned char* wl = ws + WS_W + (size_t)l * W_LAYER;
            if (r < I_IN) { p0_transpose_item<1>(a->in[6] + (size_t)l * DM * DIN, DM, DIN, (bf16r*)(wl + W_IN), nullptr, nullptr, scr, r, lane); continue; } r -= I_IN;
            if (r < I_OUT) { p0_transpose_item<3>(a->in[18] + (size_t)l * DM * DM, DM, DM, (bf16r*)(wl + W_OUT), a->in[16] + l * 512, a->in[17] + l * 512, scr, r, lane); continue; } r -= I_OUT;
            if (r < I_UP) { p0_transpose_item<2>(a->in[19] + (size_t)l * DM * DFF2, DM, DFF2, (bf16r*)(wl + W_UP), nullptr, nullptr, scr, r, lane); continue; } r -= I_UP;
            p0_transpose_item<0>(a->in[22] + (size_t)l * DFF * DM, DFF, DM, (bf16r*)(wl + W_DOWN), nullptr, nullptr, scr, r, lane);
        }
    }
}

__device__ __forceinline__ void prenorm_phase(KA a, int l, int which, int nrows, int nsplit, const float* ctx_src, int wid, int lane, int G) {
    const float* MOD = (const float*)(a->ws + WS_MOD); bf16r* HN = (bf16r*)(a->ws + WS_HN);
    float* ctxres = (float*)(a->ws + WS_CTXRES); const float* PART = (const float*)(a->ws + WS_PART);
    const int gw = blockIdx.x * 8 + wid, NGW = G * 8;
    const bool from_in = (l == 0 && which == 0);
    for (int row = gw; row < nrows; row += 2 * NGW) {
        const int row2 = row + NGW; const bool has2 = row2 < nrows; const int r2 = has2 ? row2 : row;
        const float* lat = from_in ? a->in[0] : a->out;
        const float* s0 = row < MLAT ? lat + (size_t)row * DM : ctx_src + (size_t)(row - MLAT) * DM;
        const float* s1 = r2 < MLAT ? lat + (size_t)r2 * DM : ctx_src + (size_t)(r2 - MLAT) * DM;
        const float* md0 = MOD + (l * 5 + (row < MLAT ? (row >> 12) : 4)) * 6144 + (which ? 3 * 1024 : 0);
        const float* md1 = MOD + (l * 5 + (r2 < MLAT ? (r2 >> 12) : 4)) * 6144 + (which ? 3 * 1024 : 0);
        f4 v0[4], v1[4];
#pragma unroll
        for (int j = 0; j < 4; ++j) { v0[j] = __builtin_nontemporal_load((const f4*)(s0 + 4 * (lane + 64 * j))); v1[j] = __builtin_nontemporal_load((const f4*)(s1 + 4 * (lane + 64 * j))); }
        if (nsplit > 0) {
            if (row >= MLAT) { const float* pp = PART + (size_t)(row - MLAT) * DM + 4 * lane;
                for (int ks = 0; ks < nsplit; ks += 4) {
                    f4 t_[4][4]; float wk_[4];
#pragma unroll
                    for (int kk = 0; kk < 4; ++kk) { const int k2 = ks + kk < nsplit ? ks + kk : nsplit - 1; wk_[kk] = ks + kk < nsplit ? 1.f : 0.f;
#pragma unroll
                        for (int j = 0; j < 4; ++j) t_[kk][j] = *(const f4*)(pp + (size_t)k2 * MCTX * DM + 256 * j); }
                    __builtin_amdgcn_sched_barrier(0);
#pragma unroll
                    for (int kk = 0; kk < 4; ++kk)
#pragma unroll
                        for (int j = 0; j < 4; ++j) v0[j] += t_[kk][j] * wk_[kk];
                }
#pragma unroll
                for (int j = 0; j < 4; ++j) *(f4*)(ctxres + (size_t)(row - MLAT) * DM + 4 * (lane + 64 * j)) = v0[j]; }
            if (has2 && row2 >= MLAT) { const float* pp = PART + (size_t)(row2 - MLAT) * DM + 4 * lane;
                for (int ks = 0; ks < nsplit; ks += 4) {
                    f4 t_[4][4]; float wk_[4];
#pragma unroll
                    for (int kk = 0; kk < 4; ++kk) { const int k2 = ks + kk < nsplit ? ks + kk : nsplit - 1; wk_[kk] = ks + kk < nsplit ? 1.f : 0.f;
#pragma unroll
                        for (int j = 0; j < 4; ++j) t_[kk][j] = *(const f4*)(pp + (size_t)k2 * MCTX * DM + 256 * j); }
                    __builtin_amdgcn_sched_barrier(0);
#pragma unroll
                    for (int kk = 0; kk < 4; ++kk)
#pragma unroll
                        for (int j = 0; j < 4; ++j) v1[j] += t_[kk][j] * wk_[kk];
                }
#pragma unroll
                for (int j = 0; j < 4; ++j) *(f4*)(ctxres + (size_t)(row2 - MLAT) * DM + 4 * (lane + 64 * j)) = v1[j]; }
        }
        float ss0 = 0.f, ss1 = 0.f;
#pragma unroll
        for (int j = 0; j < 4; ++j) { ss0 += (v0[j].x * v0[j].x + v0[j].y * v0[j].y) + (v0[j].z * v0[j].z + v0[j].w * v0[j].w); ss1 += (v1[j].x * v1[j].x + v1[j].y * v1[j].y) + (v1[j].z * v1[j].z + v1[j].w * v1[j].w); }
#pragma unroll
        for (int o = 1; o < 64; o <<= 1) { ss0 += __shfl_xor(ss0, o); ss1 += __shfl_xor(ss1, o); }
        const float rs0 = rsqrtf(ss0 * (1.f / DM) + EPSN), rs1 = rsqrtf(ss1 * (1.f / DM) + EPSN);
#pragma unroll
        for (int j = 0; j < 4; ++j) { const int col = 4 * (lane + 64 * j);
            { const f4 sh = *(const f4*)(md0 + col), sc = *(const f4*)(md0 + 1024 + col); const f4 h = v0[j] * rs0 * (sc + 1.f) + sh; u2 w; w.x = pk2(h.x, h.y); w.y = pk2(h.z, h.w); *(u2*)(HN + (size_t)row * DM + col) = w; }
            if (has2) { const f4 sh = *(const f4*)(md1 + col), sc = *(const f4*)(md1 + 1024 + col); const f4 h = v1[j] * rs1 * (sc + 1.f) + sh; u2 w; w.x = pk2(h.x, h.y); w.y = pk2(h.z, h.w); *(u2*)(HN + (size_t)row2 * DM + col) = w; } }
    }
}
__device__ __forceinline__ void finalnorm_phase(KA a, int wid, int lane, int G) {
    const float* fw = a->in[23];
    const int gw = blockIdx.x * 8 + wid, NGW = G * 8;
    f4 wv[4];
#pragma unroll
    for (int j = 0; j < 4; ++j) wv[j] = *(const f4*)(fw + 4 * (lane + 64 * j));
    for (int row = gw; row < MLAT; row += 2 * NGW) {
        const int row2 = row + NGW; const bool has2 = row2 < MLAT;
        float* p0 = a->out + (size_t)row * DM; float* p1 = a->out + (size_t)(has2 ? row2 : row) * DM;
        f4 v0[4], v1[4]; float ss0 = 0.f, ss1 = 0.f;
#pragma unroll
        for (int j = 0; j < 4; ++j) { v0[j] = *(const f4*)(p0 + 4 * (lane + 64 * j)); v1[j] = *(const f4*)(p1 + 4 * (lane + 64 * j)); }
#pragma unroll
        for (int j = 0; j < 4; ++j) { ss0 += (v0[j].x * v0[j].x + v0[j].y * v0[j].y) + (v0[j].z * v0[j].z + v0[j].w * v0[j].w); ss1 += (v1[j].x * v1[j].x + v1[j].y * v1[j].y) + (v1[j].z * v1[j].z + v1[j].w * v1[j].w); }
#pragma unroll
        for (int o = 1; o < 64; o <<= 1) { ss0 += __shfl_xor(ss0, o); ss1 += __shfl_xor(ss1, o); }
        const float rs0 = rsqrtf(ss0 * (1.f / DM) + EPSN), rs1 = rsqrtf(ss1 * (1.f / DM) + EPSN);
#pragma unroll
        for (int j = 0; j < 4; ++j) { __builtin_nontemporal_store(v0[j] * rs0 * wv[j], (f4*)(p0 + 4 * (lane + 64 * j))); if (has2) __builtin_nontemporal_store(v1[j] * rs1 * wv[j], (f4*)(p1 + 4 * (lane + 64 * j))); }
    }
}

struct EpiWin {
    static constexpr bool PERM = true, AFTER_DRAIN = false;
    unsigned char* ws_; const float *qw, *kw;
    __device__ __forceinline__ void operator()(const pg8::f32x4 (&acc)[2][2][4][2], const pg8::Unit& u, int wr, int wc, int fr, int fq) const {
        bf16r* const Q = (bf16r*)(ws_ + WS_Q); bf16r* const Kb = (bf16r*)(ws_ + WS_K); bf16r* const Vb = (bf16r*)(ws_ + WS_V); bf16r* const XL = (bf16r*)(ws_ + WS_XL); bf16r* const GG = (bf16r*)(ws_ + WS_GG);
        const float* const cosT = (const float*)(ws_ + WS_COS); const float* const sinT = (const float*)(ws_ + WS_SIN);
        const int pn = u.pn, row0 = u.pm * 256 + wr * 64 + fr;
        if (pn >= 3) {
            const bool isg = pn >= 5; bf16r* dst = isg ? GG : XL; const int cb = (pn - (isg ? 5 : 3)) * 256 + wc * 32 + 8 * fq;
#pragma unroll
            for (int ai = 0; ai < 2; ++ai)
#pragma unroll
                for (int m = 0; m < 4; ++m) { const int row = row0 + ai * 128 + m * 16;
#pragma unroll
                    for (int bj = 0; bj < 2; ++bj)
#pragma unroll
                        for (int n = 0; n < 2; ++n) { pg8::f32x4 v = acc[ai][bj][m][n];
                            if (isg) { v[0] = gelu_tanh(v[0]); v[1] = gelu_tanh(v[1]); v[2] = gelu_tanh(v[2]); v[3] = gelu_tanh(v[3]); }
                            u2 w; w.x = pk2(v[0], v[1]); w.y = pk2(v[2], v[3]);
                            const int col = cb + bj * 128 + n * 4;
                            if (isg) *(u2*)(dst + (size_t)(row >> 4) * 8192 + (col >> 6) * 1024 + ((col >> 4) & 3) * 256 + (row & 15) * 16 + (col & 15)) = w;
                            else *(u2*)(dst + (size_t)row * 512 + col) = w; } }
            return;
        }
        if (pn == 2 && wc >= 2) {
#pragma unroll
            for (int ai = 0; ai < 2; ++ai)
#pragma unroll
                for (int m = 0; m < 4; ++m) { const int row = row0 + ai * 128 + m * 16; bf16r* base = Vb + (size_t)kvrow(row) * 128 + (wc - 2) * 64 + 8 * fq;
#pragma unroll
                    for (int bj = 0; bj < 2; ++bj)
#pragma unroll
                        for (int n = 0; n < 2; ++n) { const pg8::f32x4 v = acc[ai][bj][m][n]; u2 w; w.x = pk2(v[0], v[1]); w.y = pk2(v[2], v[3]);
                            *(u2*)(base + 32 * bj + 4 * n) = w; } }
            return;
        }
        const bool isk = pn == 2; const float* nw = isk ? kw : qw;
        pg8::f32x4 wv[2][2];
#pragma unroll
        for (int bj = 0; bj < 2; ++bj)
#pragma unroll
            for (int n = 0; n < 2; ++n) wv[bj][n] = *(const pg8::f32x4*)(nw + 32 * bj + 8 * fq + 4 * n);
        const float osc = isk ? 1.f : attn_body::C2;
#pragma unroll
        for (int am = 0; am < 4; ++am) { const int ai = am >> 1, m0 = (am & 1) * 2;
            pg8::f32x4 csv[2][2], snv[2][2];
            const bool lat_ = (row0 + ai * 128) < MLAT;
#pragma unroll
            for (int mm = 0; mm < 2; ++mm) { const int t = (row0 + ai * 128 + (m0 + mm) * 16) & 4095;
#pragma unroll
                for (int n = 0; n < 2; ++n) { csv[mm][n] = *(const pg8::f32x4*)(cosT + t * 32 + 8 * fq + 4 * n); snv[mm][n] = *(const pg8::f32x4*)(sinT + t * 32 + 8 * fq + 4 * n); } }
            __builtin_amdgcn_sched_barrier(0);
#pragma unroll
            for (int mm = 0; mm < 2; ++mm) { const int m = m0 + mm; const int row = row0 + ai * 128 + m * 16;
                float ss = 0.f;
#pragma unroll
                for (int bj = 0; bj < 2; ++bj)
#pragma unroll
                    for (int n = 0; n < 2; ++n) { const pg8::f32x4 v = acc[ai][bj][m][n]; ss += (v[0] * v[0] + v[1] * v[1]) + (v[2] * v[2] + v[3] * v[3]); }
                ss += __shfl_xor(ss, 16); ss += __shfl_xor(ss, 32);
                const float rstd = rsqrtf(ss * (1.f / 64.f) + EPSN) * osc;
                pg8::f32x4 y[2][2];
#pragma unroll
                for (int bj = 0; bj < 2; ++bj)
#pragma unroll
                    for (int n = 0; n < 2; ++n) y[bj][n] = acc[ai][bj][m][n] * rstd * wv[bj][n];
                if (lat_) {
#pragma unroll
                    for (int n = 0; n < 2; ++n) { const pg8::f32x4 cs = csv[mm][n], sn = snv[mm][n];
                        const pg8::f32x4 o0 = y[0][n] * cs - y[1][n] * sn, o1 = y[1][n] * cs + y[0][n] * sn; y[0][n] = o0; y[1][n] = o1; } }
                bf16r* base = isk ? Kb + (size_t)kvrow(row) * 128 + wc * 64 + 8 * fq : Q + (size_t)row * 512 + (4 * pn + wc) * 64 + 8 * fq;
#pragma unroll
                for (int bj = 0; bj < 2; ++bj)
#pragma unroll
                    for (int n = 0; n < 2; ++n) { u2 w; w.x = pk2(y[bj][n][0], y[bj][n][1]); w.y = pk2(y[bj][n][2], y[bj][n][3]); *(u2*)(base + 32 * bj + 4 * n) = w; }
            }
            __builtin_amdgcn_sched_barrier(0);
        }
    }
};
struct EpiRes {
    static constexpr bool PERM = false, AFTER_DRAIN = false;
    const float *base_lat, *base_ctx; float *out_lat, *out_ctx; const float* gate;
    __device__ __forceinline__ void operator()(const pg8::f32x4 (&acc)[2][2][4][2], const pg8::Unit& u, int wr, int wc, int fr, int fq) const {
        const int pm = u.pm; const bool isctx = pm >= 64;
        const float* base = isctx ? base_ctx + (size_t)(pm - 64) * 256 * DM : base_lat + (size_t)pm * 256 * DM;
        float* out = isctx ? out_ctx + (size_t)(pm - 64) * 256 * DM : out_lat + (size_t)pm * 256 * DM;
        const float* gt = gate + (isctx ? 4 : (pm >> 4)) * 6144;
        const int col0 = u.pn * 256 + wc * 32 + 4 * fq;
        pg8::f32x4 gv[2][2];
#pragma unroll
        for (int bj = 0; bj < 2; ++bj)
#pragma unroll
            for (int n = 0; n < 2; ++n) gv[bj][n] = *(const pg8::f32x4*)(gt + col0 + bj * 128 + n * 16);
#pragma unroll
        for (int am = 0; am < 4; ++am) {
            const int ai = am >> 1, m0 = (am & 1) * 2;
            pg8::f32x4 bs[2][2][2];
#pragma unroll
            for (int mm = 0; mm < 2; ++mm) { const size_t ro = (size_t)(ai * 128 + wr * 64 + (m0 + mm) * 16 + fr) * DM + col0;
#pragma unroll
                for (int bj = 0; bj < 2; ++bj)
#pragma unroll
                    for (int n = 0; n < 2; ++n) bs[mm][bj][n] = *(const pg8::f32x4*)(base + ro + bj * 128 + n * 16); }
            __builtin_amdgcn_sched_barrier(0);
#pragma unroll
            for (int mm = 0; mm < 2; ++mm) { const size_t ro = (size_t)(ai * 128 + wr * 64 + (m0 + mm) * 16 + fr) * DM + col0;
#pragma unroll
                for (int bj = 0; bj < 2; ++bj)
#pragma unroll
                    for (int n = 0; n < 2; ++n) *(pg8::f32x4*)(out + ro + bj * 128 + n * 16) = bs[mm][bj][n] + gv[bj][n] * acc[ai][bj][m0 + mm][n]; }
            __builtin_amdgcn_sched_barrier(0);
        }
    }
};
struct EpiUpConv {
    static constexpr bool PERM = true, AFTER_DRAIN = true;
    bf16r* ACT; const float* cw; const float* cb; int mrows;
    __device__ __forceinline__ void fused(pg8::f32x4 (&acc)[2][2][4][2], const pg8::Unit& u, int wr, int wc, int fr, int fq, PG8_LAS unsigned char* lds, int wid, int lane) const {
        constexpr int PITCH = 544;
#pragma unroll
        for (int ai = 0; ai < 2; ++ai)
#pragma unroll
            for (int m = 0; m < 4; ++m) { const int lr = ai * 128 + wr * 64 + m * 16 + fr;
#pragma unroll
                for (int bj = 0; bj < 2; ++bj)
#pragma unroll
                    for (int n = 0; n < 2; ++n) { const pg8::f32x4 v = acc[ai][bj][m][n]; u2 w; w.x = pk2(v[0], v[1]); w.y = pk2(v[2], v[3]);
                        *(PG8_LAS u2*)(lds + lr * PITCH + (bj * 128 + wc * 32 + 8 * fq + 4 * n) * 2) = w; } }
        LDS_WAIT(); __syncthreads();
        const int tid = wid * 64 + lane, cgp = tid & 15, rr = tid >> 4;
        const int ch = u.pn * 128 + 8 * cgp;
        float wg[3][8], wvv[3][8], bg[8], bv[8];
#pragma unroll
        for (int k = 0; k < 3; ++k)
#pragma unroll
            for (int h = 0; h < 2; ++h) { const f4 t0 = *(const f4*)(cw + k * DFF2 + ch + 4 * h), t1 = *(const f4*)(cw + k * DFF2 + DFF + ch + 4 * h);
                wg[k][4 * h] = t0.x; wg[k][4 * h + 1] = t0.y; wg[k][4 * h + 2] = t0.z; wg[k][4 * h + 3] = t0.w; wvv[k][4 * h] = t1.x; wvv[k][4 * h + 1] = t1.y; wvv[k][4 * h + 2] = t1.z; wvv[k][4 * h + 3] = t1.w; }
#pragma unroll
        for (int h = 0; h < 2; ++h) { const f4 t0 = *(const f4*)(cb + ch + 4 * h), t1 = *(const f4*)(cb + DFF + ch + 4 * h);
            bg[4 * h] = t0.x; bg[4 * h + 1] = t0.y; bg[4 * h + 2] = t0.z; bg[4 * h + 3] = t0.w; bv[4 * h] = t1.x; bv[4 * h + 1] = t1.y; bv[4 * h + 2] = t1.z; bv[4 * h + 3] = t1.w; }
        const int row_first = u.pm * 254 - 1, lr0 = 1 + 8 * rr;
        PG8_LAS const unsigned char* up = lds + 16 * cgp;
        u4 pg_ = *(PG8_LAS const u4*)(up + (lr0 - 1) * PITCH), pv_ = *(PG8_LAS const u4*)(up + (lr0 - 1) * PITCH + 256);
        u4 cg_ = *(PG8_LAS const u4*)(up + lr0 * PITCH), cv_ = *(PG8_LAS const u4*)(up + lr0 * PITCH + 256);
#pragma unroll
        for (int i = 0; i < 8; ++i) { const int lr = lr0 + i;
            if (lr <= 254) {
                const u4 ng_ = *(PG8_LAS const u4*)(up + (lr + 1) * PITCH), nv_ = *(PG8_LAS const u4*)(up + (lr + 1) * PITCH + 256);
                const int r = row_first + lr;
                if (r < mrows) {
                    const int p = r < MLAT ? (r & 4095) : ((r - MLAT) & 255), T = r < MLAT ? SEQL : CTXL;
                    const bool hp = p > 0, hn = p < T - 1;
                    const u4 z4 = (u4){0u, 0u, 0u, 0u};
                    const u4 pgm = hp ? pg_ : z4, pvm = hp ? pv_ : z4, ngm = hn ? ng_ : z4, nvm = hn ? nv_ : z4;
                    unsigned ow[4];
#pragma unroll
                    for (int e2 = 0; e2 < 4; ++e2) {
                        float o2[2];
#pragma unroll
                        for (int hh = 0; hh < 2; ++hh) { const int e = 2 * e2 + hh;
                            const float gp = hh ? bf_hi(pgm[e2]) : bf_lo(pgm[e2]), gc = hh ? bf_hi(cg_[e2]) : bf_lo(cg_[e2]), gn = hh ? bf_hi(ngm[e2]) : bf_lo(ngm[e2]);
                            const float vp = hh ? bf_hi(pvm[e2]) : bf_lo(pvm[e2]), vc = hh ? bf_hi(cv_[e2]) : bf_lo(cv_[e2]), vn = hh ? bf_hi(nvm[e2]) : bf_lo(nvm[e2]);
                            const float g = bg[e] + wg[1][e] * gc + wg[0][e] * gp + wg[2][e] * gn;
                            const float v = bv[e] + wvv[1][e] * vc + wvv[0][e] * vp + wvv[2][e] * vn;
                            o2[hh] = g * sigmoidf_(g) * v; }
                        ow[e2] = pk2(o2[0], o2[1]); }
                    u4 o; o.x = ow[0]; o.y = ow[1]; o.z = ow[2]; o.w = ow[3];
                    __builtin_nontemporal_store(o, (u4*)(ACT + (size_t)r * DFF + ch));
                }
                pg_ = cg_; pv_ = cv_; cg_ = ng_; cv_ = nv_;
            } }
        LDS_WAIT(); __syncthreads();
    }
};
struct SplitOrder { int nsub, S, kslice, G, c;
    __device__ __forceinline__ bool next(int i, pg8::Unit& u) const { const int x = c + i * G; if (x >= nsub) return false; const int ks = x % S, t = x / S; u.pm = 64 + (t >> 2); u.pn = t & 3; u.koff = ks * kslice; return true; }
    __device__ __forceinline__ void a_ready(const pg8::Unit&) const {}
    __device__ __forceinline__ void done(const pg8::Unit&) const {} };
struct EpiPart {
    static constexpr bool PERM = false, AFTER_DRAIN = false;
    float* part; const float* gate; int kslice;
    __device__ __forceinline__ void operator()(const pg8::f32x4 (&acc)[2][2][4][2], const pg8::Unit& u, int wr, int wc, int fr, int fq) const {
        asm volatile("" : "+v"(fr), "+v"(fq));
        float* out = part + ((size_t)(u.koff / kslice) * MCTX + (size_t)(u.pm - 64) * 256) * DM;
        const float* gt = gate + 4 * 6144;
        const int col0 = u.pn * 256 + wc * 32 + 4 * fq;
        pg8::f32x4 gv[2][2];
#pragma unroll
        for (int bj = 0; bj < 2; ++bj)
#pragma unroll
            for (int n = 0; n < 2; ++n) gv[bj][n] = *(const pg8::f32x4*)(gt + col0 + bj * 128 + n * 16);
#pragma unroll
        for (int ai = 0; ai < 2; ++ai)
#pragma unroll
            for (int m = 0; m < 4; ++m) { const size_t ro = (size_t)(ai * 128 + wr * 64 + m * 16 + fr) * DM + col0;
#pragma unroll
                for (int bj = 0; bj < 2; ++bj)
#pragma unroll
                    for (int n = 0; n < 2; ++n) *(pg8::f32x4*)(out + ro + bj * 128 + n * 16) = gv[bj][n] * acc[ai][bj][m][n]; }
    }
};
struct OneUnit { pg8::Unit u;
    __device__ __forceinline__ bool next(int i, pg8::Unit& o) const { if (i) return false; o = u; return true; }
    __device__ __forceinline__ void a_ready(const pg8::Unit&) const {}
    __device__ __forceinline__ void done(const pg8::Unit&) const {} };

#define DPPF(old, src, ctrl) __builtin_bit_cast(float, __builtin_amdgcn_update_dpp(__builtin_bit_cast(int, (float)(old)), __builtin_bit_cast(int, (float)(src)), ctrl, 0xf, 0xf, false))
struct LruCtx { const bf16r* XLp; const bf16r* GWn; LAS const float* tab; LAS float* scr; int p0, T, n, tok, q; };
typedef _Float16 h2v __attribute__((ext_vector_type(2)));
__device__ __forceinline__ unsigned pkh2(float lo, float hi) { return __builtin_bit_cast(unsigned, __builtin_amdgcn_cvt_pkrtz(lo, hi)); }
__device__ __forceinline__ float h2lo(unsigned w) { return (float)__builtin_bit_cast(h2v, w).x; }
__device__ __forceinline__ float h2hi(unsigned w) { return (float)__builtin_bit_cast(h2v, w).y; }
__device__ __forceinline__ void lru_conv_load(const LruCtx& c, int s, u4 (&raw)[8]) {
    const int i = 16 * s + c.tok, p = c.p0 + i;
#pragma unroll
    for (int ks = 0; ks < 2; ++ks)
#pragma unroll
        for (int k = 0; k < 4; ++k) { const int pp = p + k - 2; const bool ok = pp >= 0 && pp < c.T;
            raw[4 * ks + k] = *(const u4*)(c.XLp + (ptrdiff_t)(ok ? i + k - 2 : i) * 512 + 32 * ks + 8 * c.q); }
}
__device__ __forceinline__ void lru_conv(const LruCtx& c, int s, const u4 (&raw)[8], s8v (&frag)[2], f4 (&xc)[4]) {
    const int i = 16 * s + c.tok, p = c.p0 + i;
    float xb[2][8];
#pragma unroll
    for (int ks = 0; ks < 2; ++ks) { const int c0 = 32 * ks + 8 * c.q, chn = 64 * c.n + c0;
#pragma unroll
        for (int h = 0; h < 2; ++h) { const f4 t = *(LAS const f4*)(c.tab + 2048 + chn + 4 * h); xb[ks][4 * h] = t.x; xb[ks][4 * h + 1] = t.y; xb[ks][4 * h + 2] = t.z; xb[ks][4 * h + 3] = t.w; }
#pragma unroll
        for (int k = 0; k < 4; ++k) { const int pp = p + k - 2; const bool ok = pp >= 0 && pp < c.T;
            const u4 rw = raw[4 * ks + k];
#pragma unroll
            for (int h = 0; h < 2; ++h) { f4 w = *(LAS const f4*)(c.tab + k * 512 + chn + 4 * h); if (!ok) w = (f4){0.f, 0.f, 0.f, 0.f};
                xb[ks][4 * h] += w.x * bf_lo(rw[2 * h]); xb[ks][4 * h + 1] += w.y * bf_hi(rw[2 * h]); xb[ks][4 * h + 2] += w.z * bf_lo(rw[2 * h + 1]); xb[ks][4 * h + 3] += w.w * bf_hi(rw[2 * h + 1]); } } }
#pragma unroll
    for (int ks = 0; ks < 2; ++ks) { LAS float* sp = c.scr + c.tok * 68 + 32 * ks + 8 * c.q;
        *(LAS f4*)sp = (f4){xb[ks][0], xb[ks][1], xb[ks][2], xb[ks][3]}; *(LAS f4*)(sp + 4) = (f4){xb[ks][4], xb[ks][5], xb[ks][6], xb[ks][7]};
        u4 w; w.x = pk2(xb[ks][0], xb[ks][1]); w.y = pk2(xb[ks][2], xb[ks][3]); w.z = pk2(xb[ks][4], xb[ks][5]); w.w = pk2(xb[ks][6], xb[ks][7]); frag[ks] = __builtin_bit_cast(s8v, w); }
    LDS_WAIT();
#pragma unroll
    for (int rb = 0; rb < 4; ++rb) xc[rb] = *(LAS const f4*)(c.scr + c.tok * 68 + 16 * rb + 4 * c.q);
    LDS_WAIT();
}
__device__ __forceinline__ void lru_wload(const LruCtx& c, int dir, s8v (&W)[16]) {
    const bf16r* gwa = c.GWn + (size_t)(dir * 2) * 8 * 4096, *gwx = gwa + 8 * 4096;
#pragma unroll
    for (int rb = 0; rb < 4; ++rb)
#pragma unroll
        for (int ks = 0; ks < 2; ++ks) { const int off = (16 * rb + c.tok) * 64 + 32 * ks + 8 * c.q; W[4 * rb + 2 * ks] = *(const s8v*)(gwa + off); W[4 * rb + 2 * ks + 1] = *(const s8v*)(gwx + off); }
}
__device__ __forceinline__ void lru_gates(const LruCtx& c, int dir, const s8v (&W)[16], const s8v (&frag)[2], const f4 (&xc)[4], float (&LA)[16], float (&AV)[16], float (&B)[16]) {
    f4 ga[4], gx[4];
#pragma unroll
    for (int rb = 0; rb < 4; ++rb) { ga[rb] = (f4){0.f, 0.f, 0.f, 0.f}; gx[rb] = (f4){0.f, 0.f, 0.f, 0.f};
#pragma unroll
        for (int ks = 0; ks < 2; ++ks) {
            ga[rb] = __builtin_amdgcn_mfma_f32_16x16x32_bf16(W[4 * rb + 2 * ks], frag[ks], ga[rb], 0, 0, 0);
            gx[rb] = __builtin_amdgcn_mfma_f32_16x16x32_bf16(W[4 * rb + 2 * ks + 1], frag[ks], gx[rb], 0, 0, 0); } }
#pragma unroll
    for (int rb = 0; rb < 4; ++rb) { const int chn = dir * 512 + 64 * c.n + 16 * rb + 4 * c.q;
        const f4 ba = *(LAS const f4*)(c.tab + 2560 + chn), bx = *(LAS const f4*)(c.tab + 3584 + chn), cl = *(LAS const f4*)(c.tab + 4608 + chn);
#pragma unroll
        for (int j = 0; j < 4; ++j) { const float r = sigmoidf_(ga[rb][j] + ba[j]), ii = sigmoidf_(gx[rb][j] + bx[j]);
            const float la = cl[j] * r, z = 1.3862943611198906f * la, av = __builtin_amdgcn_exp2f(la);
            const float om = (z > -0.0078125f) ? -z * (1.f + 0.5f * z) : __builtin_fmaf(-av, av, 1.f);
            LA[4 * rb + j] = la; AV[4 * rb + j] = av; B[4 * rb + j] = __builtin_amdgcn_sqrtf(om) * ii * xc[rb][j]; } }
}
__device__ __forceinline__ void scan_fwd(float (&A)[16], float (&B)[16]) {
#pragma unroll
    for (int k = 0; k < 16; ++k) { float a_ = A[k], b_ = B[k], ap, bp;
        ap = DPPF(1.f, a_, 0x111); bp = DPPF(0.f, b_, 0x111); b_ = a_ * bp + b_; a_ = a_ * ap;
        ap = DPPF(1.f, a_, 0x112); bp = DPPF(0.f, b_, 0x112); b_ = a_ * bp + b_; a_ = a_ * ap;
        ap = DPPF(1.f, a_, 0x114); bp = DPPF(0.f, b_, 0x114); b_ = a_ * bp + b_; a_ = a_ * ap;
        ap = DPPF(1.f, a_, 0x118); bp = DPPF(0.f, b_, 0x118); b_ = a_ * bp + b_; a_ = a_ * ap;
        A[k] = a_; B[k] = b_; }
}
__device__ __forceinline__ void scan_bwd(float (&A)[16], float (&B)[16]) {
#pragma unroll
    for (int k = 0; k < 16; ++k) { float a_ = A[k], b_ = B[k], ap, bp;
        ap = DPPF(1.f, a_, 0x101); bp = DPPF(0.f, b_, 0x101); b_ = a_ * bp + b_; a_ = a_ * ap;
        ap = DPPF(1.f, a_, 0x102); bp = DPPF(0.f, b_, 0x102); b_ = a_ * bp + b_; a_ = a_ * ap;
        ap = DPPF(1.f, a_, 0x104); bp = DPPF(0.f, b_, 0x104); b_ = a_ * bp + b_; a_ = a_ * ap;
        ap = DPPF(1.f, a_, 0x108); bp = DPPF(0.f, b_, 0x108); b_ = a_ * bp + b_; a_ = a_ * ap;
        A[k] = a_; B[k] = b_; }
}
#define DPPZ(src, ctrl) __builtin_bit_cast(float, __builtin_amdgcn_update_dpp(0, __builtin_bit_cast(int, (float)(src)), ctrl, 0xf, 0xf, true))
__device__ __forceinline__ float rowsum_fwd(float x) { x += DPPZ(x, 0x111); x += DPPZ(x, 0x112); x += DPPZ(x, 0x114); x += DPPZ(x, 0x118); return x; }
__device__ __forceinline__ float rowsum_bwd(float x) { x += DPPZ(x, 0x101); x += DPPZ(x, 0x102); x += DPPZ(x, 0x104); x += DPPZ(x, 0x108); return x; }
__device__ __forceinline__ void lru_tables(KA a, int l, LAS float* tab, int tid) {
    for (int e = tid; e < 5632; e += 512) { float v;
        if (e < 2048) v = a->in[9][l * 2048 + e];
        else if (e < 2560) v = a->in[10][l * 512 + (e - 2048)];
        else if (e < 3584) v = a->in[12][l * 1024 + (e - 2560)];
        else if (e < 4608) v = a->in[14][l * 1024 + (e - 3584)];
        else { const float lam = a->in[15][l * 1024 + (e - 4608)]; const float x = fexp(-lam); const float sp = x < 0.03f ? x * (1.f - x * (0.5f - x * (0.33333334f - x * 0.25f))) : (lam < -20.f ? -lam : __builtin_amdgcn_logf(1.f + x) * 0.6931471805599453f); v = -8.f * sp * 1.4426950408889634f; }
        tab[e] = v; }
}
__device__ __forceinline__ void lru_l1_tile(KA a, int l, int b, int cid, int dir, LAS unsigned char* lds, int tid, int wid, int lane) {
    asm volatile("" : "+v"(lane), "+v"(tid));
    unsigned char* ws = a->ws;
    LAS float* tab = (LAS float*)(lds + L1_TAB_OFF); LAS float* scr = (LAS float*)(lds + L1_TAB_OFF + 22528) + wid * (16 * 68);
    LruCtx c; c.n = wid; c.tok = lane & 15; c.q = lane >> 4; c.tab = tab; c.scr = scr;
    const bool isctx = cid < 4; c.p0 = (isctx ? cid : cid - 4) * 64; c.T = isctx ? CTXL : SEQL;
    const int rowbase = isctx ? MLAT + b * CTXL + c.p0 : b * SEQL + c.p0;
    c.XLp = (const bf16r*)(ws + WS_XL) + (size_t)rowbase * 512 + c.n * 64;
    c.GWn = (const bf16r*)(ws + WS_GW) + (size_t)(l * 4) * 8 * 4096 + c.n * 4096;
    float* AGGA = (float*)(ws + WS_AGGA); float* AGGB = (float*)(ws + WS_AGGB);
    unsigned* LAB = (unsigned*)(ws + WS_LAB) + (size_t)(rowbase >> 4) * 8192 + 1024 * c.n + 16 * c.tok + 4 * c.q;
    const int bl = (lane & 48) | 15, bf_ = (lane & 48);
    {
        LAS float* rab = (LAS float*)(lds + L1_TAB_OFF + 22528 + 34816) + wid * 128 + c.q * 32;
#pragma unroll
        for (int k = 0; k < 16; ++k) { rab[2 * k] = 1.f; rab[2 * k + 1] = 0.f; }
        s8v W[16];
        lru_wload(c, dir, W);
        u4 rawc[8];
        lru_conv_load(c, 0, rawc);
#pragma unroll 1
        for (int s = 0; s < 4; ++s) {
            s8v frag[2]; f4 xc[4];
            lru_conv(c, s, rawc, frag, xc);
            __builtin_amdgcn_sched_barrier(0);
            lru_conv_load(c, s < 3 ? s + 1 : 3, rawc);
            __builtin_amdgcn_sched_barrier(0);
            float LAv[16], A[16], B[16];
            lru_gates(c, dir, W, frag, xc, LAv, A, B);
            unsigned* lp = LAB + (size_t)dir * MALL * 512 + (size_t)s * 8192;
#pragma unroll
            for (int rb = 0; rb < 4; ++rb) { u4 w; w.x = pkh2(LAv[4 * rb], B[4 * rb]); w.y = pkh2(LAv[4 * rb + 1], B[4 * rb + 1]); w.z = pkh2(LAv[4 * rb + 2], B[4 * rb + 2]); w.w = pkh2(LAv[4 * rb + 3], B[4 * rb + 3]); __builtin_nontemporal_store(w, (u4*)(lp + 256 * rb)); }
            if (dir == 0) scan_fwd(A, B); else scan_bwd(A, B);
#pragma unroll
            for (int k = 0; k < 16; ++k) {
                const float a_ = __shfl(A[k], dir ? bf_ : bl), b_ = __shfl(B[k], dir ? bf_ : bl);
                const float ra = rab[2 * k], rb_ = rab[2 * k + 1];
                if (dir == 0) { rab[2 * k + 1] = a_ * rb_ + b_; rab[2 * k] = a_ * ra; }
                else { rab[2 * k + 1] = ra * b_ + rb_; rab[2 * k] = ra * a_; } }
            LDS_WAIT();
        }
        if (c.tok == 0) { const size_t o = ((size_t)(b * 2 + dir) * NCH + cid) * 512 + 64 * c.n + 4 * c.q;
#pragma unroll
            for (int rb = 0; rb < 4; ++rb) { *(f4*)(AGGA + o + 16 * rb) = (f4){rab[8 * rb], rab[8 * rb + 2], rab[8 * rb + 4], rab[8 * rb + 6]}; *(f4*)(AGGB + o + 16 * rb) = (f4){rab[8 * rb + 1], rab[8 * rb + 3], rab[8 * rb + 5], rab[8 * rb + 7]}; } }
    }
    LDS_WAIT(); __syncthreads();
}
__device__ __forceinline__ void lru_l2_tile(KA a, int l, int b, int cid, LAS unsigned char* lds, int tid, int wid, int lane) {
    asm volatile("" : "+v"(lane));
    unsigned char* ws = a->ws;
    LAS float* part = (LAS float*)lds;
    LAS float* hfl = (LAS float*)(lds + 4096) + wid * 4096 + lane;
    const int n = wid, tok = lane & 15, q = lane >> 4;
    const bool isctx = cid < 4; const int p0 = (isctx ? cid : cid - 4) * 64;
    const int rowbase = isctx ? MLAT + b * CTXL + p0 : b * SEQL + p0;
    const float* AGGA = (const float*)(ws + WS_AGGA); const float* AGGB = (const float*)(ws + WS_AGGB);
    const unsigned* LAB = (const unsigned*)(ws + WS_LAB) + (size_t)(rowbase >> 4) * 8192 + 1024 * n + 16 * tok + 4 * q;
    const bf16r* GGp = (const bf16r*)(ws + WS_GG) + (size_t)(rowbase >> 4) * 8192 + 1024 * n + 16 * tok + 4 * q;
    const int bl = (lane & 48) | 15, bf_ = (lane & 48);
    float hin[16], hinb[16], A[16], B[16];
#pragma unroll 1
    for (int dir = 0; dir < 2; ++dir) {
        const float* ap_ = AGGA + ((size_t)(b * 2 + dir) * NCH) * 512 + 64 * n + 4 * q; const float* bp_ = AGGB + ((size_t)(b * 2 + dir) * NCH) * 512 + 64 * n + 4 * q;
#pragma unroll
        for (int k = 0; k < 16; ++k) { A[k] = 1.f; B[k] = 0.f; }
#pragma unroll
        for (int eb = 0; eb < 5; eb += 3) {
            f4 avv[3][4], bvv[3][4]; bool okv[3];
#pragma unroll
            for (int e2 = 0; e2 < 3; ++e2) { if (eb + e2 < 5) { const int o = 5 * tok + eb + e2; int ch; bool ok;
                if (dir == 0) { ch = o; ok = o < cid; } else { ch = o < 4 ? 3 - o : 71 - o; ok = isctx ? (o < 4 && ch > cid) : (o < 4 || (o < 68 && ch > cid)); }
                ch = ch < 0 ? 0 : (ch > NCH - 1 ? NCH - 1 : ch); okv[e2] = ok;
#pragma unroll
                for (int rb = 0; rb < 4; ++rb) { avv[e2][rb] = *(const f4*)(ap_ + (size_t)ch * 512 + 16 * rb); bvv[e2][rb] = *(const f4*)(bp_ + (size_t)ch * 512 + 16 * rb); } } }
            __builtin_amdgcn_sched_barrier(0);
#pragma unroll
            for (int e2 = 0; e2 < 3; ++e2) { if (eb + e2 < 5) {
#pragma unroll
                for (int rb = 0; rb < 4; ++rb) { f4 av = avv[e2][rb], bv = bvv[e2][rb];
                    if (!okv[e2]) { av = (f4){1.f, 1.f, 1.f, 1.f}; bv = (f4){0.f, 0.f, 0.f, 0.f}; }
#pragma unroll
                    for (int jj = 0; jj < 4; ++jj) { B[4 * rb + jj] = av[jj] * B[4 * rb + jj] + bv[jj]; A[4 * rb + jj] = av[jj] * A[4 * rb + jj]; } } } }
            __builtin_amdgcn_sched_barrier(0);
        }
        scan_fwd(A, B);
        if (dir == 0) {
#pragma unroll
            for (int k = 0; k < 16; ++k) hin[k] = __shfl(B[k], bl);
        } else {
#pragma unroll
            for (int k = 0; k < 16; ++k) hinb[k] = __shfl(B[k], bl);
        }
    }
    u4 wc_[4], wn_[4]; u2 gc_[4], gn_[4];
#pragma unroll
    for (int rb = 0; rb < 4; ++rb) { wc_[rb] = *(const u4*)(LAB + 256 * rb); gc_[rb] = (u2){0u, 0u}; gn_[rb] = (u2){0u, 0u}; }
#pragma unroll 1
    for (int st = 0; st < 8; ++st) {
        const int s = st < 4 ? st : 7 - st;
        { const int sn = st + 1 < 8 ? st + 1 : 7; const int s2 = sn < 4 ? sn : 7 - sn; const bool bw = sn >= 4;
          const unsigned* lp_ = LAB + (size_t)(bw ? MALL : 0) * 512 + (size_t)s2 * 8192; const bf16r* gp_ = GGp + (size_t)s2 * 8192;
#pragma unroll
          for (int rb = 0; rb < 4; ++rb) { wn_[rb] = *(const u4*)(lp_ + 256 * rb); gn_[rb] = *(const u2*)(gp_ + 256 * rb); } }
        __builtin_amdgcn_sched_barrier(0);
#pragma unroll
        for (int rb = 0; rb < 4; ++rb)
#pragma unroll
            for (int j = 0; j < 4; ++j) { A[4 * rb + j] = h2lo(wc_[rb][j]); B[4 * rb + j] = h2hi(wc_[rb][j]); }
        LAS float* hs = hfl + s * 1024;
        if (st < 4) {
#pragma unroll
            for (int k = 0; k < 16; ++k) { const float L = rowsum_fwd(A[k]); const float P = __builtin_amdgcn_exp2f(L); const float C = rowsum_fwd(B[k] * __builtin_amdgcn_exp2f(-L)); A[k] = P; B[k] = P * C; }
#pragma unroll
            for (int k = 0; k < 16; ++k) { const float h = A[k] * hin[k] + B[k]; hs[k * 64] = h; hin[k] = __shfl(h, bl); }
        } else {
            if (st == 4) {
#pragma unroll
                for (int k = 0; k < 16; ++k) hin[k] = hinb[k]; }
#pragma unroll
            for (int k = 0; k < 16; ++k) { const float L = rowsum_bwd(A[k]); const float P = __builtin_amdgcn_exp2f(L); const float C = rowsum_bwd(B[k] * __builtin_amdgcn_exp2f(-L)); A[k] = P; B[k] = P * C; }
            float sq = 0.f;
#pragma unroll
            for (int rb = 0; rb < 4; ++rb)
#pragma unroll
                for (int j = 0; j < 4; ++j) { const int k = 4 * rb + j; const float h = A[k] * hin[k] + B[k]; hin[k] = __shfl(h, bf_);
                    const float gg = (j & 1) ? bf_hi(gc_[rb][j >> 1]) : bf_lo(gc_[rb][j >> 1]);
                    const float r = (hs[k * 64] + h) * gg; hs[k * 64] = r; sq += r * r; }
            sq += __shfl_xor(sq, 16); sq += __shfl_xor(sq, 32); if (q == 0) part[wid * 64 + 16 * s + tok] = sq;
        }
#pragma unroll
        for (int rb = 0; rb < 4; ++rb) { wc_[rb] = wn_[rb]; gc_[rb] = gn_[rb]; }
    }
    LDS_WAIT(); __syncthreads();
    bf16r* MIX = (bf16r*)(ws + WS_MIX);
#pragma unroll 1
    for (int s = 0; s < 4; ++s) { float t = 0.f;
#pragma unroll
        for (int w = 0; w < 8; ++w) t += part[w * 64 + 16 * s + tok];
        const float rstd = rsqrtf(t * (1.f / 512.f) + EPSN);
        bf16r* mp = MIX + (size_t)(rowbase + 16 * s + tok) * DM + 512 + 64 * n + 4 * q;
        const LAS float* hs = hfl + s * 1024;
#pragma unroll
        for (int rb = 0; rb < 4; ++rb) { u2 w; w.x = pk2(hs[(4 * rb) * 64] * rstd, hs[(4 * rb + 1) * 64] * rstd); w.y = pk2(hs[(4 * rb + 2) * 64] * rstd, hs[(4 * rb + 3) * 64] * rstd); *(u2*)(mp + 16 * rb) = w; } }
    const bf16r* O = (const bf16r*)(ws + WS_O) + (size_t)(rowbase + wid * 8) * 512 + 8 * lane;
    u4 rawc = *(const u4*)O;
#pragma unroll 1
    for (int tt = 0; tt < 8; ++tt) {
        const u4 rawn = *(const u4*)(O + (size_t)(tt < 7 ? tt + 1 : 7) * 512);
        float v[8]; float ss = 0.f;
#pragma unroll
        for (int e = 0; e < 4; ++e) { v[2 * e] = bf_lo(rawc[e]); v[2 * e + 1] = bf_hi(rawc[e]); ss += v[2 * e] * v[2 * e] + v[2 * e + 1] * v[2 * e + 1]; }
        const float rstd = rsqrtf(wave_sum(ss) * (1.f / 512.f) + EPSN);
        u4 o; o.x = pk2(v[0] * rstd, v[1] * rstd); o.y = pk2(v[2] * rstd, v[3] * rstd); o.z = pk2(v[4] * rstd, v[5] * rstd); o.w = pk2(v[6] * rstd, v[7] * rstd);
        *(u4*)(MIX + (size_t)(rowbase + wid * 8 + tt) * DM + 8 * lane) = o;
        rawc = rawn; }
    LDS_WAIT(); __syncthreads();
}

#define GAS __attribute__((address_space(1)))
#define XB_TMO      128
#define XB_XCNT(j)  (256  + 64 * (j))
#define XB_XSUB(j)  (1280 + 64 * (j))
#define XB_XGEN(j)  (2304 + 64 * (j))
#define XB_TOP      3328
#define XB_TOPGEN   3392
#define XCD_BAR_WORDS 3456
#define XB_SPIN_CAP (1u << 18)

__device__ __forceinline__ unsigned xb_ld(unsigned* p)              { return __hip_atomic_load(p, __ATOMIC_RELAXED, __HIP_MEMORY_SCOPE_AGENT); }
__device__ __forceinline__ unsigned xb_add(unsigned* p, unsigned v) { return __hip_atomic_fetch_add(p, v, __ATOMIC_RELAXED, __HIP_MEMORY_SCOPE_AGENT); }
__device__ __forceinline__ unsigned xb_xcc_id() { return (unsigned)__builtin_amdgcn_s_getreg((3 << 11) | 20) & 0xFu; }
#define XB_SPIN(cond, bar) do { unsigned _sp = 0; while (cond) { __builtin_amdgcn_s_sleep(1); \
    if ((++_sp & 255u) == 0u) { if (xb_ld(&(bar)[XB_TMO])) break; if (_sp > XB_SPIN_CAP) { atomicAdd(&(bar)[XB_TMO], 1u); break; } } } } while (0)

struct XcdBarrier {
    unsigned* bar; unsigned x;
    volatile LAS unsigned* st;
};

__device__ __forceinline__ XcdBarrier xcd_barrier_post(unsigned* bar, volatile LAS unsigned* st) {
    XcdBarrier b; b.bar = bar; b.x = xb_xcc_id(); b.st = st;
    if (threadIdx.x == 0) (void)xb_add(&bar[XB_XCNT(b.x)], 1u);
    return b;
}
__device__ __forceinline__ void xcd_barrier_complete(unsigned* bar, unsigned x, unsigned& nloc, unsigned& nx) {
    const unsigned G = gridDim.x * gridDim.y * gridDim.z;
    unsigned sum, cnt, mine, sp = 0u;
    for (;;) {
        sum = 0u; cnt = 0u; mine = 0u;
#pragma unroll
        for (unsigned j = 0; j < 16; ++j) { const unsigned c = xb_ld(&bar[XB_XCNT(j)]); sum += c; cnt += (c > 0u) ? 1u : 0u; mine = (j == x) ? c : mine; }
        if (sum == G) break;
        __builtin_amdgcn_s_sleep(1);
        if ((++sp & 255u) == 0u) { if (xb_ld(&bar[XB_TMO])) break; if (sp > XB_SPIN_CAP) { atomicAdd(&bar[XB_TMO], 1u); break; } }
    }
    nloc = mine > 0u ? mine : 1u; nx = cnt > 0u ? cnt : 1u;
}

__device__ __forceinline__ void xcd_barrier(const XcdBarrier& b) {
    asm volatile("s_waitcnt vmcnt(0)" ::: "memory");
    __syncthreads();
    if (threadIdx.x == 0) {
        unsigned* bar = b.bar;
        __builtin_amdgcn_s_waitcnt(0);
        unsigned nloc = b.st[0], nx = b.st[1];
        if (nloc == 0u) { xcd_barrier_complete(bar, b.x, nloc, nx); b.st[0] = nloc; b.st[1] = nx; }
        const unsigned old = xb_add(&bar[XB_XSUB(b.x)], 1u);
        const unsigned gen = old / nloc;
        if (old + 1u == (gen + 1u) * nloc) {
            __builtin_amdgcn_fence(__ATOMIC_RELEASE, "agent");
            asm volatile("s_waitcnt vmcnt(0)" ::: "memory");
            const unsigned og = xb_add(&bar[XB_TOP], 1u);
            const unsigned tg = og / nx;
            if (og + 1u == (tg + 1u) * nx) xb_add(&bar[XB_TOPGEN], 1u);
            else XB_SPIN(xb_ld(&bar[XB_TOPGEN]) == tg, bar);
            __builtin_amdgcn_fence(__ATOMIC_ACQUIRE, "agent");
            xb_add(&bar[XB_XGEN(b.x)], 1u);
            asm volatile("s_waitcnt vmcnt(0)" ::: "memory");
        } else {
            XB_SPIN(xb_ld(&bar[XB_XGEN(b.x)]) == gen, bar);
            __builtin_amdgcn_fence(__ATOMIC_ACQUIRE, "agent");
            asm volatile("s_waitcnt vmcnt(0)" ::: "memory");
        }
    }
    __syncthreads();
}

#ifndef REP_PH
#define REP_PH -1
#endif
#ifndef REP_SKIP_L1
#define REP_SKIP_L1 0
#endif
#ifndef USE_XBAR
#define USE_XBAR 1
#endif
__global__ void __launch_bounds__(512, 2) mega(Args a_) {
    extern __shared__ __attribute__((aligned(16))) unsigned char lds_raw[];
    LAS unsigned char* lds = (LAS unsigned char*)lds_raw;
    const int G = gridDim.x, bx = blockIdx.x;
    const int vcu = (G % 8 == 0) ? (bx % 8) * (G / 8) + bx / 8 : bx;
    KA a = (KA)__builtin_amdgcn_kernarg_segment_ptr();
    volatile LAS unsigned* bst = (volatile LAS unsigned*)(lds + LDS_BYTES - 64);
    if (threadIdx.x < 2) bst[threadIdx.x] = 0u;
    __syncthreads();
    (void)xcd_barrier_post((unsigned*)a->ws, bst);
    int nsync = 0;
#define GRID_SYNC() do { if (!USE_XBAR || a->ph_lo < 0) cg::this_grid().sync();     else { XcdBarrier xb_; xb_.bar = (unsigned*)a->ws; xb_.x = xb_xcc_id(); xb_.st = (volatile LAS unsigned*)(lds + LDS_BYTES - 64); xcd_barrier(xb_); } ++nsync; } while (0)
    const int ph_hi = a->ph_hi;
    for (int ph = a->ph_lo; ph < ph_hi; ++ph) {
        asm volatile("" : "+s"(a));
        for (int rep = 0; rep < (ph == REP_PH ? 2 : 1); ++rep) {
        if (rep) GRID_SYNC();
#define TL const int tid = mk_tid(), lane = tid & 63, wid = __builtin_amdgcn_readfirstlane(tid >> 6); (void)tid; (void)lane; (void)wid
        unsigned char* ws = a->ws;
        float* MOD = (float*)(ws + WS_MOD); float* ctxres = (float*)(ws + WS_CTXRES);
        bf16r* HN = (bf16r*)(ws + WS_HN);
        if (ph == 0) { if (PON(8)) { TL; p0_phase(a, lds, tid, wid, lane, G); } }
        else if (ph == NPHASE - 1) { if (PON(9)) { TL; finalnorm_phase(a, wid, lane, G); } }
        else {
            const int l = (ph - 1) >> 3, sub = (ph - 1) & 7;
            unsigned char* wl = ws + WS_W + (size_t)l * W_LAYER;
            const bool ctx_out = l == 0;
            if (sub == 0) { if (PON(0)) { TL; prenorm_phase(a, l, 0, MALL, l == 0 ? 0 : 11, l == 0 ? a->in[2] : ctxres, wid, lane, G); } }
            else if (sub == 1) { if (PON(1)) {
                pg8::Gemm g{HN, (const bf16r*)(wl + W_IN), MALL, DIN, DM, 256, DM}; pg8::StaticOrder S; S.init(MALL, DIN, G, bx);
                EpiWin E{ws, a->in[7] + l * 64, a->in[8] + l * 64};
                pg8::gemm_phase<EpiWin, pg8::StaticOrder, true, true>(lds, g, S, E); }
            } else if (sub == 2) { if (PON(2)) { TL;
                const int nctx = ctx_out ? 4 : 0, cnt = 64 + nctx + ((rep && REP_SKIP_L1) ? 0 : 68);
                attn_body::bf16* Qb = (attn_body::bf16*)(ws + WS_Q); attn_body::bf16* Ob = (attn_body::bf16*)(ws + WS_O); const attn_body::bf16* Kb = (const attn_body::bf16*)(ws + WS_K); const attn_body::bf16* Vb = (const attn_body::bf16*)(ws + WS_V);
                LAS unsigned char* l3 = lds; asm volatile("" : "+s"(l3)); char* shm = (char*)l3;
                volatile LAS int* qw = (volatile LAS int*)(lds + LDS_BYTES - 32);
                unsigned* qctr = (unsigned*)ws + 3584 + (l * 2 + rep) * 8 * 64;
                const int hx = (int)(xb_xcc_id() & 7u);
                lru_tables(a, l, (LAS float*)(lds + L1_TAB_OFF), tid); __syncthreads();
                for (int li = 0; li < 8; ++li) { const int x = (hx + li) & 7; const int b = x >> 1, kvh = x & 1;
                    for (;;) {
                        __syncthreads();
                        if (tid == 0) *qw = (int)__hip_atomic_fetch_add(qctr + x * 64, 1u, __ATOMIC_RELAXED, __HIP_MEMORY_SCOPE_AGENT);
                        __syncthreads();
                        const int i = __builtin_amdgcn_readfirstlane(*qw);
                        if (i >= cnt) break;
                        if (i < 64 + nctx) {
                            const bool lat = i < 64; const int h = kvh * 4 + (lat ? (i >> 4) : (i - 64));
                            const size_t qo = (size_t)(lat ? b * SEQL + (i & 15) * 256 : MLAT + b * CTXL) * 512 + h * 64;
                            attn_body::attn_unit<8>(Qb + qo, Kb + (size_t)b * KVR * 128 + kvh * 64, Vb + (size_t)b * KVR * 128 + kvh * 64, Ob + qo, lat ? NCH : 4, shm);
                        } else { const int it = i - 64 - nctx, t = x * 34 + (it >> 1); lru_l1_tile(a, l, t / NCH, t % NCH, it & 1, lds, tid, wid, lane); }
                    }
                } }
            } else if (sub == 3) { if (PON(3)) { TL;
                const int nt = ctx_out ? 4 * NCH : 4 * 64;
                for (int t = vcu; t < nt; t += G) { int b, cid; if (ctx_out) { b = t / NCH; cid = t % NCH; } else { b = t >> 6; cid = 4 + (t & 63); }
                    lru_l2_tile(a, l, b, cid, lds, tid, wid, lane); } }
            } else if (sub == 4) { if (PON(4)) {
                { pg8::Gemm g{(const bf16r*)(ws + WS_MIX), (const bf16r*)(wl + W_OUT), MLAT, DM, DM, 256, DM}; pg8::StaticOrder S; S.init(MLAT, DM, G, bx);
                  EpiRes E{l == 0 ? a->in[0] : a->out, l == 0 ? a->in[2] : ctxres, a->out, ctxres, MOD + l * 5 * 6144 + 2 * 1024};
                  pg8::gemm_phase<EpiRes, pg8::StaticOrder, true, true>(lds, g, S, E); }
                if (ctx_out) {
                    pg8::Gemm g{(const bf16r*)(ws + WS_MIX), (const bf16r*)(wl + W_OUT), MALL, DM, 256, 256, DM}; SplitOrder S{64, 4, 256, G, bx};
                    EpiPart E{(float*)(ws + WS_PART), MOD + l * 5 * 6144 + 2 * 1024, 256};
                    pg8::gemm_phase<EpiPart, SplitOrder, true, true>(lds, g, S, E); } }
            } else if (sub == 5) { if (PON(5)) { TL; prenorm_phase(a, l, 1, ctx_out ? MALL : MLAT, ctx_out ? 4 : 0, ctx_out ? a->in[2] : ctxres, wid, lane, G); } }
            else if (sub == 6) { if (PON(6)) {
                const int mrows = ctx_out ? MALL : MLAT, nM = (mrows + 253) / 254;
                pg8::Gemm g{HN - DM, (const bf16r*)(wl + W_UP), nM * 256, DFF2, DM, 254, DM}; pg8::StaticOrder S; S.init(nM * 256, DFF2, G, bx);
                EpiUpConv E{(bf16r*)(ws + WS_ACT), a->in[20] + (size_t)l * 3 * DFF2, a->in[21] + (size_t)l * DFF2, mrows};
                for (int i = 0;; ++i) { pg8::Unit u; if (!S.next(i, u)) break; OneUnit S1{u}; pg8::gemm_phase<EpiUpConv, OneUnit, false, true>(lds, g, S1, E); } }
            } else { if (PON(7)) {
                { pg8::Gemm g{(const bf16r*)(ws + WS_ACT), (const bf16r*)(wl + W_DOWN), MLAT, DM, DFF, 256, DFF}; pg8::StaticOrder S; S.init(MLAT, DM, G, bx);
                  EpiRes E{a->out, ctxres, a->out, ctxres, MOD + l * 5 * 6144 + 5 * 1024};
                  pg8::gemm_phase<EpiRes, pg8::StaticOrder, true, true>(lds, g, S, E); }
                if (ctx_out) {
                    pg8::Gemm g{(const bf16r*)(ws + WS_ACT), (const bf16r*)(wl + W_DOWN), MALL, DM, 256, 256, DFF}; SplitOrder S{176, 11, 256, G, bx};
                    EpiPart E{(float*)(ws + WS_PART), MOD + l * 5 * 6144 + 5 * 1024, 256};
                    pg8::gemm_phase<EpiPart, SplitOrder, true, true>(lds, g, S, E); } }
            }
        }
        }
        if (ph + 1 < ph_hi) GRID_SYNC();
    }
}

extern "C" void kernel_launch(void* const* d_in, const int* in_sizes, int n_in, void* d_out, int out_size, void* d_ws, size_t ws_size, hipStream_t stream) {
    static int grid = 0;
    if (grid == 0) {
        int dev = 0, cus = 0, per_cu = 0;
        if (n_in != 24 || ws_size < 255 * MiB) { fprintf(stderr, "kernel_launch: unexpected n_in %d / ws %zu\n", n_in, ws_size); grid = -1; return; }
        hipGetDevice(&dev); hipDeviceGetAttribute(&cus, hipDeviceAttributeMultiprocessorCount, dev);
        if (hipFuncSetAttribute((const void*)mega, hipFuncAttributeMaxDynamicSharedMemorySize, LDS_BYTES) != hipSuccess) { fprintf(stderr, "kernel_launch: hipFuncSetAttribute failed\n"); grid = -1; return; }
        if (hipOccupancyMaxActiveBlocksPerMultiprocessor(&per_cu, (const void*)mega, 512, LDS_BYTES) != hipSuccess || per_cu < 1) { fprintf(stderr, "kernel_launch: occupancy query says %d\n", per_cu); per_cu = 1; }
        (void)hipGetLastError();
        grid = cus;
    }
    if (grid < 0) return;
    if (hipMemsetAsync(d_ws, 0, 32768, stream) != hipSuccess) { fprintf(stderr, "kernel_launch: memset failed\n"); return; }
    Args a{};
    for (int i = 0; i < 24; ++i) a.in[i] = (const float*)d_in[i];
    a.out = (float*)d_out; a.ws = (unsigned char*)d_ws;
#if MK_MULTI
    for (int ph = 0; ph < NPHASE; ++ph) { a.ph_lo = ph; a.ph_hi = ph + 1; hipLaunchKernelGGL(mega, dim3(grid), dim3(512), LDS_BYTES, stream, a); }
#else
    a.ph_lo = 0; a.ph_hi = NPHASE;
    void* args[] = {&a};
    hipError_t e = hipLaunchCooperativeKernel((const void*)mega, dim3(grid), dim3(512), args, LDS_BYTES, stream);
    if (e != hipSuccess) fprintf(stderr, "cooperative launch failed: %s (grid %d)\n", hipGetErrorString(e), grid);
#endif
}
```
